# Optimizing an MI355X kernel written in HIP

```python
import jax
import jax.numpy as jnp
from jax import lax
import numpy as np

D_MODEL = 1024
BATCH = 16
SEQ = 2048
DEPTH = 4

GRID_W = 64
CTX_LEN = 256
QBLK = 128
ROPE_THETA = 10000.0
EPS = 1e-6
NEG = -1e30
DH = 64
N_BRANCH = 4
BR_WIDTH = 8 * DH
H_A = 8
Q_LORA = 256
KV_LORA = 128
NOPE_A = 64
ROPE_A = 32
V_A = 64
H_B = 8
KV_B = 2
WINDOW = 128
H_C = 8
KH_MAX = 8
KW = 16
H_D = 8
KV_D = 2
D_FF = 256 * (-(-8 * D_MODEL // (3 * 256)))
MOD_CHUNKS = 6

IN_SPLITS = (
    ('a_cq', Q_LORA), ('a_ckv', KV_LORA), ('a_kr', ROPE_A),
    ('b_q', H_B * DH), ('b_k', KV_B * DH), ('b_v', KV_B * DH),
    ('c_q', H_C * DH), ('c_k', H_C * DH), ('c_v', H_C * DH),
    ('d_q', H_D * DH), ('d_k', KV_D * DH), ('d_v', KV_D * DH),
    ('gate', N_BRANCH * D_MODEL),
)
IN_COLS = sum(w for _, w in IN_SPLITS)

kernel_name = 'hybrid_gated_mixer_dit'


def rmsnorm(x, g):
    xf = x.astype(jnp.float32)
    y = xf * lax.rsqrt(jnp.mean(xf * xf, axis=-1, keepdims=True) + EPS)
    return (y * g.astype(jnp.float32)).astype(x.dtype)


def split_cols(p):
    out = {}
    off = 0
    for name, w in IN_SPLITS:
        out[name] = p[..., off:off + w]
        off += w
    return out


def heads(t, h):
    return t.reshape(t.shape[0], t.shape[1], h, t.shape[-1] // h)


def rope_1d(x, pos):
    d = x.shape[-1]
    inv = ROPE_THETA ** (-jnp.arange(d // 2, dtype=jnp.float32) * 2.0 / d)
    ang = pos.astype(jnp.float32)[:, None] * inv[None, :]
    cos = jnp.cos(ang)[:, None, :]
    sin = jnp.sin(ang)[:, None, :]
    xf = x.astype(jnp.float32)
    x1, x2 = xf[..., :d // 2], xf[..., d // 2:]
    return jnp.concatenate([x1 * cos - x2 * sin, x2 * cos + x1 * sin], axis=-1).astype(x.dtype)


def axial_rope(x, rows_pos, cols_pos):
    h = x.shape[-1] // 2
    return jnp.concatenate([rope_1d(x[..., :h], rows_pos), rope_1d(x[..., h:], cols_pos)], axis=-1)


def attend_dense(q, k, v, scale, sink=None):
    B, Tq, Hkv, G, dk = q.shape
    nb = Tq // QBLK
    qb = jnp.moveaxis(q.reshape(B, nb, QBLK, Hkv, G, dk), 1, 0)

    def block(qi):
        s = jnp.einsum('bqhgd,bkhd->bhgqk', qi, k, preferred_element_type=jnp.float32) * scale
        if sink is not None:
            sk = jnp.broadcast_to(sink.astype(jnp.float32)[None, :, :, None, None], s.shape[:-1] + (1,))
            p = jax.nn.softmax(jnp.concatenate([s, sk], axis=-1), axis=-1)[..., :-1]
        else:
            p = jax.nn.softmax(s, axis=-1)
        return jnp.einsum('bhgqk,bkhd->bqhgd', p.astype(v.dtype), v)

    o = lax.map(block, qb)
    return jnp.moveaxis(o, 0, 1).reshape(B, Tq, Hkv * G * v.shape[-1])


def attend_window(q, k, v, ck, cv, sink, scale):
    B, T, Hkv, G, d = q.shape
    L = ck.shape[1]
    nb = T // QBLK
    pad = ((0, 0), (QBLK, QBLK), (0, 0), (0, 0))

    def band(t):
        tp = jnp.pad(t, pad).reshape(B, nb + 2, QBLK, Hkv, t.shape[-1])
        tb = jnp.concatenate([tp[:, :-2], tp[:, 1:-1], tp[:, 2:]], axis=2)
        return jnp.moveaxis(tb, 1, 0)

    kb, vb = band(k), band(v)
    qb = jnp.moveaxis(q.reshape(B, nb, QBLK, Hkv, G, d), 1, 0)
    qi = jnp.arange(QBLK)[:, None] + QBLK
    kj = jnp.arange(3 * QBLK)[None, :]
    near = jnp.abs(qi - kj) <= WINDOW
    nloc = 3 * QBLK

    def block(args):
        n, qn, kn, vn = args
        kabs = n * QBLK - QBLK + kj
        valid = near & (kabs >= 0) & (kabs < T)
        s_loc = jnp.einsum('bqhgd,bkhd->bhgqk', qn, kn, preferred_element_type=jnp.float32) * scale
        s_loc = jnp.where(valid, s_loc, NEG)
        s_ctx = jnp.einsum('bqhgd,bkhd->bhgqk', qn, ck, preferred_element_type=jnp.float32) * scale
        s_snk = jnp.broadcast_to(sink.astype(jnp.float32)[None, :, :, None, None], s_loc.shape[:-1] + (1,))
        p = jax.nn.softmax(jnp.concatenate([s_loc, s_ctx, s_snk], axis=-1), axis=-1)
        p_loc = p[..., :nloc].astype(v.dtype)
        p_ctx = p[..., nloc:nloc + L].astype(v.dtype)
        return jnp.einsum('bhgqk,bkhd->bqhgd', p_loc, vn) + jnp.einsum('bhgqk,bkhd->bqhgd', p_ctx, cv)

    o = lax.map(block, (jnp.arange(nb), qb, kb, vb))
    return jnp.moveaxis(o, 0, 1).reshape(B, T, Hkv * G * d)


def attend_neighbourhood(q, k, v, ck, cv, rpb, scale):
    B, T, H, d = q.shape
    rows = T // GRID_W
    kh = min(KH_MAX, rows)
    nk = kh * GRID_W
    kg = k.reshape(B, rows, GRID_W, H, d)
    vg = v.reshape(B, rows, GRID_W, H, d)
    qg = jnp.moveaxis(q.reshape(B, rows, GRID_W, H, d), 1, 0)
    qc = jnp.arange(GRID_W)
    c0 = jnp.clip(qc - KW // 2, 0, GRID_W - KW)
    kc = jnp.arange(nk) % GRID_W
    kr_off = jnp.arange(nk) // GRID_W
    col_ok = (kc[None, :] >= c0[:, None]) & (kc[None, :] < c0[:, None] + KW)
    dc_idx = jnp.clip(kc[None, :] - qc[:, None], -(KW - 1), KW - 1) + (KW - 1)
    L = ck.shape[1]

    def row(args):
        r, qr = args
        r0 = jnp.clip(r - kh // 2, 0, rows - kh)
        kr = lax.dynamic_slice_in_dim(kg, r0, kh, axis=1).reshape(B, nk, H, d)
        vr = lax.dynamic_slice_in_dim(vg, r0, kh, axis=1).reshape(B, nk, H, d)
        dr_idx = jnp.clip(r0 + kr_off - r, -(KH_MAX - 1), KH_MAX - 1) + (KH_MAX - 1)
        bias = rpb[:, dr_idx[None, :], dc_idx].astype(jnp.float32)
        s_loc = jnp.einsum('bqhd,bkhd->bhqk', qr, kr, preferred_element_type=jnp.float32) * scale + bias
        s_loc = jnp.where(col_ok, s_loc, NEG)
        s_ctx = jnp.einsum('bqhd,bkhd->bhqk', qr, ck, preferred_element_type=jnp.float32) * scale
        p = jax.nn.softmax(jnp.concatenate([s_loc, s_ctx], axis=-1), axis=-1)
        p_loc = p[..., :nk].astype(v.dtype)
        p_ctx = p[..., nk:nk + L].astype(v.dtype)
        return jnp.einsum('bhqk,bkhd->bqhd', p_loc, vr) + jnp.einsum('bhqk,bkhd->bqhd', p_ctx, cv)

    o = lax.map(row, (jnp.arange(rows), qg))
    return jnp.moveaxis(o, 0, 1).reshape(B, T, H * d)


def gated_merge(gate_pre, branches, w_branch, w_out):
    o = jnp.stack(branches, axis=2)
    up = jnp.einsum('btnw,nwd->btnd', o, w_branch)
    g = jax.nn.sigmoid(gate_pre.reshape(up.shape))
    return jnp.sum(g * up, axis=2) @ w_out


def swiglu(u, w1, w2):
    a, b = jnp.split(u @ w1, 2, axis=-1)
    return (jax.nn.silu(a) * b) @ w2


def token_mixers(ux, uc, rows_pos, cols_pos, ctx_out, w_in, g_a_q, g_a_kv, w_a_uq, w_a_ukv,
                 sink_b, rpb_c, g_d_q, g_d_k, w_branch, w_out):
    B, T, _ = ux.shape
    L = uc.shape[1]
    px = split_cols(ux @ w_in)
    pc = split_cols(uc @ w_in)
    rope = lambda t: axial_rope(t, rows_pos, cols_pos)
    g_b = H_B // KV_B
    g_d = H_D // KV_D
    s_a = (NOPE_A + ROPE_A) ** -0.5
    s_h = DH ** -0.5

    def mla_q(p):
        return heads(rmsnorm(p['a_cq'], g_a_q) @ w_a_uq, H_A)

    def mla_kv(p, rotate):
        kv = heads(rmsnorm(p['a_ckv'], g_a_kv) @ w_a_ukv, H_A)
        kr = p['a_kr'][:, :, None, :]
        if rotate:
            kr = rope(kr)
        k = jnp.concatenate([kv[..., :NOPE_A], jnp.broadcast_to(kr, kv.shape[:-1] + (ROPE_A,))], axis=-1)
        return k, kv[..., NOPE_A:]

    qa = mla_q(px)
    qa = jnp.concatenate([qa[..., :NOPE_A], rope(qa[..., NOPE_A:])], axis=-1)
    ka, va = mla_kv(px, True)
    kca, vca = mla_kv(pc, False)
    oa = attend_dense(qa[:, :, :, None], jnp.concatenate([ka, kca], axis=1),
                      jnp.concatenate([va, vca], axis=1), s_a)

    qb = rope(heads(px['b_q'], H_B)).reshape(B, T, KV_B, g_b, DH)
    kb = rope(heads(px['b_k'], KV_B))
    vb = heads(px['b_v'], KV_B)
    kcb = heads(pc['b_k'], KV_B)
    vcb = heads(pc['b_v'], KV_B)
    sink = sink_b.reshape(KV_B, g_b)
    ob = attend_window(qb, kb, vb, kcb, vcb, sink, s_h)

    kcc = heads(pc['c_k'], H_C)
    vcc = heads(pc['c_v'], H_C)
    oc = attend_neighbourhood(heads(px['c_q'], H_C), heads(px['c_k'], H_C), heads(px['c_v'], H_C),
                              kcc, vcc, rpb_c, s_h)

    qd = rope(rmsnorm(heads(px['d_q'], H_D), g_d_q)).reshape(B, T, KV_D, g_d, DH)
    kd = rope(rmsnorm(heads(px['d_k'], KV_D), g_d_k))
    vd = heads(px['d_v'], KV_D)
    kcd = rmsnorm(heads(pc['d_k'], KV_D), g_d_k)
    vcd = heads(pc['d_v'], KV_D)
    od = attend_dense(qd, jnp.concatenate([kd, kcd], axis=1), jnp.concatenate([vd, vcd], axis=1), s_h)

    yx = gated_merge(px['gate'], (oa, ob, oc, od), w_branch, w_out)
    if not ctx_out:
        return yx, None

    oca = attend_dense(mla_q(pc)[:, :, :, None], kca, vca, s_a)
    ocb = attend_dense(heads(pc['b_q'], H_B).reshape(B, L, KV_B, g_b, DH), kcb, vcb, s_h, sink)
    occ = attend_dense(heads(pc['c_q'], H_C)[:, :, :, None], kcc, vcc, s_h)
    ocd = attend_dense(rmsnorm(heads(pc['d_q'], H_D), g_d_q).reshape(B, L, KV_D, g_d, DH), kcd, vcd, s_h)
    yc = gated_merge(pc['gate'], (oca, ocb, occ, ocd), w_branch, w_out)
    return yx, yc


def setup_inputs(seed: int = 0) -> dict:
    key = jax.random.key(seed)
    ks = jax.random.split(key, 23)
    f32 = jnp.float32

    def nrm(k, shape, std):
        return jax.random.normal(k, shape, f32) * std

    def gain(k, n):
        return 1.0 + 0.05 * jax.random.normal(k, (DEPTH, n), f32)

    L = DEPTH
    return {
        'x': nrm(ks[0], (BATCH, SEQ, D_MODEL), 1.0),
        'c': nrm(ks[1], (BATCH, D_MODEL), 1.0),
        'ctx': nrm(ks[2], (BATCH, CTX_LEN, D_MODEL), 1.0),
        'c_ctx': nrm(ks[3], (D_MODEL,), 1.0),
        'w_mod': nrm(ks[4], (L, D_MODEL, MOD_CHUNKS * D_MODEL), 0.5 * D_MODEL ** -0.5),
        'b_mod': nrm(ks[5], (L, MOD_CHUNKS * D_MODEL), 0.02),
        'g_pre_mix': gain(ks[6], D_MODEL),
        'g_post_mix': gain(ks[7], D_MODEL),
        'g_pre_ffn': gain(ks[8], D_MODEL),
        'g_post_ffn': gain(ks[9], D_MODEL),
        'w_in': nrm(ks[10], (L, D_MODEL, IN_COLS), D_MODEL ** -0.5),
        'g_a_q': gain(ks[11], Q_LORA),
        'g_a_kv': gain(ks[12], KV_LORA),
        'w_a_uq': nrm(ks[13], (L, Q_LORA, H_A * (NOPE_A + ROPE_A)), Q_LORA ** -0.5),
        'w_a_ukv': nrm(ks[14], (L, KV_LORA, H_A * (NOPE_A + V_A)), KV_LORA ** -0.5),
        'sink_b': nrm(ks[15], (L, H_B), 0.5),
        'rpb_c': nrm(ks[16], (L, H_C, 2 * KH_MAX - 1, 2 * KW - 1), 0.2),
        'g_d_q': gain(ks[17], DH),
        'g_d_k': gain(ks[18], DH),
        'w_branch': nrm(ks[19], (L, N_BRANCH, BR_WIDTH, D_MODEL), BR_WIDTH ** -0.5),
        'w_out': nrm(ks[20], (L, D_MODEL, D_MODEL), D_MODEL ** -0.5),
        'w_ffn_in': nrm(ks[21], (L, D_MODEL, 2 * D_FF), D_MODEL ** -0.5),
        'w_ffn_out': nrm(ks[22], (L, D_FF, D_MODEL), D_FF ** -0.5),
    }


def reference(x, c, ctx, c_ctx, w_mod, b_mod, g_pre_mix, g_post_mix, g_pre_ffn, g_post_ffn,
              w_in, g_a_q, g_a_kv, w_a_uq, w_a_ukv, sink_b, rpb_c, g_d_q, g_d_k,
              w_branch, w_out, w_ffn_in, w_ffn_out):
    T = x.shape[1]
    t = jnp.arange(T)
    rows_pos = t // GRID_W
    cols_pos = t % GRID_W
    sc = jax.nn.silu(c)
    scc = jax.nn.silu(c_ctx)
    h, hc = x, ctx
    for l in range(DEPTH):
        last = l == DEPTH - 1
        sh1x, sc1x, ga1x, sh2x, sc2x, ga2x = jnp.split((sc @ w_mod[l] + b_mod[l])[:, None, :], MOD_CHUNKS, axis=-1)
        sh1c, sc1c, ga1c, sh2c, sc2c, ga2c = jnp.split(scc @ w_mod[l] + b_mod[l], MOD_CHUNKS, axis=-1)
        ux = rmsnorm(h, g_pre_mix[l]) * (1 + sc1x) + sh1x
        uc = rmsnorm(hc, g_pre_mix[l]) * (1 + sc1c) + sh1c
        yx, yc = token_mixers(ux, uc, rows_pos, cols_pos, not last, w_in[l], g_a_q[l], g_a_kv[l],
                              w_a_uq[l], w_a_ukv[l], sink_b[l], rpb_c[l], g_d_q[l], g_d_k[l],
                              w_branch[l], w_out[l])
        h = h + ga1x * rmsnorm(yx, g_post_mix[l])
        ux = rmsnorm(h, g_pre_ffn[l]) * (1 + sc2x) + sh2x
        h = h + ga2x * rmsnorm(swiglu(ux, w_ffn_in[l], w_ffn_out[l]), g_post_ffn[l])
        if not last:
            hc = hc + ga1c * rmsnorm(yc, g_post_mix[l])
            uc = rmsnorm(hc, g_pre_ffn[l]) * (1 + sc2c) + sh2c
            hc = hc + ga2c * rmsnorm(swiglu(uc, w_ffn_in[l], w_ffn_out[l]), g_post_ffn[l])
    return h
```

```cpp
#include <hip/hip_runtime.h>
#include <hip/hip_cooperative_groups.h>
#include <cstdio>
#include <cstdint>
namespace cg = cooperative_groups;

typedef unsigned short bf16_t;
typedef short bf16x8 __attribute__((ext_vector_type(8)));
typedef short bf16x4 __attribute__((ext_vector_type(4)));
typedef float f32x4 __attribute__((ext_vector_type(4)));
typedef float f32x2 __attribute__((ext_vector_type(2)));
typedef unsigned u32x2 __attribute__((ext_vector_type(2)));
typedef unsigned u32x4 __attribute__((ext_vector_type(4)));
#define DEV __device__ __forceinline__

constexpr int DM = 1024, NBATCH = 16, SEQ = 2048, CTX = 256, DEPTH = 4;
constexpr int NCH = 2, BPC = NBATCH / NCH, LAT_C = BPC * SEQ, CTX_C = BPC * CTX, MC = LAT_C + CTX_C, MTOT = MC * NCH;
constexpr int INC = 7584, NPROJ = 3584, NWIN = 7680, PJLD = 2816, DFF = 2816, VTROWS = 1280;
#ifndef REP_G
#define REP_G 1
#endif
#ifndef REP_M
#define REP_M 1
#endif
#ifndef REP_A
#define REP_A 1
#endif
constexpr float LOG2E = 1.4426950408889634f;
constexpr int LST = 72;
constexpr int TILE_E = 128 * LST;
constexpr int SMEM_BYTES = 4 * TILE_E * 2 + 1024;

struct P {
    const float *x, *c, *ctx, *c_ctx, *w_mod, *b_mod, *g_pre_mix, *g_post_mix, *g_pre_ffn, *g_post_ffn, *w_in, *g_a_q, *g_a_kv,
        *w_a_uq, *w_a_ukv, *sink_b, *rpb_c, *g_d_q, *g_d_k, *w_branch, *w_out, *w_ffn_in, *w_ffn_out;
    float* out;
    bf16_t *WinT, *WuqT, *WukvT, *WbrT, *WoutT, *Wf1T, *Wf2T;
    float* mod; f32x2 *rt16, *rt8; float* hc;
    bf16_t *U, *YC, *PJ, *QA, *KN, *VT, *O, *MB, *ACT;
    unsigned char* G;
    unsigned* barw;
};

typedef __bf16 bf16v2 __attribute__((ext_vector_type(2)));
DEV unsigned pk_bf16(float lo, float hi) { bf16v2 v = __builtin_convertvector((f32x2){lo, hi}, bf16v2); return __builtin_bit_cast(unsigned, v); }
DEV float bf2f(unsigned short v) { return __uint_as_float(((unsigned)v) << 16); }
DEV void store4(bf16_t* p, f32x4 v) { u32x2 w; w.x = pk_bf16(v[0], v[1]); w.y = pk_bf16(v[2], v[3]); *(u32x2*)p = w; }
DEV float fexp2(float x) { return __builtin_amdgcn_exp2f(x); }
DEV float frcp(float x) { return __builtin_amdgcn_rcpf(x); }
DEV float wave_sum(float v) {
    v += __shfl_xor(v, 1); v += __shfl_xor(v, 2); v += __shfl_xor(v, 4); v += __shfl_xor(v, 8); v += __shfl_xor(v, 16); v += __shfl_xor(v, 32); return v;
}
DEV int ltid() { int t = threadIdx.x & 255; asm volatile("" : "+v"(t)); return t; }
DEV int uni(int v) { return __builtin_amdgcn_readfirstlane(v); }
DEV f32x4 mfma16(bf16x8 a, bf16x8 b, f32x4 c) { return __builtin_amdgcn_mfma_f32_16x16x32_bf16(a, b, c, 0, 0, 0); }

template <int NFT, bool SWAP>
DEV void gemm_mainloop(const bf16_t* __restrict__ A, int lda, const bf16_t* __restrict__ Bt, int ldb, int K, f32x4 (&acc)[NFT][4], bf16_t* sm) {
    const int tid = ltid(), lane = tid & 63, wid = uni(tid >> 6), wm = wid & 1, wn = wid >> 1, fr = lane & 15, fq = lane >> 4;
    bf16_t* sA = sm; bf16_t* sB = sm + 2 * TILE_E;
    const int lrow = tid >> 3, lc8 = (tid & 7) * 8;
    const bf16_t* ga = A + (size_t)lrow * lda + lc8;
    const bf16_t* gb = Bt + (size_t)lrow * ldb + lc8;
    u32x4 ra[4], rb[NFT];
#pragma unroll
    for (int ft = 0; ft < NFT; ++ft)
#pragma unroll
        for (int tt = 0; tt < 4; ++tt) acc[ft][tt] = (f32x4){0.f, 0.f, 0.f, 0.f};
#pragma unroll
    for (int i = 0; i < 4; ++i) ra[i] = *(const u32x4*)(ga + (size_t)(i * 32) * lda);
#pragma unroll
    for (int i = 0; i < NFT; ++i) rb[i] = *(const u32x4*)(gb + (size_t)(i * 32) * ldb);
#pragma unroll
    for (int i = 0; i < 4; ++i) *(u32x4*)(sA + (lrow + i * 32) * LST + lc8) = ra[i];
#pragma unroll
    for (int i = 0; i < NFT; ++i) *(u32x4*)(sB + (lrow + i * 32) * LST + lc8) = rb[i];
    const int nk = K >> 6;
    if (nk > 1) {
#pragma unroll
        for (int i = 0; i < 4; ++i) ra[i] = *(const u32x4*)(ga + (size_t)(i * 32) * lda + 64);
#pragma unroll
        for (int i = 0; i < NFT; ++i) rb[i] = *(const u32x4*)(gb + (size_t)(i * 32) * ldb + 64);
    }
    __syncthreads();
    for (int kt = 0; kt < nk; ++kt) {
        const int cur = kt & 1;
        if (kt + 1 < nk) {
            const int nx = cur ^ 1;
#pragma unroll
            for (int i = 0; i < 4; ++i) *(u32x4*)(sA + nx * TILE_E + (lrow + i * 32) * LST + lc8) = ra[i];
#pragma unroll
            for (int i = 0; i < NFT; ++i) *(u32x4*)(sB + nx * TILE_E + (lrow + i * 32) * LST + lc8) = rb[i];
        }
        if (kt + 2 < nk) {
            const int ko = (kt + 2) * 64;
#pragma unroll
            for (int i = 0; i < 4; ++i) ra[i] = *(const u32x4*)(ga + (size_t)(i * 32) * lda + ko);
#pragma unroll
            for (int i = 0; i < NFT; ++i) rb[i] = *(const u32x4*)(gb + (size_t)(i * 32) * ldb + ko);
        }
        __builtin_amdgcn_sched_barrier(0);
        const bf16_t* cA = sA + cur * TILE_E + (wm * 64 + fr) * LST + fq * 8;
        const bf16_t* cB = sB + cur * TILE_E + (wn * NFT * 16 + fr) * LST + fq * 8;
#pragma unroll
        for (int ks = 0; ks < 2; ++ks) {
            bf16x8 af[4], wf[NFT];
#pragma unroll
            for (int tt = 0; tt < 4; ++tt) af[tt] = *(const bf16x8*)(cA + tt * 16 * LST + ks * 32);
#pragma unroll
            for (int ft = 0; ft < NFT; ++ft) wf[ft] = *(const bf16x8*)(cB + ft * 16 * LST + ks * 32);
#pragma unroll
            for (int ft = 0; ft < NFT; ++ft)
#pragma unroll
                for (int tt = 0; tt < 4; ++tt) acc[ft][tt] = SWAP ? mfma16(af[tt], wf[ft], acc[ft][tt]) : mfma16(wf[ft], af[tt], acc[ft][tt]);
        }
        __syncthreads();
    }
}

DEV bool tile_xcd(int q, int x, int nM, int nN, int& m, int& n) {
    const int j = q >> 5, w = q & 31;
    const int pp = (((j >> 1) * 8 + x) << 1) + (j & 1);
    const int npn = nN >> 2;
    if (pp >= (nM >> 3) * npn) return false;
    const int pm = pp / npn, pn = pp - pm * npn;
    m = pm * 8 + (w & 7); n = pn * 4 + (w >> 3);
    return true;
}
#define TILE_LOOP(nM, nN) const int x_ = bid & 7, spx_ = G >> 3; int mt, nt; for (int q_ = bid >> 3; tile_xcd(q_, x_, nM, nN, mt, nt); q_ += spx_)

DEV int srccol(int mapid, int n) {
    switch (mapid) {
    case 0:
        if (n < 2816) { const int rho = n & 255; n = (n & ~255) + ((rho >> 5) & 3) * 64 + (rho >> 7) * 32 + (rho & 31); }
        if (n < 384) return n;
        if (n < 896) return n - 384 + 416;
        if (n < 1024) return n - 896 + 928;
        if (n < 1536) return n - 1024 + 1184;
        if (n < 2048) return n - 1536 + 1696;
        if (n < 2560) return n - 2048 + 2720;
        if (n < 2688) return n - 2560 + 3232;
        if (n < 2720) return n - 2688 + 384;
        if (n < 2816) return -1;
        if (n < 2944) return n - 2816 + 1056;
        if (n < 3456) return n - 2944 + 2208;
        if (n < 3584) return n - 3456 + 3360;
        return n - 3584 + 3488;
    case 1: if (n < 512) return (n >> 6) * 96 + (n & 63); { const int q = n - 512; return (q >> 5) * 96 + 64 + (q & 31); }
    case 2: if (n < 512) return (n >> 6) * 128 + (n & 63); { const int q = n - 512; return (q >> 6) * 128 + 64 + (q & 63); }
    case 4: { const int pn = n >> 8, bj = (n >> 7) & 1, wc = (n >> 5) & 3, s = (n >> 4) & 1, f = n & 15; return s * DFF + pn * 128 + bj * 64 + wc * 16 + f; }
    default: return n;
    }
}
DEV void conv_tile(const float* __restrict__ src, int lds_, int K, bf16_t* __restrict__ dst, int n0, int k0, int mapid, const float* rowscale, float* st) {
    const int tid = ltid();
    {
        const int n = tid & 63, kk = tid >> 6; const int sc_ = srccol(mapid, n0 + n);
#pragma unroll
        for (int i = 0; i < 16; ++i) {
            const int k = kk * 16 + i;
            float v = sc_ >= 0 ? src[(size_t)(k0 + k) * lds_ + sc_] : 0.f;
            if (rowscale) v *= rowscale[k0 + k];
            st[k * 65 + n] = v;
        }
    }
    __syncthreads();
    {
        const int n = tid >> 2, kq = tid & 3; u32x4 w0, w1;
        const float* s = st + (kq * 16) * 65 + n;
        w0.x = pk_bf16(s[0 * 65], s[1 * 65]); w0.y = pk_bf16(s[2 * 65], s[3 * 65]); w0.z = pk_bf16(s[4 * 65], s[5 * 65]); w0.w = pk_bf16(s[6 * 65], s[7 * 65]);
        w1.x = pk_bf16(s[8 * 65], s[9 * 65]); w1.y = pk_bf16(s[10 * 65], s[11 * 65]); w1.z = pk_bf16(s[12 * 65], s[13 * 65]); w1.w = pk_bf16(s[14 * 65], s[15 * 65]);
        bf16_t* d = dst + (size_t)(n0 + n) * K + k0 + kq * 16;
        *(u32x4*)d = w0; *(u32x4*)(d + 8) = w1;
    }
    __syncthreads();
}
constexpr int CONV_TILES = 4880;
DEV void conv_job(const P& p, int layer, int t, float* st) {
    if (t < 1920) { conv_tile(p.w_in + (size_t)layer * DM * INC, INC, 1024, p.WinT, (t >> 4) * 64, (t & 15) * 64, 0, nullptr, st); return; }
    t -= 1920;
    if (t < 48) { conv_tile(p.w_a_uq + (size_t)layer * 256 * 768, 768, 256, p.WuqT, (t >> 2) * 64, (t & 3) * 64, 1, p.g_a_q + layer * 256, st); return; }
    t -= 48;
    if (t < 32) { conv_tile(p.w_a_ukv + (size_t)layer * 128 * 1024, 1024, 128, p.WukvT, (t >> 1) * 64, (t & 1) * 64, 2, p.g_a_kv + layer * 128, st); return; }
    t -= 32;
    if (t < 512) { const int n = t >> 7, r = t & 127; conv_tile(p.w_branch + ((size_t)layer * 4 + n) * 512 * 1024, 1024, 512, p.WbrT + (size_t)n * 1024 * 512, (r >> 3) * 64, (r & 7) * 64, 3, nullptr, st); return; }
    t -= 512;
    if (t < 256) { conv_tile(p.w_out + (size_t)layer * 1024 * 1024, 1024, 1024, p.WoutT, (t >> 4) * 64, (t & 15) * 64, 3, nullptr, st); return; }
    t -= 256;
    if (t < 1408) { conv_tile(p.w_ffn_in + (size_t)layer * 1024 * 2 * DFF, 2 * DFF, 1024, p.Wf1T, (t >> 4) * 64, (t & 15) * 64, 4, nullptr, st); return; }
    t -= 1408;
    { const int nt = t / 44, kt = t - nt * 44; conv_tile(p.w_ffn_out + (size_t)layer * DFF * 1024, 1024, DFF, p.Wf2T, nt * 64, kt * 64, 3, nullptr, st); }
}

DEV void mod_item(const P& p, int item, unsigned char* smraw) {
    const int tid = ltid(), lane = tid & 63, wid = uni(tid >> 6);
    float* sc = (float*)smraw;
    const int l = item / 96, cgp = item - l * 96;
    for (int i = tid; i < 17 * 1024; i += 256) {
        const int r = i >> 10, k = i & 1023; const float v = r < 16 ? p.c[r * 1024 + k] : p.c_ctx[k];
        sc[i] = v * frcp(1.f + fexp2(-v * LOG2E));
    }
    __syncthreads();
    float acc[17];
#pragma unroll
    for (int r = 0; r < 17; ++r) acc[r] = 0.f;
    const float* w = p.w_mod + ((size_t)l * 1024 + wid * 256) * 6144 + cgp * 64 + lane;
    for (int k = 0; k < 256; k += 4) {
        const float w0 = w[(size_t)k * 6144], w1 = w[(size_t)(k + 1) * 6144], w2 = w[(size_t)(k + 2) * 6144], w3 = w[(size_t)(k + 3) * 6144];
#pragma unroll
        for (int r = 0; r < 17; ++r) { const f32x4 s = *(const f32x4*)(sc + r * 1024 + wid * 256 + k); acc[r] += s[0] * w0 + s[1] * w1 + s[2] * w2 + s[3] * w3; }
    }
    __syncthreads();
    float* red = (float*)smraw;
#pragma unroll
    for (int r = 0; r < 17; ++r) red[(wid * 17 + r) * 64 + lane] = acc[r];
    __syncthreads();
    for (int i = tid; i < 17 * 64; i += 256) {
        const int r = i >> 6, ci = i & 63;
        const float v = red[(0 * 17 + r) * 64 + ci] + red[(1 * 17 + r) * 64 + ci] + red[(2 * 17 + r) * 64 + ci] + red[(3 * 17 + r) * 64 + ci] + p.b_mod[l * 6144 + cgp * 64 + ci];
        p.mod[((size_t)l * 17 + r) * 6144 + cgp * 64 + ci] = v;
    }
    __syncthreads();
}

DEV void r_phase(const P& p, int mode, int layer, int vb, int VG, int g_lo, int g_hi) {
    const int tid_ = ltid(), lane = tid_ & 63, wid = uni(tid_ >> 6);
    const int nw = VG * 4;
    for (int g = g_lo + vb * 4 + wid; g < g_hi; g += nw) {
        const int ch = g / MC, local = g - ch * MC;
        const float* hin; float* hout; const float* mod;
        if (local < LAT_C) {
            const int idx = ch * LAT_C + local; const int b = idx >> 11;
            hin = (mode == 0 ? p.x : p.out) + (size_t)idx * 1024; hout = p.out + (size_t)idx * 1024; mod = p.mod + ((size_t)layer * 17 + b) * 6144;
        } else {
            const int idx = ch * CTX_C + local - LAT_C;
            hin = (mode == 0 ? p.ctx : p.hc) + (size_t)idx * 1024; hout = p.hc + (size_t)idx * 1024; mod = p.mod + ((size_t)layer * 17 + 16) * 6144;
        }
        f32x4 h[4];
#pragma unroll
        for (int i = 0; i < 4; ++i) h[i] = *(const f32x4*)(hin + (i * 64 + lane) * 4);
        if (mode != 0) {
            f32x4 y[4]; float ss = 0.f;
#pragma unroll
            for (int i = 0; i < 4; ++i) {
                const u32x2 w = *(const u32x2*)((mode == 1 ? p.YC + (size_t)local * 1024 : p.U + (size_t)g * 1024) + (i * 64 + lane) * 4);
                y[i] = (f32x4){__uint_as_float(w.x << 16), __uint_as_float(w.x & 0xffff0000u), __uint_as_float(w.y << 16), __uint_as_float(w.y & 0xffff0000u)};
                ss += y[i][0] * y[i][0] + y[i][1] * y[i][1] + y[i][2] * y[i][2] + y[i][3] * y[i][3];
            }
            ss = wave_sum(ss);
            const float rs = rsqrtf(ss * (1.f / 1024.f) + 1e-6f);
            const float* gp = (mode == 1 ? p.g_post_mix : p.g_post_ffn) + layer * 1024;
            const float* ga = mod + (mode == 1 ? 2048 : 5120);
#pragma unroll
            for (int i = 0; i < 4; ++i) {
                const f32x4 gg = *(const f32x4*)(gp + (i * 64 + lane) * 4), aa = *(const f32x4*)(ga + (i * 64 + lane) * 4);
                h[i] = h[i] + aa * (y[i] * rs * gg);
            }
        }
#pragma unroll
        for (int i = 0; i < 4; ++i) *(f32x4*)(hout + (i * 64 + lane) * 4) = h[i];
        const int nl = (mode == 2) ? layer + 1 : layer;
        if (nl < DEPTH) {
            float ss = 0.f;
#pragma unroll
            for (int i = 0; i < 4; ++i) ss += h[i][0] * h[i][0] + h[i][1] * h[i][1] + h[i][2] * h[i][2] + h[i][3] * h[i][3];
            ss = wave_sum(ss);
            const float rs = rsqrtf(ss * (1.f / 1024.f) + 1e-6f);
            const float* gpre = (mode == 1 ? p.g_pre_ffn : p.g_pre_mix) + nl * 1024;
            const float* modn = (mode == 2) ? mod + 17 * 6144 : mod;
            const float* sh = modn + (mode == 1 ? 3072 : 0);
            const float* sc = modn + (mode == 1 ? 4096 : 1024);
#pragma unroll
            for (int i = 0; i < 4; ++i) {
                const int e = (i * 64 + lane) * 4;
                const f32x4 gg = *(const f32x4*)(gpre + e), s1 = *(const f32x4*)(sc + e), s0 = *(const f32x4*)(sh + e);
                const f32x4 u = h[i] * rs * gg * (s1 + 1.f) + s0;
                store4(p.U + (size_t)g * 1024 + e, u);
            }
        }
    }
}

DEV void gemm1_row(f32x4 (&v)[4], int row, int slab, bool lat, const P& p, int layer, int fq) {
    const bool hnorm = (slab >= 2048 && slab < 2688);
    const bool rope64 = lat && ((slab >= 384 && slab < 1024) || hnorm);
    const bool isq = (slab >= 384 && slab < 896) || (slab >= 1024 && slab < 1536) || (slab >= 2048 && slab < 2560);
    const float sc = isq ? 0.125f * LOG2E : 1.f;
    const bool kr = (slab == 2688);
    const int tok = row & 2047; const int pr = tok >> 6, pc = tok & 63;
    if (hnorm) {
        float ss = 0.f;
#pragma unroll
        for (int ft = 0; ft < 4; ++ft) ss += v[ft][0] * v[ft][0] + v[ft][1] * v[ft][1] + v[ft][2] * v[ft][2] + v[ft][3] * v[ft][3];
        ss += __shfl_xor(ss, 16); ss += __shfl_xor(ss, 32);
        const float rs = rsqrtf(ss * (1.f / 64.f) + 1e-6f);
        const float* g = (slab < 2560 ? p.g_d_q : p.g_d_k) + layer * 64;
#pragma unroll
        for (int ft = 0; ft < 4; ++ft) { const f32x4 gg = *(const f32x4*)(g + ft * 16 + fq * 4); v[ft] = v[ft] * rs * gg; }
    }
    if (rope64) {
#pragma unroll
        for (int j = 0; j < 4; ++j) {
            const int i = fq * 4 + j;
            f32x2 cs = p.rt16[pr * 16 + i]; float a = v[0][j], b = v[1][j];
            v[0][j] = a * cs[0] - b * cs[1]; v[1][j] = b * cs[0] + a * cs[1];
            cs = p.rt16[pc * 16 + i]; a = v[2][j]; b = v[3][j];
            v[2][j] = a * cs[0] - b * cs[1]; v[3][j] = b * cs[0] + a * cs[1];
        }
    }
    if (kr && lat) {
#pragma unroll
        for (int ft = 0; ft < 2; ++ft) {
            const int pos = ft == 0 ? pr : pc;
#pragma unroll
            for (int j = 0; j < 4; ++j) {
                const int i = (fq & 1) * 4 + j; const f32x2 cs = p.rt8[pos * 8 + i];
                const float xv = v[ft][j]; const float o = __shfl_xor(xv, 32);
                v[ft][j] = fq < 2 ? xv * cs[0] - o * cs[1] : xv * cs[0] + o * cs[1];
            }
        }
    }
    bf16_t* dst = p.PJ + (size_t)row * PJLD + slab + fq * 4;
    store4(dst, v[0] * sc); store4(dst + 16, v[1] * sc);
    if (!kr) { store4(dst + 32, v[2] * sc); store4(dst + 48, v[3] * sc); }
}
DEV void stage2_tile(const P& p, int mt, int j, unsigned char* smraw) {
    bf16_t* sm = (bf16_t*)smraw; float* s_rs = (float*)(smraw + 73728);
    const int tid = ltid(), lane = tid & 63, wid = uni(tid >> 6), wm = wid & 1, wn = wid >> 1, fr = lane & 15, fq = lane >> 4;
    const int m0 = mt * 128; const bool isq = j < 6; const bool lat = m0 < LAT_C;
    const int K = isq ? 256 : 128; const int acol = isq ? 0 : 256;
    {
        const int r = tid >> 1, hf = tid & 1; const int n = K >> 1;
        const bf16_t* src = p.PJ + (size_t)(m0 + r) * PJLD + acol + hf * n; float ss = 0.f;
        for (int i = 0; i < n; i += 8) {
            const u32x4 w = *(const u32x4*)(src + i);
#pragma unroll
            for (int q = 0; q < 4; ++q) { const float a = __uint_as_float(w[q] << 16), b = __uint_as_float(w[q] & 0xffff0000u); ss += a * a + b * b; }
        }
        ss += __shfl_xor(ss, 1);
        if (hf == 0) s_rs[r] = rsqrtf(ss / (float)K + 1e-6f);
    }
    __syncthreads();
    f32x4 acc[4][4];
    const bf16_t* A = p.PJ + (size_t)m0 * PJLD + acol;
    if (isq) {
        const int n0 = j * 128;
        gemm_mainloop<4, false>(A, PJLD, p.WuqT + (size_t)n0 * 256, 256, 256, acc, sm);
        const int slab = n0 + wn * 64; const float qs = 0.10206207261596577f * LOG2E;
#pragma unroll
        for (int tt = 0; tt < 4; ++tt) {
            const int lr = wm * 64 + tt * 16 + fr; const int row = m0 + lr; const float rs = s_rs[lr] * qs;
            const int tok = row & 2047; const int pr = tok >> 6, pc = tok & 63;
            f32x4 v[4] = {acc[0][tt], acc[1][tt], acc[2][tt], acc[3][tt]};
            if (slab >= 512 && lat) {
#pragma unroll
                for (int ft = 0; ft < 4; ++ft) {
                    const int pos = (ft & 1) == 0 ? pr : pc;
#pragma unroll
                    for (int jj = 0; jj < 4; ++jj) {
                        const int i = (fq & 1) * 4 + jj; const f32x2 cs = p.rt8[pos * 8 + i];
                        const float xv = v[ft][jj]; const float o = __shfl_xor(xv, 32);
                        v[ft][jj] = fq < 2 ? xv * cs[0] - o * cs[1] : xv * cs[0] + o * cs[1];
                    }
                }
            }
            bf16_t* dst = p.QA + (size_t)row * 768 + slab + fq * 4;
#pragma unroll
            for (int ft = 0; ft < 4; ++ft) store4(dst + ft * 16, v[ft] * rs);
        }
    } else {
        const int n0 = (j - 6) * 128;
        if (n0 < 512) {
            gemm_mainloop<4, false>(A, PJLD, p.WukvT + (size_t)n0 * 128, 128, 128, acc, sm);
#pragma unroll
            for (int tt = 0; tt < 4; ++tt) {
                const int lr = wm * 64 + tt * 16 + fr; const float rs = s_rs[lr];
                bf16_t* dst = p.KN + (size_t)(m0 + lr) * 512 + n0 + wn * 64 + fq * 4;
#pragma unroll
                for (int ft = 0; ft < 4; ++ft) store4(dst + ft * 16, acc[ft][tt] * rs);
            }
        } else {
            gemm_mainloop<4, true>(A, PJLD, p.WukvT + (size_t)n0 * 128, 128, 128, acc, sm);
            const int vrow0 = 768 + (n0 - 512) + wn * 64;
#pragma unroll
            for (int tt = 0; tt < 4; ++tt) {
                const int lr = wm * 64 + tt * 16 + fq * 4;
                const f32x4 rs = *(const f32x4*)(s_rs + lr);
#pragma unroll
                for (int ft = 0; ft < 4; ++ft) store4(p.VT + (size_t)(vrow0 + ft * 16 + fr) * MC + m0 + lr, acc[ft][tt] * rs);
            }
        }
    }
    __syncthreads();
}

template <int MODE>
DEV void attn_item(const P& p, int layer, int item, bool ctxq, unsigned char* smraw) {
    constexpr bool GQA = (MODE == 1 || MODE == 3);
    constexpr int DQK = (MODE == 0) ? 96 : 64, NKS = DQK / 32, KST = DQK + 8;
    constexpr int KS_E = 64 * 104, VS_E = 64 * 72;
    bf16_t* Ks = (bf16_t*)smraw; bf16_t* Vs = Ks + 2 * KS_E; float* bias_s = (float*)(smraw + (2 * KS_E + 2 * VS_E) * 2);
    const int tid = ltid(), lane = tid & 63, wid = uni(tid >> 6), fr = lane & 15, fq = lane >> 4;
    const int nqt = ctxq ? (GQA ? 8 : 2) : (GQA ? 64 : 16);
    const int nh = GQA ? 2 : 8;
    const int qt = item % nqt, hh = (item / nqt) % nh, lb = item / (nqt * nh);
    const int head = GQA ? hh * 4 + wid : hh;
    const int tok0 = GQA ? qt * 32 : qt * 128 + wid * 32;
    const int qrow0 = (ctxq ? LAT_C + lb * CTX : lb * SEQ) + tok0;
    bf16x8 qf[2][NKS];
#pragma unroll
    for (int q = 0; q < 2; ++q) {
        const int row = qrow0 + q * 16 + fr;
        if (MODE == 0) {
            qf[q][0] = *(const bf16x8*)(p.QA + (size_t)row * 768 + head * 64 + fq * 8);
            qf[q][1] = *(const bf16x8*)(p.QA + (size_t)row * 768 + head * 64 + 32 + fq * 8);
            qf[q][NKS - 1] = *(const bf16x8*)(p.QA + (size_t)row * 768 + 512 + head * 32 + fq * 8);
        } else {
            const int qoff = MODE == 1 ? 384 : (MODE == 2 ? 1024 : 2048);
#pragma unroll
            for (int ks = 0; ks < NKS; ++ks) qf[q][ks] = *(const bf16x8*)(p.PJ + (size_t)row * PJLD + qoff + head * 64 + ks * 32 + fq * 8);
        }
    }
    const int koff = MODE == 1 ? 896 + hh * 64 : (MODE == 2 ? 1536 + hh * 64 : 2560 + hh * 64);
    const int vrow0 = MODE == 0 ? 768 + hh * 64 : (MODE == 1 ? hh * 64 : (MODE == 2 ? 128 + hh * 64 : 640 + hh * 64));
    int ktlo = 0, nlat = 0;
    if (!ctxq) {
        if (MODE == 0 || MODE == 3) { ktlo = 0; nlat = 32; }
        else if (MODE == 1) { const int q0 = qt * 32; const int lo = max(0, q0 - 128), hi = min(SEQ - 1, q0 + 159); ktlo = lo >> 6; nlat = (hi >> 6) - ktlo + 1; }
        else { const int r0a = min(max(2 * qt - 4, 0), 24), r0b = min(max(2 * qt + 1 - 4, 0), 24); ktlo = r0a; nlat = r0b + 8 - r0a; }
    }
    const int nt = 4 + nlat;
    const int ntf = ctxq ? 4 : ((MODE == 0 || MODE == 3) ? 36 : (MODE == 1 ? 9 : 13));
    if (MODE == 2 && !ctxq) { for (int i = tid; i < 465; i += 256) bias_s[i] = p.rpb_c[(layer * 8 + hh) * 465 + i] * LOG2E; }

    u32x4 rk[NKS], rv[2];
    auto tile_krow = [&](int it) { it = min(it, nt - 1); return it < 4 ? LAT_C + lb * CTX + it * 64 : lb * SEQ + (ktlo + it - 4) * 64; };
    auto gload = [&](int it) {
        const int krow = tile_krow(it);
#pragma unroll
        for (int i = 0; i < NKS; ++i) {
            const int id = tid + i * 256;
            if (MODE == 0) {
                const int key = id / 12, c = id - key * 12;
                const bf16_t* src = c < 8 ? p.KN + (size_t)(krow + key) * 512 + hh * 64 + c * 8 : p.PJ + (size_t)(krow + key) * PJLD + 2688 + (c - 8) * 8;
                rk[i] = *(const u32x4*)src;
            } else {
                const int key = id >> 3, c = id & 7;
                rk[i] = *(const u32x4*)(p.PJ + (size_t)(krow + key) * PJLD + koff + c * 8);
            }
        }
#pragma unroll
        for (int i = 0; i < 2; ++i) { const int id = tid + i * 256; const int dv = id >> 3, c = id & 7; rv[i] = *(const u32x4*)(p.VT + (size_t)(vrow0 + dv) * MC + krow + c * 8); }
    };
    auto lstore = [&](int buf) {
#pragma unroll
        for (int i = 0; i < NKS; ++i) {
            const int id = tid + i * 256; int key, c;
            if (MODE == 0) { key = id / 12; c = id - key * 12; } else { key = id >> 3; c = id & 7; }
            *(u32x4*)(Ks + buf * KS_E + key * KST + c * 8) = rk[i];
        }
#pragma unroll
        for (int i = 0; i < 2; ++i) { const int id = tid + i * 256; const int dv = id >> 3, c = id & 7; *(u32x4*)(Vs + buf * VS_E + dv * 72 + c * 8) = rv[i]; }
    };

    f32x4 o[4][2]; float mrun[2], lsum[2];
#pragma unroll
    for (int q = 0; q < 2; ++q) { mrun[q] = -1e30f; lsum[q] = 0.f;
#pragma unroll
        for (int d = 0; d < 4; ++d) o[d][q] = (f32x4){0.f, 0.f, 0.f, 0.f}; }

    gload(0); lstore(0); gload(1); __syncthreads();
    for (int it = 0; it < ntf; ++it) {
        const int cur = it & 1;
        if (it + 1 < ntf) lstore(cur ^ 1);
        if (it + 2 < ntf) gload(it + 2);
        __builtin_amdgcn_sched_barrier(0);
        const int kt = ktlo + it - 4;
        bool active = it < nt;
        int r = 0, r0 = 0;
        if (MODE == 2 && !ctxq && it >= 4) { r = 2 * qt + (wid >> 1); r0 = min(max(r - 4, 0), 24); active = active && (kt >= r0 && kt < r0 + 8); }
        if (active) {
            f32x4 s[4][2];
            const bf16_t* kb = Ks + cur * KS_E + fr * KST + fq * 8;
            bf16x8 kf[4][NKS];
#pragma unroll
            for (int k4 = 0; k4 < 4; ++k4)
#pragma unroll
                for (int ks = 0; ks < NKS; ++ks) kf[k4][ks] = *(const bf16x8*)(kb + k4 * 16 * KST + ks * 32);
            __builtin_amdgcn_sched_barrier(0);
#pragma unroll
            for (int k4 = 0; k4 < 4; ++k4) {
#pragma unroll
                for (int q = 0; q < 2; ++q) s[k4][q] = (f32x4){0.f, 0.f, 0.f, 0.f};
#pragma unroll
                for (int ks = 0; ks < NKS; ++ks)
#pragma unroll
                    for (int q = 0; q < 2; ++q) s[k4][q] = mfma16(kf[k4][ks], qf[q][ks], s[k4][q]);
            }
            const bf16_t* vb = Vs + cur * VS_E + fr * 72 + fq * 4;
            bf16x8 vf[4][2];
#pragma unroll
            for (int d = 0; d < 4; ++d)
#pragma unroll
                for (int kb2 = 0; kb2 < 2; ++kb2) {
                    const u32x2 lo = *(const u32x2*)(vb + d * 16 * 72 + kb2 * 32), hi = *(const u32x2*)(vb + d * 16 * 72 + kb2 * 32 + 16);
                    u32x4 w; w.x = lo.x; w.y = lo.y; w.z = hi.x; w.w = hi.y;
                    vf[d][kb2] = __builtin_bit_cast(bf16x8, w);
                }
            __builtin_amdgcn_sched_barrier(0);
            if (!ctxq && it >= 4) {
                if (MODE == 1) {
#pragma unroll
                    for (int q = 0; q < 2; ++q) {
                        const int qpos = tok0 + q * 16 + fr;
#pragma unroll
                        for (int k4 = 0; k4 < 4; ++k4)
#pragma unroll
                            for (int j = 0; j < 4; ++j) { const int d = qpos - (kt * 64 + k4 * 16 + fq * 4 + j); if (d > 128 || d < -128) s[k4][q][j] = -1e30f; }
                    }
                }
                if (MODE == 2) {
#pragma unroll
                    for (int q = 0; q < 2; ++q) {
                        const int qc = (wid & 1) * 32 + q * 16 + fr; const int c0 = min(max(qc - 8, 0), 48);
                        const int bbase = (kt - r + 7) * 31 + 15 - qc;
#pragma unroll
                        for (int k4 = 0; k4 < 4; ++k4)
#pragma unroll
                            for (int j = 0; j < 4; ++j) {
                                const int kc = k4 * 16 + fq * 4 + j; const bool ok = (kc >= c0 && kc < c0 + 16);
                                const float bv = bias_s[ok ? bbase + kc : 0];
                                s[k4][q][j] = ok ? s[k4][q][j] + bv : -1e30f;
                            }
                    }
                }
            }
            bf16x8 pf[2][2];
#pragma unroll
            for (int q = 0; q < 2; ++q) {
                float mx = -1e30f;
#pragma unroll
                for (int k4 = 0; k4 < 4; ++k4) mx = fmaxf(mx, fmaxf(fmaxf(s[k4][q][0], s[k4][q][1]), fmaxf(s[k4][q][2], s[k4][q][3])));
                mx = fmaxf(mx, __shfl_xor(mx, 16)); mx = fmaxf(mx, __shfl_xor(mx, 32));
                const bool need = mx > mrun[q] + 8.f;
                if (__builtin_amdgcn_ballot_w64(need) != 0ull) {
                    const float mnew = need ? mx : mrun[q]; const float alpha = fexp2(mrun[q] - mnew); mrun[q] = mnew;
                    lsum[q] = lsum[q] * alpha;
#pragma unroll
                    for (int d = 0; d < 4; ++d) o[d][q] = o[d][q] * alpha;
                }
                const float mcur = mrun[q];
                float ps = 0.f;
#pragma unroll
                for (int k4 = 0; k4 < 4; ++k4)
#pragma unroll
                    for (int j = 0; j < 4; ++j) { const float e = fexp2(s[k4][q][j] - mcur); s[k4][q][j] = e; ps += e; }
                lsum[q] += ps;
#pragma unroll
                for (int kb2 = 0; kb2 < 2; ++kb2) {
                    u32x4 w; w.x = pk_bf16(s[2 * kb2][q][0], s[2 * kb2][q][1]); w.y = pk_bf16(s[2 * kb2][q][2], s[2 * kb2][q][3]);
                    w.z = pk_bf16(s[2 * kb2 + 1][q][0], s[2 * kb2 + 1][q][1]); w.w = pk_bf16(s[2 * kb2 + 1][q][2], s[2 * kb2 + 1][q][3]);
                    pf[q][kb2] = __builtin_bit_cast(bf16x8, w);
                }
            }
#pragma unroll
            for (int d = 0; d < 4; ++d)
#pragma unroll
                for (int kb2 = 0; kb2 < 2; ++kb2)
#pragma unroll
                    for (int q = 0; q < 2; ++q) o[d][q] = mfma16(vf[d][kb2], pf[q][kb2], o[d][q]);
        }
        __syncthreads();
    }
#pragma unroll
    for (int q = 0; q < 2; ++q) {
        float l = lsum[q]; l += __shfl_xor(l, 16); l += __shfl_xor(l, 32);
        if (MODE == 1) l += fexp2(p.sink_b[layer * 8 + head] * LOG2E - mrun[q]);
        const float inv = 1.f / l;
        bf16_t* dst = p.O + (size_t)(qrow0 + q * 16 + fr) * 2048 + MODE * 512 + head * 64 + fq * 4;
#pragma unroll
        for (int d = 0; d < 4; ++d) store4(dst + d * 16, o[d][q] * inv);
    }
}

DEV void merge_tile(const P& p, int ch, int mt, int nt, bf16_t* sm) {
    const int tid_ = ltid(), lane = tid_ & 63, wid = uni(tid_ >> 6), wm = wid & 1, wn = wid >> 1, fr = lane & 15, fq = lane >> 4;
    const int m0 = mt * 128, n0 = nt * 64;
    f32x4 tot[2][4];
#pragma unroll
    for (int ft = 0; ft < 2; ++ft)
#pragma unroll
        for (int tt = 0; tt < 4; ++tt) tot[ft][tt] = (f32x4){0.f, 0.f, 0.f, 0.f};
    for (int n = 0; n < 4; ++n) {
        f32x4 u[2][4];
        gemm_mainloop<2, false>(p.O + (size_t)m0 * 2048 + n * 512, 2048, p.WbrT + ((size_t)n * 1024 + n0) * 512, 512, 512, u, sm);
#pragma unroll
        for (int tt = 0; tt < 4; ++tt) {
            const unsigned char* gp = p.G + (size_t)(m0 + wm * 64 + tt * 16 + fr) * 4096 + n * 1024 + n0 + wn * 32 + fq * 4;
#pragma unroll
            for (int ft = 0; ft < 2; ++ft) {
                const unsigned w = *(const unsigned*)(gp + ft * 16);
                f32x4 g; g[0] = (float)(w & 255u); g[1] = (float)((w >> 8) & 255u); g[2] = (float)((w >> 16) & 255u); g[3] = (float)(w >> 24);
                tot[ft][tt] = tot[ft][tt] + (g * (1.f / 255.f)) * u[ft][tt];
            }
        }
    }
#pragma unroll
    for (int tt = 0; tt < 4; ++tt) {
        bf16_t* dst = p.MB + (size_t)(m0 + wm * 64 + tt * 16 + fr) * 1024 + n0 + wn * 32 + fq * 4;
        store4(dst, tot[0][tt]); store4(dst + 16, tot[1][tt]);
    }
}
DEV void store_tile_T(const f32x4 (&acc)[4][4], bf16_t* base, int ld, int row0, int col0) {
    const int tid_ = ltid(), lane = tid_ & 63, wid = uni(tid_ >> 6), wm = wid & 1, wn = wid >> 1, fr = lane & 15, fq = lane >> 4;
#pragma unroll
    for (int tt = 0; tt < 4; ++tt) {
        bf16_t* dst = base + (size_t)(row0 + wm * 64 + tt * 16 + fr) * ld + col0 + wn * 64 + fq * 4;
#pragma unroll
        for (int ft = 0; ft < 4; ++ft) store4(dst + ft * 16, acc[ft][tt]);
    }
}

namespace pg8 {
#define PG8_LAS __attribute__((address_space(3)))
constexpr int BM = 256, BK = 64, HALF = 128, HTB = HALF * BK * 2  , STAGE_BYTES = 8 * HTB, NXCD = 8, WGM = 8;

__host__ __device__ __forceinline__ int lds_byte(int r, int c) { const int st = (r >> 4) * 2 + (c >> 5), rr = r & 15, cc = c & 31, ob = rr * 64 + cc * 2; return st * 1024 + (ob ^ (((ob >> 9) & 1) << 5)); }
__host__ __device__ __forceinline__ void stage_rc(int b, int& R, int& C) { const int st = b / 1024, sb = b % 1024, swz = sb ^ (((sb >> 9) & 1) << 5); R = (st >> 1) * 16 + swz / 64; C = (st & 1) * 32 + (swz % 64) / 2; }
__host__ __device__ __forceinline__ int perm32(int rho) { const int n = rho >> 4, i = rho & 15; return 8 * (i >> 2) + 4 * n + (i & 3); }

struct Unit { int pm, pn; };
struct Gemm { const bf16_t* A; const bf16_t* Bt; int M, N, K; };

template <class Epi, class Sched, bool ALIGN_EPI = false, bool SP2 = false, bool SWAPMMA = false>
__device__ __forceinline__ void gemm_phase(PG8_LAS unsigned char* lds, const Gemm g, const Sched& S, const Epi& E) {
    const int tid = threadIdx.x, wid = __builtin_amdgcn_readfirstlane(tid >> 6), lane = tid & 63, wr = wid >> 2, wc = wid & 3, fr = lane & 15, fq = lane >> 4;
    const int K = g.K, nt = K / BK;
    unsigned voffA[2], voffB[2];
#pragma unroll
    for (int i = 0; i < 2; ++i) { int R, C; stage_rc(tid * 16 + i * 8192, R, C); const int Rb = Epi::PERM ? ((R & ~31) + perm32(R & 31)) : R;
        voffA[i] = (unsigned)(R * K + C) * 2u; voffB[i] = (unsigned)(Rb * K + C) * 2u; }
    const size_t kstep = (size_t)(BK * 2);
    const size_t hstep = (size_t)HALF * K * 2;
    const size_t tstep = 2 * hstep;
    const unsigned ldsw = (unsigned)wid * 1024u;
    const int aoff = lds_byte(wr * 64 + fr, fq * 8), boff = lds_byte(wc * 32 + fr, fq * 8);
#define PG8_SA(b, h) (((b) * 2 + (h)) * HTB)
#define PG8_SB(b, h) ((4 + (b) * 2 + (h)) * HTB)
#define PG8_STAGE(bufoff, gbase, voff) do { _Pragma("unroll") for (int _i = 0; _i < 2; ++_i) \
        __builtin_amdgcn_global_load_lds((const unsigned*)((const char*)(gbase) + (voff)[_i]), (PG8_LAS unsigned*)(lds + (bufoff) + ldsw + _i * 8192), 16, 0, 0); } while (0)
#define PG8_LDA(dst, b, h) do { _Pragma("unroll") for (int m = 0; m < 4; ++m) _Pragma("unroll") for (int k = 0; k < 2; ++k) dst[m][k] = *(const PG8_LAS bf16x8*)(lds + PG8_SA(b, h) + aoff + m * 2048 + k * 1024); } while (0)
#define PG8_LDB(dst, b, h) do { _Pragma("unroll") for (int n = 0; n < 2; ++n) _Pragma("unroll") for (int k = 0; k < 2; ++k) dst[n][k] = *(const PG8_LAS bf16x8*)(lds + PG8_SB(b, h) + boff + n * 2048 + k * 1024); } while (0)
#define PG8_MMA(ai, bj, At, Bt) do { __builtin_amdgcn_s_setprio(1); _Pragma("unroll") for (int m = 0; m < 4; ++m) _Pragma("unroll") for (int n = 0; n < 2; ++n) _Pragma("unroll") for (int k = 0; k < 2; ++k) \
        acc[ai][bj][m][n] = SWAPMMA ? __builtin_amdgcn_mfma_f32_16x16x32_bf16(At[m][k], Bt[n][k], acc[ai][bj][m][n], 0, 0, 0) : __builtin_amdgcn_mfma_f32_16x16x32_bf16(Bt[n][k], At[m][k], acc[ai][bj][m][n], 0, 0, 0); __builtin_amdgcn_s_setprio(0); } while (0)
#define PG8_WAIT_V(n) asm volatile("s_waitcnt vmcnt(" #n ")" ::: "memory")
#define PG8_WAIT_L(n) asm volatile("s_waitcnt lgkmcnt(" #n ")" ::: "memory")
#define PG8_BAR __builtin_amdgcn_s_barrier()
#define PG8_SCHED __builtin_amdgcn_sched_barrier(0)
    Unit cur, nxt; int ui = 0;
    if (!S.next(0, cur)) return;
    f32x4 acc[2][2][4][2];
#pragma unroll
    for (int a = 0; a < 2; ++a)
#pragma unroll
        for (int b = 0; b < 2; ++b)
#pragma unroll
            for (int m = 0; m < 4; ++m)
#pragma unroll
                for (int n = 0; n < 2; ++n) acc[a][b][m][n] = (f32x4){0.f, 0.f, 0.f, 0.f};
    bf16x8 At[4][2], B0[2][2], B1[2][2];
    const char* cA = (const char*)g.A + (size_t)cur.pm * tstep; const char* cB = (const char*)g.Bt + (size_t)cur.pn * tstep;
    S.a_ready(cur);
    if constexpr (SP2) {
        PG8_STAGE(PG8_SB(0, 0), cB, voffB); PG8_STAGE(PG8_SB(0, 1), cB + hstep, voffB); PG8_STAGE(PG8_SA(0, 0), cA, voffA); PG8_STAGE(PG8_SA(0, 1), cA + hstep, voffA);
        if (wr == 1) PG8_BAR;
        PG8_WAIT_V(2); PG8_BAR;
        PG8_STAGE(PG8_SB(1, 0), cB + kstep, voffB); PG8_STAGE(PG8_SA(1, 0), cA + kstep, voffA); PG8_STAGE(PG8_SB(1, 1), cB + hstep + kstep, voffB);
        PG8_WAIT_V(6); PG8_BAR;
    } else {
        PG8_STAGE(PG8_SB(0, 0), cB, voffB); PG8_STAGE(PG8_SA(0, 0), cA, voffA); PG8_STAGE(PG8_SB(0, 1), cB + hstep, voffB); PG8_STAGE(PG8_SA(0, 1), cA + hstep, voffA);
        if (wr == 1) PG8_BAR;
        PG8_WAIT_V(4); PG8_BAR;
        PG8_STAGE(PG8_SB(1, 0), cB + kstep, voffB); PG8_STAGE(PG8_SA(1, 0), cA + kstep, voffA); PG8_STAGE(PG8_SB(1, 1), cB + hstep + kstep, voffB);
        PG8_WAIT_V(6); PG8_BAR;
    }
    for (;;) {
        const bool has_next = S.next(ui + 1, nxt);
        const char* nA = has_next ? (const char*)g.A + (size_t)nxt.pm * tstep : cA; const char* nB = has_next ? (const char*)g.Bt + (size_t)nxt.pn * tstep : cB;
        for (int t = 0; t < nt; t += 2) {
            const bool last = (t == nt - 2);
            const char* a1 = cA + (size_t)(t + 1) * kstep;
            const char* a2 = last ? nA : cA + (size_t)(t + 2) * kstep; const char* b2 = last ? nB : cB + (size_t)(t + 2) * kstep;
            const char* a3 = a2 + kstep; const char* b3 = b2 + kstep;
            if (last && has_next) S.a_ready(nxt);
            if constexpr (SP2) {
            PG8_LDB(B0, 0, 0); PG8_LDB(B1, 0, 1); PG8_SCHED; PG8_LDA(At, 0, 0); PG8_STAGE(PG8_SA(1, 1), a1 + hstep, voffA);
            PG8_WAIT_V(8); PG8_WAIT_L(0); PG8_BAR; PG8_MMA(0, 0, At, B0); PG8_MMA(0, 1, At, B1); PG8_BAR; PG8_SCHED;
            PG8_LDA(At, 0, 1); PG8_STAGE(PG8_SB(0, 0), b2, voffB); PG8_STAGE(PG8_SB(0, 1), b2 + hstep, voffB); PG8_STAGE(PG8_SA(0, 0), a2, voffA);
            PG8_WAIT_V(8); PG8_WAIT_L(0); PG8_BAR; PG8_MMA(1, 0, At, B0); PG8_MMA(1, 1, At, B1); PG8_BAR; PG8_SCHED;
            PG8_LDB(B0, 1, 0); PG8_LDB(B1, 1, 1); PG8_SCHED; PG8_LDA(At, 1, 0); PG8_STAGE(PG8_SA(0, 1), a2 + hstep, voffA);
            PG8_WAIT_V(8); PG8_WAIT_L(0); PG8_BAR; PG8_MMA(0, 0, At, B0); PG8_MMA(0, 1, At, B1); PG8_BAR; PG8_SCHED;
            PG8_LDA(At, 1, 1); PG8_STAGE(PG8_SB(1, 0), b3, voffB); PG8_STAGE(PG8_SB(1, 1), b3 + hstep, voffB); PG8_STAGE(PG8_SA(1, 0), a3, voffA);
            PG8_WAIT_V(8); PG8_WAIT_L(0); PG8_BAR; PG8_MMA(1, 0, At, B0); PG8_MMA(1, 1, At, B1); PG8_BAR; PG8_SCHED;
            } else {
            PG8_LDB(B0, 0, 0); PG8_SCHED; PG8_LDA(At, 0, 0); PG8_STAGE(PG8_SA(1, 1), a1 + hstep, voffA);
            PG8_WAIT_L(8); PG8_BAR; PG8_WAIT_L(0); PG8_MMA(0, 0, At, B0); PG8_BAR; PG8_SCHED;
            PG8_LDB(B1, 0, 1); PG8_STAGE(PG8_SB(0, 0), b2, voffB);
            PG8_BAR; PG8_WAIT_L(0); PG8_MMA(0, 1, At, B1); PG8_BAR;
            PG8_LDA(At, 0, 1); PG8_STAGE(PG8_SA(0, 0), a2, voffA);
            PG8_BAR; PG8_WAIT_L(0); PG8_MMA(1, 0, At, B0); PG8_BAR; PG8_SCHED;
            PG8_STAGE(PG8_SB(0, 1), b2 + hstep, voffB);
            PG8_WAIT_V(6); PG8_BAR; PG8_MMA(1, 1, At, B1); PG8_BAR;
            PG8_LDB(B0, 1, 0); PG8_SCHED; PG8_LDA(At, 1, 0); PG8_STAGE(PG8_SA(0, 1), a2 + hstep, voffA);
            PG8_WAIT_L(8); PG8_BAR; PG8_WAIT_L(0); PG8_MMA(0, 0, At, B0); PG8_BAR; PG8_SCHED;
            PG8_LDB(B1, 1, 1); PG8_STAGE(PG8_SB(1, 0), b3, voffB);
            PG8_BAR; PG8_WAIT_L(0); PG8_MMA(0, 1, At, B1); PG8_BAR;
            PG8_LDA(At, 1, 1); PG8_STAGE(PG8_SA(1, 0), a3, voffA);
            PG8_BAR; PG8_WAIT_L(0); PG8_MMA(1, 0, At, B0); PG8_BAR; PG8_SCHED;
            PG8_STAGE(PG8_SB(1, 1), b3 + hstep, voffB);
            PG8_WAIT_V(6); PG8_BAR; PG8_MMA(1, 1, At, B1); PG8_BAR;
            }
        }
        if constexpr (ALIGN_EPI) { if (wr == 0) PG8_BAR; }
        if constexpr (!Epi::AFTER_DRAIN) { E(acc, cur, wr, wc, fr, fq); S.done(cur); }
        if (!has_next) break;
#pragma unroll
        for (int a = 0; a < 2; ++a)
#pragma unroll
            for (int b = 0; b < 2; ++b)
#pragma unroll
                for (int m = 0; m < 4; ++m)
#pragma unroll
                    for (int n = 0; n < 2; ++n) acc[a][b][m][n] = (f32x4){0.f, 0.f, 0.f, 0.f};
        cur = nxt; cA = nA; cB = nB; ++ui;
        if constexpr (ALIGN_EPI) { if (wr == 1) PG8_BAR; }
    }
    PG8_WAIT_V(0);
    if constexpr (!ALIGN_EPI) { if (wr == 0) PG8_BAR; }
    PG8_BAR;
    if constexpr (Epi::AFTER_DRAIN) { E.fused(acc, cur, wr, wc, fr, fq, lds, wid, lane); S.done(cur); }
#undef PG8_SA
#undef PG8_SB
#undef PG8_STAGE
#undef PG8_LDA
#undef PG8_LDB
#undef PG8_MMA
#undef PG8_WAIT_V
#undef PG8_WAIT_L
#undef PG8_BAR
#undef PG8_SCHED
}
}

struct XSched {
    int nN, nunits, G, c;
    DEV bool next(int i, pg8::Unit& u) const {
        const int L = i * G + c; if (L >= nunits) return false;
        const int U = ((nunits & 7) == 0 && (G & 7) == 0) ? (L & 7) * (nunits >> 3) + (L >> 3) : L;
        u.pm = U / nN; u.pn = U - u.pm * nN; return true;
    }
    DEV void a_ready(const pg8::Unit&) const {}
    DEV void done(const pg8::Unit&) const {}
};
struct EpiStoreT {
    static constexpr bool PERM = false, AFTER_DRAIN = false;
    bf16_t* out; int ld; int row_off;
    DEV void operator()(const f32x4 (&acc)[2][2][4][2], const pg8::Unit& u, int wr, int wc, int fr, int fq) const {
#pragma unroll
        for (int ai = 0; ai < 2; ++ai)
#pragma unroll
            for (int m = 0; m < 4; ++m) {
                bf16_t* d = out + (size_t)(row_off + u.pm * 256 + ai * 128 + wr * 64 + m * 16 + fr) * ld + u.pn * 256 + wc * 32 + fq * 4;
#pragma unroll
                for (int bj = 0; bj < 2; ++bj)
#pragma unroll
                    for (int n = 0; n < 2; ++n) store4(d + bj * 128 + n * 16, acc[ai][bj][m][n]);
            }
    }
};
struct EpiSwiglu {
    static constexpr bool PERM = false, AFTER_DRAIN = false;
    bf16_t* act;
    DEV void operator()(const f32x4 (&acc)[2][2][4][2], const pg8::Unit& u, int wr, int wc, int fr, int fq) const {
#pragma unroll
        for (int ai = 0; ai < 2; ++ai)
#pragma unroll
            for (int m = 0; m < 4; ++m) {
                bf16_t* d = act + (size_t)(u.pm * 256 + ai * 128 + wr * 64 + m * 16 + fr) * DFF + u.pn * 128 + wc * 16 + fq * 4;
#pragma unroll
                for (int bj = 0; bj < 2; ++bj) {
                    const f32x4 a = acc[ai][bj][m][0], b = acc[ai][bj][m][1]; f32x4 r;
#pragma unroll
                    for (int j = 0; j < 4; ++j) r[j] = a[j] * frcp(1.f + fexp2(-a[j] * LOG2E)) * b[j];
                    store4(d + bj * 64, r);
                }
            }
    }
};
struct EpiVT {
    static constexpr bool PERM = false, AFTER_DRAIN = false;
    bf16_t* vt;
    DEV void operator()(const f32x4 (&acc)[2][2][4][2], const pg8::Unit& u, int wr, int wc, int fr, int fq) const {
#pragma unroll
        for (int bj = 0; bj < 2; ++bj)
#pragma unroll
            for (int n = 0; n < 2; ++n) {
                bf16_t* d = vt + (size_t)(u.pn * 256 + bj * 128 + wc * 32 + n * 16 + fr) * MC + u.pm * 256 + wr * 64 + fq * 4;
#pragma unroll
                for (int ai = 0; ai < 2; ++ai)
#pragma unroll
                    for (int m = 0; m < 4; ++m) store4(d + ai * 128 + m * 16, acc[ai][bj][m][n]);
            }
    }
};
struct EpiGate {
    static constexpr bool PERM = false, AFTER_DRAIN = false;
    unsigned char* g8;
    DEV void operator()(const f32x4 (&acc)[2][2][4][2], const pg8::Unit& u, int wr, int wc, int fr, int fq) const {
#pragma unroll
        for (int ai = 0; ai < 2; ++ai)
#pragma unroll
            for (int m = 0; m < 4; ++m) {
                unsigned char* d = g8 + (size_t)(u.pm * 256 + ai * 128 + wr * 64 + m * 16 + fr) * 4096 + u.pn * 256 + wc * 32 + fq * 4;
#pragma unroll
                for (int bj = 0; bj < 2; ++bj)
#pragma unroll
                    for (int n = 0; n < 2; ++n) {
                        const f32x4 a = acc[ai][bj][m][n]; unsigned w = 0;
#pragma unroll
                        for (int j = 0; j < 4; ++j) { const float s = frcp(1.f + fexp2(-a[j] * LOG2E)); w |= ((unsigned)(s * 255.f + 0.5f)) << (8 * j); }
                        *(unsigned*)(d + bj * 128 + n * 16) = w;
                    }
            }
    }
};
struct EpiGemm1 {
    static constexpr bool PERM = false, AFTER_DRAIN = false;
    const P* pp; int layer;
    DEV void operator()(const f32x4 (&acc)[2][2][4][2], const pg8::Unit& u, int wr, int wc, int fr, int fq) const {
        const int slab = u.pn * 256 + wc * 64; const bool lat = u.pm * 256 < LAT_C;
        if (slab >= 2752) return;
#pragma unroll
        for (int ai = 0; ai < 2; ++ai)
#pragma unroll
            for (int m = 0; m < 4; ++m) {
                f32x4 v[4] = {acc[ai][0][m][0], acc[ai][0][m][1], acc[ai][1][m][0], acc[ai][1][m][1]};
                gemm1_row(v, u.pm * 256 + ai * 128 + wr * 64 + m * 16 + fr, slab, lat, *pp, layer, fq);
            }
    }
};

#define LAS __attribute__((address_space(3)))
#define XB_TMO      128
#define XB_XCNT(j)  (256  + 64 * (j))
#define XB_XSUB(j)  (1280 + 64 * (j))
#define XB_XGEN(j)  (2304 + 64 * (j))
#define XB_TOP      3328
#define XB_TOPGEN   3392
#define XCD_BAR_WORDS 3456
#define XB_SPIN_CAP (1u << 18)

__device__ __forceinline__ unsigned xb_ld(unsigned* p)              { return __hip_atomic_load(p, __ATOMIC_RELAXED, __HIP_MEMORY_SCOPE_AGENT); }
__device__ __forceinline__ unsigned xb_add(unsigned* p, unsigned v) { return __hip_atomic_fetch_add(p, v, __ATOMIC_RELAXED, __HIP_MEMORY_SCOPE_AGENT); }
__device__ __forceinline__ unsigned xb_xcc_id() { return (unsigned)__builtin_amdgcn_s_getreg((3 << 11) | 20) & 0xFu; }
#define XB_SPIN(cond, bar) do { unsigned _sp = 0; while (cond) { __builtin_amdgcn_s_sleep(1); \
    if ((++_sp & 255u) == 0u) { if (xb_ld(&(bar)[XB_TMO])) break; if (_sp > XB_SPIN_CAP) { atomicAdd(&(bar)[XB_TMO], 1u); break; } } } } while (0)

struct XcdBarrier {
    unsigned* bar; unsigned x;
    volatile LAS unsigned* st;
};

__device__ __forceinline__ XcdBarrier xcd_barrier_post(unsigned* bar, volatile LAS unsigned* st) {
    XcdBarrier b; b.bar = bar; b.x = xb_xcc_id(); b.st = st;
    if (threadIdx.x == 0) (void)xb_add(&bar[XB_XCNT(b.x)], 1u);
    return b;
}
__device__ __forceinline__ void xcd_barrier_complete(unsigned* bar, unsigned x, unsigned& nloc, unsigned& nx) {
    const unsigned G = gridDim.x * gridDim.y * gridDim.z;
    unsigned sum, cnt, mine, sp = 0u;
    for (;;) {
        sum = 0u; cnt = 0u; mine = 0u;
#pragma unroll
        for (unsigned j = 0; j < 16; ++j) { const unsigned c = xb_ld(&bar[XB_XCNT(j)]); sum += c; cnt += (c > 0u) ? 1u : 0u; mine = (j == x) ? c : mine; }
        if (sum == G) break;
        __builtin_amdgcn_s_sleep(1);
        if ((++sp & 255u) == 0u) { if (xb_ld(&bar[XB_TMO])) break; if (sp > XB_SPIN_CAP) { atomicAdd(&bar[XB_TMO], 1u); break; } }
    }
    nloc = mine > 0u ? mine : 1u; nx = cnt > 0u ? cnt : 1u;
}

__device__ __forceinline__ void xcd_barrier(const XcdBarrier& b) {
    asm volatile("s_waitcnt vmcnt(0)" ::: "memory");
    __syncthreads();
    if (threadIdx.x == 0) {
        unsigned* bar = b.bar;
        __builtin_amdgcn_s_waitcnt(0);
        unsigned nloc = b.st[0], nx = b.st[1];
        if (nloc == 0u) { xcd_barrier_complete(bar, b.x, nloc, nx); b.st[0] = nloc; b.st[1] = nx; }
        const unsigned old = xb_add(&bar[XB_XSUB(b.x)], 1u);
        const unsigned gen = old / nloc;
        if (old + 1u == (gen + 1u) * nloc) {
            __builtin_amdgcn_fence(__ATOMIC_RELEASE, "agent");
            asm volatile("s_waitcnt vmcnt(0)" ::: "memory");
            const unsigned og = xb_add(&bar[XB_TOP], 1u);
            const unsigned tg = og / nx;
            if (og + 1u == (tg + 1u) * nx) xb_add(&bar[XB_TOPGEN], 1u);
            else XB_SPIN(xb_ld(&bar[XB_TOPGEN]) == tg, bar);
            __builtin_amdgcn_fence(__ATOMIC_ACQUIRE, "agent");
            xb_add(&bar[XB_XGEN(b.x)], 1u);
            asm volatile("s_waitcnt vmcnt(0)" ::: "memory");
        } else {
            XB_SPIN(xb_ld(&bar[XB_XGEN(b.x)]) == gen, bar);
            __builtin_amdgcn_fence(__ATOMIC_ACQUIRE, "agent");
            asm volatile("s_waitcnt vmcnt(0)" ::: "memory");
        }
    }
    __syncthreads();
}

typedef const __attribute__((address_space(4))) P* PP;
#define FRESH_P PP q_ = pp0; asm volatile("" : "+s"(q_)); const P& p = *(const P*)q_;
constexpr int DYN_LDS = 2 * SMEM_BYTES + 64;
__global__ void __launch_bounds__(512, 2) mega(P pv_) {
    cg::grid_group grid = cg::this_grid();
    PP pp0 = (PP)__builtin_amdgcn_kernarg_segment_ptr();
    extern __shared__ __attribute__((aligned(16))) unsigned char lds_dyn[];
    const int half = __builtin_amdgcn_readfirstlane((int)threadIdx.x >> 8);
    unsigned char* smraw = lds_dyn + half * SMEM_BYTES;
    bf16_t* sm = (bf16_t*)smraw;
    PG8_LAS unsigned char* ldsL = (PG8_LAS unsigned char*)lds_dyn;
    const int bid = blockIdx.x, G = gridDim.x, vb = bid * 2 + half, VG = G * 2, tid = threadIdx.x & 255;
    const int xcd_ = bid & 7, slot_ = (bid >> 3) * 2 + half, nslot_ = (G >> 3) * 2;
    const bool xok_ = (G & 7) == 0;
#define XLOOP(N, var) for (int var##u_ = xok_ ? slot_ : vb, var = xok_ ? xcd_ * ((N) >> 3) + slot_ : vb; var##u_ < (xok_ ? ((N) >> 3) : (N)); var##u_ += (xok_ ? nslot_ : VG), var += (xok_ ? nslot_ : VG))
    {
        FRESH_P
        volatile LAS unsigned* xst = (volatile LAS unsigned*)(ldsL + 2 * SMEM_BYTES);
        if (threadIdx.x == 0) { xst[0] = 0u; xst[1] = 0u; }
        __syncthreads();
        const XcdBarrier xb0 = xcd_barrier_post(p.barw, xst);
        if (threadIdx.x == 0) xst[2] = xb0.x;
        __syncthreads();
    }
#define GBAR() do { FRESH_P XcdBarrier b_; b_.bar = p.barw; b_.st = (volatile LAS unsigned*)(ldsL + 2 * SMEM_BYTES); b_.x = b_.st[2]; xcd_barrier(b_); } while (0)

    { FRESH_P
    for (int i = vb * 256 + tid; i < 64 * 16 + 64 * 8; i += VG * 256) {
        if (i < 1024) { const int pos = i >> 4, k = i & 15; const float inv = fexp2(-(float)k * (13.287712379549449f / 16.f)); const float a = (float)pos * inv; p.rt16[i] = (f32x2){__cosf(a), __sinf(a)}; }
        else { const int q = i - 1024; const int pos = q >> 3, k = q & 7; const float inv = fexp2(-(float)k * (13.287712379549449f / 8.f)); const float a = (float)pos * inv; p.rt8[q] = (f32x2){__cosf(a), __sinf(a)}; }
    }
    for (int t = vb; t < 384 + CONV_TILES; t += VG) { if (t < 384) mod_item(p, t, smraw); else conv_job(p, 0, t - 384, (float*)smraw); }
    }
    GBAR();
    { FRESH_P r_phase(p, 0, 0, vb, VG, 0, MTOT); }
    GBAR();

    for (int layer = 0; layer < DEPTH; ++layer) {
        for (int ch = 0; ch < NCH; ++ch) {
            { FRESH_P
              const bf16_t* A = p.U + (size_t)ch * MC * 1024;
              { pg8::Gemm g{A, p.WinT, MC, 2816, 1024}; XSched S{11, 792, G, bid}; EpiGemm1 E{&p, layer};
                pg8::gemm_phase<EpiGemm1, XSched, true, true, false>(ldsL, g, S, E); }
              { pg8::Gemm g{A, p.WinT + (size_t)2816 * 1024, MC, 768, 1024}; XSched S{3, 216, G, (bid + G - (792 % G)) % G}; EpiVT E{p.VT};
                pg8::gemm_phase<EpiVT, XSched, true, true, true>(ldsL, g, S, E); }
              { pg8::Gemm g{A, p.WinT + (size_t)NPROJ * 1024, MC, 4096, 1024}; XSched S{16, 1152, G, (bid + G - (1008 % G)) % G}; EpiGate E{p.G};
                pg8::gemm_phase<EpiGate, XSched, true, true, false>(ldsL, g, S, E); }
            }
            GBAR();
            { FRESH_P
              XLOOP(1024, t) attn_item<2>(p, layer, t, false, smraw);
              XLOOP(1024, t) attn_item<1>(p, layer, t, false, smraw);
              XLOOP(2016, q) stage2_tile(p, q / 14, q % 14, smraw);
              XLOOP(128, t) attn_item<1>(p, layer, t, true, smraw);
              XLOOP(128, t) attn_item<2>(p, layer, t, true, smraw);
              XLOOP(128, t) attn_item<3>(p, layer, t, true, smraw);
            }
            GBAR();
            { FRESH_P
              XLOOP(1024, t) attn_item<0>(p, layer, t, false, smraw);
              XLOOP(1024, t) attn_item<3>(p, layer, t, false, smraw);
              XLOOP(128, t) attn_item<0>(p, layer, t, true, smraw);
            }
            GBAR();
            { FRESH_P XLOOP(2304, t) merge_tile(p, ch, t >> 4, t & 15, sm); }
            GBAR();
            { FRESH_P pg8::Gemm g{p.MB, p.WoutT, MC, 1024, 1024}; XSched S{4, 288, G, bid}; EpiStoreT E{p.YC, 1024, 0};
              pg8::gemm_phase<EpiStoreT, XSched, true, true, false>(ldsL, g, S, E); }
            GBAR();
            { FRESH_P r_phase(p, 1, layer, vb, VG, ch * MC, (ch + 1) * MC); }
            if (ch + 1 == NCH) GBAR();
        }
        { FRESH_P pg8::Gemm g{p.U, p.Wf1T, MTOT, 2 * DFF, 1024}; XSched S{22, 3168, G, bid}; EpiSwiglu E{p.ACT};
          pg8::gemm_phase<EpiSwiglu, XSched, true, true, false>(ldsL, g, S, E); }
        GBAR();
        { FRESH_P pg8::Gemm g{p.ACT, p.Wf2T, MTOT, 1024, DFF}; XSched S{4, 576, G, bid}; EpiStoreT E{p.U, 1024, 0};
          pg8::gemm_phase<EpiStoreT, XSched, true, true, false>(ldsL, g, S, E); }
        GBAR();
        { FRESH_P r_phase(p, 2, layer, vb, VG, 0, MTOT);
          if (layer + 1 < DEPTH) { for (int t = vb; t < CONV_TILES; t += VG) conv_job(p, layer + 1, t, (float*)smraw); } }
        GBAR();
    }
}

extern "C" void kernel_launch(void* const* d_in, const int* in_sizes, int n_in, void* d_out, int out_size, void* d_ws, size_t ws_size, hipStream_t stream) {
    static int grid_blocks = 0;
    if (!grid_blocks) {
        int dev = 0, cus = 0, per_cu = 0;
        (void)hipGetDevice(&dev);
        (void)hipDeviceGetAttribute(&cus, hipDeviceAttributeMultiprocessorCount, dev);
        if (hipFuncSetAttribute((const void*)mega, hipFuncAttributeMaxDynamicSharedMemorySize, DYN_LDS) != hipSuccess) fprintf(stderr, "hipFuncSetAttribute failed\n");
        (void)hipOccupancyMaxActiveBlocksPerMultiprocessor(&per_cu, mega, 512, DYN_LDS);
        grid_blocks = cus;
    }
    P p{};
    const float** f = (const float**)&p;
    for (int i = 0; i < 23; ++i) f[i] = (const float*)d_in[i];
    p.out = (float*)d_out;
    unsigned char* w = (unsigned char*)d_ws; size_t off = 0;
    auto take = [&](size_t bytes) { void* r = w + off; off += (bytes + 255) & ~(size_t)255; return r; };
    p.WinT = (bf16_t*)take((size_t)NWIN * 1024 * 2);
    p.WuqT = (bf16_t*)take((size_t)768 * 256 * 2);
    p.WukvT = (bf16_t*)take((size_t)1024 * 128 * 2);
    p.WbrT = (bf16_t*)take((size_t)4 * 1024 * 512 * 2);
    p.WoutT = (bf16_t*)take((size_t)1024 * 1024 * 2);
    p.Wf1T = (bf16_t*)take((size_t)2 * DFF * 1024 * 2);
    p.Wf2T = (bf16_t*)take((size_t)1024 * DFF * 2);
    p.mod = (float*)take((size_t)DEPTH * 17 * 6144 * 4);
    p.rt16 = (f32x2*)take(64 * 16 * 8);
    p.rt8 = (f32x2*)take(64 * 8 * 8);
    p.hc = (float*)take((size_t)NBATCH * CTX * 1024 * 4);
    p.U = (bf16_t*)take((size_t)MTOT * 1024 * 2);
    p.G = (unsigned char*)take((size_t)MC * 4096);
    p.barw = (unsigned*)take((size_t)XCD_BAR_WORDS * 4);
    unsigned char* R = (unsigned char*)take(0);
    p.PJ = (bf16_t*)take((size_t)MC * PJLD * 2);
    p.QA = (bf16_t*)take((size_t)MC * 768 * 2);
    p.KN = (bf16_t*)take((size_t)MC * 512 * 2);
    p.VT = (bf16_t*)take((size_t)VTROWS * MC * 2);
    p.O = (bf16_t*)take((size_t)MC * 2048 * 2);
    p.YC = p.O;
    p.MB = p.PJ;
    p.ACT = (bf16_t*)R;
    if (off > ws_size) { fprintf(stderr, "workspace too small: need %zu have %zu\n", off, ws_size); return; }
    (void)hipMemsetAsync(p.barw, 0, (size_t)XCD_BAR_WORDS * 4, stream);
    void* args[] = {&p};
    hipError_t e = hipLaunchCooperativeKernel((void*)mega, dim3(grid_blocks), dim3(512), args, DYN_LDS, stream);
    if (e != hipSuccess) fprintf(stderr, "cooperative launch failed: %s (grid %d)\n", hipGetErrorString(e), grid_blocks);
}
```

```cpp
#include <hip/hip_runtime.h>
#include <hip/hip_cooperative_groups.h>
#include <cstdio>
#include <cstdint>
namespace cg = cooperative_groups;

typedef unsigned short bf16_t;
typedef short bf16x8 __attribute__((ext_vector_type(8)));
typedef short bf16x4 __attribute__((ext_vector_type(4)));
typedef float f32x4 __attribute__((ext_vector_type(4)));
typedef float f32x2 __attribute__((ext_vector_type(2)));
typedef unsigned u32x2 __attribute__((ext_vector_type(2)));
typedef unsigned u32x4 __attribute__((ext_vector_type(4)));
#define DEV __device__ __forceinline__

constexpr int DM = 1024, NBATCH = 16, SEQ = 2048, CTX = 256, DEPTH = 4;
constexpr int NCH = 2, BPC = NBATCH / NCH, LAT_C = BPC * SEQ, CTX_C = BPC * CTX, MC = LAT_C + CTX_C, MTOT = MC * NCH;
constexpr int INC = 7584, NPROJ = 3584, NWIN = 7680, PJLD = 2816, DFF = 2816, VTROWS = 1280;
#ifndef REP_G
#define REP_G 1
#endif
#ifndef REP_M
#define REP_M 1
#endif
#ifndef REP_A
#define REP_A 1
#endif
constexpr float LOG2E = 1.4426950408889634f;
constexpr int LST = 72;
constexpr int TILE_E = 128 * LST;
constexpr int SMEM_BYTES = 4 * TILE_E * 2 + 1024;

struct P {
    const float *x, *c, *ctx, *c_ctx, *w_mod, *b_mod, *g_pre_mix, *g_post_mix, *g_pre_ffn, *g_post_ffn, *w_in, *g_a_q, *g_a_kv,
        *w_a_uq, *w_a_ukv, *sink_b, *rpb_c, *g_d_q, *g_d_k, *w_branch, *w_out, *w_ffn_in, *w_ffn_out;
    float* out;
    bf16_t *WinT, *WuqT, *WukvT, *WbrT, *WoutT, *Wf1T, *Wf2T;
    float* mod; f32x2 *rt16, *rt8; float* hc;
    bf16_t *U, *YC, *PJ, *QA, *KN, *VT, *O, *MB, *ACT;
    unsigned char* G;
    unsigned* barw;
};

typedef __bf16 bf16v2 __attribute__((ext_vector_type(2)));
DEV unsigned pk_bf16(float lo, float hi) { bf16v2 v = __builtin_convertvector((f32x2){lo, hi}, bf16v2); return __builtin_bit_cast(unsigned, v); }
DEV float bf2f(unsigned short v) { return __uint_as_float(((unsigned)v) << 16); }
DEV void store4(bf16_t* p, f32x4 v) { u32x2 w; w.x = pk_bf16(v[0], v[1]); w.y = pk_bf16(v[2], v[3]); *(u32x2*)p = w; }
DEV float fexp2(float x) { return __builtin_amdgcn_exp2f(x); }
DEV float frcp(float x) { return __builtin_amdgcn_rcpf(x); }
DEV float wave_sum(float v) {
    v += __shfl_xor(v, 1); v += __shfl_xor(v, 2); v += __shfl_xor(v, 4); v += __shfl_xor(v, 8); v += __shfl_xor(v, 16); v += __shfl_xor(v, 32); return v;
}
DEV int ltid() { int t = threadIdx.x & 255; asm volatile("" : "+v"(t)); return t; }
DEV int uni(int v) { return __builtin_amdgcn_readfirstlane(v); }
DEV float xmax16(float x) { auto r = __builtin_amdgcn_permlane16_swap(__float_as_uint(x), __float_as_uint(x), false, false); return fmaxf(__uint_as_float(r[0]), __uint_as_float(r[1])); }
DEV float xmax32(float x) { auto r = __builtin_amdgcn_permlane32_swap(__float_as_uint(x), __float_as_uint(x), false, false); return fmaxf(__uint_as_float(r[0]), __uint_as_float(r[1])); }
DEV float xadd16(float x) { auto r = __builtin_amdgcn_permlane16_swap(__float_as_uint(x), __float_as_uint(x), false, false); return __uint_as_float(r[0]) + __uint_as_float(r[1]); }
DEV float xadd32(float x) { auto r = __builtin_amdgcn_permlane32_swap(__float_as_uint(x), __float_as_uint(x), false, false); return __uint_as_float(r[0]) + __uint_as_float(r[1]); }
DEV f32x4 mfma16(bf16x8 a, bf16x8 b, f32x4 c) { return __builtin_amdgcn_mfma_f32_16x16x32_bf16(a, b, c, 0, 0, 0); }

template <int NFT, bool SWAP>
DEV void gemm_mainloop(const bf16_t* __restrict__ A, int lda, const bf16_t* __restrict__ Bt, int ldb, int K, f32x4 (&acc)[NFT][4], bf16_t* sm) {
    const int tid = ltid(), lane = tid & 63, wid = uni(tid >> 6), wm = wid & 1, wn = wid >> 1, fr = lane & 15, fq = lane >> 4;
    bf16_t* sA = sm; bf16_t* sB = sm + 2 * TILE_E;
    const int lrow = tid >> 3, lc8 = (tid & 7) * 8;
    const bf16_t* ga = A + (size_t)lrow * lda + lc8;
    const bf16_t* gb = Bt + (size_t)lrow * ldb + lc8;
    u32x4 ra[4], rb[NFT];
#pragma unroll
    for (int ft = 0; ft < NFT; ++ft)
#pragma unroll
        for (int tt = 0; tt < 4; ++tt) acc[ft][tt] = (f32x4){0.f, 0.f, 0.f, 0.f};
#pragma unroll
    for (int i = 0; i < 4; ++i) ra[i] = *(const u32x4*)(ga + (size_t)(i * 32) * lda);
#pragma unroll
    for (int i = 0; i < NFT; ++i) rb[i] = *(const u32x4*)(gb + (size_t)(i * 32) * ldb);
#pragma unroll
    for (int i = 0; i < 4; ++i) *(u32x4*)(sA + (lrow + i * 32) * LST + lc8) = ra[i];
#pragma unroll
    for (int i = 0; i < NFT; ++i) *(u32x4*)(sB + (lrow + i * 32) * LST + lc8) = rb[i];
    const int nk = K >> 6;
    if (nk > 1) {
#pragma unroll
        for (int i = 0; i < 4; ++i) ra[i] = *(const u32x4*)(ga + (size_t)(i * 32) * lda + 64);
#pragma unroll
        for (int i = 0; i < NFT; ++i) rb[i] = *(const u32x4*)(gb + (size_t)(i * 32) * ldb + 64);
    }
    __syncthreads();
    for (int kt = 0; kt < nk; ++kt) {
        const int cur = kt & 1;
        if (kt + 1 < nk) {
            const int nx = cur ^ 1;
#pragma unroll
            for (int i = 0; i < 4; ++i) *(u32x4*)(sA + nx * TILE_E + (lrow + i * 32) * LST + lc8) = ra[i];
#pragma unroll
            for (int i = 0; i < NFT; ++i) *(u32x4*)(sB + nx * TILE_E + (lrow + i * 32) * LST + lc8) = rb[i];
        }
        if (kt + 2 < nk) {
            const int ko = (kt + 2) * 64;
#pragma unroll
            for (int i = 0; i < 4; ++i) ra[i] = *(const u32x4*)(ga + (size_t)(i * 32) * lda + ko);
#pragma unroll
            for (int i = 0; i < NFT; ++i) rb[i] = *(const u32x4*)(gb + (size_t)(i * 32) * ldb + ko);
        }
        __builtin_amdgcn_sched_barrier(0);
        const bf16_t* cA = sA + cur * TILE_E + (wm * 64 + fr) * LST + fq * 8;
        const bf16_t* cB = sB + cur * TILE_E + (wn * NFT * 16 + fr) * LST + fq * 8;
#pragma unroll
        for (int ks = 0; ks < 2; ++ks) {
            bf16x8 af[4], wf[NFT];
#pragma unroll
            for (int tt = 0; tt < 4; ++tt) af[tt] = *(const bf16x8*)(cA + tt * 16 * LST + ks * 32);
#pragma unroll
            for (int ft = 0; ft < NFT; ++ft) wf[ft] = *(const bf16x8*)(cB + ft * 16 * LST + ks * 32);
#pragma unroll
            for (int ft = 0; ft < NFT; ++ft)
#pragma unroll
                for (int tt = 0; tt < 4; ++tt) acc[ft][tt] = SWAP ? mfma16(af[tt], wf[ft], acc[ft][tt]) : mfma16(wf[ft], af[tt], acc[ft][tt]);
        }
        __syncthreads();
    }
}

DEV bool tile_xcd(int q, int x, int nM, int nN, int& m, int& n) {
    const int j = q >> 5, w = q & 31;
    const int pp = (((j >> 1) * 8 + x) << 1) + (j & 1);
    const int npn = nN >> 2;
    if (pp >= (nM >> 3) * npn) return false;
    const int pm = pp / npn, pn = pp - pm * npn;
    m = pm * 8 + (w & 7); n = pn * 4 + (w >> 3);
    return true;
}
#define TILE_LOOP(nM, nN) const int x_ = bid & 7, spx_ = G >> 3; int mt, nt; for (int q_ = bid >> 3; tile_xcd(q_, x_, nM, nN, mt, nt); q_ += spx_)

DEV int srccol(int mapid, int n) {
    switch (mapid) {
    case 0:
        if (n < 2816) { const int rho = n & 255; n = (n & ~255) + ((rho >> 5) & 3) * 64 + (rho >> 7) * 32 + (rho & 31); }
        if (n < 384) return n;
        if (n < 896) return n - 384 + 416;
        if (n < 1024) return n - 896 + 928;
        if (n < 1536) return n - 1024 + 1184;
        if (n < 2048) return n - 1536 + 1696;
        if (n < 2560) return n - 2048 + 2720;
        if (n < 2688) return n - 2560 + 3232;
        if (n < 2720) return n - 2688 + 384;
        if (n < 2816) return -1;
        if (n < 2944) return n - 2816 + 1056;
        if (n < 3456) return n - 2944 + 2208;
        if (n < 3584) return n - 3456 + 3360;
        return n - 3584 + 3488;
    case 1: if (n < 512) return (n >> 6) * 96 + (n & 63); { const int q = n - 512; return (q >> 5) * 96 + 64 + (q & 31); }
    case 2: if (n < 512) return (n >> 6) * 128 + (n & 63); { const int q = n - 512; return (q >> 6) * 128 + 64 + (q & 63); }
    case 4: { const int pn = n >> 8, bj = (n >> 7) & 1, wc = (n >> 5) & 3, s = (n >> 4) & 1, f = n & 15; return s * DFF + pn * 128 + bj * 64 + wc * 16 + f; }
    default: return n;
    }
}
DEV void conv_tile(const float* __restrict__ src, int lds_, int K, bf16_t* __restrict__ dst, int n0, int k0, int mapid, const float* rowscale, float* st) {
    const int tid = ltid();
    {
        const int n = tid & 63, kk = tid >> 6; const int sc_ = srccol(mapid, n0 + n);
#pragma unroll
        for (int i = 0; i < 16; ++i) {
            const int k = kk * 16 + i;
            float v = sc_ >= 0 ? src[(size_t)(k0 + k) * lds_ + sc_] : 0.f;
            if (rowscale) v *= rowscale[k0 + k];
            st[k * 65 + n] = v;
        }
    }
    __syncthreads();
    {
        const int n = tid >> 2, kq = tid & 3; u32x4 w0, w1;
        const float* s = st + (kq * 16) * 65 + n;
        w0.x = pk_bf16(s[0 * 65], s[1 * 65]); w0.y = pk_bf16(s[2 * 65], s[3 * 65]); w0.z = pk_bf16(s[4 * 65], s[5 * 65]); w0.w = pk_bf16(s[6 * 65], s[7 * 65]);
        w1.x = pk_bf16(s[8 * 65], s[9 * 65]); w1.y = pk_bf16(s[10 * 65], s[11 * 65]); w1.z = pk_bf16(s[12 * 65], s[13 * 65]); w1.w = pk_bf16(s[14 * 65], s[15 * 65]);
        bf16_t* d = dst + (size_t)(n0 + n) * K + k0 + kq * 16;
        *(u32x4*)d = w0; *(u32x4*)(d + 8) = w1;
    }
    __syncthreads();
}
constexpr int CONV_TILES = 4880;
DEV void conv_job(const P& p, int layer, int t, float* st) {
    if (t < 1920) { conv_tile(p.w_in + (size_t)layer * DM * INC, INC, 1024, p.WinT, (t >> 4) * 64, (t & 15) * 64, 0, nullptr, st); return; }
    t -= 1920;
    if (t < 48) { conv_tile(p.w_a_uq + (size_t)layer * 256 * 768, 768, 256, p.WuqT, (t >> 2) * 64, (t & 3) * 64, 1, p.g_a_q + layer * 256, st); return; }
    t -= 48;
    if (t < 32) { conv_tile(p.w_a_ukv + (size_t)layer * 128 * 1024, 1024, 128, p.WukvT, (t >> 1) * 64, (t & 1) * 64, 2, p.g_a_kv + layer * 128, st); return; }
    t -= 32;
    if (t < 512) { const int n = t >> 7, r = t & 127; conv_tile(p.w_branch + ((size_t)layer * 4 + n) * 512 * 1024, 1024, 512, p.WbrT + (size_t)n * 1024 * 512, (r >> 3) * 64, (r & 7) * 64, 3, nullptr, st); return; }
    t -= 512;
    if (t < 256) { conv_tile(p.w_out + (size_t)layer * 1024 * 1024, 1024, 1024, p.WoutT, (t >> 4) * 64, (t & 15) * 64, 3, nullptr, st); return; }
    t -= 256;
    if (t < 1408) { conv_tile(p.w_ffn_in + (size_t)layer * 1024 * 2 * DFF, 2 * DFF, 1024, p.Wf1T, (t >> 4) * 64, (t & 15) * 64, 4, nullptr, st); return; }
    t -= 1408;
    { const int nt = t / 44, kt = t - nt * 44; conv_tile(p.w_ffn_out + (size_t)layer * DFF * 1024, 1024, DFF, p.Wf2T, nt * 64, kt * 64, 3, nullptr, st); }
}

DEV void mod_item(const P& p, int item, unsigned char* smraw) {
    const int tid = ltid(), lane = tid & 63, wid = uni(tid >> 6);
    float* sc = (float*)smraw;
    const int l = item / 96, cgp = item - l * 96;
    for (int i = tid; i < 17 * 1024; i += 256) {
        const int r = i >> 10, k = i & 1023; const float v = r < 16 ? p.c[r * 1024 + k] : p.c_ctx[k];
        sc[i] = v * frcp(1.f + fexp2(-v * LOG2E));
    }
    __syncthreads();
    float acc[17];
#pragma unroll
    for (int r = 0; r < 17; ++r) acc[r] = 0.f;
    const float* w = p.w_mod + ((size_t)l * 1024 + wid * 256) * 6144 + cgp * 64 + lane;
    for (int k = 0; k < 256; k += 4) {
        const float w0 = w[(size_t)k * 6144], w1 = w[(size_t)(k + 1) * 6144], w2 = w[(size_t)(k + 2) * 6144], w3 = w[(size_t)(k + 3) * 6144];
#pragma unroll
        for (int r = 0; r < 17; ++r) { const f32x4 s = *(const f32x4*)(sc + r * 1024 + wid * 256 + k); acc[r] += s[0] * w0 + s[1] * w1 + s[2] * w2 + s[3] * w3; }
    }
    __syncthreads();
    float* red = (float*)smraw;
#pragma unroll
    for (int r = 0; r < 17; ++r) red[(wid * 17 + r) * 64 + lane] = acc[r];
    __syncthreads();
    for (int i = tid; i < 17 * 64; i += 256) {
        const int r = i >> 6, ci = i & 63;
        const float v = red[(0 * 17 + r) * 64 + ci] + red[(1 * 17 + r) * 64 + ci] + red[(2 * 17 + r) * 64 + ci] + red[(3 * 17 + r) * 64 + ci] + p.b_mod[l * 6144 + cgp * 64 + ci];
        p.mod[((size_t)l * 17 + r) * 6144 + cgp * 64 + ci] = v;
    }
    __syncthreads();
}

DEV void r_phase(const P& p, int mode, int layer, int vb, int VG, int g_lo, int g_hi) {
    const int tid_ = ltid(), lane = tid_ & 63, wid = uni(tid_ >> 6);
    const int nw = VG * 4;
    for (int g = g_lo + vb * 4 + wid; g < g_hi; g += nw) {
        const int ch = g / MC, local = g - ch * MC;
        const float* hin; float* hout; const float* mod;
        if (local < LAT_C) {
            const int idx = ch * LAT_C + local; const int b = idx >> 11;
            hin = (mode == 0 ? p.x : p.out) + (size_t)idx * 1024; hout = p.out + (size_t)idx * 1024; mod = p.mod + ((size_t)layer * 17 + b) * 6144;
        } else {
            const int idx = ch * CTX_C + local - LAT_C;
            hin = (mode == 0 ? p.ctx : p.hc) + (size_t)idx * 1024; hout = p.hc + (size_t)idx * 1024; mod = p.mod + ((size_t)layer * 17 + 16) * 6144;
        }
        f32x4 h[4];
#pragma unroll
        for (int i = 0; i < 4; ++i) h[i] = *(const f32x4*)(hin + (i * 64 + lane) * 4);
        if (mode != 0) {
            f32x4 y[4]; float ss = 0.f;
#pragma unroll
            for (int i = 0; i < 4; ++i) {
                const u32x2 w = *(const u32x2*)((mode == 1 ? p.YC + (size_t)local * 1024 : p.U + (size_t)g * 1024) + (i * 64 + lane) * 4);
                y[i] = (f32x4){__uint_as_float(w.x << 16), __uint_as_float(w.x & 0xffff0000u), __uint_as_float(w.y << 16), __uint_as_float(w.y & 0xffff0000u)};
                ss += y[i][0] * y[i][0] + y[i][1] * y[i][1] + y[i][2] * y[i][2] + y[i][3] * y[i][3];
            }
            ss = wave_sum(ss);
            const float rs = rsqrtf(ss * (1.f / 1024.f) + 1e-6f);
            const float* gp = (mode == 1 ? p.g_post_mix : p.g_post_ffn) + layer * 1024;
            const float* ga = mod + (mode == 1 ? 2048 : 5120);
#pragma unroll
            for (int i = 0; i < 4; ++i) {
                const f32x4 gg = *(const f32x4*)(gp + (i * 64 + lane) * 4), aa = *(const f32x4*)(ga + (i * 64 + lane) * 4);
                h[i] = h[i] + aa * (y[i] * rs * gg);
            }
        }
#pragma unroll
        for (int i = 0; i < 4; ++i) *(f32x4*)(hout + (i * 64 + lane) * 4) = h[i];
        const int nl = (mode == 2) ? layer + 1 : layer;
        if (nl < DEPTH) {
            float ss = 0.f;
#pragma unroll
            for (int i = 0; i < 4; ++i) ss += h[i][0] * h[i][0] + h[i][1] * h[i][1] + h[i][2] * h[i][2] + h[i][3] * h[i][3];
            ss = wave_sum(ss);
            const float rs = rsqrtf(ss * (1.f / 1024.f) + 1e-6f);
            const float* gpre = (mode == 1 ? p.g_pre_ffn : p.g_pre_mix) + nl * 1024;
            const float* modn = (mode == 2) ? mod + 17 * 6144 : mod;
            const float* sh = modn + (mode == 1 ? 3072 : 0);
            const float* sc = modn + (mode == 1 ? 4096 : 1024);
#pragma unroll
            for (int i = 0; i < 4; ++i) {
                const int e = (i * 64 + lane) * 4;
                const f32x4 gg = *(const f32x4*)(gpre + e), s1 = *(const f32x4*)(sc + e), s0 = *(const f32x4*)(sh + e);
                const f32x4 u = h[i] * rs * gg * (s1 + 1.f) + s0;
                store4(p.U + (size_t)g * 1024 + e, u);
            }
        }
    }
}

DEV void gemm1_row(f32x4 (&v)[4], int row, int slab, bool lat, const P& p, int layer, int fq) {
    const bool hnorm = (slab >= 2048 && slab < 2688);
    const bool rope64 = lat && ((slab >= 384 && slab < 1024) || hnorm);
    const bool isq = (slab >= 384 && slab < 896) || (slab >= 1024 && slab < 1536) || (slab >= 2048 && slab < 2560);
    const float sc = isq ? 0.125f * LOG2E : 1.f;
    const bool kr = (slab == 2688);
    const int tok = row & 2047; const int pr = tok >> 6, pc = tok & 63;
    if (hnorm) {
        float ss = 0.f;
#pragma unroll
        for (int ft = 0; ft < 4; ++ft) ss += v[ft][0] * v[ft][0] + v[ft][1] * v[ft][1] + v[ft][2] * v[ft][2] + v[ft][3] * v[ft][3];
        ss += __shfl_xor(ss, 16); ss += __shfl_xor(ss, 32);
        const float rs = rsqrtf(ss * (1.f / 64.f) + 1e-6f);
        const float* g = (slab < 2560 ? p.g_d_q : p.g_d_k) + layer * 64;
#pragma unroll
        for (int ft = 0; ft < 4; ++ft) { const f32x4 gg = *(const f32x4*)(g + ft * 16 + fq * 4); v[ft] = v[ft] * rs * gg; }
    }
    if (rope64) {
#pragma unroll
        for (int j = 0; j < 4; ++j) {
            const int i = fq * 4 + j;
            f32x2 cs = p.rt16[pr * 16 + i]; float a = v[0][j], b = v[1][j];
            v[0][j] = a * cs[0] - b * cs[1]; v[1][j] = b * cs[0] + a * cs[1];
            cs = p.rt16[pc * 16 + i]; a = v[2][j]; b = v[3][j];
            v[2][j] = a * cs[0] - b * cs[1]; v[3][j] = b * cs[0] + a * cs[1];
        }
    }
    if (kr && lat) {
#pragma unroll
        for (int ft = 0; ft < 2; ++ft) {
            const int pos = ft == 0 ? pr : pc;
#pragma unroll
            for (int j = 0; j < 4; ++j) {
                const int i = (fq & 1) * 4 + j; const f32x2 cs = p.rt8[pos * 8 + i];
                const float xv = v[ft][j]; const float o = __shfl_xor(xv, 32);
                v[ft][j] = fq < 2 ? xv * cs[0] - o * cs[1] : xv * cs[0] + o * cs[1];
            }
        }
    }
    bf16_t* dst = p.PJ + (size_t)row * PJLD + slab + fq * 4;
    store4(dst, v[0] * sc); store4(dst + 16, v[1] * sc);
    if (!kr) { store4(dst + 32, v[2] * sc); store4(dst + 48, v[3] * sc); }
}
DEV void stage2_tile(const P& p, int mt, int j, unsigned char* smraw) {
    bf16_t* sm = (bf16_t*)smraw; float* s_rs = (float*)(smraw + 73728);
    const int tid = ltid(), lane = tid & 63, wid = uni(tid >> 6), wm = wid & 1, wn = wid >> 1, fr = lane & 15, fq = lane >> 4;
    const int m0 = mt * 128; const bool isq = j < 6; const bool lat = m0 < LAT_C;
    const int K = isq ? 256 : 128; const int acol = isq ? 0 : 256;
    {
        const int r = tid >> 1, hf = tid & 1; const int n = K >> 1;
        const bf16_t* src = p.PJ + (size_t)(m0 + r) * PJLD + acol + hf * n; float ss = 0.f;
        for (int i = 0; i < n; i += 8) {
            const u32x4 w = *(const u32x4*)(src + i);
#pragma unroll
            for (int q = 0; q < 4; ++q) { const float a = __uint_as_float(w[q] << 16), b = __uint_as_float(w[q] & 0xffff0000u); ss += a * a + b * b; }
        }
        ss += __shfl_xor(ss, 1);
        if (hf == 0) s_rs[r] = rsqrtf(ss / (float)K + 1e-6f);
    }
    __syncthreads();
    f32x4 acc[4][4];
    const bf16_t* A = p.PJ + (size_t)m0 * PJLD + acol;
    if (isq) {
        const int n0 = j * 128;
        gemm_mainloop<4, false>(A, PJLD, p.WuqT + (size_t)n0 * 256, 256, 256, acc, sm);
        const int slab = n0 + wn * 64; const float qs = 0.10206207261596577f * LOG2E;
#pragma unroll
        for (int tt = 0; tt < 4; ++tt) {
            const int lr = wm * 64 + tt * 16 + fr; const int row = m0 + lr; const float rs = s_rs[lr] * qs;
            const int tok = row & 2047; const int pr = tok >> 6, pc = tok & 63;
            f32x4 v[4] = {acc[0][tt], acc[1][tt], acc[2][tt], acc[3][tt]};
            if (slab >= 512 && lat) {
#pragma unroll
                for (int ft = 0; ft < 4; ++ft) {
                    const int pos = (ft & 1) == 0 ? pr : pc;
#pragma unroll
                    for (int jj = 0; jj < 4; ++jj) {
                        const int i = (fq & 1) * 4 + jj; const f32x2 cs = p.rt8[pos * 8 + i];
                        const float xv = v[ft][jj]; const float o = __shfl_xor(xv, 32);
                        v[ft][jj] = fq < 2 ? xv * cs[0] - o * cs[1] : xv * cs[0] + o * cs[1];
                    }
                }
            }
            bf16_t* dst = p.QA + (size_t)row * 768 + slab + fq * 4;
#pragma unroll
            for (int ft = 0; ft < 4; ++ft) store4(dst + ft * 16, v[ft] * rs);
        }
    } else {
        const int n0 = (j - 6) * 128;
        if (n0 < 512) {
            gemm_mainloop<4, false>(A, PJLD, p.WukvT + (size_t)n0 * 128, 128, 128, acc, sm);
#pragma unroll
            for (int tt = 0; tt < 4; ++tt) {
                const int lr = wm * 64 + tt * 16 + fr; const float rs = s_rs[lr];
                bf16_t* dst = p.KN + (size_t)(m0 + lr) * 512 + n0 + wn * 64 + fq * 4;
#pragma unroll
                for (int ft = 0; ft < 4; ++ft) store4(dst + ft * 16, acc[ft][tt] * rs);
            }
        } else {
            gemm_mainloop<4, true>(A, PJLD, p.WukvT + (size_t)n0 * 128, 128, 128, acc, sm);
            const int vrow0 = 768 + (n0 - 512) + wn * 64;
#pragma unroll
            for (int tt = 0; tt < 4; ++tt) {
                const int lr = wm * 64 + tt * 16 + fq * 4;
                const f32x4 rs = *(const f32x4*)(s_rs + lr);
#pragma unroll
                for (int ft = 0; ft < 4; ++ft) store4(p.VT + (size_t)(vrow0 + ft * 16 + fr) * MC + m0 + lr, acc[ft][tt] * rs);
            }
        }
    }
    __syncthreads();
}

template <int MODE>
DEV void attn_item(const P& p, int layer, int item, bool ctxq, unsigned char* smraw) {
    constexpr bool GQA = (MODE == 1 || MODE == 3);
    constexpr int DQK = (MODE == 0) ? 96 : 64, NKS = DQK / 32, KST = DQK + 8;
    constexpr int KS_E = 64 * 104, VS_E = 64 * 72;
    bf16_t* Ks = (bf16_t*)smraw; bf16_t* Vs = Ks + 2 * KS_E; float* bias_s = (float*)(smraw + (2 * KS_E + 2 * VS_E) * 2);
    const int tid = ltid(), lane = tid & 63, wid = uni(tid >> 6), fr = lane & 15, fq = lane >> 4;
    const int nqt = ctxq ? (GQA ? 8 : 2) : (GQA ? 64 : 16);
    const int nh = GQA ? 2 : 8;
    const int qt = item % nqt, hh = (item / nqt) % nh, lb = item / (nqt * nh);
    const int head = GQA ? hh * 4 + wid : hh;
    const int tok0 = GQA ? qt * 32 : qt * 128 + wid * 32;
    const int qrow0 = (ctxq ? LAT_C + lb * CTX : lb * SEQ) + tok0;
    bf16x8 qf[2][NKS];
#pragma unroll
    for (int q = 0; q < 2; ++q) {
        const int row = qrow0 + q * 16 + fr;
        if (MODE == 0) {
            qf[q][0] = *(const bf16x8*)(p.QA + (size_t)row * 768 + head * 64 + fq * 8);
            qf[q][1] = *(const bf16x8*)(p.QA + (size_t)row * 768 + head * 64 + 32 + fq * 8);
            qf[q][NKS - 1] = *(const bf16x8*)(p.QA + (size_t)row * 768 + 512 + head * 32 + fq * 8);
        } else {
            const int qoff = MODE == 1 ? 384 : (MODE == 2 ? 1024 : 2048);
#pragma unroll
            for (int ks = 0; ks < NKS; ++ks) qf[q][ks] = *(const bf16x8*)(p.PJ + (size_t)row * PJLD + qoff + head * 64 + ks * 32 + fq * 8);
        }
    }
    const int koff = MODE == 1 ? 896 + hh * 64 : (MODE == 2 ? 1536 + hh * 64 : 2560 + hh * 64);
    const int vrow0 = MODE == 0 ? 768 + hh * 64 : (MODE == 1 ? hh * 64 : (MODE == 2 ? 128 + hh * 64 : 640 + hh * 64));
    int ktlo = 0, nlat = 0;
    if (!ctxq) {
        if (MODE == 0 || MODE == 3) { ktlo = 0; nlat = 32; }
        else if (MODE == 1) { const int q0 = qt * 32; const int lo = max(0, q0 - 128), hi = min(SEQ - 1, q0 + 159); ktlo = lo >> 6; nlat = (hi >> 6) - ktlo + 1; }
        else { const int r0a = min(max(2 * qt - 4, 0), 24), r0b = min(max(2 * qt + 1 - 4, 0), 24); ktlo = r0a; nlat = r0b + 8 - r0a; }
    }
    const int nt = 4 + nlat;
    const int ntf = ctxq ? 4 : ((MODE == 0 || MODE == 3) ? 36 : (MODE == 1 ? 9 : 13));
    if (MODE == 2 && !ctxq) { for (int i = tid; i < 465; i += 256) bias_s[i] = p.rpb_c[(layer * 8 + hh) * 465 + i] * LOG2E; }

    u32x4 rk[NKS], rv[2];
    auto tile_krow = [&](int it) { it = min(it, nt - 1); return it < 4 ? LAT_C + lb * CTX + it * 64 : lb * SEQ + (ktlo + it - 4) * 64; };
    auto gload = [&](int it) {
        const int krow = tile_krow(it);
#pragma unroll
        for (int i = 0; i < NKS; ++i) {
            const int id = tid + i * 256;
            if (MODE == 0) {
                const int key = id / 12, c = id - key * 12;
                const bf16_t* src = c < 8 ? p.KN + (size_t)(krow + key) * 512 + hh * 64 + c * 8 : p.PJ + (size_t)(krow + key) * PJLD + 2688 + (c - 8) * 8;
                rk[i] = *(const u32x4*)src;
            } else {
                const int key = id >> 3, c = id & 7;
                rk[i] = *(const u32x4*)(p.PJ + (size_t)(krow + key) * PJLD + koff + c * 8);
            }
        }
#pragma unroll
        for (int i = 0; i < 2; ++i) { const int id = tid + i * 256; const int dv = id >> 3, c = id & 7; rv[i] = *(const u32x4*)(p.VT + (size_t)(vrow0 + dv) * MC + krow + c * 8); }
    };
    auto lstore = [&](int buf) {
#pragma unroll
        for (int i = 0; i < NKS; ++i) {
            const int id = tid + i * 256; int key, c;
            if (MODE == 0) { key = id / 12; c = id - key * 12; } else { key = id >> 3; c = id & 7; }
            *(u32x4*)(Ks + buf * KS_E + key * KST + c * 8) = rk[i];
        }
#pragma unroll
        for (int i = 0; i < 2; ++i) { const int id = tid + i * 256; const int dv = id >> 3, c = id & 7; *(u32x4*)(Vs + buf * VS_E + dv * 72 + c * 8) = rv[i]; }
    };

    f32x4 o[4][2]; float mrun[2], lsum[2];
#pragma unroll
    for (int q = 0; q < 2; ++q) { mrun[q] = -1e30f; lsum[q] = 0.f;
#pragma unroll
        for (int d = 0; d < 4; ++d) o[d][q] = (f32x4){0.f, 0.f, 0.f, 0.f}; }

    gload(0); lstore(0); gload(1); __syncthreads();
    for (int it = 0; it < ntf; ++it) {
        const int cur = it & 1;
        if (it + 1 < ntf) lstore(cur ^ 1);
        if (it + 2 < ntf) gload(it + 2);
        __builtin_amdgcn_sched_barrier(0);
        const int kt = ktlo + it - 4;
        bool active = it < nt;
        int r = 0, r0 = 0;
        if (MODE == 2 && !ctxq && it >= 4) { r = 2 * qt + (wid >> 1); r0 = min(max(r - 4, 0), 24); active = active && (kt >= r0 && kt < r0 + 8); }
        if (active) {
            f32x4 s[4][2];
            const bf16_t* kb = Ks + cur * KS_E + fr * KST + fq * 8;
            bf16x8 kf[4][NKS];
#pragma unroll
            for (int k4 = 0; k4 < 4; ++k4)
#pragma unroll
                for (int ks = 0; ks < NKS; ++ks) kf[k4][ks] = *(const bf16x8*)(kb + k4 * 16 * KST + ks * 32);
            __builtin_amdgcn_sched_barrier(0);
#pragma unroll
            for (int k4 = 0; k4 < 4; ++k4) {
#pragma unroll
                for (int q = 0; q < 2; ++q) s[k4][q] = (f32x4){0.f, 0.f, 0.f, 0.f};
#pragma unroll
                for (int ks = 0; ks < NKS; ++ks)
#pragma unroll
                    for (int q = 0; q < 2; ++q) s[k4][q] = mfma16(kf[k4][ks], qf[q][ks], s[k4][q]);
            }
            const bf16_t* vb = Vs + cur * VS_E + fr * 72 + fq * 4;
            bf16x8 vf[4][2];
#pragma unroll
            for (int d = 0; d < 4; ++d)
#pragma unroll
                for (int kb2 = 0; kb2 < 2; ++kb2) {
                    const u32x2 lo = *(const u32x2*)(vb + d * 16 * 72 + kb2 * 32), hi = *(const u32x2*)(vb + d * 16 * 72 + kb2 * 32 + 16);
                    u32x4 w; w.x = lo.x; w.y = lo.y; w.z = hi.x; w.w = hi.y;
                    vf[d][kb2] = __builtin_bit_cast(bf16x8, w);
                }
            __builtin_amdgcn_sched_barrier(0);
            if (!ctxq && it >= 4) {
                if (MODE == 1) {
#pragma unroll
                    for (int q = 0; q < 2; ++q) {
                        const int qpos = tok0 + q * 16 + fr;
#pragma unroll
                        for (int k4 = 0; k4 < 4; ++k4)
#pragma unroll
                            for (int j = 0; j < 4; ++j) { const int d = qpos - (kt * 64 + k4 * 16 + fq * 4 + j); if (d > 128 || d < -128) s[k4][q][j] = -1e30f; }
                    }
                }
                if (MODE == 2) {
#pragma unroll
                    for (int q = 0; q < 2; ++q) {
                        const int qc = (wid & 1) * 32 + q * 16 + fr; const int c0 = min(max(qc - 8, 0), 48);
                        const int bbase = (kt - r + 7) * 31 + 15 - qc;
#pragma unroll
                        for (int k4 = 0; k4 < 4; ++k4)
#pragma unroll
                            for (int j = 0; j < 4; ++j) {
                                const int kc = k4 * 16 + fq * 4 + j; const bool ok = (kc >= c0 && kc < c0 + 16);
                                const float bv = bias_s[ok ? bbase + kc : 0];
                                s[k4][q][j] = ok ? s[k4][q][j] + bv : -1e30f;
                            }
                    }
                }
            }
            bf16x8 pf[2][2];
#pragma unroll
            for (int q = 0; q < 2; ++q) {
                float mx = -1e30f;
#pragma unroll
                for (int k4 = 0; k4 < 4; ++k4) mx = fmaxf(mx, fmaxf(fmaxf(s[k4][q][0], s[k4][q][1]), fmaxf(s[k4][q][2], s[k4][q][3])));
                mx = xmax32(xmax16(mx));
                const float mnew = fmaxf(mrun[q], mx); const float alpha = fexp2(mrun[q] - mnew); mrun[q] = mnew;
                float ps = 0.f;
#pragma unroll
                for (int k4 = 0; k4 < 4; ++k4)
#pragma unroll
                    for (int j = 0; j < 4; ++j) { const float e = fexp2(s[k4][q][j] - mnew); s[k4][q][j] = e; ps += e; }
                lsum[q] = lsum[q] * alpha + ps;
#pragma unroll
                for (int d = 0; d < 4; ++d) o[d][q] = o[d][q] * alpha;
#pragma unroll
                for (int kb2 = 0; kb2 < 2; ++kb2) {
                    u32x4 w; w.x = pk_bf16(s[2 * kb2][q][0], s[2 * kb2][q][1]); w.y = pk_bf16(s[2 * kb2][q][2], s[2 * kb2][q][3]);
                    w.z = pk_bf16(s[2 * kb2 + 1][q][0], s[2 * kb2 + 1][q][1]); w.w = pk_bf16(s[2 * kb2 + 1][q][2], s[2 * kb2 + 1][q][3]);
                    pf[q][kb2] = __builtin_bit_cast(bf16x8, w);
                }
            }
#pragma unroll
            for (int d = 0; d < 4; ++d)
#pragma unroll
                for (int kb2 = 0; kb2 < 2; ++kb2)
#pragma unroll
                    for (int q = 0; q < 2; ++q) o[d][q] = mfma16(vf[d][kb2], pf[q][kb2], o[d][q]);
        }
        __syncthreads();
    }
#pragma unroll
    for (int q = 0; q < 2; ++q) {
        float l = xadd32(xadd16(lsum[q]));
        if (MODE == 1) l += fexp2(p.sink_b[layer * 8 + head] * LOG2E - mrun[q]);
        const float inv = 1.f / l;
        bf16_t* dst = p.O + (size_t)(qrow0 + q * 16 + fr) * 2048 + MODE * 512 + head * 64 + fq * 4;
#pragma unroll
        for (int d = 0; d < 4; ++d) store4(dst + d * 16, o[d][q] * inv);
    }
}

DEV void merge_tile(const P& p, int ch, int mt, int nt, bf16_t* sm) {
    const int tid_ = ltid(), lane = tid_ & 63, wid = uni(tid_ >> 6), wm = wid & 1, wn = wid >> 1, fr = lane & 15, fq = lane >> 4;
    const int m0 = mt * 128, n0 = nt * 64;
    f32x4 tot[2][4];
#pragma unroll
    for (int ft = 0; ft < 2; ++ft)
#pragma unroll
        for (int tt = 0; tt < 4; ++tt) tot[ft][tt] = (f32x4){0.f, 0.f, 0.f, 0.f};
    for (int n = 0; n < 4; ++n) {
        f32x4 u[2][4];
        gemm_mainloop<2, false>(p.O + (size_t)m0 * 2048 + n * 512, 2048, p.WbrT + ((size_t)n * 1024 + n0) * 512, 512, 512, u, sm);
#pragma unroll
        for (int tt = 0; tt < 4; ++tt) {
            const unsigned char* gp = p.G + (size_t)(m0 + wm * 64 + tt * 16 + fr) * 4096 + n * 1024 + n0 + wn * 32 + fq * 4;
#pragma unroll
            for (int ft = 0; ft < 2; ++ft) {
                const unsigned w = *(const unsigned*)(gp + ft * 16);
                f32x4 g; g[0] = (float)(w & 255u); g[1] = (float)((w >> 8) & 255u); g[2] = (float)((w >> 16) & 255u); g[3] = (float)(w >> 24);
                tot[ft][tt] = tot[ft][tt] + (g * (1.f / 255.f)) * u[ft][tt];
            }
        }
    }
#pragma unroll
    for (int tt = 0; tt < 4; ++tt) {
        bf16_t* dst = p.MB + (size_t)(m0 + wm * 64 + tt * 16 + fr) * 1024 + n0 + wn * 32 + fq * 4;
        store4(dst, tot[0][tt]); store4(dst + 16, tot[1][tt]);
    }
}
DEV void store_tile_T(const f32x4 (&acc)[4][4], bf16_t* base, int ld, int row0, int col0) {
    const int tid_ = ltid(), lane = tid_ & 63, wid = uni(tid_ >> 6), wm = wid & 1, wn = wid >> 1, fr = lane & 15, fq = lane >> 4;
#pragma unroll
    for (int tt = 0; tt < 4; ++tt) {
        bf16_t* dst = base + (size_t)(row0 + wm * 64 + tt * 16 + fr) * ld + col0 + wn * 64 + fq * 4;
#pragma unroll
        for (int ft = 0; ft < 4; ++ft) store4(dst + ft * 16, acc[ft][tt]);
    }
}

namespace pg8 {
#define PG8_LAS __attribute__((address_space(3)))
constexpr int BM = 256, BK = 64, HALF = 128, HTB = HALF * BK * 2  , STAGE_BYTES = 8 * HTB, NXCD = 8, WGM = 8;

__host__ __device__ __forceinline__ int lds_byte(int r, int c) { const int st = (r >> 4) * 2 + (c >> 5), rr = r & 15, cc = c & 31, ob = rr * 64 + cc * 2; return st * 1024 + (ob ^ (((ob >> 9) & 1) << 5)); }
__host__ __device__ __forceinline__ void stage_rc(int b, int& R, int& C) { const int st = b / 1024, sb = b % 1024, swz = sb ^ (((sb >> 9) & 1) << 5); R = (st >> 1) * 16 + swz / 64; C = (st & 1) * 32 + (swz % 64) / 2; }
__host__ __device__ __forceinline__ int perm32(int rho) { const int n = rho >> 4, i = rho & 15; return 8 * (i >> 2) + 4 * n + (i & 3); }

struct Unit { int pm, pn; };
struct Gemm { const bf16_t* A; const bf16_t* Bt; int M, N, K; };

template <class Epi, class Sched, bool ALIGN_EPI = false, bool SP2 = false, bool SWAPMMA = false>
__device__ __forceinline__ void gemm_phase(PG8_LAS unsigned char* lds, const Gemm g, const Sched& S, const Epi& E) {
    int tid = threadIdx.x; asm volatile("" : "+v"(tid));
    const int wid = __builtin_amdgcn_readfirstlane(tid >> 6), lane = tid & 63, wr = wid >> 2, wc = wid & 3, fr = lane & 15, fq = lane >> 4;
    const int K = g.K, nt = K / BK;
    unsigned voffA[2], voffB[2];
#pragma unroll
    for (int i = 0; i < 2; ++i) { int R, C; stage_rc(tid * 16 + i * 8192, R, C); const int Rb = Epi::PERM ? ((R & ~31) + perm32(R & 31)) : R;
        voffA[i] = (unsigned)(R * K + C) * 2u; voffB[i] = (unsigned)(Rb * K + C) * 2u; }
    const size_t kstep = (size_t)(BK * 2);
    const size_t hstep = (size_t)HALF * K * 2;
    const size_t tstep = 2 * hstep;
    const unsigned ldsw = (unsigned)wid * 1024u;
    const int aoff = lds_byte(wr * 64 + fr, fq * 8), boff = lds_byte(wc * 32 + fr, fq * 8);
#define PG8_SA(b, h) (((b) * 2 + (h)) * HTB)
#define PG8_SB(b, h) ((4 + (b) * 2 + (h)) * HTB)
#define PG8_STAGE(bufoff, gbase, voff) do { _Pragma("unroll") for (int _i = 0; _i < 2; ++_i) \
        __builtin_amdgcn_global_load_lds((const unsigned*)((const char*)(gbase) + (voff)[_i]), (PG8_LAS unsigned*)(lds + (bufoff) + ldsw + _i * 8192), 16, 0, 0); } while (0)
#define PG8_LDA(dst, b, h) do { _Pragma("unroll") for (int m = 0; m < 4; ++m) _Pragma("unroll") for (int k = 0; k < 2; ++k) dst[m][k] = *(const PG8_LAS bf16x8*)(lds + PG8_SA(b, h) + aoff + m * 2048 + k * 1024); } while (0)
#define PG8_LDB(dst, b, h) do { _Pragma("unroll") for (int n = 0; n < 2; ++n) _Pragma("unroll") for (int k = 0; k < 2; ++k) dst[n][k] = *(const PG8_LAS bf16x8*)(lds + PG8_SB(b, h) + boff + n * 2048 + k * 1024); } while (0)
#define PG8_MMA(ai, bj, At, Bt) do { __builtin_amdgcn_s_setprio(1); _Pragma("unroll") for (int m = 0; m < 4; ++m) _Pragma("unroll") for (int n = 0; n < 2; ++n) _Pragma("unroll") for (int k = 0; k < 2; ++k) \
        acc[ai][bj][m][n] = SWAPMMA ? __builtin_amdgcn_mfma_f32_16x16x32_bf16(At[m][k], Bt[n][k], acc[ai][bj][m][n], 0, 0, 0) : __builtin_amdgcn_mfma_f32_16x16x32_bf16(Bt[n][k], At[m][k], acc[ai][bj][m][n], 0, 0, 0); __builtin_amdgcn_s_setprio(0); } while (0)
#define PG8_WAIT_V(n) asm volatile("s_waitcnt vmcnt(" #n ")" ::: "memory")
#define PG8_WAIT_L(n) asm volatile("s_waitcnt lgkmcnt(" #n ")" ::: "memory")
#define PG8_BAR __builtin_amdgcn_s_barrier()
#define PG8_SCHED __builtin_amdgcn_sched_barrier(0)
    Unit cur, nxt; int ui = 0;
    if (!S.next(0, cur)) return;
    f32x4 acc[2][2][4][2];
#pragma unroll
    for (int a = 0; a < 2; ++a)
#pragma unroll
        for (int b = 0; b < 2; ++b)
#pragma unroll
            for (int m = 0; m < 4; ++m)
#pragma unroll
                for (int n = 0; n < 2; ++n) acc[a][b][m][n] = (f32x4){0.f, 0.f, 0.f, 0.f};
    bf16x8 At[4][2], B0[2][2], B1[2][2];
    const char* cA = (const char*)g.A + (size_t)cur.pm * tstep; const char* cB = (const char*)g.Bt + (size_t)cur.pn * tstep;
    S.a_ready(cur);
    if constexpr (SP2) {
        PG8_STAGE(PG8_SB(0, 0), cB, voffB); PG8_STAGE(PG8_SB(0, 1), cB + hstep, voffB); PG8_STAGE(PG8_SA(0, 0), cA, voffA); PG8_STAGE(PG8_SA(0, 1), cA + hstep, voffA);
        if (wr == 1) PG8_BAR;
        PG8_WAIT_V(2); PG8_BAR;
        PG8_STAGE(PG8_SB(1, 0), cB + kstep, voffB); PG8_STAGE(PG8_SA(1, 0), cA + kstep, voffA); PG8_STAGE(PG8_SB(1, 1), cB + hstep + kstep, voffB);
        PG8_WAIT_V(6); PG8_BAR;
    } else {
        PG8_STAGE(PG8_SB(0, 0), cB, voffB); PG8_STAGE(PG8_SA(0, 0), cA, voffA); PG8_STAGE(PG8_SB(0, 1), cB + hstep, voffB); PG8_STAGE(PG8_SA(0, 1), cA + hstep, voffA);
        if (wr == 1) PG8_BAR;
        PG8_WAIT_V(4); PG8_BAR;
        PG8_STAGE(PG8_SB(1, 0), cB + kstep, voffB); PG8_STAGE(PG8_SA(1, 0), cA + kstep, voffA); PG8_STAGE(PG8_SB(1, 1), cB + hstep + kstep, voffB);
        PG8_WAIT_V(6); PG8_BAR;
    }
    for (;;) {
        const bool has_next = S.next(ui + 1, nxt);
        const char* nA = has_next ? (const char*)g.A + (size_t)nxt.pm * tstep : cA; const char* nB = has_next ? (const char*)g.Bt + (size_t)nxt.pn * tstep : cB;
        for (int t = 0; t < nt; t += 2) {
            const bool last = (t == nt - 2);
            const char* a1 = cA + (size_t)(t + 1) * kstep;
            const char* a2 = last ? nA : cA + (size_t)(t + 2) * kstep; const char* b2 = last ? nB : cB + (size_t)(t + 2) * kstep;
            const char* a3 = a2 + kstep; const char* b3 = b2 + kstep;
            if (last && has_next) S.a_ready(nxt);
            if constexpr (SP2) {
            PG8_LDB(B0, 0, 0); PG8_LDB(B1, 0, 1); PG8_SCHED; PG8_LDA(At, 0, 0); PG8_STAGE(PG8_SA(1, 1), a1 + hstep, voffA);
            PG8_WAIT_V(8); PG8_WAIT_L(0); PG8_BAR; PG8_MMA(0, 0, At, B0); PG8_MMA(0, 1, At, B1); PG8_BAR; PG8_SCHED;
            PG8_LDA(At, 0, 1); PG8_STAGE(PG8_SB(0, 0), b2, voffB); PG8_STAGE(PG8_SB(0, 1), b2 + hstep, voffB); PG8_STAGE(PG8_SA(0, 0), a2, voffA);
            PG8_WAIT_V(8); PG8_WAIT_L(0); PG8_BAR; PG8_MMA(1, 0, At, B0); PG8_MMA(1, 1, At, B1); PG8_BAR; PG8_SCHED;
            PG8_LDB(B0, 1, 0); PG8_LDB(B1, 1, 1); PG8_SCHED; PG8_LDA(At, 1, 0); PG8_STAGE(PG8_SA(0, 1), a2 + hstep, voffA);
            PG8_WAIT_V(8); PG8_WAIT_L(0); PG8_BAR; PG8_MMA(0, 0, At, B0); PG8_MMA(0, 1, At, B1); PG8_BAR; PG8_SCHED;
            PG8_LDA(At, 1, 1); PG8_STAGE(PG8_SB(1, 0), b3, voffB); PG8_STAGE(PG8_SB(1, 1), b3 + hstep, voffB); PG8_STAGE(PG8_SA(1, 0), a3, voffA);
            PG8_WAIT_V(8); PG8_WAIT_L(0); PG8_BAR; PG8_MMA(1, 0, At, B0); PG8_MMA(1, 1, At, B1); PG8_BAR; PG8_SCHED;
            } else {
            PG8_LDB(B0, 0, 0); PG8_SCHED; PG8_LDA(At, 0, 0); PG8_STAGE(PG8_SA(1, 1), a1 + hstep, voffA);
            PG8_WAIT_L(8); PG8_BAR; PG8_WAIT_L(0); PG8_MMA(0, 0, At, B0); PG8_BAR; PG8_SCHED;
            PG8_LDB(B1, 0, 1); PG8_STAGE(PG8_SB(0, 0), b2, voffB);
            PG8_BAR; PG8_WAIT_L(0); PG8_MMA(0, 1, At, B1); PG8_BAR;
            PG8_LDA(At, 0, 1); PG8_STAGE(PG8_SA(0, 0), a2, voffA);
            PG8_BAR; PG8_WAIT_L(0); PG8_MMA(1, 0, At, B0); PG8_BAR; PG8_SCHED;
            PG8_STAGE(PG8_SB(0, 1), b2 + hstep, voffB);
            PG8_WAIT_V(6); PG8_BAR; PG8_MMA(1, 1, At, B1); PG8_BAR;
            PG8_LDB(B0, 1, 0); PG8_SCHED; PG8_LDA(At, 1, 0); PG8_STAGE(PG8_SA(0, 1), a2 + hstep, voffA);
            PG8_WAIT_L(8); PG8_BAR; PG8_WAIT_L(0); PG8_MMA(0, 0, At, B0); PG8_BAR; PG8_SCHED;
            PG8_LDB(B1, 1, 1); PG8_STAGE(PG8_SB(1, 0), b3, voffB);
            PG8_BAR; PG8_WAIT_L(0); PG8_MMA(0, 1, At, B1); PG8_BAR;
            PG8_LDA(At, 1, 1); PG8_STAGE(PG8_SA(1, 0), a3, voffA);
            PG8_BAR; PG8_WAIT_L(0); PG8_MMA(1, 0, At, B0); PG8_BAR; PG8_SCHED;
            PG8_STAGE(PG8_SB(1, 1), b3 + hstep, voffB);
            PG8_WAIT_V(6); PG8_BAR; PG8_MMA(1, 1, At, B1); PG8_BAR;
            }
        }
        if constexpr (ALIGN_EPI) { if (wr == 0) PG8_BAR; }
        if constexpr (!Epi::AFTER_DRAIN) { E(acc, cur, wr, wc, fr, fq); S.done(cur); }
        if (!has_next) break;
#pragma unroll
        for (int a = 0; a < 2; ++a)
#pragma unroll
            for (int b = 0; b < 2; ++b)
#pragma unroll
                for (int m = 0; m < 4; ++m)
#pragma unroll
                    for (int n = 0; n < 2; ++n) acc[a][b][m][n] = (f32x4){0.f, 0.f, 0.f, 0.f};
        cur = nxt; cA = nA; cB = nB; ++ui;
        if constexpr (ALIGN_EPI) { if (wr == 1) PG8_BAR; }
    }
    PG8_WAIT_V(0);
    if constexpr (!ALIGN_EPI) { if (wr == 0) PG8_BAR; }
    PG8_BAR;
    if constexpr (Epi::AFTER_DRAIN) { E.fused(acc, cur, wr, wc, fr, fq, lds, wid, lane); S.done(cur); }
#undef PG8_SA
#undef PG8_SB
#undef PG8_STAGE
#undef PG8_LDA
#undef PG8_LDB
#undef PG8_MMA
#undef PG8_WAIT_V
#undef PG8_WAIT_L
#undef PG8_BAR
#undef PG8_SCHED
}
}

struct XSched {
    int nN, nunits, G, c;
    DEV bool next(int i, pg8::Unit& u) const {
        const int L = i * G + c; if (L >= nunits) return false;
        const int U = ((nunits & 7) == 0 && (G & 7) == 0) ? (L & 7) * (nunits >> 3) + (L >> 3) : L;
        u.pm = U / nN; u.pn = U - u.pm * nN; return true;
    }
    DEV void a_ready(const pg8::Unit&) const {}
    DEV void done(const pg8::Unit&) const {}
};
struct EpiStoreT {
    static constexpr bool PERM = false, AFTER_DRAIN = false;
    bf16_t* out; int ld; int row_off;
    DEV void operator()(const f32x4 (&acc)[2][2][4][2], const pg8::Unit& u, int wr, int wc, int fr, int fq) const {
#pragma unroll
        for (int ai = 0; ai < 2; ++ai)
#pragma unroll
            for (int m = 0; m < 4; ++m) {
                bf16_t* d = out + (size_t)(row_off + u.pm * 256 + ai * 128 + wr * 64 + m * 16 + fr) * ld + u.pn * 256 + wc * 32 + fq * 4;
#pragma unroll
                for (int bj = 0; bj < 2; ++bj)
#pragma unroll
                    for (int n = 0; n < 2; ++n) store4(d + bj * 128 + n * 16, acc[ai][bj][m][n]);
            }
    }
};
struct EpiSwiglu {
    static constexpr bool PERM = false, AFTER_DRAIN = false;
    bf16_t* act;
    DEV void operator()(const f32x4 (&acc)[2][2][4][2], const pg8::Unit& u, int wr, int wc, int fr, int fq) const {
#pragma unroll
        for (int ai = 0; ai < 2; ++ai)
#pragma unroll
            for (int m = 0; m < 4; ++m) {
                bf16_t* d = act + (size_t)(u.pm * 256 + ai * 128 + wr * 64 + m * 16 + fr) * DFF + u.pn * 128 + wc * 16 + fq * 4;
#pragma unroll
                for (int bj = 0; bj < 2; ++bj) {
                    const f32x4 a = acc[ai][bj][m][0], b = acc[ai][bj][m][1]; f32x4 r;
#pragma unroll
                    for (int j = 0; j < 4; ++j) r[j] = a[j] * frcp(1.f + fexp2(-a[j] * LOG2E)) * b[j];
                    store4(d + bj * 64, r);
                }
            }
    }
};
struct EpiVT {
    static constexpr bool PERM = false, AFTER_DRAIN = false;
    bf16_t* vt;
    DEV void operator()(const f32x4 (&acc)[2][2][4][2], const pg8::Unit& u, int wr, int wc, int fr, int fq) const {
#pragma unroll
        for (int bj = 0; bj < 2; ++bj)
#pragma unroll
            for (int n = 0; n < 2; ++n) {
                bf16_t* d = vt + (size_t)(u.pn * 256 + bj * 128 + wc * 32 + n * 16 + fr) * MC + u.pm * 256 + wr * 64 + fq * 4;
#pragma unroll
                for (int ai = 0; ai < 2; ++ai)
#pragma unroll
                    for (int m = 0; m < 4; ++m) store4(d + ai * 128 + m * 16, acc[ai][bj][m][n]);
            }
    }
};
struct EpiGate {
    static constexpr bool PERM = false, AFTER_DRAIN = false;
    unsigned char* g8;
    DEV void operator()(const f32x4 (&acc)[2][2][4][2], const pg8::Unit& u, int wr, int wc, int fr, int fq) const {
#pragma unroll
        for (int ai = 0; ai < 2; ++ai)
#pragma unroll
            for (int m = 0; m < 4; ++m) {
                unsigned char* d = g8 + (size_t)(u.pm * 256 + ai * 128 + wr * 64 + m * 16 + fr) * 4096 + u.pn * 256 + wc * 32 + fq * 4;
#pragma unroll
                for (int bj = 0; bj < 2; ++bj)
#pragma unroll
                    for (int n = 0; n < 2; ++n) {
                        const f32x4 a = acc[ai][bj][m][n]; unsigned w = 0;
#pragma unroll
                        for (int j = 0; j < 4; ++j) { const float s = frcp(1.f + fexp2(-a[j] * LOG2E)); w |= ((unsigned)(s * 255.f + 0.5f)) << (8 * j); }
                        *(unsigned*)(d + bj * 128 + n * 16) = w;
                    }
            }
    }
};
struct EpiGemm1 {
    static constexpr bool PERM = false, AFTER_DRAIN = false;
    const P* pp; int layer;
    DEV void operator()(const f32x4 (&acc)[2][2][4][2], const pg8::Unit& u, int wr, int wc, int fr, int fq) const {
        const int slab = u.pn * 256 + wc * 64; const bool lat = u.pm * 256 < LAT_C;
        if (slab >= 2752) return;
#pragma unroll
        for (int ai = 0; ai < 2; ++ai)
#pragma unroll
            for (int m = 0; m < 4; ++m) {
                f32x4 v[4] = {acc[ai][0][m][0], acc[ai][0][m][1], acc[ai][1][m][0], acc[ai][1][m][1]};
                gemm1_row(v, u.pm * 256 + ai * 128 + wr * 64 + m * 16 + fr, slab, lat, *pp, layer, fq);
            }
    }
};

#define LAS __attribute__((address_space(3)))
#define XB_TMO      128
#define XB_XCNT(j)  (256  + 64 * (j))
#define XB_XSUB(j)  (1280 + 64 * (j))
#define XB_XGEN(j)  (2304 + 64 * (j))
#define XB_TOP      3328
#define XB_TOPGEN   3392
#define XCD_BAR_WORDS 3456
#define XB_SPIN_CAP (1u << 18)

__device__ __forceinline__ unsigned xb_ld(unsigned* p)              { return __hip_atomic_load(p, __ATOMIC_RELAXED, __HIP_MEMORY_SCOPE_AGENT); }
__device__ __forceinline__ unsigned xb_add(unsigned* p, unsigned v) { return __hip_atomic_fetch_add(p, v, __ATOMIC_RELAXED, __HIP_MEMORY_SCOPE_AGENT); }
__device__ __forceinline__ unsigned xb_xcc_id() { return (unsigned)__builtin_amdgcn_s_getreg((3 << 11) | 20) & 0xFu; }
#define XB_SPIN(cond, bar) do { unsigned _sp = 0; while (cond) { __builtin_amdgcn_s_sleep(1); \
    if ((++_sp & 255u) == 0u) { if (xb_ld(&(bar)[XB_TMO])) break; if (_sp > XB_SPIN_CAP) { atomicAdd(&(bar)[XB_TMO], 1u); break; } } } } while (0)

struct XcdBarrier {
    unsigned* bar; unsigned x;
    volatile LAS unsigned* st;
};

__device__ __forceinline__ XcdBarrier xcd_barrier_post(unsigned* bar, volatile LAS unsigned* st) {
    XcdBarrier b; b.bar = bar; b.x = xb_xcc_id(); b.st = st;
    if (threadIdx.x == 0) (void)xb_add(&bar[XB_XCNT(b.x)], 1u);
    return b;
}
__device__ __forceinline__ void xcd_barrier_complete(unsigned* bar, unsigned x, unsigned& nloc, unsigned& nx) {
    const unsigned G = gridDim.x * gridDim.y * gridDim.z;
    unsigned sum, cnt, mine, sp = 0u;
    for (;;) {
        sum = 0u; cnt = 0u; mine = 0u;
#pragma unroll
        for (unsigned j = 0; j < 16; ++j) { const unsigned c = xb_ld(&bar[XB_XCNT(j)]); sum += c; cnt += (c > 0u) ? 1u : 0u; mine = (j == x) ? c : mine; }
        if (sum == G) break;
        __builtin_amdgcn_s_sleep(1);
        if ((++sp & 255u) == 0u) { if (xb_ld(&bar[XB_TMO])) break; if (sp > XB_SPIN_CAP) { atomicAdd(&bar[XB_TMO], 1u); break; } }
    }
    nloc = mine > 0u ? mine : 1u; nx = cnt > 0u ? cnt : 1u;
}

__device__ __forceinline__ void xcd_barrier(const XcdBarrier& b) {
    asm volatile("s_waitcnt vmcnt(0)" ::: "memory");
    __syncthreads();
    if (threadIdx.x == 0) {
        unsigned* bar = b.bar;
        __builtin_amdgcn_s_waitcnt(0);
        unsigned nloc = b.st[0], nx = b.st[1];
        if (nloc == 0u) { xcd_barrier_complete(bar, b.x, nloc, nx); b.st[0] = nloc; b.st[1] = nx; }
        const unsigned old = xb_add(&bar[XB_XSUB(b.x)], 1u);
        const unsigned gen = old / nloc;
        if (old + 1u == (gen + 1u) * nloc) {
            __builtin_amdgcn_fence(__ATOMIC_RELEASE, "agent");
            asm volatile("s_waitcnt vmcnt(0)" ::: "memory");
            const unsigned og = xb_add(&bar[XB_TOP], 1u);
            const unsigned tg = og / nx;
            if (og + 1u == (tg + 1u) * nx) xb_add(&bar[XB_TOPGEN], 1u);
            else XB_SPIN(xb_ld(&bar[XB_TOPGEN]) == tg, bar);
            __builtin_amdgcn_fence(__ATOMIC_ACQUIRE, "agent");
            xb_add(&bar[XB_XGEN(b.x)], 1u);
            asm volatile("s_waitcnt vmcnt(0)" ::: "memory");
        } else {
            XB_SPIN(xb_ld(&bar[XB_XGEN(b.x)]) == gen, bar);
            __builtin_amdgcn_fence(__ATOMIC_ACQUIRE, "agent");
            asm volatile("s_waitcnt vmcnt(0)" ::: "memory");
        }
    }
    __syncthreads();
}

typedef const __attribute__((address_space(4))) P* PP;
#define FRESH_P PP q_ = pp0; asm volatile("" : "+s"(q_)); const P& p = *(const P*)q_;
#define FRESH_BG int bidL = bid, GL = G; asm volatile("" : "+s"(bidL), "+s"(GL));
constexpr int DYN_LDS = 2 * SMEM_BYTES + 64;
__global__ void __launch_bounds__(512, 2) mega(P pv_) {
    cg::grid_group grid = cg::this_grid();
    PP pp0 = (PP)__builtin_amdgcn_kernarg_segment_ptr();
    extern __shared__ __attribute__((aligned(16))) unsigned char lds_dyn[];
    const int half = __builtin_amdgcn_readfirstlane((int)threadIdx.x >> 8);
    unsigned char* smraw = lds_dyn + half * SMEM_BYTES;
    bf16_t* sm = (bf16_t*)smraw;
    PG8_LAS unsigned char* ldsL = (PG8_LAS unsigned char*)lds_dyn;
    const int bid = blockIdx.x, G = gridDim.x, vb = bid * 2 + half, VG = G * 2, tid = threadIdx.x & 255;
    {
        FRESH_P
        volatile LAS unsigned* xst = (volatile LAS unsigned*)(ldsL + 2 * SMEM_BYTES);
        if (threadIdx.x == 0) { xst[0] = 0u; xst[1] = 0u; }
        __syncthreads();
        const XcdBarrier xb0 = xcd_barrier_post(p.barw, xst);
        if (threadIdx.x == 0) xst[2] = xb0.x;
        __syncthreads();
    }
#define GBAR() do { FRESH_P XcdBarrier b_; b_.bar = p.barw; b_.st = (volatile LAS unsigned*)(ldsL + 2 * SMEM_BYTES); b_.x = b_.st[2]; xcd_barrier(b_); } while (0)

    { FRESH_P
    for (int i = vb * 256 + tid; i < 64 * 16 + 64 * 8; i += VG * 256) {
        if (i < 1024) { const int pos = i >> 4, k = i & 15; const float inv = fexp2(-(float)k * (13.287712379549449f / 16.f)); const float a = (float)pos * inv; p.rt16[i] = (f32x2){__cosf(a), __sinf(a)}; }
        else { const int q = i - 1024; const int pos = q >> 3, k = q & 7; const float inv = fexp2(-(float)k * (13.287712379549449f / 8.f)); const float a = (float)pos * inv; p.rt8[q] = (f32x2){__cosf(a), __sinf(a)}; }
    }
    for (int t = vb; t < 384 + CONV_TILES; t += VG) { if (t < 384) mod_item(p, t, smraw); else conv_job(p, 0, t - 384, (float*)smraw); }
    }
    GBAR();
    { FRESH_P r_phase(p, 0, 0, vb, VG, 0, MTOT); }
    GBAR();

    for (int layer = 0; layer < DEPTH; ++layer) {
        for (int ch = 0; ch < NCH; ++ch) {
            { FRESH_P FRESH_BG
              const bf16_t* A = p.U + (size_t)ch * MC * 1024;
              { pg8::Gemm g{A, p.WinT, MC, 2816, 1024}; XSched S{11, 792, GL, bidL}; EpiGemm1 E{&p, layer};
                pg8::gemm_phase<EpiGemm1, XSched, true, true, false>(ldsL, g, S, E); }
              { pg8::Gemm g{A, p.WinT + (size_t)2816 * 1024, MC, 768, 1024}; XSched S{3, 216, GL, (bidL + GL - (792 % GL)) % GL}; EpiVT E{p.VT};
                pg8::gemm_phase<EpiVT, XSched, true, true, true>(ldsL, g, S, E); }
              { pg8::Gemm g{A, p.WinT + (size_t)NPROJ * 1024, MC, 4096, 1024}; XSched S{16, 1152, GL, (bidL + GL - (1008 % GL)) % GL}; EpiGate E{p.G};
                pg8::gemm_phase<EpiGate, XSched, true, true, false>(ldsL, g, S, E); }
            }
            GBAR();
            { FRESH_P for (int t = vb; t < 1024 + 1024 + 2016 + 384; t += VG) {
                if (t < 1024) attn_item<2>(p, layer, t, false, smraw);
                else if (t < 2048) attn_item<1>(p, layer, t - 1024, false, smraw);
                else if (t < 4064) { const int q = t - 2048; stage2_tile(p, q / 14, q % 14, smraw); }
                else if (t < 4192) attn_item<1>(p, layer, t - 4064, true, smraw);
                else if (t < 4320) attn_item<2>(p, layer, t - 4192, true, smraw);
                else attn_item<3>(p, layer, t - 4320, true, smraw);
            } }
            GBAR();
            { FRESH_P for (int t = vb; t < 1024 + 1024 + 128; t += VG) {
                if (t < 1024) attn_item<0>(p, layer, t, false, smraw);
                else if (t < 2048) attn_item<3>(p, layer, t - 1024, false, smraw);
                else attn_item<0>(p, layer, t - 2048, true, smraw);
            } }
            GBAR();
            { FRESH_P for (int t = vb; t < 144 * 16; t += VG) merge_tile(p, ch, t >> 4, t & 15, sm); }
            GBAR();
            { FRESH_P FRESH_BG pg8::Gemm g{p.MB, p.WoutT, MC, 1024, 1024}; XSched S{4, 288, GL, bidL}; EpiStoreT E{p.YC, 1024, 0};
              pg8::gemm_phase<EpiStoreT, XSched, true, true, false>(ldsL, g, S, E); }
            GBAR();
            { FRESH_P r_phase(p, 1, layer, vb, VG, ch * MC, (ch + 1) * MC); }
            GBAR();
        }
        { FRESH_P FRESH_BG pg8::Gemm g{p.U, p.Wf1T, MTOT, 2 * DFF, 1024}; XSched S{22, 3168, GL, bidL}; EpiSwiglu E{p.ACT};
          pg8::gemm_phase<EpiSwiglu, XSched, true, true, false>(ldsL, g, S, E); }
        GBAR();
        { FRESH_P FRESH_BG pg8::Gemm g{p.ACT, p.Wf2T, MTOT, 1024, DFF}; XSched S{4, 576, GL, bidL}; EpiStoreT E{p.U, 1024, 0};
          pg8::gemm_phase<EpiStoreT, XSched, true, true, false>(ldsL, g, S, E); }
        GBAR();
        { FRESH_P r_phase(p, 2, layer, vb, VG, 0, MTOT);
          if (layer + 1 < DEPTH) { for (int t = vb; t < CONV_TILES; t += VG) conv_job(p, layer + 1, t, (float*)smraw); } }
        GBAR();
    }
}

extern "C" void kernel_launch(void* const* d_in, const int* in_sizes, int n_in, void* d_out, int out_size, void* d_ws, size_t ws_size, hipStream_t stream) {
    static int grid_blocks = 0;
    if (!grid_blocks) {
        int dev = 0, cus = 0, per_cu = 0;
        (void)hipGetDevice(&dev);
        (void)hipDeviceGetAttribute(&cus, hipDeviceAttributeMultiprocessorCount, dev);
        if (hipFuncSetAttribute((const void*)mega, hipFuncAttributeMaxDynamicSharedMemorySize, DYN_LDS) != hipSuccess) fprintf(stderr, "hipFuncSetAttribute failed\n");
        (void)hipOccupancyMaxActiveBlocksPerMultiprocessor(&per_cu, mega, 512, DYN_LDS);
        grid_blocks = cus;
    }
    P p{};
    const float** f = (const float**)&p;
    for (int i = 0; i < 23; ++i) f[i] = (const float*)d_in[i];
    p.out = (float*)d_out;
    unsigned char* w = (unsigned char*)d_ws; size_t off = 0;
    auto take = [&](size_t bytes) { void* r = w + off; off += (bytes + 255) & ~(size_t)255; return r; };
    p.WinT = (bf16_t*)take((size_t)NWIN * 1024 * 2);
    p.WuqT = (bf16_t*)take((size_t)768 * 256 * 2);
    p.WukvT = (bf16_t*)take((size_t)1024 * 128 * 2);
    p.WbrT = (bf16_t*)take((size_t)4 * 1024 * 512 * 2);
    p.WoutT = (bf16_t*)take((size_t)1024 * 1024 * 2);
    p.Wf1T = (bf16_t*)take((size_t)2 * DFF * 1024 * 2);
    p.Wf2T = (bf16_t*)take((size_t)1024 * DFF * 2);
    p.mod = (float*)take((size_t)DEPTH * 17 * 6144 * 4);
    p.rt16 = (f32x2*)take(64 * 16 * 8);
    p.rt8 = (f32x2*)take(64 * 8 * 8);
    p.hc = (float*)take((size_t)NBATCH * CTX * 1024 * 4);
    p.U = (bf16_t*)take((size_t)MTOT * 1024 * 2);
    p.G = (unsigned char*)take((size_t)MC * 4096);
    p.barw = (unsigned*)take((size_t)XCD_BAR_WORDS * 4);
    unsigned char* R = (unsigned char*)take(0);
    p.PJ = (bf16_t*)take((size_t)MC * PJLD * 2);
    p.QA = (bf16_t*)take((size_t)MC * 768 * 2);
    p.KN = (bf16_t*)take((size_t)MC * 512 * 2);
    p.VT = (bf16_t*)take((size_t)VTROWS * MC * 2);
    p.O = (bf16_t*)take((size_t)MC * 2048 * 2);
    p.YC = p.O;
    p.MB = p.PJ;
    p.ACT = (bf16_t*)R;
    if (off > ws_size) { fprintf(stderr, "workspace too small: need %zu have %zu\n", off, ws_size); return; }
    (void)hipMemsetAsync(p.barw, 0, (size_t)XCD_BAR_WORDS * 4, stream);
    void* args[] = {&p};
    hipError_t e = hipLaunchCooperativeKernel((void*)mega, dim3(grid_blocks), dim3(512), args, DYN_LDS, stream);
    if (e != hipSuccess) fprintf(stderr, "cooperative launch failed: %s (grid %d)\n", hipGetErrorString(e), grid_blocks);
}
```

```cpp
#include <hip/hip_runtime.h>
#include <hip/hip_cooperative_groups.h>
#include <cstdio>
#include <cstdint>
namespace cg = cooperative_groups;

typedef unsigned short bf16_t;
typedef short bf16x8 __attribute__((ext_vector_type(8)));
typedef short bf16x4 __attribute__((ext_vector_type(4)));
typedef float f32x4 __attribute__((ext_vector_type(4)));
typedef float f32x2 __attribute__((ext_vector_type(2)));
typedef unsigned u32x2 __attribute__((ext_vector_type(2)));
typedef unsigned u32x4 __attribute__((ext_vector_type(4)));
#define DEV __device__ __forceinline__

constexpr int DM = 1024, NBATCH = 16, SEQ = 2048, CTX = 256, DEPTH = 4;
constexpr int NCH = 2, BPC = NBATCH / NCH, LAT_C = BPC * SEQ, CTX_C = BPC * CTX, MC = LAT_C + CTX_C, MTOT = MC * NCH;
constexpr int INC = 7584, NPROJ = 3584, NWIN = 7680, PJLD = 2816, DFF = 2816, VTROWS = 1280;
#ifndef REP_G
#define REP_G 1
#endif
#ifndef REP_M
#define REP_M 1
#endif
#ifndef REP_A
#define REP_A 1
#endif
constexpr float LOG2E = 1.4426950408889634f;
constexpr int LST = 72;
constexpr int TILE_E = 128 * LST;
constexpr int SMEM_BYTES = 4 * TILE_E * 2 + 1024;

struct P {
    const float *x, *c, *ctx, *c_ctx, *w_mod, *b_mod, *g_pre_mix, *g_post_mix, *g_pre_ffn, *g_post_ffn, *w_in, *g_a_q, *g_a_kv,
        *w_a_uq, *w_a_ukv, *sink_b, *rpb_c, *g_d_q, *g_d_k, *w_branch, *w_out, *w_ffn_in, *w_ffn_out;
    float* out;
    bf16_t *WinT, *WuqT, *WukvT, *WbrT, *WoutT, *Wf1T, *Wf2T;
    float* mod; f32x2 *rt16, *rt8; float* hc;
    bf16_t *U, *YC, *PJ, *QA, *KN, *VT, *O, *MB, *ACT;
    unsigned char* G;
    unsigned* barw;
};

typedef __bf16 bf16v2 __attribute__((ext_vector_type(2)));
DEV unsigned pk_bf16(float lo, float hi) { bf16v2 v = __builtin_convertvector((f32x2){lo, hi}, bf16v2); return __builtin_bit_cast(unsigned, v); }
DEV float bf2f(unsigned short v) { return __uint_as_float(((unsigned)v) << 16); }
DEV void store4(bf16_t* p, f32x4 v) { u32x2 w; w.x = pk_bf16(v[0], v[1]); w.y = pk_bf16(v[2], v[3]); *(u32x2*)p = w; }
DEV float fexp2(float x) { return __builtin_amdgcn_exp2f(x); }
DEV float frcp(float x) { return __builtin_amdgcn_rcpf(x); }
DEV float wave_sum(float v) {
    v += __shfl_xor(v, 1); v += __shfl_xor(v, 2); v += __shfl_xor(v, 4); v += __shfl_xor(v, 8); v += __shfl_xor(v, 16); v += __shfl_xor(v, 32); return v;
}
DEV int ltid() { int t = threadIdx.x & 255; asm volatile("" : "+v"(t)); return t; }
DEV int uni(int v) { return __builtin_amdgcn_readfirstlane(v); }
DEV float xmax16(float x) { auto r = __builtin_amdgcn_permlane16_swap(__float_as_uint(x), __float_as_uint(x), false, false); return fmaxf(__uint_as_float(r[0]), __uint_as_float(r[1])); }
DEV float xmax32(float x) { auto r = __builtin_amdgcn_permlane32_swap(__float_as_uint(x), __float_as_uint(x), false, false); return fmaxf(__uint_as_float(r[0]), __uint_as_float(r[1])); }
DEV float xadd16(float x) { auto r = __builtin_amdgcn_permlane16_swap(__float_as_uint(x), __float_as_uint(x), false, false); return __uint_as_float(r[0]) + __uint_as_float(r[1]); }
DEV float xadd32(float x) { auto r = __builtin_amdgcn_permlane32_swap(__float_as_uint(x), __float_as_uint(x), false, false); return __uint_as_float(r[0]) + __uint_as_float(r[1]); }
DEV f32x4 mfma16(bf16x8 a, bf16x8 b, f32x4 c) { return __builtin_amdgcn_mfma_f32_16x16x32_bf16(a, b, c, 0, 0, 0); }

template <int NFT, bool SWAP>
DEV void gemm_mainloop(const bf16_t* __restrict__ A, int lda, const bf16_t* __restrict__ Bt, int ldb, int K, f32x4 (&acc)[NFT][4], bf16_t* sm) {
    const int tid = ltid(), lane = tid & 63, wid = uni(tid >> 6), wm = wid & 1, wn = wid >> 1, fr = lane & 15, fq = lane >> 4;
    unsigned char* sA = (unsigned char*)sm; unsigned char* sB = sA + 2 * 16384;
    const int lrow = tid >> 3, lc8 = (tid & 7) * 8;
    const int wofs = lrow * 128 + (((tid & 7) ^ (lrow & 7)) << 4);
    const bf16_t* ga = A + (size_t)lrow * lda + lc8;
    const bf16_t* gb = Bt + (size_t)lrow * ldb + lc8;
    u32x4 ra[4], rb[NFT];
#pragma unroll
    for (int ft = 0; ft < NFT; ++ft)
#pragma unroll
        for (int tt = 0; tt < 4; ++tt) acc[ft][tt] = (f32x4){0.f, 0.f, 0.f, 0.f};
#pragma unroll
    for (int i = 0; i < 4; ++i) ra[i] = *(const u32x4*)(ga + (size_t)(i * 32) * lda);
#pragma unroll
    for (int i = 0; i < NFT; ++i) rb[i] = *(const u32x4*)(gb + (size_t)(i * 32) * ldb);
#pragma unroll
    for (int i = 0; i < 4; ++i) *(u32x4*)(sA + wofs + i * 4096) = ra[i];
#pragma unroll
    for (int i = 0; i < NFT; ++i) *(u32x4*)(sB + wofs + i * 4096) = rb[i];
    const int nk = K >> 6;
    if (nk > 1) {
#pragma unroll
        for (int i = 0; i < 4; ++i) ra[i] = *(const u32x4*)(ga + (size_t)(i * 32) * lda + 64);
#pragma unroll
        for (int i = 0; i < NFT; ++i) rb[i] = *(const u32x4*)(gb + (size_t)(i * 32) * ldb + 64);
    }
    __syncthreads();
    const int rofs0 = ((0 + fq) ^ (fr & 7)) << 4, rofs1 = ((4 + fq) ^ (fr & 7)) << 4;
    for (int kt = 0; kt < nk; ++kt) {
        const int cur = kt & 1;
        if (kt + 1 < nk) {
            const int nx = cur ^ 1;
#pragma unroll
            for (int i = 0; i < 4; ++i) *(u32x4*)(sA + nx * 16384 + wofs + i * 4096) = ra[i];
#pragma unroll
            for (int i = 0; i < NFT; ++i) *(u32x4*)(sB + nx * 16384 + wofs + i * 4096) = rb[i];
        }
        if (kt + 2 < nk) {
            const int ko = (kt + 2) * 64;
#pragma unroll
            for (int i = 0; i < 4; ++i) ra[i] = *(const u32x4*)(ga + (size_t)(i * 32) * lda + ko);
#pragma unroll
            for (int i = 0; i < NFT; ++i) rb[i] = *(const u32x4*)(gb + (size_t)(i * 32) * ldb + ko);
        }
        __builtin_amdgcn_sched_barrier(0);
        const unsigned char* cA = sA + cur * 16384 + (wm * 64 + fr) * 128;
        const unsigned char* cB = sB + cur * 16384 + (wn * NFT * 16 + fr) * 128;
#pragma unroll
        for (int ks = 0; ks < 2; ++ks) {
            const int ro = ks ? rofs1 : rofs0;
            bf16x8 af[4], wf[NFT];
#pragma unroll
            for (int tt = 0; tt < 4; ++tt) af[tt] = *(const bf16x8*)(cA + tt * 2048 + ro);
#pragma unroll
            for (int ft = 0; ft < NFT; ++ft) wf[ft] = *(const bf16x8*)(cB + ft * 2048 + ro);
#pragma unroll
            for (int ft = 0; ft < NFT; ++ft)
#pragma unroll
                for (int tt = 0; tt < 4; ++tt) acc[ft][tt] = SWAP ? mfma16(af[tt], wf[ft], acc[ft][tt]) : mfma16(wf[ft], af[tt], acc[ft][tt]);
        }
        __syncthreads();
    }
}

DEV bool tile_xcd(int q, int x, int nM, int nN, int& m, int& n) {
    const int j = q >> 5, w = q & 31;
    const int pp = (((j >> 1) * 8 + x) << 1) + (j & 1);
    const int npn = nN >> 2;
    if (pp >= (nM >> 3) * npn) return false;
    const int pm = pp / npn, pn = pp - pm * npn;
    m = pm * 8 + (w & 7); n = pn * 4 + (w >> 3);
    return true;
}
#define TILE_LOOP(nM, nN) const int x_ = bid & 7, spx_ = G >> 3; int mt, nt; for (int q_ = bid >> 3; tile_xcd(q_, x_, nM, nN, mt, nt); q_ += spx_)

DEV int srccol(int mapid, int n) {
    switch (mapid) {
    case 0:
        if (n < 2816) { const int rho = n & 255; n = (n & ~255) + ((rho >> 5) & 3) * 64 + (rho >> 7) * 32 + (rho & 31); }
        if (n < 384) return n;
        if (n < 896) return n - 384 + 416;
        if (n < 1024) return n - 896 + 928;
        if (n < 1536) return n - 1024 + 1184;
        if (n < 2048) return n - 1536 + 1696;
        if (n < 2560) return n - 2048 + 2720;
        if (n < 2688) return n - 2560 + 3232;
        if (n < 2720) return n - 2688 + 384;
        if (n < 2816) return -1;
        if (n < 2944) return n - 2816 + 1056;
        if (n < 3456) return n - 2944 + 2208;
        if (n < 3584) return n - 3456 + 3360;
        return n - 3584 + 3488;
    case 1: if (n < 512) return (n >> 6) * 96 + (n & 63); { const int q = n - 512; return (q >> 5) * 96 + 64 + (q & 31); }
    case 2: if (n < 512) return (n >> 6) * 128 + (n & 63); { const int q = n - 512; return (q >> 6) * 128 + 64 + (q & 63); }
    case 4: { const int pn = n >> 8, bj = (n >> 7) & 1, wc = (n >> 5) & 3, s = (n >> 4) & 1, f = n & 15; return s * DFF + pn * 128 + bj * 64 + wc * 16 + f; }
    default: return n;
    }
}
DEV void conv_tile(const float* __restrict__ src, int lds_, int K, bf16_t* __restrict__ dst, int n0, int k0, int mapid, const float* rowscale, float* st) {
    const int tid = ltid();
    {
        const int n = tid & 63, kk = tid >> 6; const int sc_ = srccol(mapid, n0 + n);
#pragma unroll
        for (int i = 0; i < 16; ++i) {
            const int k = kk * 16 + i;
            float v = sc_ >= 0 ? src[(size_t)(k0 + k) * lds_ + sc_] : 0.f;
            if (rowscale) v *= rowscale[k0 + k];
            st[k * 65 + n] = v;
        }
    }
    __syncthreads();
    {
        const int n = tid >> 2, kq = tid & 3; u32x4 w0, w1;
        const float* s = st + (kq * 16) * 65 + n;
        w0.x = pk_bf16(s[0 * 65], s[1 * 65]); w0.y = pk_bf16(s[2 * 65], s[3 * 65]); w0.z = pk_bf16(s[4 * 65], s[5 * 65]); w0.w = pk_bf16(s[6 * 65], s[7 * 65]);
        w1.x = pk_bf16(s[8 * 65], s[9 * 65]); w1.y = pk_bf16(s[10 * 65], s[11 * 65]); w1.z = pk_bf16(s[12 * 65], s[13 * 65]); w1.w = pk_bf16(s[14 * 65], s[15 * 65]);
        bf16_t* d = dst + (size_t)(n0 + n) * K + k0 + kq * 16;
        *(u32x4*)d = w0; *(u32x4*)(d + 8) = w1;
    }
    __syncthreads();
}
constexpr int CONV_TILES = 4880;
DEV void conv_job(const P& p, int layer, int t, float* st) {
    if (t < 1920) { conv_tile(p.w_in + (size_t)layer * DM * INC, INC, 1024, p.WinT, (t >> 4) * 64, (t & 15) * 64, 0, nullptr, st); return; }
    t -= 1920;
    if (t < 48) { conv_tile(p.w_a_uq + (size_t)layer * 256 * 768, 768, 256, p.WuqT, (t >> 2) * 64, (t & 3) * 64, 1, p.g_a_q + layer * 256, st); return; }
    t -= 48;
    if (t < 32) { conv_tile(p.w_a_ukv + (size_t)layer * 128 * 1024, 1024, 128, p.WukvT, (t >> 1) * 64, (t & 1) * 64, 2, p.g_a_kv + layer * 128, st); return; }
    t -= 32;
    if (t < 512) { const int n = t >> 7, r = t & 127; conv_tile(p.w_branch + ((size_t)layer * 4 + n) * 512 * 1024, 1024, 512, p.WbrT + (size_t)n * 1024 * 512, (r >> 3) * 64, (r & 7) * 64, 3, nullptr, st); return; }
    t -= 512;
    if (t < 256) { conv_tile(p.w_out + (size_t)layer * 1024 * 1024, 1024, 1024, p.WoutT, (t >> 4) * 64, (t & 15) * 64, 3, nullptr, st); return; }
    t -= 256;
    if (t < 1408) { conv_tile(p.w_ffn_in + (size_t)layer * 1024 * 2 * DFF, 2 * DFF, 1024, p.Wf1T, (t >> 4) * 64, (t & 15) * 64, 4, nullptr, st); return; }
    t -= 1408;
    { const int nt = t / 44, kt = t - nt * 44; conv_tile(p.w_ffn_out + (size_t)layer * DFF * 1024, 1024, DFF, p.Wf2T, nt * 64, kt * 64, 3, nullptr, st); }
}

DEV void mod_item(const P& p, int item, unsigned char* smraw) {
    const int tid = ltid(), lane = tid & 63, wid = uni(tid >> 6);
    float* sc = (float*)smraw;
    const int l = item / 96, cgp = item - l * 96;
    for (int i = tid; i < 17 * 1024; i += 256) {
        const int r = i >> 10, k = i & 1023; const float v = r < 16 ? p.c[r * 1024 + k] : p.c_ctx[k];
        sc[i] = v * frcp(1.f + fexp2(-v * LOG2E));
    }
    __syncthreads();
    float acc[17];
#pragma unroll
    for (int r = 0; r < 17; ++r) acc[r] = 0.f;
    const float* w = p.w_mod + ((size_t)l * 1024 + wid * 256) * 6144 + cgp * 64 + lane;
    for (int k = 0; k < 256; k += 4) {
        const float w0 = w[(size_t)k * 6144], w1 = w[(size_t)(k + 1) * 6144], w2 = w[(size_t)(k + 2) * 6144], w3 = w[(size_t)(k + 3) * 6144];
#pragma unroll
        for (int r = 0; r < 17; ++r) { const f32x4 s = *(const f32x4*)(sc + r * 1024 + wid * 256 + k); acc[r] += s[0] * w0 + s[1] * w1 + s[2] * w2 + s[3] * w3; }
    }
    __syncthreads();
    float* red = (float*)smraw;
#pragma unroll
    for (int r = 0; r < 17; ++r) red[(wid * 17 + r) * 64 + lane] = acc[r];
    __syncthreads();
    for (int i = tid; i < 17 * 64; i += 256) {
        const int r = i >> 6, ci = i & 63;
        const float v = red[(0 * 17 + r) * 64 + ci] + red[(1 * 17 + r) * 64 + ci] + red[(2 * 17 + r) * 64 + ci] + red[(3 * 17 + r) * 64 + ci] + p.b_mod[l * 6144 + cgp * 64 + ci];
        p.mod[((size_t)l * 17 + r) * 6144 + cgp * 64 + ci] = v;
    }
    __syncthreads();
}

DEV void r_phase(const P& p, int mode, int layer, int vb, int VG, int g_lo, int g_hi) {
    const int tid_ = ltid(), lane = tid_ & 63, wid = uni(tid_ >> 6);
    const int nw = VG * 4;
    for (int g = g_lo + vb * 4 + wid; g < g_hi; g += nw) {
        const int ch = g / MC, local = g - ch * MC;
        const float* hin; float* hout; const float* mod;
        if (local < LAT_C) {
            const int idx = ch * LAT_C + local; const int b = idx >> 11;
            hin = (mode == 0 ? p.x : p.out) + (size_t)idx * 1024; hout = p.out + (size_t)idx * 1024; mod = p.mod + ((size_t)layer * 17 + b) * 6144;
        } else {
            const int idx = ch * CTX_C + local - LAT_C;
            hin = (mode == 0 ? p.ctx : p.hc) + (size_t)idx * 1024; hout = p.hc + (size_t)idx * 1024; mod = p.mod + ((size_t)layer * 17 + 16) * 6144;
        }
        f32x4 h[4];
#pragma unroll
        for (int i = 0; i < 4; ++i) h[i] = *(const f32x4*)(hin + (i * 64 + lane) * 4);
        if (mode != 0) {
            f32x4 y[4]; float ss = 0.f;
#pragma unroll
            for (int i = 0; i < 4; ++i) {
                const u32x2 w = *(const u32x2*)((mode == 1 ? p.YC + (size_t)local * 1024 : p.U + (size_t)g * 1024) + (i * 64 + lane) * 4);
                y[i] = (f32x4){__uint_as_float(w.x << 16), __uint_as_float(w.x & 0xffff0000u), __uint_as_float(w.y << 16), __uint_as_float(w.y & 0xffff0000u)};
                ss += y[i][0] * y[i][0] + y[i][1] * y[i][1] + y[i][2] * y[i][2] + y[i][3] * y[i][3];
            }
            ss = wave_sum(ss);
            const float rs = rsqrtf(ss * (1.f / 1024.f) + 1e-6f);
            const float* gp = (mode == 1 ? p.g_post_mix : p.g_post_ffn) + layer * 1024;
            const float* ga = mod + (mode == 1 ? 2048 : 5120);
#pragma unroll
            for (int i = 0; i < 4; ++i) {
                const f32x4 gg = *(const f32x4*)(gp + (i * 64 + lane) * 4), aa = *(const f32x4*)(ga + (i * 64 + lane) * 4);
                h[i] = h[i] + aa * (y[i] * rs * gg);
            }
        }
#pragma unroll
        for (int i = 0; i < 4; ++i) *(f32x4*)(hout + (i * 64 + lane) * 4) = h[i];
        const int nl = (mode == 2) ? layer + 1 : layer;
        if (nl < DEPTH) {
            float ss = 0.f;
#pragma unroll
            for (int i = 0; i < 4; ++i) ss += h[i][0] * h[i][0] + h[i][1] * h[i][1] + h[i][2] * h[i][2] + h[i][3] * h[i][3];
            ss = wave_sum(ss);
            const float rs = rsqrtf(ss * (1.f / 1024.f) + 1e-6f);
            const float* gpre = (mode == 1 ? p.g_pre_ffn : p.g_pre_mix) + nl * 1024;
            const float* modn = (mode == 2) ? mod + 17 * 6144 : mod;
            const float* sh = modn + (mode == 1 ? 3072 : 0);
            const float* sc = modn + (mode == 1 ? 4096 : 1024);
#pragma unroll
            for (int i = 0; i < 4; ++i) {
                const int e = (i * 64 + lane) * 4;
                const f32x4 gg = *(const f32x4*)(gpre + e), s1 = *(const f32x4*)(sc + e), s0 = *(const f32x4*)(sh + e);
                const f32x4 u = h[i] * rs * gg * (s1 + 1.f) + s0;
                store4(p.U + (size_t)g * 1024 + e, u);
            }
        }
    }
}

DEV void gemm1_row(f32x4 (&v)[4], int row, int slab, bool lat, const P& p, int layer, int fq) {
    const bool hnorm = (slab >= 2048 && slab < 2688);
    const bool rope64 = lat && ((slab >= 384 && slab < 1024) || hnorm);
    const bool isq = (slab >= 384 && slab < 896) || (slab >= 1024 && slab < 1536) || (slab >= 2048 && slab < 2560);
    const float sc = isq ? 0.125f * LOG2E : 1.f;
    const bool kr = (slab == 2688);
    const int tok = row & 2047; const int pr = tok >> 6, pc = tok & 63;
    if (hnorm) {
        float ss = 0.f;
#pragma unroll
        for (int ft = 0; ft < 4; ++ft) ss += v[ft][0] * v[ft][0] + v[ft][1] * v[ft][1] + v[ft][2] * v[ft][2] + v[ft][3] * v[ft][3];
        ss += __shfl_xor(ss, 16); ss += __shfl_xor(ss, 32);
        const float rs = rsqrtf(ss * (1.f / 64.f) + 1e-6f);
        const float* g = (slab < 2560 ? p.g_d_q : p.g_d_k) + layer * 64;
#pragma unroll
        for (int ft = 0; ft < 4; ++ft) { const f32x4 gg = *(const f32x4*)(g + ft * 16 + fq * 4); v[ft] = v[ft] * rs * gg; }
    }
    if (rope64) {
#pragma unroll
        for (int j = 0; j < 4; ++j) {
            const int i = fq * 4 + j;
            f32x2 cs = p.rt16[pr * 16 + i]; float a = v[0][j], b = v[1][j];
            v[0][j] = a * cs[0] - b * cs[1]; v[1][j] = b * cs[0] + a * cs[1];
            cs = p.rt16[pc * 16 + i]; a = v[2][j]; b = v[3][j];
            v[2][j] = a * cs[0] - b * cs[1]; v[3][j] = b * cs[0] + a * cs[1];
        }
    }
    if (kr && lat) {
#pragma unroll
        for (int ft = 0; ft < 2; ++ft) {
            const int pos = ft == 0 ? pr : pc;
#pragma unroll
            for (int j = 0; j < 4; ++j) {
                const int i = (fq & 1) * 4 + j; const f32x2 cs = p.rt8[pos * 8 + i];
                const float xv = v[ft][j]; const float o = __shfl_xor(xv, 32);
                v[ft][j] = fq < 2 ? xv * cs[0] - o * cs[1] : xv * cs[0] + o * cs[1];
            }
        }
    }
    bf16_t* dst = p.PJ + (size_t)row * PJLD + slab + fq * 4;
    store4(dst, v[0] * sc); store4(dst + 16, v[1] * sc);
    if (!kr) { store4(dst + 32, v[2] * sc); store4(dst + 48, v[3] * sc); }
}
DEV void stage2_tile(const P& p, int mt, int j, unsigned char* smraw) {
    bf16_t* sm = (bf16_t*)smraw; float* s_rs = (float*)(smraw + 73728);
    const int tid = ltid(), lane = tid & 63, wid = uni(tid >> 6), wm = wid & 1, wn = wid >> 1, fr = lane & 15, fq = lane >> 4;
    const int m0 = mt * 128; const bool isq = j < 6; const bool lat = m0 < LAT_C;
    const int K = isq ? 256 : 128; const int acol = isq ? 0 : 256;
    {
        const int r = tid >> 1, hf = tid & 1; const int n = K >> 1;
        const bf16_t* src = p.PJ + (size_t)(m0 + r) * PJLD + acol + hf * n; float ss = 0.f;
        for (int i = 0; i < n; i += 8) {
            const u32x4 w = *(const u32x4*)(src + i);
#pragma unroll
            for (int q = 0; q < 4; ++q) { const float a = __uint_as_float(w[q] << 16), b = __uint_as_float(w[q] & 0xffff0000u); ss += a * a + b * b; }
        }
        ss += __shfl_xor(ss, 1);
        if (hf == 0) s_rs[r] = rsqrtf(ss / (float)K + 1e-6f);
    }
    __syncthreads();
    f32x4 acc[4][4];
    const bf16_t* A = p.PJ + (size_t)m0 * PJLD + acol;
    if (isq) {
        const int n0 = j * 128;
        gemm_mainloop<4, false>(A, PJLD, p.WuqT + (size_t)n0 * 256, 256, 256, acc, sm);
        const int slab = n0 + wn * 64; const float qs = 0.10206207261596577f * LOG2E;
#pragma unroll
        for (int tt = 0; tt < 4; ++tt) {
            const int lr = wm * 64 + tt * 16 + fr; const int row = m0 + lr; const float rs = s_rs[lr] * qs;
            const int tok = row & 2047; const int pr = tok >> 6, pc = tok & 63;
            f32x4 v[4] = {acc[0][tt], acc[1][tt], acc[2][tt], acc[3][tt]};
            if (slab >= 512 && lat) {
#pragma unroll
                for (int ft = 0; ft < 4; ++ft) {
                    const int pos = (ft & 1) == 0 ? pr : pc;
#pragma unroll
                    for (int jj = 0; jj < 4; ++jj) {
                        const int i = (fq & 1) * 4 + jj; const f32x2 cs = p.rt8[pos * 8 + i];
                        const float xv = v[ft][jj]; const float o = __shfl_xor(xv, 32);
                        v[ft][jj] = fq < 2 ? xv * cs[0] - o * cs[1] : xv * cs[0] + o * cs[1];
                    }
                }
            }
            bf16_t* dst = p.QA + (size_t)row * 768 + slab + fq * 4;
#pragma unroll
            for (int ft = 0; ft < 4; ++ft) store4(dst + ft * 16, v[ft] * rs);
        }
    } else {
        const int n0 = (j - 6) * 128;
        if (n0 < 512) {
            gemm_mainloop<4, false>(A, PJLD, p.WukvT + (size_t)n0 * 128, 128, 128, acc, sm);
#pragma unroll
            for (int tt = 0; tt < 4; ++tt) {
                const int lr = wm * 64 + tt * 16 + fr; const float rs = s_rs[lr];
                bf16_t* dst = p.KN + (size_t)(m0 + lr) * 512 + n0 + wn * 64 + fq * 4;
#pragma unroll
                for (int ft = 0; ft < 4; ++ft) store4(dst + ft * 16, acc[ft][tt] * rs);
            }
        } else {
            gemm_mainloop<4, true>(A, PJLD, p.WukvT + (size_t)n0 * 128, 128, 128, acc, sm);
            const int vrow0 = 768 + (n0 - 512) + wn * 64;
#pragma unroll
            for (int tt = 0; tt < 4; ++tt) {
                const int lr = wm * 64 + tt * 16 + fq * 4;
                const f32x4 rs = *(const f32x4*)(s_rs + lr);
                const int lp = wm * 64 + (tt >> 1) * 32 + fq * 8 + (tt & 1) * 4;
#pragma unroll
                for (int ft = 0; ft < 4; ++ft) store4(p.VT + (size_t)(vrow0 + ft * 16 + fr) * MC + m0 + lp, acc[ft][tt] * rs);
            }
        }
    }
    __syncthreads();
}

template <int MODE>
DEV void attn_item(const P& p, int layer, int item, bool ctxq, unsigned char* smraw) {
    constexpr bool GQA = (MODE == 1 || MODE == 3);
    constexpr int DQK = (MODE == 0) ? 96 : 64, NKS = DQK / 32;
    constexpr int KRB = (MODE == 0) ? 256 : 128, KM = (MODE == 0) ? 15 : 7;
    constexpr int KT_B = 64 * KRB, VT_B = 64 * 128;
    unsigned char* Ks = smraw; unsigned char* Vs = smraw + 32768; float* bias_s = (float*)(smraw + 49152);
    const int tid = ltid(), lane = tid & 63, wid = uni(tid >> 6), fr = lane & 15, fq = lane >> 4;
    const int nqt = ctxq ? (GQA ? 8 : 2) : (GQA ? 64 : 16);
    const int nh = GQA ? 2 : 8;
    const int qt = item % nqt, hh = (item / nqt) % nh, lb = item / (nqt * nh);
    const int head = GQA ? hh * 4 + wid : hh;
    const int tok0 = GQA ? qt * 32 : qt * 128 + wid * 32;
    const int qrow0 = (ctxq ? LAT_C + lb * CTX : lb * SEQ) + tok0;
    bf16x8 qf[2][NKS];
#pragma unroll
    for (int q = 0; q < 2; ++q) {
        const int row = qrow0 + q * 16 + fr;
        if (MODE == 0) {
            qf[q][0] = *(const bf16x8*)(p.QA + (size_t)row * 768 + head * 64 + fq * 8);
            qf[q][1] = *(const bf16x8*)(p.QA + (size_t)row * 768 + head * 64 + 32 + fq * 8);
            qf[q][NKS - 1] = *(const bf16x8*)(p.QA + (size_t)row * 768 + 512 + head * 32 + fq * 8);
        } else {
            const int qoff = MODE == 1 ? 384 : (MODE == 2 ? 1024 : 2048);
#pragma unroll
            for (int ks = 0; ks < NKS; ++ks) qf[q][ks] = *(const bf16x8*)(p.PJ + (size_t)row * PJLD + qoff + head * 64 + ks * 32 + fq * 8);
        }
    }
    const int koff = MODE == 1 ? 896 + hh * 64 : (MODE == 2 ? 1536 + hh * 64 : 2560 + hh * 64);
    const int vrow0 = MODE == 0 ? 768 + hh * 64 : (MODE == 1 ? hh * 64 : (MODE == 2 ? 128 + hh * 64 : 640 + hh * 64));
    int ktlo = 0, nlat = 0;
    if (!ctxq) {
        if (MODE == 0 || MODE == 3) { ktlo = 0; nlat = 32; }
        else if (MODE == 1) { const int q0 = qt * 32; const int lo = max(0, q0 - 128), hi = min(SEQ - 1, q0 + 159); ktlo = lo >> 6; nlat = (hi >> 6) - ktlo + 1; }
        else { const int r0a = min(max(2 * qt - 4, 0), 24), r0b = min(max(2 * qt + 1 - 4, 0), 24); ktlo = r0a; nlat = r0b + 8 - r0a; }
    }
    const int nt = 4 + nlat;
    const int ntf = ctxq ? 4 : ((MODE == 0 || MODE == 3) ? 36 : (MODE == 1 ? 9 : 13));
    if (MODE == 2 && !ctxq) { for (int i = tid; i < 465; i += 256) bias_s[i] = p.rpb_c[(layer * 8 + hh) * 465 + i] * LOG2E; }

    u32x4 rk[NKS], rv[2];
    auto tile_krow = [&](int it) { it = min(it, nt - 1); return it < 4 ? LAT_C + lb * CTX + it * 64 : lb * SEQ + (ktlo + it - 4) * 64; };
    auto gload = [&](int it) {
        const int krow = tile_krow(it);
#pragma unroll
        for (int i = 0; i < NKS; ++i) {
            const int id = tid + i * 256;
            if (MODE == 0) {
                const int key = id / 12, c = id - key * 12;
                const bf16_t* src = c < 8 ? p.KN + (size_t)(krow + key) * 512 + hh * 64 + c * 8 : p.PJ + (size_t)(krow + key) * PJLD + 2688 + (c - 8) * 8;
                rk[i] = *(const u32x4*)src;
            } else {
                const int key = id >> 3, c = id & 7;
                rk[i] = *(const u32x4*)(p.PJ + (size_t)(krow + key) * PJLD + koff + c * 8);
            }
        }
#pragma unroll
        for (int i = 0; i < 2; ++i) { const int id = tid + i * 256; const int dv = id >> 3, c = id & 7; rv[i] = *(const u32x4*)(p.VT + (size_t)(vrow0 + dv) * MC + krow + c * 8); }
    };
    auto lstore = [&](int buf) {
#pragma unroll
        for (int i = 0; i < NKS; ++i) {
            const int id = tid + i * 256; int key, c;
            if (MODE == 0) { key = id / 12; c = id - key * 12; } else { key = id >> 3; c = id & 7; }
            *(u32x4*)(Ks + buf * KT_B + key * KRB + ((c ^ (key & KM)) << 4)) = rk[i];
        }
#pragma unroll
        for (int i = 0; i < 2; ++i) { const int id = tid + i * 256; const int dv = id >> 3, c = id & 7; *(u32x4*)(Vs + buf * VT_B + dv * 128 + ((c ^ (dv & 7)) << 4)) = rv[i]; }
    };

    f32x4 o[4][2], lo[2], negm4[2]; float mref[2];
    const bf16x8 ones8 = __builtin_bit_cast(bf16x8, (u32x4){0x3F803F80u, 0x3F803F80u, 0x3F803F80u, 0x3F803F80u});
#pragma unroll
    for (int q = 0; q < 2; ++q) { mref[q] = 0.f; lo[q] = (f32x4){0.f, 0.f, 0.f, 0.f}; negm4[q] = (f32x4){0.f, 0.f, 0.f, 0.f};
#pragma unroll
        for (int d = 0; d < 4; ++d) o[d][q] = (f32x4){0.f, 0.f, 0.f, 0.f}; }

    gload(0); lstore(0); gload(1); __syncthreads();
    for (int it = 0; it < ntf; ++it) {
        const int cur = it & 1;
        if (it + 1 < ntf) lstore(cur ^ 1);
        if (it + 2 < ntf) gload(it + 2);
        __builtin_amdgcn_sched_barrier(0);
        const int kt = ktlo + it - 4;
        bool active = it < nt;
        int r = 0, r0 = 0;
        if (MODE == 2 && !ctxq && it >= 4) { r = 2 * qt + (wid >> 1); r0 = min(max(r - 4, 0), 24); active = active && (kt >= r0 && kt < r0 + 8); }
        if (active) {
            f32x4 s[4][2];
            const unsigned char* kb = Ks + cur * KT_B + fr * KRB;
            bf16x8 kf[4][NKS];
#pragma unroll
            for (int k4 = 0; k4 < 4; ++k4)
#pragma unroll
                for (int ks = 0; ks < NKS; ++ks) kf[k4][ks] = *(const bf16x8*)(kb + k4 * 16 * KRB + (((ks * 4 + fq) ^ (fr & KM)) << 4));
            __builtin_amdgcn_sched_barrier(0);
#pragma unroll
            for (int k4 = 0; k4 < 4; ++k4) {
#pragma unroll
                for (int q = 0; q < 2; ++q) s[k4][q] = mfma16(kf[k4][0], qf[q][0], negm4[q]);
#pragma unroll
                for (int ks = 1; ks < NKS; ++ks)
#pragma unroll
                    for (int q = 0; q < 2; ++q) s[k4][q] = mfma16(kf[k4][ks], qf[q][ks], s[k4][q]);
            }
            const unsigned char* vb = Vs + cur * VT_B + fr * 128;
            bf16x8 vf[4][2];
#pragma unroll
            for (int d = 0; d < 4; ++d)
#pragma unroll
                for (int kb2 = 0; kb2 < 2; ++kb2) vf[d][kb2] = *(const bf16x8*)(vb + d * 16 * 128 + (((kb2 * 4 + fq) ^ (fr & 7)) << 4));
            __builtin_amdgcn_sched_barrier(0);
            if (!ctxq && it >= 4) {
                if (MODE == 1) {
#pragma unroll
                    for (int q = 0; q < 2; ++q) {
                        const int qpos = tok0 + q * 16 + fr;
#pragma unroll
                        for (int k4 = 0; k4 < 4; ++k4)
#pragma unroll
                            for (int j = 0; j < 4; ++j) { const int d = qpos - (kt * 64 + k4 * 16 + fq * 4 + j); if (d > 128 || d < -128) s[k4][q][j] = -1e30f; }
                    }
                }
                if (MODE == 2) {
#pragma unroll
                    for (int q = 0; q < 2; ++q) {
                        const int qc = (wid & 1) * 32 + q * 16 + fr; const int c0 = min(max(qc - 8, 0), 48);
                        const int bbase = (kt - r + 7) * 31 + 15 - qc;
#pragma unroll
                        for (int k4 = 0; k4 < 4; ++k4)
#pragma unroll
                            for (int j = 0; j < 4; ++j) {
                                const int kc = k4 * 16 + fq * 4 + j; const bool ok = (kc >= c0 && kc < c0 + 16);
                                const float bv = bias_s[ok ? bbase + kc : 0];
                                s[k4][q][j] = ok ? s[k4][q][j] + bv : -1e30f;
                            }
                    }
                }
            }
            bf16x8 pf[2][2];
#pragma unroll
            for (int q = 0; q < 2; ++q) {
                float mx = -1e30f;
#pragma unroll
                for (int k4 = 0; k4 < 4; ++k4) mx = fmaxf(mx, fmaxf(fmaxf(s[k4][q][0], s[k4][q][1]), fmaxf(s[k4][q][2], s[k4][q][3])));
                mx = xmax32(xmax16(mx));
                const bool need = (it == 0) || (mx > 8.f);
                if (__builtin_amdgcn_ballot_w64(need) != 0ull) {
                    const float delta = need ? mx : 0.f;
                    mref[q] += delta; negm4[q] = negm4[q] - delta;
#pragma unroll
                    for (int k4 = 0; k4 < 4; ++k4) s[k4][q] = s[k4][q] - delta;
                    const float alpha = fexp2(-delta);
                    lo[q] = lo[q] * alpha;
#pragma unroll
                    for (int d = 0; d < 4; ++d) o[d][q] = o[d][q] * alpha;
                }
#pragma unroll
                for (int k4 = 0; k4 < 4; ++k4)
#pragma unroll
                    for (int j = 0; j < 4; ++j) s[k4][q][j] = fexp2(s[k4][q][j]);
#pragma unroll
                for (int kb2 = 0; kb2 < 2; ++kb2) {
                    u32x4 w; w.x = pk_bf16(s[2 * kb2][q][0], s[2 * kb2][q][1]); w.y = pk_bf16(s[2 * kb2][q][2], s[2 * kb2][q][3]);
                    w.z = pk_bf16(s[2 * kb2 + 1][q][0], s[2 * kb2 + 1][q][1]); w.w = pk_bf16(s[2 * kb2 + 1][q][2], s[2 * kb2 + 1][q][3]);
                    pf[q][kb2] = __builtin_bit_cast(bf16x8, w);
                }
            }
#pragma unroll
            for (int d = 0; d < 4; ++d)
#pragma unroll
                for (int kb2 = 0; kb2 < 2; ++kb2)
#pragma unroll
                    for (int q = 0; q < 2; ++q) o[d][q] = mfma16(vf[d][kb2], pf[q][kb2], o[d][q]);
#pragma unroll
            for (int kb2 = 0; kb2 < 2; ++kb2)
#pragma unroll
                for (int q = 0; q < 2; ++q) lo[q] = mfma16(ones8, pf[q][kb2], lo[q]);
        }
        __syncthreads();
    }
#pragma unroll
    for (int q = 0; q < 2; ++q) {
        float l = lo[q][0];
        if (MODE == 1) l += fexp2(p.sink_b[layer * 8 + head] * LOG2E - mref[q]);
        const float inv = 1.f / l;
        bf16_t* dst = p.O + (size_t)(qrow0 + q * 16 + fr) * 2048 + MODE * 512 + head * 64 + fq * 4;
#pragma unroll
        for (int d = 0; d < 4; ++d) store4(dst + d * 16, o[d][q] * inv);
    }
}

DEV void merge_tile(const P& p, int ch, int mt, int nt, bf16_t* sm) {
    const int tid_ = ltid(), lane = tid_ & 63, wid = uni(tid_ >> 6), wm = wid & 1, wn = wid >> 1, fr = lane & 15, fq = lane >> 4;
    const int m0 = mt * 128, n0 = nt * 64;
    f32x4 tot[2][4];
#pragma unroll
    for (int ft = 0; ft < 2; ++ft)
#pragma unroll
        for (int tt = 0; tt < 4; ++tt) tot[ft][tt] = (f32x4){0.f, 0.f, 0.f, 0.f};
    for (int n = 0; n < 4; ++n) {
        f32x4 u[2][4];
        gemm_mainloop<2, false>(p.O + (size_t)m0 * 2048 + n * 512, 2048, p.WbrT + ((size_t)n * 1024 + n0) * 512, 512, 512, u, sm);
#pragma unroll
        for (int tt = 0; tt < 4; ++tt) {
            const unsigned char* gp = p.G + (size_t)(m0 + wm * 64 + tt * 16 + fr) * 4096 + n * 1024 + n0 + wn * 32 + fq * 4;
#pragma unroll
            for (int ft = 0; ft < 2; ++ft) {
                const unsigned w = *(const unsigned*)(gp + ft * 16);
                f32x4 g; g[0] = (float)(w & 255u); g[1] = (float)((w >> 8) & 255u); g[2] = (float)((w >> 16) & 255u); g[3] = (float)(w >> 24);
                tot[ft][tt] = tot[ft][tt] + (g * (1.f / 255.f)) * u[ft][tt];
            }
        }
    }
#pragma unroll
    for (int tt = 0; tt < 4; ++tt) {
        bf16_t* dst = p.MB + (size_t)(m0 + wm * 64 + tt * 16 + fr) * 1024 + n0 + wn * 32 + fq * 4;
        store4(dst, tot[0][tt]); store4(dst + 16, tot[1][tt]);
    }
}
DEV void store_tile_T(const f32x4 (&acc)[4][4], bf16_t* base, int ld, int row0, int col0) {
    const int tid_ = ltid(), lane = tid_ & 63, wid = uni(tid_ >> 6), wm = wid & 1, wn = wid >> 1, fr = lane & 15, fq = lane >> 4;
#pragma unroll
    for (int tt = 0; tt < 4; ++tt) {
        bf16_t* dst = base + (size_t)(row0 + wm * 64 + tt * 16 + fr) * ld + col0 + wn * 64 + fq * 4;
#pragma unroll
        for (int ft = 0; ft < 4; ++ft) store4(dst + ft * 16, acc[ft][tt]);
    }
}

namespace pg8 {
#define PG8_LAS __attribute__((address_space(3)))
constexpr int BM = 256, BK = 64, HALF = 128, HTB = HALF * BK * 2  , STAGE_BYTES = 8 * HTB, NXCD = 8, WGM = 8;

__host__ __device__ __forceinline__ int lds_byte(int r, int c) { const int st = (r >> 4) * 2 + (c >> 5), rr = r & 15, cc = c & 31, ob = rr * 64 + cc * 2; return st * 1024 + (ob ^ (((ob >> 9) & 1) << 5)); }
__host__ __device__ __forceinline__ void stage_rc(int b, int& R, int& C) { const int st = b / 1024, sb = b % 1024, swz = sb ^ (((sb >> 9) & 1) << 5); R = (st >> 1) * 16 + swz / 64; C = (st & 1) * 32 + (swz % 64) / 2; }
__host__ __device__ __forceinline__ int perm32(int rho) { const int n = rho >> 4, i = rho & 15; return 8 * (i >> 2) + 4 * n + (i & 3); }

struct Unit { int pm, pn; };
struct Gemm { const bf16_t* A; const bf16_t* Bt; int M, N, K; };

template <class Epi, class Sched, bool ALIGN_EPI = false, bool SP2 = false, bool SWAPMMA = false>
__device__ __forceinline__ void gemm_phase(PG8_LAS unsigned char* lds, const Gemm g, const Sched& S, const Epi& E) {
    int tid = threadIdx.x; asm volatile("" : "+v"(tid));
    const int wid = __builtin_amdgcn_readfirstlane(tid >> 6), lane = tid & 63, wr = wid >> 2, wc = wid & 3, fr = lane & 15, fq = lane >> 4;
    const int K = g.K, nt = K / BK;
    unsigned voffA[2], voffB[2];
#pragma unroll
    for (int i = 0; i < 2; ++i) { int R, C; stage_rc(tid * 16 + i * 8192, R, C); const int Rb = Epi::PERM ? ((R & ~31) + perm32(R & 31)) : R;
        voffA[i] = (unsigned)(R * K + C) * 2u; voffB[i] = (unsigned)(Rb * K + C) * 2u; }
    const size_t kstep = (size_t)(BK * 2);
    const size_t hstep = (size_t)HALF * K * 2;
    const size_t tstep = 2 * hstep;
    const unsigned ldsw = (unsigned)wid * 1024u;
    const int aoff = lds_byte(wr * 64 + fr, fq * 8), boff = lds_byte(wc * 32 + fr, fq * 8);
#define PG8_SA(b, h) (((b) * 2 + (h)) * HTB)
#define PG8_SB(b, h) ((4 + (b) * 2 + (h)) * HTB)
#define PG8_STAGE(bufoff, gbase, voff) do { _Pragma("unroll") for (int _i = 0; _i < 2; ++_i) \
        __builtin_amdgcn_global_load_lds((const unsigned*)((const char*)(gbase) + (voff)[_i]), (PG8_LAS unsigned*)(lds + (bufoff) + ldsw + _i * 8192), 16, 0, 0); } while (0)
#define PG8_LDA(dst, b, h) do { _Pragma("unroll") for (int m = 0; m < 4; ++m) _Pragma("unroll") for (int k = 0; k < 2; ++k) dst[m][k] = *(const PG8_LAS bf16x8*)(lds + PG8_SA(b, h) + aoff + m * 2048 + k * 1024); } while (0)
#define PG8_LDB(dst, b, h) do { _Pragma("unroll") for (int n = 0; n < 2; ++n) _Pragma("unroll") for (int k = 0; k < 2; ++k) dst[n][k] = *(const PG8_LAS bf16x8*)(lds + PG8_SB(b, h) + boff + n * 2048 + k * 1024); } while (0)
#define PG8_MMA(ai, bj, At, Bt) do { __builtin_amdgcn_s_setprio(1); _Pragma("unroll") for (int m = 0; m < 4; ++m) _Pragma("unroll") for (int n = 0; n < 2; ++n) _Pragma("unroll") for (int k = 0; k < 2; ++k) \
        acc[ai][bj][m][n] = SWAPMMA ? __builtin_amdgcn_mfma_f32_16x16x32_bf16(At[m][k], Bt[n][k], acc[ai][bj][m][n], 0, 0, 0) : __builtin_amdgcn_mfma_f32_16x16x32_bf16(Bt[n][k], At[m][k], acc[ai][bj][m][n], 0, 0, 0); __builtin_amdgcn_s_setprio(0); } while (0)
#define PG8_WAIT_V(n) asm volatile("s_waitcnt vmcnt(" #n ")" ::: "memory")
#define PG8_WAIT_L(n) asm volatile("s_waitcnt lgkmcnt(" #n ")" ::: "memory")
#define PG8_BAR __builtin_amdgcn_s_barrier()
#define PG8_SCHED __builtin_amdgcn_sched_barrier(0)
    Unit cur, nxt; int ui = 0;
    if (!S.next(0, cur)) return;
    f32x4 acc[2][2][4][2];
#pragma unroll
    for (int a = 0; a < 2; ++a)
#pragma unroll
        for (int b = 0; b < 2; ++b)
#pragma unroll
            for (int m = 0; m < 4; ++m)
#pragma unroll
                for (int n = 0; n < 2; ++n) acc[a][b][m][n] = (f32x4){0.f, 0.f, 0.f, 0.f};
    bf16x8 At[4][2], B0[2][2], B1[2][2];
    const char* cA = (const char*)g.A + (size_t)cur.pm * tstep; const char* cB = (const char*)g.Bt + (size_t)cur.pn * tstep;
    S.a_ready(cur);
    if constexpr (SP2) {
        PG8_STAGE(PG8_SB(0, 0), cB, voffB); PG8_STAGE(PG8_SB(0, 1), cB + hstep, voffB); PG8_STAGE(PG8_SA(0, 0), cA, voffA); PG8_STAGE(PG8_SA(0, 1), cA + hstep, voffA);
        if (wr == 1) PG8_BAR;
        PG8_WAIT_V(2); PG8_BAR;
        PG8_STAGE(PG8_SB(1, 0), cB + kstep, voffB); PG8_STAGE(PG8_SA(1, 0), cA + kstep, voffA); PG8_STAGE(PG8_SB(1, 1), cB + hstep + kstep, voffB);
        PG8_WAIT_V(6); PG8_BAR;
    } else {
        PG8_STAGE(PG8_SB(0, 0), cB, voffB); PG8_STAGE(PG8_SA(0, 0), cA, voffA); PG8_STAGE(PG8_SB(0, 1), cB + hstep, voffB); PG8_STAGE(PG8_SA(0, 1), cA + hstep, voffA);
        if (wr == 1) PG8_BAR;
        PG8_WAIT_V(4); PG8_BAR;
        PG8_STAGE(PG8_SB(1, 0), cB + kstep, voffB); PG8_STAGE(PG8_SA(1, 0), cA + kstep, voffA); PG8_STAGE(PG8_SB(1, 1), cB + hstep + kstep, voffB);
        PG8_WAIT_V(6); PG8_BAR;
    }
    for (;;) {
        const bool has_next = S.next(ui + 1, nxt);
        const char* nA = has_next ? (const char*)g.A + (size_t)nxt.pm * tstep : cA; const char* nB = has_next ? (const char*)g.Bt + (size_t)nxt.pn * tstep : cB;
        for (int t = 0; t < nt; t += 2) {
            const bool last = (t == nt - 2);
            const char* a1 = cA + (size_t)(t + 1) * kstep;
            const char* a2 = last ? nA : cA + (size_t)(t + 2) * kstep; const char* b2 = last ? nB : cB + (size_t)(t + 2) * kstep;
            const char* a3 = a2 + kstep; const char* b3 = b2 + kstep;
            if (last && has_next) S.a_ready(nxt);
            if constexpr (SP2) {
            PG8_LDB(B0, 0, 0); PG8_LDB(B1, 0, 1); PG8_SCHED; PG8_LDA(At, 0, 0); PG8_STAGE(PG8_SA(1, 1), a1 + hstep, voffA);
            PG8_WAIT_V(8); PG8_WAIT_L(0); PG8_BAR; PG8_MMA(0, 0, At, B0); PG8_MMA(0, 1, At, B1); PG8_BAR; PG8_SCHED;
            PG8_LDA(At, 0, 1); PG8_STAGE(PG8_SB(0, 0), b2, voffB); PG8_STAGE(PG8_SB(0, 1), b2 + hstep, voffB); PG8_STAGE(PG8_SA(0, 0), a2, voffA);
            PG8_WAIT_V(8); PG8_WAIT_L(0); PG8_BAR; PG8_MMA(1, 0, At, B0); PG8_MMA(1, 1, At, B1); PG8_BAR; PG8_SCHED;
            PG8_LDB(B0, 1, 0); PG8_LDB(B1, 1, 1); PG8_SCHED; PG8_LDA(At, 1, 0); PG8_STAGE(PG8_SA(0, 1), a2 + hstep, voffA);
            PG8_WAIT_V(8); PG8_WAIT_L(0); PG8_BAR; PG8_MMA(0, 0, At, B0); PG8_MMA(0, 1, At, B1); PG8_BAR; PG8_SCHED;
            PG8_LDA(At, 1, 1); PG8_STAGE(PG8_SB(1, 0), b3, voffB); PG8_STAGE(PG8_SB(1, 1), b3 + hstep, voffB); PG8_STAGE(PG8_SA(1, 0), a3, voffA);
            PG8_WAIT_V(8); PG8_WAIT_L(0); PG8_BAR; PG8_MMA(1, 0, At, B0); PG8_MMA(1, 1, At, B1); PG8_BAR; PG8_SCHED;
            } else {
            PG8_LDB(B0, 0, 0); PG8_SCHED; PG8_LDA(At, 0, 0); PG8_STAGE(PG8_SA(1, 1), a1 + hstep, voffA);
            PG8_WAIT_L(8); PG8_BAR; PG8_WAIT_L(0); PG8_MMA(0, 0, At, B0); PG8_BAR; PG8_SCHED;
            PG8_LDB(B1, 0, 1); PG8_STAGE(PG8_SB(0, 0), b2, voffB);
            PG8_BAR; PG8_WAIT_L(0); PG8_MMA(0, 1, At, B1); PG8_BAR;
            PG8_LDA(At, 0, 1); PG8_STAGE(PG8_SA(0, 0), a2, voffA);
            PG8_BAR; PG8_WAIT_L(0); PG8_MMA(1, 0, At, B0); PG8_BAR; PG8_SCHED;
            PG8_STAGE(PG8_SB(0, 1), b2 + hstep, voffB);
            PG8_WAIT_V(6); PG8_BAR; PG8_MMA(1, 1, At, B1); PG8_BAR;
            PG8_LDB(B0, 1, 0); PG8_SCHED; PG8_LDA(At, 1, 0); PG8_STAGE(PG8_SA(0, 1), a2 + hstep, voffA);
            PG8_WAIT_L(8); PG8_BAR; PG8_WAIT_L(0); PG8_MMA(0, 0, At, B0); PG8_BAR; PG8_SCHED;
            PG8_LDB(B1, 1, 1); PG8_STAGE(PG8_SB(1, 0), b3, voffB);
            PG8_BAR; PG8_WAIT_L(0); PG8_MMA(0, 1, At, B1); PG8_BAR;
            PG8_LDA(At, 1, 1); PG8_STAGE(PG8_SA(1, 0), a3, voffA);
            PG8_BAR; PG8_WAIT_L(0); PG8_MMA(1, 0, At, B0); PG8_BAR; PG8_SCHED;
            PG8_STAGE(PG8_SB(1, 1), b3 + hstep, voffB);
            PG8_WAIT_V(6); PG8_BAR; PG8_MMA(1, 1, At, B1); PG8_BAR;
            }
        }
        if constexpr (ALIGN_EPI) { if (wr == 0) PG8_BAR; }
        if constexpr (!Epi::AFTER_DRAIN) { E(acc, cur, wr, wc, fr, fq); S.done(cur); }
        if (!has_next) break;
#pragma unroll
        for (int a = 0; a < 2; ++a)
#pragma unroll
            for (int b = 0; b < 2; ++b)
#pragma unroll
                for (int m = 0; m < 4; ++m)
#pragma unroll
                    for (int n = 0; n < 2; ++n) acc[a][b][m][n] = (f32x4){0.f, 0.f, 0.f, 0.f};
        cur = nxt; cA = nA; cB = nB; ++ui;
        if constexpr (ALIGN_EPI) { if (wr == 1) PG8_BAR; }
    }
    PG8_WAIT_V(0);
    if constexpr (!ALIGN_EPI) { if (wr == 0) PG8_BAR; }
    PG8_BAR;
    if constexpr (Epi::AFTER_DRAIN) { E.fused(acc, cur, wr, wc, fr, fq, lds, wid, lane); S.done(cur); }
#undef PG8_SA
#undef PG8_SB
#undef PG8_STAGE
#undef PG8_LDA
#undef PG8_LDB
#undef PG8_MMA
#undef PG8_WAIT_V
#undef PG8_WAIT_L
#undef PG8_BAR
#undef PG8_SCHED
}
}

struct XSched {
    int nN, nunits, G, c;
    DEV bool next(int i, pg8::Unit& u) const {
        const int L = i * G + c; if (L >= nunits) return false;
        const int U = ((nunits & 7) == 0 && (G & 7) == 0) ? (L & 7) * (nunits >> 3) + (L >> 3) : L;
        u.pm = U / nN; u.pn = U - u.pm * nN; return true;
    }
    DEV void a_ready(const pg8::Unit&) const {}
    DEV void done(const pg8::Unit&) const {}
};
struct EpiStoreT {
    static constexpr bool PERM = false, AFTER_DRAIN = false;
    bf16_t* out; int ld; int row_off;
    DEV void operator()(const f32x4 (&acc)[2][2][4][2], const pg8::Unit& u, int wr, int wc, int fr, int fq) const {
#pragma unroll
        for (int ai = 0; ai < 2; ++ai)
#pragma unroll
            for (int m = 0; m < 4; ++m) {
                bf16_t* d = out + (size_t)(row_off + u.pm * 256 + ai * 128 + wr * 64 + m * 16 + fr) * ld + u.pn * 256 + wc * 32 + fq * 4;
#pragma unroll
                for (int bj = 0; bj < 2; ++bj)
#pragma unroll
                    for (int n = 0; n < 2; ++n) store4(d + bj * 128 + n * 16, acc[ai][bj][m][n]);
            }
    }
};
struct EpiSwiglu {
    static constexpr bool PERM = false, AFTER_DRAIN = false;
    bf16_t* act;
    DEV void operator()(const f32x4 (&acc)[2][2][4][2], const pg8::Unit& u, int wr, int wc, int fr, int fq) const {
#pragma unroll
        for (int ai = 0; ai < 2; ++ai)
#pragma unroll
            for (int m = 0; m < 4; ++m) {
                bf16_t* d = act + (size_t)(u.pm * 256 + ai * 128 + wr * 64 + m * 16 + fr) * DFF + u.pn * 128 + wc * 16 + fq * 4;
#pragma unroll
                for (int bj = 0; bj < 2; ++bj) {
                    const f32x4 a = acc[ai][bj][m][0], b = acc[ai][bj][m][1]; f32x4 r;
#pragma unroll
                    for (int j = 0; j < 4; ++j) r[j] = a[j] * frcp(1.f + fexp2(-a[j] * LOG2E)) * b[j];
                    store4(d + bj * 64, r);
                }
            }
    }
};
struct EpiVT {
    static constexpr bool PERM = false, AFTER_DRAIN = false;
    bf16_t* vt;
    DEV void operator()(const f32x4 (&acc)[2][2][4][2], const pg8::Unit& u, int wr, int wc, int fr, int fq) const {
#pragma unroll
        for (int bj = 0; bj < 2; ++bj)
#pragma unroll
            for (int n = 0; n < 2; ++n) {
                bf16_t* d = vt + (size_t)(u.pn * 256 + bj * 128 + wc * 32 + n * 16 + fr) * MC + u.pm * 256 + wr * 64 + fq * 8;
#pragma unroll
                for (int ai = 0; ai < 2; ++ai)
#pragma unroll
                    for (int m = 0; m < 4; ++m) store4(d + ai * 128 + (m >> 1) * 32 + (m & 1) * 4, acc[ai][bj][m][n]);
            }
    }
};
struct EpiGate {
    static constexpr bool PERM = false, AFTER_DRAIN = false;
    unsigned char* g8;
    DEV void operator()(const f32x4 (&acc)[2][2][4][2], const pg8::Unit& u, int wr, int wc, int fr, int fq) const {
#pragma unroll
        for (int ai = 0; ai < 2; ++ai)
#pragma unroll
            for (int m = 0; m < 4; ++m) {
                unsigned char* d = g8 + (size_t)(u.pm * 256 + ai * 128 + wr * 64 + m * 16 + fr) * 4096 + u.pn * 256 + wc * 32 + fq * 4;
#pragma unroll
                for (int bj = 0; bj < 2; ++bj)
#pragma unroll
                    for (int n = 0; n < 2; ++n) {
                        const f32x4 a = acc[ai][bj][m][n]; unsigned w = 0;
#pragma unroll
                        for (int j = 0; j < 4; ++j) { const float s = frcp(1.f + fexp2(-a[j] * LOG2E)); w |= ((unsigned)(s * 255.f + 0.5f)) << (8 * j); }
                        *(unsigned*)(d + bj * 128 + n * 16) = w;
                    }
            }
    }
};
struct EpiGemm1 {
    static constexpr bool PERM = false, AFTER_DRAIN = false;
    const P* pp; int layer;
    DEV void operator()(const f32x4 (&acc)[2][2][4][2], const pg8::Unit& u, int wr, int wc, int fr, int fq) const {
        const int slab = u.pn * 256 + wc * 64; const bool lat = u.pm * 256 < LAT_C;
        if (slab >= 2752) return;
#pragma unroll
        for (int ai = 0; ai < 2; ++ai)
#pragma unroll
            for (int m = 0; m < 4; ++m) {
                f32x4 v[4] = {acc[ai][0][m][0], acc[ai][0][m][1], acc[ai][1][m][0], acc[ai][1][m][1]};
                gemm1_row(v, u.pm * 256 + ai * 128 + wr * 64 + m * 16 + fr, slab, lat, *pp, layer, fq);
            }
    }
};

#define LAS __attribute__((address_space(3)))
#define XB_TMO      128
#define XB_XCNT(j)  (256  + 64 * (j))
#define XB_XSUB(j)  (1280 + 64 * (j))
#define XB_XGEN(j)  (2304 + 64 * (j))
#define XB_TOP      3328
#define XB_TOPGEN   3392
#define XCD_BAR_WORDS 3456
#define XB_SPIN_CAP (1u << 18)

__device__ __forceinline__ unsigned xb_ld(unsigned* p)              { return __hip_atomic_load(p, __ATOMIC_RELAXED, __HIP_MEMORY_SCOPE_AGENT); }
__device__ __forceinline__ unsigned xb_add(unsigned* p, unsigned v) { return __hip_atomic_fetch_add(p, v, __ATOMIC_RELAXED, __HIP_MEMORY_SCOPE_AGENT); }
__device__ __forceinline__ unsigned xb_xcc_id() { return (unsigned)__builtin_amdgcn_s_getreg((3 << 11) | 20) & 0xFu; }
#define XB_SPIN(cond, bar) do { unsigned _sp = 0; while (cond) { __builtin_amdgcn_s_sleep(1); \
    if ((++_sp & 255u) == 0u) { if (xb_ld(&(bar)[XB_TMO])) break; if (_sp > XB_SPIN_CAP) { atomicAdd(&(bar)[XB_TMO], 1u); break; } } } } while (0)

struct XcdBarrier {
    unsigned* bar; unsigned x;
    volatile LAS unsigned* st;
};

__device__ __forceinline__ XcdBarrier xcd_barrier_post(unsigned* bar, volatile LAS unsigned* st) {
    XcdBarrier b; b.bar = bar; b.x = xb_xcc_id(); b.st = st;
    if (threadIdx.x == 0) (void)xb_add(&bar[XB_XCNT(b.x)], 1u);
    return b;
}
__device__ __forceinline__ void xcd_barrier_complete(unsigned* bar, unsigned x, unsigned& nloc, unsigned& nx) {
    const unsigned G = gridDim.x * gridDim.y * gridDim.z;
    unsigned sum, cnt, mine, sp = 0u;
    for (;;) {
        sum = 0u; cnt = 0u; mine = 0u;
#pragma unroll
        for (unsigned j = 0; j < 16; ++j) { const unsigned c = xb_ld(&bar[XB_XCNT(j)]); sum += c; cnt += (c > 0u) ? 1u : 0u; mine = (j == x) ? c : mine; }
        if (sum == G) break;
        __builtin_amdgcn_s_sleep(1);
        if ((++sp & 255u) == 0u) { if (xb_ld(&bar[XB_TMO])) break; if (sp > XB_SPIN_CAP) { atomicAdd(&bar[XB_TMO], 1u); break; } }
    }
    nloc = mine > 0u ? mine : 1u; nx = cnt > 0u ? cnt : 1u;
}

__device__ __forceinline__ void xcd_barrier(const XcdBarrier& b) {
    asm volatile("s_waitcnt vmcnt(0)" ::: "memory");
    __syncthreads();
    if (threadIdx.x == 0) {
        unsigned* bar = b.bar;
        __builtin_amdgcn_s_waitcnt(0);
        unsigned nloc = b.st[0], nx = b.st[1];
        if (nloc == 0u) { xcd_barrier_complete(bar, b.x, nloc, nx); b.st[0] = nloc; b.st[1] = nx; }
        const unsigned old = xb_add(&bar[XB_XSUB(b.x)], 1u);
        const unsigned gen = old / nloc;
        if (old + 1u == (gen + 1u) * nloc) {
            __builtin_amdgcn_fence(__ATOMIC_RELEASE, "agent");
            asm volatile("s_waitcnt vmcnt(0)" ::: "memory");
            const unsigned og = xb_add(&bar[XB_TOP], 1u);
            const unsigned tg = og / nx;
            if (og + 1u == (tg + 1u) * nx) xb_add(&bar[XB_TOPGEN], 1u);
            else XB_SPIN(xb_ld(&bar[XB_TOPGEN]) == tg, bar);
            __builtin_amdgcn_fence(__ATOMIC_ACQUIRE, "agent");
            xb_add(&bar[XB_XGEN(b.x)], 1u);
            asm volatile("s_waitcnt vmcnt(0)" ::: "memory");
        } else {
            XB_SPIN(xb_ld(&bar[XB_XGEN(b.x)]) == gen, bar);
            __builtin_amdgcn_fence(__ATOMIC_ACQUIRE, "agent");
            asm volatile("s_waitcnt vmcnt(0)" ::: "memory");
        }
    }
    __syncthreads();
}

typedef const __attribute__((address_space(4))) P* PP;
#define FRESH_P PP q_ = pp0; asm volatile("" : "+s"(q_)); const P& p = *(const P*)q_;
#define FRESH_BG int bidL = bid, GL = G; asm volatile("" : "+s"(bidL), "+s"(GL));
constexpr int DYN_LDS = 2 * SMEM_BYTES + 64;
__global__ void __launch_bounds__(512, 2) mega(P pv_) {
    cg::grid_group grid = cg::this_grid();
    PP pp0 = (PP)__builtin_amdgcn_kernarg_segment_ptr();
    extern __shared__ __attribute__((aligned(16))) unsigned char lds_dyn[];
    const int half = __builtin_amdgcn_readfirstlane((int)threadIdx.x >> 8);
    unsigned char* smraw = lds_dyn + half * SMEM_BYTES;
    bf16_t* sm = (bf16_t*)smraw;
    PG8_LAS unsigned char* ldsL = (PG8_LAS unsigned char*)lds_dyn;
    const int bid = blockIdx.x, G = gridDim.x, vb = bid * 2 + half, VG = G * 2, tid = threadIdx.x & 255;
    {
        FRESH_P
        volatile LAS unsigned* xst = (volatile LAS unsigned*)(ldsL + 2 * SMEM_BYTES);
        if (threadIdx.x == 0) { xst[0] = 0u; xst[1] = 0u; }
        __syncthreads();
        const XcdBarrier xb0 = xcd_barrier_post(p.barw, xst);
        if (threadIdx.x == 0) xst[2] = xb0.x;
        __syncthreads();
    }
#define GBAR() do { FRESH_P XcdBarrier b_; b_.bar = p.barw; b_.st = (volatile LAS unsigned*)(ldsL + 2 * SMEM_BYTES); b_.x = b_.st[2]; xcd_barrier(b_); } while (0)

    { FRESH_P
    for (int i = vb * 256 + tid; i < 64 * 16 + 64 * 8; i += VG * 256) {
        if (i < 1024) { const int pos = i >> 4, k = i & 15; const float inv = fexp2(-(float)k * (13.287712379549449f / 16.f)); const float a = (float)pos * inv; p.rt16[i] = (f32x2){__cosf(a), __sinf(a)}; }
        else { const int q = i - 1024; const int pos = q >> 3, k = q & 7; const float inv = fexp2(-(float)k * (13.287712379549449f / 8.f)); const float a = (float)pos * inv; p.rt8[q] = (f32x2){__cosf(a), __sinf(a)}; }
    }
    for (int t = vb; t < 384 + CONV_TILES; t += VG) { if (t < 384) mod_item(p, t, smraw); else conv_job(p, 0, t - 384, (float*)smraw); }
    }
    GBAR();
    { FRESH_P r_phase(p, 0, 0, vb, VG, 0, MTOT); }
    GBAR();

    for (int layer = 0; layer < DEPTH; ++layer) {
        for (int ch = 0; ch < NCH; ++ch) {
            { FRESH_P FRESH_BG
              const bf16_t* A = p.U + (size_t)ch * MC * 1024;
              { pg8::Gemm g{A, p.WinT, MC, 2816, 1024}; XSched S{11, 792, GL, bidL}; EpiGemm1 E{&p, layer};
                pg8::gemm_phase<EpiGemm1, XSched, true, true, false>(ldsL, g, S, E); }
              { pg8::Gemm g{A, p.WinT + (size_t)2816 * 1024, MC, 768, 1024}; XSched S{3, 216, GL, (bidL + GL - (792 % GL)) % GL}; EpiVT E{p.VT};
                pg8::gemm_phase<EpiVT, XSched, true, true, true>(ldsL, g, S, E); }
              { pg8::Gemm g{A, p.WinT + (size_t)NPROJ * 1024, MC, 4096, 1024}; XSched S{16, 1152, GL, (bidL + GL - (1008 % GL)) % GL}; EpiGate E{p.G};
                pg8::gemm_phase<EpiGate, XSched, true, true, false>(ldsL, g, S, E); }
            }
            GBAR();
            { FRESH_P for (int t = vb; t < 1024 + 1024 + 2016 + 384; t += VG) {
                if (t < 1024) attn_item<2>(p, layer, t, false, smraw);
                else if (t < 2048) attn_item<1>(p, layer, t - 1024, false, smraw);
                else if (t < 4064) { const int q = t - 2048; stage2_tile(p, q / 14, q % 14, smraw); }
                else if (t < 4192) attn_item<1>(p, layer, t - 4064, true, smraw);
                else if (t < 4320) attn_item<2>(p, layer, t - 4192, true, smraw);
                else attn_item<3>(p, layer, t - 4320, true, smraw);
            } }
            GBAR();
            { FRESH_P for (int t = vb; t < 1024 + 1024 + 128; t += VG) {
                if (t < 1024) attn_item<0>(p, layer, t, false, smraw);
                else if (t < 2048) attn_item<3>(p, layer, t - 1024, false, smraw);
                else attn_item<0>(p, layer, t - 2048, true, smraw);
            } }
            GBAR();
            { FRESH_P for (int t = vb; t < 144 * 16; t += VG) merge_tile(p, ch, t >> 4, t & 15, sm); }
            GBAR();
            { FRESH_P FRESH_BG pg8::Gemm g{p.MB, p.WoutT, MC, 1024, 1024}; XSched S{4, 288, GL, bidL}; EpiStoreT E{p.YC, 1024, 0};
              pg8::gemm_phase<EpiStoreT, XSched, true, true, false>(ldsL, g, S, E); }
            GBAR();
            { FRESH_P r_phase(p, 1, layer, vb, VG, ch * MC, (ch + 1) * MC); }
            GBAR();
        }
        { FRESH_P FRESH_BG pg8::Gemm g{p.U, p.Wf1T, MTOT, 2 * DFF, 1024}; XSched S{22, 3168, GL, bidL}; EpiSwiglu E{p.ACT};
          pg8::gemm_phase<EpiSwiglu, XSched, true, true, false>(ldsL, g, S, E); }
        GBAR();
        { FRESH_P FRESH_BG pg8::Gemm g{p.ACT, p.Wf2T, MTOT, 1024, DFF}; XSched S{4, 576, GL, bidL}; EpiStoreT E{p.U, 1024, 0};
          pg8::gemm_phase<EpiStoreT, XSched, true, true, false>(ldsL, g, S, E); }
        GBAR();
        { FRESH_P r_phase(p, 2, layer, vb, VG, 0, MTOT);
          if (layer + 1 < DEPTH) { for (int t = vb; t < CONV_TILES; t += VG) conv_job(p, layer + 1, t, (float*)smraw); } }
        GBAR();
    }
}

extern "C" void kernel_launch(void* const* d_in, const int* in_sizes, int n_in, void* d_out, int out_size, void* d_ws, size_t ws_size, hipStream_t stream) {
    static int grid_blocks = 0;
    if (!grid_blocks) {
        int dev = 0, cus = 0, per_cu = 0;
        (void)hipGetDevice(&dev);
        (void)hipDeviceGetAttribute(&cus, hipDeviceAttributeMultiprocessorCount, dev);
        if (hipFuncSetAttribute((const void*)mega, hipFuncAttributeMaxDynamicSharedMemorySize, DYN_LDS) != hipSuccess) fprintf(stderr, "hipFuncSetAttribute failed\n");
        (void)hipOccupancyMaxActiveBlocksPerMultiprocessor(&per_cu, mega, 512, DYN_LDS);
        grid_blocks = cus;
    }
    P p{};
    const float** f = (const float**)&p;
    for (int i = 0; i < 23; ++i) f[i] = (const float*)d_in[i];
    p.out = (float*)d_out;
    unsigned char* w = (unsigned char*)d_ws; size_t off = 0;
    auto take = [&](size_t bytes) { void* r = w + off; off += (bytes + 255) & ~(size_t)255; return r; };
    p.WinT = (bf16_t*)take((size_t)NWIN * 1024 * 2);
    p.WuqT = (bf16_t*)take((size_t)768 * 256 * 2);
    p.WukvT = (bf16_t*)take((size_t)1024 * 128 * 2);
    p.WbrT = (bf16_t*)take((size_t)4 * 1024 * 512 * 2);
    p.WoutT = (bf16_t*)take((size_t)1024 * 1024 * 2);
    p.Wf1T = (bf16_t*)take((size_t)2 * DFF * 1024 * 2);
    p.Wf2T = (bf16_t*)take((size_t)1024 * DFF * 2);
    p.mod = (float*)take((size_t)DEPTH * 17 * 6144 * 4);
    p.rt16 = (f32x2*)take(64 * 16 * 8);
    p.rt8 = (f32x2*)take(64 * 8 * 8);
    p.hc = (float*)take((size_t)NBATCH * CTX * 1024 * 4);
    p.U = (bf16_t*)take((size_t)MTOT * 1024 * 2);
    p.G = (unsigned char*)take((size_t)MC * 4096);
    p.barw = (unsigned*)take((size_t)XCD_BAR_WORDS * 4);
    unsigned char* R = (unsigned char*)take(0);
    p.PJ = (bf16_t*)take((size_t)MC * PJLD * 2);
    p.QA = (bf16_t*)take((size_t)MC * 768 * 2);
    p.KN = (bf16_t*)take((size_t)MC * 512 * 2);
    p.VT = (bf16_t*)take((size_t)VTROWS * MC * 2);
    p.O = (bf16_t*)take((size_t)MC * 2048 * 2);
    p.YC = p.O;
    p.MB = p.PJ;
    p.ACT = (bf16_t*)R;
    if (off > ws_size) { fprintf(stderr, "workspace too small: need %zu have %zu\n", off, ws_size); return; }
    (void)hipMemsetAsync(p.barw, 0, (size_t)XCD_BAR_WORDS * 4, stream);
    void* args[] = {&p};
    hipError_t e = hipLaunchCooperativeKernel((void*)mega, dim3(grid_blocks), dim3(512), args, DYN_LDS, stream);
    if (e != hipSuccess) fprintf(stderr, "cooperative launch failed: %s (grid %d)\n", hipGetErrorString(e), grid_blocks);
}
```

```cpp
#include <hip/hip_runtime.h>
#include <hip/hip_cooperative_groups.h>
#include <cstdio>
#include <cstdint>
namespace cg = cooperative_groups;

typedef unsigned short bf16_t;
typedef short bf16x8 __attribute__((ext_vector_type(8)));
typedef short bf16x4 __attribute__((ext_vector_type(4)));
typedef float f32x4 __attribute__((ext_vector_type(4)));
typedef float f32x2 __attribute__((ext_vector_type(2)));
typedef unsigned u32x2 __attribute__((ext_vector_type(2)));
typedef unsigned u32x4 __attribute__((ext_vector_type(4)));
#define DEV __device__ __forceinline__

constexpr int DM = 1024, NBATCH = 16, SEQ = 2048, CTX = 256, DEPTH = 4;
constexpr int NCH = 2, BPC = NBATCH / NCH, LAT_C = BPC * SEQ, CTX_C = BPC * CTX, MC = LAT_C + CTX_C, MTOT = MC * NCH;
constexpr int INC = 7584, NPROJ = 3584, NWIN = 7680, PJLD = 2816, DFF = 2816, VTROWS = 1280;
#ifndef REP_G
#define REP_G 1
#endif
#ifndef REP_M
#define REP_M 1
#endif
#ifndef REP_A
#define REP_A 1
#endif
constexpr float LOG2E = 1.4426950408889634f;
constexpr int LST = 72;
constexpr int TILE_E = 128 * LST;
constexpr int SMEM_BYTES = 4 * TILE_E * 2 + 1024;

struct P {
    const float *x, *c, *ctx, *c_ctx, *w_mod, *b_mod, *g_pre_mix, *g_post_mix, *g_pre_ffn, *g_post_ffn, *w_in, *g_a_q, *g_a_kv,
        *w_a_uq, *w_a_ukv, *sink_b, *rpb_c, *g_d_q, *g_d_k, *w_branch, *w_out, *w_ffn_in, *w_ffn_out;
    float* out;
    bf16_t *WinT, *WuqT, *WukvT, *WbrT, *WoutT, *Wf1T, *Wf2T;
    float* mod; f32x2 *rt16, *rt8; float* hc;
    bf16_t *U, *YC, *PJ, *QA, *KN, *VT, *O, *MB, *ACT;
    unsigned char* G;
    unsigned* barw;
};

typedef __bf16 bf16v2 __attribute__((ext_vector_type(2)));
DEV unsigned pk_bf16(float lo, float hi) { bf16v2 v = __builtin_convertvector((f32x2){lo, hi}, bf16v2); return __builtin_bit_cast(unsigned, v); }
DEV float bf2f(unsigned short v) { return __uint_as_float(((unsigned)v) << 16); }
DEV void store4(bf16_t* p, f32x4 v) { u32x2 w; w.x = pk_bf16(v[0], v[1]); w.y = pk_bf16(v[2], v[3]); *(u32x2*)p = w; }
DEV float fexp2(float x) { return __builtin_amdgcn_exp2f(x); }
DEV float frcp(float x) { return __builtin_amdgcn_rcpf(x); }
DEV float wave_sum(float v) {
    v += __shfl_xor(v, 1); v += __shfl_xor(v, 2); v += __shfl_xor(v, 4); v += __shfl_xor(v, 8); v += __shfl_xor(v, 16); v += __shfl_xor(v, 32); return v;
}
DEV int ltid() { int t = threadIdx.x & 255; asm volatile("" : "+v"(t)); return t; }
DEV int uni(int v) { return __builtin_amdgcn_readfirstlane(v); }
DEV float xmax16(float x) { auto r = __builtin_amdgcn_permlane16_swap(__float_as_uint(x), __float_as_uint(x), false, false); return fmaxf(__uint_as_float(r[0]), __uint_as_float(r[1])); }
DEV float xmax32(float x) { auto r = __builtin_amdgcn_permlane32_swap(__float_as_uint(x), __float_as_uint(x), false, false); return fmaxf(__uint_as_float(r[0]), __uint_as_float(r[1])); }
DEV float xadd16(float x) { auto r = __builtin_amdgcn_permlane16_swap(__float_as_uint(x), __float_as_uint(x), false, false); return __uint_as_float(r[0]) + __uint_as_float(r[1]); }
DEV float xadd32(float x) { auto r = __builtin_amdgcn_permlane32_swap(__float_as_uint(x), __float_as_uint(x), false, false); return __uint_as_float(r[0]) + __uint_as_float(r[1]); }
DEV f32x4 mfma16(bf16x8 a, bf16x8 b, f32x4 c) { return __builtin_amdgcn_mfma_f32_16x16x32_bf16(a, b, c, 0, 0, 0); }

template <int NFT, bool SWAP>
DEV void gemm_mainloop(const bf16_t* __restrict__ A, int lda, const bf16_t* __restrict__ Bt, int ldb, int K, f32x4 (&acc)[NFT][4], bf16_t* sm) {
    const int tid = ltid(), lane = tid & 63, wid = uni(tid >> 6), wm = wid & 1, wn = wid >> 1, fr = lane & 15, fq = lane >> 4;
    unsigned char* sA = (unsigned char*)sm; unsigned char* sB = sA + 2 * 16384;
    const int lrow = tid >> 3, lc8 = (tid & 7) * 8;
    const int wofs = lrow * 128 + (((tid & 7) ^ (lrow & 7)) << 4);
    const bf16_t* ga = A + (size_t)lrow * lda + lc8;
    const bf16_t* gb = Bt + (size_t)lrow * ldb + lc8;
    u32x4 ra[4], rb[NFT];
#pragma unroll
    for (int ft = 0; ft < NFT; ++ft)
#pragma unroll
        for (int tt = 0; tt < 4; ++tt) acc[ft][tt] = (f32x4){0.f, 0.f, 0.f, 0.f};
#pragma unroll
    for (int i = 0; i < 4; ++i) ra[i] = *(const u32x4*)(ga + (size_t)(i * 32) * lda);
#pragma unroll
    for (int i = 0; i < NFT; ++i) rb[i] = *(const u32x4*)(gb + (size_t)(i * 32) * ldb);
#pragma unroll
    for (int i = 0; i < 4; ++i) *(u32x4*)(sA + wofs + i * 4096) = ra[i];
#pragma unroll
    for (int i = 0; i < NFT; ++i) *(u32x4*)(sB + wofs + i * 4096) = rb[i];
    const int nk = K >> 6;
    if (nk > 1) {
#pragma unroll
        for (int i = 0; i < 4; ++i) ra[i] = *(const u32x4*)(ga + (size_t)(i * 32) * lda + 64);
#pragma unroll
        for (int i = 0; i < NFT; ++i) rb[i] = *(const u32x4*)(gb + (size_t)(i * 32) * ldb + 64);
    }
    __syncthreads();
    const int rofs0 = ((0 + fq) ^ (fr & 7)) << 4, rofs1 = ((4 + fq) ^ (fr & 7)) << 4;
    for (int kt = 0; kt < nk; ++kt) {
        const int cur = kt & 1;
        if (kt + 1 < nk) {
            const int nx = cur ^ 1;
#pragma unroll
            for (int i = 0; i < 4; ++i) *(u32x4*)(sA + nx * 16384 + wofs + i * 4096) = ra[i];
#pragma unroll
            for (int i = 0; i < NFT; ++i) *(u32x4*)(sB + nx * 16384 + wofs + i * 4096) = rb[i];
        }
        if (kt + 2 < nk) {
            const int ko = (kt + 2) * 64;
#pragma unroll
            for (int i = 0; i < 4; ++i) ra[i] = *(const u32x4*)(ga + (size_t)(i * 32) * lda + ko);
#pragma unroll
            for (int i = 0; i < NFT; ++i) rb[i] = *(const u32x4*)(gb + (size_t)(i * 32) * ldb + ko);
        }
        __builtin_amdgcn_sched_barrier(0);
        const unsigned char* cA = sA + cur * 16384 + (wm * 64 + fr) * 128;
        const unsigned char* cB = sB + cur * 16384 + (wn * NFT * 16 + fr) * 128;
#pragma unroll
        for (int ks = 0; ks < 2; ++ks) {
            const int ro = ks ? rofs1 : rofs0;
            bf16x8 af[4], wf[NFT];
#pragma unroll
            for (int tt = 0; tt < 4; ++tt) af[tt] = *(const bf16x8*)(cA + tt * 2048 + ro);
#pragma unroll
            for (int ft = 0; ft < NFT; ++ft) wf[ft] = *(const bf16x8*)(cB + ft * 2048 + ro);
#pragma unroll
            for (int ft = 0; ft < NFT; ++ft)
#pragma unroll
                for (int tt = 0; tt < 4; ++tt) acc[ft][tt] = SWAP ? mfma16(af[tt], wf[ft], acc[ft][tt]) : mfma16(wf[ft], af[tt], acc[ft][tt]);
        }
        __syncthreads();
    }
}

DEV bool tile_xcd(int q, int x, int nM, int nN, int& m, int& n) {
    const int j = q >> 5, w = q & 31;
    const int pp = (((j >> 1) * 8 + x) << 1) + (j & 1);
    const int npn = nN >> 2;
    if (pp >= (nM >> 3) * npn) return false;
    const int pm = pp / npn, pn = pp - pm * npn;
    m = pm * 8 + (w & 7); n = pn * 4 + (w >> 3);
    return true;
}
#define TILE_LOOP(nM, nN) const int x_ = bid & 7, spx_ = G >> 3; int mt, nt; for (int q_ = bid >> 3; tile_xcd(q_, x_, nM, nN, mt, nt); q_ += spx_)

DEV int srccol(int mapid, int n) {
    switch (mapid) {
    case 0:
        if (n < 2816) { const int rho = n & 255; n = (n & ~255) + ((rho >> 5) & 3) * 64 + (rho >> 7) * 32 + (rho & 31); }
        if (n < 384) return n;
        if (n < 896) return n - 384 + 416;
        if (n < 1024) return n - 896 + 928;
        if (n < 1536) return n - 1024 + 1184;
        if (n < 2048) return n - 1536 + 1696;
        if (n < 2560) return n - 2048 + 2720;
        if (n < 2688) return n - 2560 + 3232;
        if (n < 2720) return n - 2688 + 384;
        if (n < 2816) return -1;
        if (n < 2944) return n - 2816 + 1056;
        if (n < 3456) return n - 2944 + 2208;
        if (n < 3584) return n - 3456 + 3360;
        return n - 3584 + 3488;
    case 1: if (n < 512) return (n >> 6) * 96 + (n & 63); { const int q = n - 512; return (q >> 5) * 96 + 64 + (q & 31); }
    case 2: if (n < 512) return (n >> 6) * 128 + (n & 63); { const int q = n - 512; return (q >> 6) * 128 + 64 + (q & 63); }
    case 4: { const int pn = n >> 8, bj = (n >> 7) & 1, wc = (n >> 5) & 3, s = (n >> 4) & 1, f = n & 15; return s * DFF + pn * 128 + bj * 64 + wc * 16 + f; }
    default: return n;
    }
}
DEV void conv_tile(const float* __restrict__ src, int lds_, int K, bf16_t* __restrict__ dst, int n0, int k0, int mapid, const float* rowscale, float* st) {
    const int tid = ltid();
    {
        const int n = tid & 63, kk = tid >> 6; const int sc_ = srccol(mapid, n0 + n);
#pragma unroll
        for (int i = 0; i < 16; ++i) {
            const int k = kk * 16 + i;
            float v = sc_ >= 0 ? src[(size_t)(k0 + k) * lds_ + sc_] : 0.f;
            if (rowscale) v *= rowscale[k0 + k];
            st[k * 65 + n] = v;
        }
    }
    __syncthreads();
    {
        const int n = tid >> 2, kq = tid & 3; u32x4 w0, w1;
        const float* s = st + (kq * 16) * 65 + n;
        w0.x = pk_bf16(s[0 * 65], s[1 * 65]); w0.y = pk_bf16(s[2 * 65], s[3 * 65]); w0.z = pk_bf16(s[4 * 65], s[5 * 65]); w0.w = pk_bf16(s[6 * 65], s[7 * 65]);
        w1.x = pk_bf16(s[8 * 65], s[9 * 65]); w1.y = pk_bf16(s[10 * 65], s[11 * 65]); w1.z = pk_bf16(s[12 * 65], s[13 * 65]); w1.w = pk_bf16(s[14 * 65], s[15 * 65]);
        bf16_t* d = dst + (size_t)(n0 + n) * K + k0 + kq * 16;
        *(u32x4*)d = w0; *(u32x4*)(d + 8) = w1;
    }
    __syncthreads();
}
constexpr int CONV_TILES = 4880;
DEV void conv_job(const P& p, int layer, int t, float* st) {
    if (t < 1920) { conv_tile(p.w_in + (size_t)layer * DM * INC, INC, 1024, p.WinT, (t >> 4) * 64, (t & 15) * 64, 0, nullptr, st); return; }
    t -= 1920;
    if (t < 48) { conv_tile(p.w_a_uq + (size_t)layer * 256 * 768, 768, 256, p.WuqT, (t >> 2) * 64, (t & 3) * 64, 1, p.g_a_q + layer * 256, st); return; }
    t -= 48;
    if (t < 32) { conv_tile(p.w_a_ukv + (size_t)layer * 128 * 1024, 1024, 128, p.WukvT, (t >> 1) * 64, (t & 1) * 64, 2, p.g_a_kv + layer * 128, st); return; }
    t -= 32;
    if (t < 512) { conv_tile(p.w_branch + (size_t)layer * 4 * 512 * 1024, 1024, 2048, p.WbrT, (t >> 5) * 64, (t & 31) * 64, 3, nullptr, st); return; }
    t -= 512;
    if (t < 256) { conv_tile(p.w_out + (size_t)layer * 1024 * 1024, 1024, 1024, p.WoutT, (t >> 4) * 64, (t & 15) * 64, 3, nullptr, st); return; }
    t -= 256;
    if (t < 1408) { conv_tile(p.w_ffn_in + (size_t)layer * 1024 * 2 * DFF, 2 * DFF, 1024, p.Wf1T, (t >> 4) * 64, (t & 15) * 64, 4, nullptr, st); return; }
    t -= 1408;
    { const int nt = t / 44, kt = t - nt * 44; conv_tile(p.w_ffn_out + (size_t)layer * DFF * 1024, 1024, DFF, p.Wf2T, nt * 64, kt * 64, 3, nullptr, st); }
}

DEV void mod_item(const P& p, int item, unsigned char* smraw) {
    const int tid = ltid(), lane = tid & 63, wid = uni(tid >> 6);
    float* sc = (float*)smraw;
    const int l = item / 96, cgp = item - l * 96;
    for (int i = tid; i < 17 * 1024; i += 256) {
        const int r = i >> 10, k = i & 1023; const float v = r < 16 ? p.c[r * 1024 + k] : p.c_ctx[k];
        sc[i] = v * frcp(1.f + fexp2(-v * LOG2E));
    }
    __syncthreads();
    float acc[17];
#pragma unroll
    for (int r = 0; r < 17; ++r) acc[r] = 0.f;
    const float* w = p.w_mod + ((size_t)l * 1024 + wid * 256) * 6144 + cgp * 64 + lane;
    for (int k = 0; k < 256; k += 4) {
        const float w0 = w[(size_t)k * 6144], w1 = w[(size_t)(k + 1) * 6144], w2 = w[(size_t)(k + 2) * 6144], w3 = w[(size_t)(k + 3) * 6144];
#pragma unroll
        for (int r = 0; r < 17; ++r) { const f32x4 s = *(const f32x4*)(sc + r * 1024 + wid * 256 + k); acc[r] += s[0] * w0 + s[1] * w1 + s[2] * w2 + s[3] * w3; }
    }
    __syncthreads();
    float* red = (float*)smraw;
#pragma unroll
    for (int r = 0; r < 17; ++r) red[(wid * 17 + r) * 64 + lane] = acc[r];
    __syncthreads();
    for (int i = tid; i < 17 * 64; i += 256) {
        const int r = i >> 6, ci = i & 63;
        const float v = red[(0 * 17 + r) * 64 + ci] + red[(1 * 17 + r) * 64 + ci] + red[(2 * 17 + r) * 64 + ci] + red[(3 * 17 + r) * 64 + ci] + p.b_mod[l * 6144 + cgp * 64 + ci];
        p.mod[((size_t)l * 17 + r) * 6144 + cgp * 64 + ci] = v;
    }
    __syncthreads();
}

DEV void r_phase(const P& p, int mode, int layer, int vb, int VG, int g_lo, int g_hi) {
    const int tid_ = ltid(), lane = tid_ & 63, wid = uni(tid_ >> 6);
    const int nw = VG * 4;
    for (int g = g_lo + vb * 4 + wid; g < g_hi; g += nw) {
        const int ch = g / MC, local = g - ch * MC;
        const float* hin; float* hout; const float* mod;
        if (local < LAT_C) {
            const int idx = ch * LAT_C + local; const int b = idx >> 11;
            hin = (mode == 0 ? p.x : p.out) + (size_t)idx * 1024; hout = p.out + (size_t)idx * 1024; mod = p.mod + ((size_t)layer * 17 + b) * 6144;
        } else {
            const int idx = ch * CTX_C + local - LAT_C;
            hin = (mode == 0 ? p.ctx : p.hc) + (size_t)idx * 1024; hout = p.hc + (size_t)idx * 1024; mod = p.mod + ((size_t)layer * 17 + 16) * 6144;
        }
        f32x4 h[4];
#pragma unroll
        for (int i = 0; i < 4; ++i) h[i] = *(const f32x4*)(hin + (i * 64 + lane) * 4);
        if (mode != 0) {
            f32x4 y[4]; float ss = 0.f;
#pragma unroll
            for (int i = 0; i < 4; ++i) {
                const u32x2 w = *(const u32x2*)((mode == 1 ? p.YC + (size_t)local * 1024 : p.U + (size_t)g * 1024) + (i * 64 + lane) * 4);
                y[i] = (f32x4){__uint_as_float(w.x << 16), __uint_as_float(w.x & 0xffff0000u), __uint_as_float(w.y << 16), __uint_as_float(w.y & 0xffff0000u)};
                ss += y[i][0] * y[i][0] + y[i][1] * y[i][1] + y[i][2] * y[i][2] + y[i][3] * y[i][3];
            }
            ss = wave_sum(ss);
            const float rs = rsqrtf(ss * (1.f / 1024.f) + 1e-6f);
            const float* gp = (mode == 1 ? p.g_post_mix : p.g_post_ffn) + layer * 1024;
            const float* ga = mod + (mode == 1 ? 2048 : 5120);
#pragma unroll
            for (int i = 0; i < 4; ++i) {
                const f32x4 gg = *(const f32x4*)(gp + (i * 64 + lane) * 4), aa = *(const f32x4*)(ga + (i * 64 + lane) * 4);
                h[i] = h[i] + aa * (y[i] * rs * gg);
            }
        }
#pragma unroll
        for (int i = 0; i < 4; ++i) *(f32x4*)(hout + (i * 64 + lane) * 4) = h[i];
        const int nl = (mode == 2) ? layer + 1 : layer;
        if (nl < DEPTH) {
            float ss = 0.f;
#pragma unroll
            for (int i = 0; i < 4; ++i) ss += h[i][0] * h[i][0] + h[i][1] * h[i][1] + h[i][2] * h[i][2] + h[i][3] * h[i][3];
            ss = wave_sum(ss);
            const float rs = rsqrtf(ss * (1.f / 1024.f) + 1e-6f);
            const float* gpre = (mode == 1 ? p.g_pre_ffn : p.g_pre_mix) + nl * 1024;
            const float* modn = (mode == 2) ? mod + 17 * 6144 : mod;
            const float* sh = modn + (mode == 1 ? 3072 : 0);
            const float* sc = modn + (mode == 1 ? 4096 : 1024);
#pragma unroll
            for (int i = 0; i < 4; ++i) {
                const int e = (i * 64 + lane) * 4;
                const f32x4 gg = *(const f32x4*)(gpre + e), s1 = *(const f32x4*)(sc + e), s0 = *(const f32x4*)(sh + e);
                const f32x4 u = h[i] * rs * gg * (s1 + 1.f) + s0;
                store4(p.U + (size_t)g * 1024 + e, u);
            }
        }
    }
}

DEV void gemm1_row(f32x4 (&v)[4], int row, int slab, bool lat, const P& p, int layer, int fq) {
    const bool hnorm = (slab >= 2048 && slab < 2688);
    const bool rope64 = lat && ((slab >= 384 && slab < 1024) || hnorm);
    const bool isq = (slab >= 384 && slab < 896) || (slab >= 1024 && slab < 1536) || (slab >= 2048 && slab < 2560);
    const float sc = isq ? 0.125f * LOG2E : 1.f;
    const bool kr = (slab == 2688);
    const int tok = row & 2047; const int pr = tok >> 6, pc = tok & 63;
    if (hnorm) {
        float ss = 0.f;
#pragma unroll
        for (int ft = 0; ft < 4; ++ft) ss += v[ft][0] * v[ft][0] + v[ft][1] * v[ft][1] + v[ft][2] * v[ft][2] + v[ft][3] * v[ft][3];
        ss += __shfl_xor(ss, 16); ss += __shfl_xor(ss, 32);
        const float rs = rsqrtf(ss * (1.f / 64.f) + 1e-6f);
        const float* g = (slab < 2560 ? p.g_d_q : p.g_d_k) + layer * 64;
#pragma unroll
        for (int ft = 0; ft < 4; ++ft) { const f32x4 gg = *(const f32x4*)(g + ft * 16 + fq * 4); v[ft] = v[ft] * rs * gg; }
    }
    if (rope64) {
#pragma unroll
        for (int j = 0; j < 4; ++j) {
            const int i = fq * 4 + j;
            f32x2 cs = p.rt16[pr * 16 + i]; float a = v[0][j], b = v[1][j];
            v[0][j] = a * cs[0] - b * cs[1]; v[1][j] = b * cs[0] + a * cs[1];
            cs = p.rt16[pc * 16 + i]; a = v[2][j]; b = v[3][j];
            v[2][j] = a * cs[0] - b * cs[1]; v[3][j] = b * cs[0] + a * cs[1];
        }
    }
    if (kr && lat) {
#pragma unroll
        for (int ft = 0; ft < 2; ++ft) {
            const int pos = ft == 0 ? pr : pc;
#pragma unroll
            for (int j = 0; j < 4; ++j) {
                const int i = (fq & 1) * 4 + j; const f32x2 cs = p.rt8[pos * 8 + i];
                const float xv = v[ft][j]; const float o = __shfl_xor(xv, 32);
                v[ft][j] = fq < 2 ? xv * cs[0] - o * cs[1] : xv * cs[0] + o * cs[1];
            }
        }
    }
    bf16_t* dst = p.PJ + (size_t)row * PJLD + slab + fq * 4;
    store4(dst, v[0] * sc); store4(dst + 16, v[1] * sc);
    if (!kr) { store4(dst + 32, v[2] * sc); store4(dst + 48, v[3] * sc); }
}
DEV void stage2_tile(const P& p, int mt, int j, unsigned char* smraw) {
    bf16_t* sm = (bf16_t*)smraw; float* s_rs = (float*)(smraw + 73728);
    const int tid = ltid(), lane = tid & 63, wid = uni(tid >> 6), wm = wid & 1, wn = wid >> 1, fr = lane & 15, fq = lane >> 4;
    const int m0 = mt * 128; const bool isq = j < 6; const bool lat = m0 < LAT_C;
    const int K = isq ? 256 : 128; const int acol = isq ? 0 : 256;
    {
        const int r = tid >> 1, hf = tid & 1; const int n = K >> 1;
        const bf16_t* src = p.PJ + (size_t)(m0 + r) * PJLD + acol + hf * n; float ss = 0.f;
        for (int i = 0; i < n; i += 8) {
            const u32x4 w = *(const u32x4*)(src + i);
#pragma unroll
            for (int q = 0; q < 4; ++q) { const float a = __uint_as_float(w[q] << 16), b = __uint_as_float(w[q] & 0xffff0000u); ss += a * a + b * b; }
        }
        ss += __shfl_xor(ss, 1);
        if (hf == 0) s_rs[r] = rsqrtf(ss / (float)K + 1e-6f);
    }
    __syncthreads();
    f32x4 acc[4][4];
    const bf16_t* A = p.PJ + (size_t)m0 * PJLD + acol;
    if (isq) {
        const int n0 = j * 128;
        gemm_mainloop<4, false>(A, PJLD, p.WuqT + (size_t)n0 * 256, 256, 256, acc, sm);
        const int slab = n0 + wn * 64; const float qs = 0.10206207261596577f * LOG2E;
#pragma unroll
        for (int tt = 0; tt < 4; ++tt) {
            const int lr = wm * 64 + tt * 16 + fr; const int row = m0 + lr; const float rs = s_rs[lr] * qs;
            const int tok = row & 2047; const int pr = tok >> 6, pc = tok & 63;
            f32x4 v[4] = {acc[0][tt], acc[1][tt], acc[2][tt], acc[3][tt]};
            if (slab >= 512 && lat) {
#pragma unroll
                for (int ft = 0; ft < 4; ++ft) {
                    const int pos = (ft & 1) == 0 ? pr : pc;
#pragma unroll
                    for (int jj = 0; jj < 4; ++jj) {
                        const int i = (fq & 1) * 4 + jj; const f32x2 cs = p.rt8[pos * 8 + i];
                        const float xv = v[ft][jj]; const float o = __shfl_xor(xv, 32);
                        v[ft][jj] = fq < 2 ? xv * cs[0] - o * cs[1] : xv * cs[0] + o * cs[1];
                    }
                }
            }
            bf16_t* dst = p.QA + (size_t)row * 768 + slab + fq * 4;
#pragma unroll
            for (int ft = 0; ft < 4; ++ft) store4(dst + ft * 16, v[ft] * rs);
        }
    } else {
        const int n0 = (j - 6) * 128;
        if (n0 < 512) {
            gemm_mainloop<4, false>(A, PJLD, p.WukvT + (size_t)n0 * 128, 128, 128, acc, sm);
#pragma unroll
            for (int tt = 0; tt < 4; ++tt) {
                const int lr = wm * 64 + tt * 16 + fr; const float rs = s_rs[lr];
                bf16_t* dst = p.KN + (size_t)(m0 + lr) * 512 + n0 + wn * 64 + fq * 4;
#pragma unroll
                for (int ft = 0; ft < 4; ++ft) store4(dst + ft * 16, acc[ft][tt] * rs);
            }
        } else {
            gemm_mainloop<4, true>(A, PJLD, p.WukvT + (size_t)n0 * 128, 128, 128, acc, sm);
            const int vrow0 = 768 + (n0 - 512) + wn * 64;
#pragma unroll
            for (int tt = 0; tt < 4; ++tt) {
                const int lr = wm * 64 + tt * 16 + fq * 4;
                const f32x4 rs = *(const f32x4*)(s_rs + lr);
                const int lp = wm * 64 + (tt >> 1) * 32 + fq * 8 + (tt & 1) * 4;
#pragma unroll
                for (int ft = 0; ft < 4; ++ft) store4(p.VT + (size_t)(vrow0 + ft * 16 + fr) * MC + m0 + lp, acc[ft][tt] * rs);
            }
        }
    }
    __syncthreads();
}

template <int MODE>
DEV void attn_item(const P& p, int layer, int item, bool ctxq, unsigned char* smraw) {
    constexpr bool GQA = (MODE == 1 || MODE == 3);
    constexpr int DQK = (MODE == 0) ? 96 : 64, NKS = DQK / 32;
    constexpr int KRB = (MODE == 0) ? 256 : 128, KM = (MODE == 0) ? 15 : 7;
    constexpr int KT_B = 64 * KRB, VT_B = 64 * 128;
    unsigned char* Ks = smraw; unsigned char* Vs = smraw + 32768; float* bias_s = (float*)(smraw + 49152);
    const int tid = ltid(), lane = tid & 63, wid = uni(tid >> 6), fr = lane & 15, fq = lane >> 4;
    const int nqt = ctxq ? (GQA ? 8 : 2) : (GQA ? 64 : 16);
    const int nh = GQA ? 2 : 8;
    const int qt = item % nqt, hh = (item / nqt) % nh, lb = item / (nqt * nh);
    const int head = GQA ? hh * 4 + wid : hh;
    const int tok0 = GQA ? qt * 32 : qt * 128 + wid * 32;
    const int qrow0 = (ctxq ? LAT_C + lb * CTX : lb * SEQ) + tok0;
    bf16x8 qf[2][NKS];
#pragma unroll
    for (int q = 0; q < 2; ++q) {
        const int row = qrow0 + q * 16 + fr;
        if (MODE == 0) {
            qf[q][0] = *(const bf16x8*)(p.QA + (size_t)row * 768 + head * 64 + fq * 8);
            qf[q][1] = *(const bf16x8*)(p.QA + (size_t)row * 768 + head * 64 + 32 + fq * 8);
            qf[q][NKS - 1] = *(const bf16x8*)(p.QA + (size_t)row * 768 + 512 + head * 32 + fq * 8);
        } else {
            const int qoff = MODE == 1 ? 384 : (MODE == 2 ? 1024 : 2048);
#pragma unroll
            for (int ks = 0; ks < NKS; ++ks) qf[q][ks] = *(const bf16x8*)(p.PJ + (size_t)row * PJLD + qoff + head * 64 + ks * 32 + fq * 8);
        }
    }
    const int koff = MODE == 1 ? 896 + hh * 64 : (MODE == 2 ? 1536 + hh * 64 : 2560 + hh * 64);
    const int vrow0 = MODE == 0 ? 768 + hh * 64 : (MODE == 1 ? hh * 64 : (MODE == 2 ? 128 + hh * 64 : 640 + hh * 64));
    int ktlo = 0, nlat = 0;
    if (!ctxq) {
        if (MODE == 0 || MODE == 3) { ktlo = 0; nlat = 32; }
        else if (MODE == 1) { const int q0 = qt * 32; const int lo = max(0, q0 - 128), hi = min(SEQ - 1, q0 + 159); ktlo = lo >> 6; nlat = (hi >> 6) - ktlo + 1; }
        else { const int r0a = min(max(2 * qt - 4, 0), 24), r0b = min(max(2 * qt + 1 - 4, 0), 24); ktlo = r0a; nlat = r0b + 8 - r0a; }
    }
    const int nt = 4 + nlat;
    const int ntf = ctxq ? 4 : ((MODE == 0 || MODE == 3) ? 36 : (MODE == 1 ? 9 : 13));
    if (MODE == 2 && !ctxq) { for (int i = tid; i < 465; i += 256) bias_s[i] = p.rpb_c[(layer * 8 + hh) * 465 + i] * LOG2E; }

    u32x4 rk[NKS], rv[2];
    auto tile_krow = [&](int it) { it = min(it, nt - 1); return it < 4 ? LAT_C + lb * CTX + it * 64 : lb * SEQ + (ktlo + it - 4) * 64; };
    auto gload = [&](int it) {
        const int krow = tile_krow(it);
#pragma unroll
        for (int i = 0; i < NKS; ++i) {
            const int id = tid + i * 256;
            if (MODE == 0) {
                const int key = id / 12, c = id - key * 12;
                const bf16_t* src = c < 8 ? p.KN + (size_t)(krow + key) * 512 + hh * 64 + c * 8 : p.PJ + (size_t)(krow + key) * PJLD + 2688 + (c - 8) * 8;
                rk[i] = *(const u32x4*)src;
            } else {
                const int key = id >> 3, c = id & 7;
                rk[i] = *(const u32x4*)(p.PJ + (size_t)(krow + key) * PJLD + koff + c * 8);
            }
        }
#pragma unroll
        for (int i = 0; i < 2; ++i) { const int id = tid + i * 256; const int dv = id >> 3, c = id & 7; rv[i] = *(const u32x4*)(p.VT + (size_t)(vrow0 + dv) * MC + krow + c * 8); }
    };
    auto lstore = [&](int buf) {
#pragma unroll
        for (int i = 0; i < NKS; ++i) {
            const int id = tid + i * 256; int key, c;
            if (MODE == 0) { key = id / 12; c = id - key * 12; } else { key = id >> 3; c = id & 7; }
            *(u32x4*)(Ks + buf * KT_B + key * KRB + ((c ^ (key & KM)) << 4)) = rk[i];
        }
#pragma unroll
        for (int i = 0; i < 2; ++i) { const int id = tid + i * 256; const int dv = id >> 3, c = id & 7; *(u32x4*)(Vs + buf * VT_B + dv * 128 + ((c ^ (dv & 7)) << 4)) = rv[i]; }
    };

    f32x4 o[4][2], lo[2], negm4[2]; float mref[2];
    const bf16x8 ones8 = __builtin_bit_cast(bf16x8, (u32x4){0x3F803F80u, 0x3F803F80u, 0x3F803F80u, 0x3F803F80u});
#pragma unroll
    for (int q = 0; q < 2; ++q) { mref[q] = 0.f; lo[q] = (f32x4){0.f, 0.f, 0.f, 0.f}; negm4[q] = (f32x4){0.f, 0.f, 0.f, 0.f};
#pragma unroll
        for (int d = 0; d < 4; ++d) o[d][q] = (f32x4){0.f, 0.f, 0.f, 0.f}; }

    gload(0); lstore(0); gload(1); __syncthreads();
    for (int it = 0; it < ntf; ++it) {
        const int cur = it & 1;
        if (it + 1 < ntf) lstore(cur ^ 1);
        if (it + 2 < ntf) gload(it + 2);
        __builtin_amdgcn_sched_barrier(0);
        const int kt = ktlo + it - 4;
        bool active = it < nt;
        int r = 0, r0 = 0;
        if (MODE == 2 && !ctxq && it >= 4) { r = 2 * qt + (wid >> 1); r0 = min(max(r - 4, 0), 24); active = active && (kt >= r0 && kt < r0 + 8); }
        if (active) {
            f32x4 s[4][2];
            const unsigned char* kb = Ks + cur * KT_B + fr * KRB;
            bf16x8 kf[4][NKS];
#pragma unroll
            for (int k4 = 0; k4 < 4; ++k4)
#pragma unroll
                for (int ks = 0; ks < NKS; ++ks) kf[k4][ks] = *(const bf16x8*)(kb + k4 * 16 * KRB + (((ks * 4 + fq) ^ (fr & KM)) << 4));
            __builtin_amdgcn_sched_barrier(0);
#pragma unroll
            for (int k4 = 0; k4 < 4; ++k4) {
#pragma unroll
                for (int q = 0; q < 2; ++q) s[k4][q] = mfma16(kf[k4][0], qf[q][0], negm4[q]);
#pragma unroll
                for (int ks = 1; ks < NKS; ++ks)
#pragma unroll
                    for (int q = 0; q < 2; ++q) s[k4][q] = mfma16(kf[k4][ks], qf[q][ks], s[k4][q]);
            }
            const unsigned char* vb = Vs + cur * VT_B + fr * 128;
            bf16x8 vf[4][2];
#pragma unroll
            for (int d = 0; d < 4; ++d)
#pragma unroll
                for (int kb2 = 0; kb2 < 2; ++kb2) vf[d][kb2] = *(const bf16x8*)(vb + d * 16 * 128 + (((kb2 * 4 + fq) ^ (fr & 7)) << 4));
            __builtin_amdgcn_sched_barrier(0);
            if (!ctxq && it >= 4) {
                if (MODE == 1) {
#pragma unroll
                    for (int q = 0; q < 2; ++q) {
                        const int qpos = tok0 + q * 16 + fr;
#pragma unroll
                        for (int k4 = 0; k4 < 4; ++k4)
#pragma unroll
                            for (int j = 0; j < 4; ++j) { const int d = qpos - (kt * 64 + k4 * 16 + fq * 4 + j); if (d > 128 || d < -128) s[k4][q][j] = -1e30f; }
                    }
                }
                if (MODE == 2) {
#pragma unroll
                    for (int q = 0; q < 2; ++q) {
                        const int qc = (wid & 1) * 32 + q * 16 + fr; const int c0 = min(max(qc - 8, 0), 48);
                        const int bbase = (kt - r + 7) * 31 + 15 - qc;
#pragma unroll
                        for (int k4 = 0; k4 < 4; ++k4)
#pragma unroll
                            for (int j = 0; j < 4; ++j) {
                                const int kc = k4 * 16 + fq * 4 + j; const bool ok = (kc >= c0 && kc < c0 + 16);
                                const float bv = bias_s[ok ? bbase + kc : 0];
                                s[k4][q][j] = ok ? s[k4][q][j] + bv : -1e30f;
                            }
                    }
                }
            }
            bf16x8 pf[2][2];
#pragma unroll
            for (int q = 0; q < 2; ++q) {
                float mx = -1e30f;
#pragma unroll
                for (int k4 = 0; k4 < 4; ++k4) mx = fmaxf(mx, fmaxf(fmaxf(s[k4][q][0], s[k4][q][1]), fmaxf(s[k4][q][2], s[k4][q][3])));
                mx = xmax32(xmax16(mx));
                const bool need = (it == 0) || (mx > 8.f);
                if (__builtin_amdgcn_ballot_w64(need) != 0ull) {
                    const float delta = need ? mx : 0.f;
                    mref[q] += delta; negm4[q] = negm4[q] - delta;
#pragma unroll
                    for (int k4 = 0; k4 < 4; ++k4) s[k4][q] = s[k4][q] - delta;
                    const float alpha = fexp2(-delta);
                    lo[q] = lo[q] * alpha;
#pragma unroll
                    for (int d = 0; d < 4; ++d) o[d][q] = o[d][q] * alpha;
                }
#pragma unroll
                for (int k4 = 0; k4 < 4; ++k4)
#pragma unroll
                    for (int j = 0; j < 4; ++j) s[k4][q][j] = fexp2(s[k4][q][j]);
#pragma unroll
                for (int kb2 = 0; kb2 < 2; ++kb2) {
                    u32x4 w; w.x = pk_bf16(s[2 * kb2][q][0], s[2 * kb2][q][1]); w.y = pk_bf16(s[2 * kb2][q][2], s[2 * kb2][q][3]);
                    w.z = pk_bf16(s[2 * kb2 + 1][q][0], s[2 * kb2 + 1][q][1]); w.w = pk_bf16(s[2 * kb2 + 1][q][2], s[2 * kb2 + 1][q][3]);
                    pf[q][kb2] = __builtin_bit_cast(bf16x8, w);
                }
            }
#pragma unroll
            for (int d = 0; d < 4; ++d)
#pragma unroll
                for (int kb2 = 0; kb2 < 2; ++kb2)
#pragma unroll
                    for (int q = 0; q < 2; ++q) o[d][q] = mfma16(vf[d][kb2], pf[q][kb2], o[d][q]);
#pragma unroll
            for (int kb2 = 0; kb2 < 2; ++kb2)
#pragma unroll
                for (int q = 0; q < 2; ++q) lo[q] = mfma16(ones8, pf[q][kb2], lo[q]);
        }
        __syncthreads();
    }
#pragma unroll
    for (int q = 0; q < 2; ++q) {
        float l = lo[q][0];
        if (MODE == 1) l += fexp2(p.sink_b[layer * 8 + head] * LOG2E - mref[q]);
        const float inv = 1.f / l;
        bf16_t* dst = p.O + (size_t)(qrow0 + q * 16 + fr) * 2048 + MODE * 512 + head * 64 + fq * 4;
#pragma unroll
        for (int d = 0; d < 4; ++d) store4(dst + d * 16, o[d][q] * inv);
    }
}

DEV void merge_tile(const P& p, int ch, int mt, int nt, bf16_t* sm) {
    const int tid_ = ltid(), lane = tid_ & 63, wid = uni(tid_ >> 6), wm = wid & 1, wn = wid >> 1, fr = lane & 15, fq = lane >> 4;
    const int m0 = mt * 128, n0 = nt * 64;
    f32x4 tot[2][4];
#pragma unroll
    for (int ft = 0; ft < 2; ++ft)
#pragma unroll
        for (int tt = 0; tt < 4; ++tt) tot[ft][tt] = (f32x4){0.f, 0.f, 0.f, 0.f};
    for (int n = 0; n < 4; ++n) {
        f32x4 u[2][4];
        gemm_mainloop<2, false>(p.O + (size_t)m0 * 2048 + n * 512, 2048, p.WbrT + ((size_t)n * 1024 + n0) * 512, 512, 512, u, sm);
#pragma unroll
        for (int tt = 0; tt < 4; ++tt) {
            const unsigned char* gp = p.G + (size_t)(m0 + wm * 64 + tt * 16 + fr) * 4096 + n * 1024 + n0 + wn * 32 + fq * 4;
#pragma unroll
            for (int ft = 0; ft < 2; ++ft) {
                const unsigned w = *(const unsigned*)(gp + ft * 16);
                f32x4 g; g[0] = (float)(w & 255u); g[1] = (float)((w >> 8) & 255u); g[2] = (float)((w >> 16) & 255u); g[3] = (float)(w >> 24);
                tot[ft][tt] = tot[ft][tt] + (g * (1.f / 255.f)) * u[ft][tt];
            }
        }
    }
#pragma unroll
    for (int tt = 0; tt < 4; ++tt) {
        bf16_t* dst = p.MB + (size_t)(m0 + wm * 64 + tt * 16 + fr) * 1024 + n0 + wn * 32 + fq * 4;
        store4(dst, tot[0][tt]); store4(dst + 16, tot[1][tt]);
    }
}
DEV void store_tile_T(const f32x4 (&acc)[4][4], bf16_t* base, int ld, int row0, int col0) {
    const int tid_ = ltid(), lane = tid_ & 63, wid = uni(tid_ >> 6), wm = wid & 1, wn = wid >> 1, fr = lane & 15, fq = lane >> 4;
#pragma unroll
    for (int tt = 0; tt < 4; ++tt) {
        bf16_t* dst = base + (size_t)(row0 + wm * 64 + tt * 16 + fr) * ld + col0 + wn * 64 + fq * 4;
#pragma unroll
        for (int ft = 0; ft < 4; ++ft) store4(dst + ft * 16, acc[ft][tt]);
    }
}

namespace pg8 {
#define PG8_LAS __attribute__((address_space(3)))
constexpr int BM = 256, BK = 64, HALF = 128, HTB = HALF * BK * 2  , STAGE_BYTES = 8 * HTB, NXCD = 8, WGM = 8;

__host__ __device__ __forceinline__ int lds_byte(int r, int c) { const int st = (r >> 4) * 2 + (c >> 5), rr = r & 15, cc = c & 31, ob = rr * 64 + cc * 2; return st * 1024 + (ob ^ (((ob >> 9) & 1) << 5)); }
__host__ __device__ __forceinline__ void stage_rc(int b, int& R, int& C) { const int st = b / 1024, sb = b % 1024, swz = sb ^ (((sb >> 9) & 1) << 5); R = (st >> 1) * 16 + swz / 64; C = (st & 1) * 32 + (swz % 64) / 2; }
__host__ __device__ __forceinline__ int perm32(int rho) { const int n = rho >> 4, i = rho & 15; return 8 * (i >> 2) + 4 * n + (i & 3); }

struct Unit { int pm, pn; };
struct Gemm { const bf16_t* A; const bf16_t* Bt; int M, N, K; };

template <class Epi, class Sched, bool ALIGN_EPI = false, bool SP2 = false, bool SWAPMMA = false>
__device__ __forceinline__ void gemm_phase(PG8_LAS unsigned char* lds, const Gemm g, const Sched& S, const Epi& E) {
    int tid = threadIdx.x; asm volatile("" : "+v"(tid));
    const int wid = __builtin_amdgcn_readfirstlane(tid >> 6), lane = tid & 63, wr = wid >> 2, wc = wid & 3, fr = lane & 15, fq = lane >> 4;
    const int K = g.K, nt = K / BK;
    unsigned voffA[2], voffB[2];
#pragma unroll
    for (int i = 0; i < 2; ++i) { int R, C; stage_rc(tid * 16 + i * 8192, R, C); const int Rb = Epi::PERM ? ((R & ~31) + perm32(R & 31)) : R;
        voffA[i] = (unsigned)(R * K + C) * 2u; voffB[i] = (unsigned)(Rb * K + C) * 2u; }
    const size_t kstep = (size_t)(BK * 2);
    const size_t hstep = (size_t)HALF * K * 2;
    const size_t tstep = 2 * hstep;
    const unsigned ldsw = (unsigned)wid * 1024u;
    const int aoff = lds_byte(wr * 64 + fr, fq * 8), boff = lds_byte(wc * 32 + fr, fq * 8);
#define PG8_SA(b, h) (((b) * 2 + (h)) * HTB)
#define PG8_SB(b, h) ((4 + (b) * 2 + (h)) * HTB)
#define PG8_STAGE(bufoff, gbase, voff) do { _Pragma("unroll") for (int _i = 0; _i < 2; ++_i) \
        __builtin_amdgcn_global_load_lds((const unsigned*)((const char*)(gbase) + (voff)[_i]), (PG8_LAS unsigned*)(lds + (bufoff) + ldsw + _i * 8192), 16, 0, 0); } while (0)
#define PG8_LDA(dst, b, h) do { _Pragma("unroll") for (int m = 0; m < 4; ++m) _Pragma("unroll") for (int k = 0; k < 2; ++k) dst[m][k] = *(const PG8_LAS bf16x8*)(lds + PG8_SA(b, h) + aoff + m * 2048 + k * 1024); } while (0)
#define PG8_LDB(dst, b, h) do { _Pragma("unroll") for (int n = 0; n < 2; ++n) _Pragma("unroll") for (int k = 0; k < 2; ++k) dst[n][k] = *(const PG8_LAS bf16x8*)(lds + PG8_SB(b, h) + boff + n * 2048 + k * 1024); } while (0)
#define PG8_MMA(ai, bj, At, Bt) do { __builtin_amdgcn_s_setprio(1); _Pragma("unroll") for (int m = 0; m < 4; ++m) _Pragma("unroll") for (int n = 0; n < 2; ++n) _Pragma("unroll") for (int k = 0; k < 2; ++k) \
        acc[ai][bj][m][n] = SWAPMMA ? __builtin_amdgcn_mfma_f32_16x16x32_bf16(At[m][k], Bt[n][k], acc[ai][bj][m][n], 0, 0, 0) : __builtin_amdgcn_mfma_f32_16x16x32_bf16(Bt[n][k], At[m][k], acc[ai][bj][m][n], 0, 0, 0); __builtin_amdgcn_s_setprio(0); } while (0)
#define PG8_WAIT_V(n) asm volatile("s_waitcnt vmcnt(" #n ")" ::: "memory")
#define PG8_WAIT_L(n) asm volatile("s_waitcnt lgkmcnt(" #n ")" ::: "memory")
#define PG8_BAR __builtin_amdgcn_s_barrier()
#define PG8_SCHED __builtin_amdgcn_sched_barrier(0)
    Unit cur, nxt; int ui = 0;
    if (!S.next(0, cur)) return;
    f32x4 acc[2][2][4][2];
#pragma unroll
    for (int a = 0; a < 2; ++a)
#pragma unroll
        for (int b = 0; b < 2; ++b)
#pragma unroll
            for (int m = 0; m < 4; ++m)
#pragma unroll
                for (int n = 0; n < 2; ++n) acc[a][b][m][n] = (f32x4){0.f, 0.f, 0.f, 0.f};
    bf16x8 At[4][2], B0[2][2], B1[2][2];
    const char* cA = (const char*)g.A + (size_t)cur.pm * tstep; const char* cB = (const char*)g.Bt + (size_t)cur.pn * tstep;
    S.a_ready(cur);
    if constexpr (SP2) {
        PG8_STAGE(PG8_SB(0, 0), cB, voffB); PG8_STAGE(PG8_SB(0, 1), cB + hstep, voffB); PG8_STAGE(PG8_SA(0, 0), cA, voffA); PG8_STAGE(PG8_SA(0, 1), cA + hstep, voffA);
        if (wr == 1) PG8_BAR;
        PG8_WAIT_V(2); PG8_BAR;
        PG8_STAGE(PG8_SB(1, 0), cB + kstep, voffB); PG8_STAGE(PG8_SA(1, 0), cA + kstep, voffA); PG8_STAGE(PG8_SB(1, 1), cB + hstep + kstep, voffB);
        PG8_WAIT_V(6); PG8_BAR;
    } else {
        PG8_STAGE(PG8_SB(0, 0), cB, voffB); PG8_STAGE(PG8_SA(0, 0), cA, voffA); PG8_STAGE(PG8_SB(0, 1), cB + hstep, voffB); PG8_STAGE(PG8_SA(0, 1), cA + hstep, voffA);
        if (wr == 1) PG8_BAR;
        PG8_WAIT_V(4); PG8_BAR;
        PG8_STAGE(PG8_SB(1, 0), cB + kstep, voffB); PG8_STAGE(PG8_SA(1, 0), cA + kstep, voffA); PG8_STAGE(PG8_SB(1, 1), cB + hstep + kstep, voffB);
        PG8_WAIT_V(6); PG8_BAR;
    }
    for (;;) {
        const bool has_next = S.next(ui + 1, nxt);
        const char* nA = has_next ? (const char*)g.A + (size_t)nxt.pm * tstep : cA; const char* nB = has_next ? (const char*)g.Bt + (size_t)nxt.pn * tstep : cB;
        for (int t = 0; t < nt; t += 2) {
            if constexpr (Epi::HAS_MID) { if (t != 0 && (t & 7) == 0) { E.mid(acc, cur, t >> 3, wid, lane); asm volatile("s_waitcnt vmcnt(0)" ::: "memory"); } }
            const bool last = (t == nt - 2);
            const char* a1 = cA + (size_t)(t + 1) * kstep;
            const char* a2 = last ? nA : cA + (size_t)(t + 2) * kstep; const char* b2 = last ? nB : cB + (size_t)(t + 2) * kstep;
            const char* a3 = a2 + kstep; const char* b3 = b2 + kstep;
            if (last && has_next) S.a_ready(nxt);
            if constexpr (SP2) {
            PG8_LDB(B0, 0, 0); PG8_LDB(B1, 0, 1); PG8_SCHED; PG8_LDA(At, 0, 0); PG8_STAGE(PG8_SA(1, 1), a1 + hstep, voffA);
            PG8_WAIT_V(8); PG8_WAIT_L(0); PG8_BAR; PG8_MMA(0, 0, At, B0); PG8_MMA(0, 1, At, B1); PG8_BAR; PG8_SCHED;
            PG8_LDA(At, 0, 1); PG8_STAGE(PG8_SB(0, 0), b2, voffB); PG8_STAGE(PG8_SB(0, 1), b2 + hstep, voffB); PG8_STAGE(PG8_SA(0, 0), a2, voffA);
            PG8_WAIT_V(8); PG8_WAIT_L(0); PG8_BAR; PG8_MMA(1, 0, At, B0); PG8_MMA(1, 1, At, B1); PG8_BAR; PG8_SCHED;
            PG8_LDB(B0, 1, 0); PG8_LDB(B1, 1, 1); PG8_SCHED; PG8_LDA(At, 1, 0); PG8_STAGE(PG8_SA(0, 1), a2 + hstep, voffA);
            PG8_WAIT_V(8); PG8_WAIT_L(0); PG8_BAR; PG8_MMA(0, 0, At, B0); PG8_MMA(0, 1, At, B1); PG8_BAR; PG8_SCHED;
            PG8_LDA(At, 1, 1); PG8_STAGE(PG8_SB(1, 0), b3, voffB); PG8_STAGE(PG8_SB(1, 1), b3 + hstep, voffB); PG8_STAGE(PG8_SA(1, 0), a3, voffA);
            PG8_WAIT_V(8); PG8_WAIT_L(0); PG8_BAR; PG8_MMA(1, 0, At, B0); PG8_MMA(1, 1, At, B1); PG8_BAR; PG8_SCHED;
            } else {
            PG8_LDB(B0, 0, 0); PG8_SCHED; PG8_LDA(At, 0, 0); PG8_STAGE(PG8_SA(1, 1), a1 + hstep, voffA);
            PG8_WAIT_L(8); PG8_BAR; PG8_WAIT_L(0); PG8_MMA(0, 0, At, B0); PG8_BAR; PG8_SCHED;
            PG8_LDB(B1, 0, 1); PG8_STAGE(PG8_SB(0, 0), b2, voffB);
            PG8_BAR; PG8_WAIT_L(0); PG8_MMA(0, 1, At, B1); PG8_BAR;
            PG8_LDA(At, 0, 1); PG8_STAGE(PG8_SA(0, 0), a2, voffA);
            PG8_BAR; PG8_WAIT_L(0); PG8_MMA(1, 0, At, B0); PG8_BAR; PG8_SCHED;
            PG8_STAGE(PG8_SB(0, 1), b2 + hstep, voffB);
            PG8_WAIT_V(6); PG8_BAR; PG8_MMA(1, 1, At, B1); PG8_BAR;
            PG8_LDB(B0, 1, 0); PG8_SCHED; PG8_LDA(At, 1, 0); PG8_STAGE(PG8_SA(0, 1), a2 + hstep, voffA);
            PG8_WAIT_L(8); PG8_BAR; PG8_WAIT_L(0); PG8_MMA(0, 0, At, B0); PG8_BAR; PG8_SCHED;
            PG8_LDB(B1, 1, 1); PG8_STAGE(PG8_SB(1, 0), b3, voffB);
            PG8_BAR; PG8_WAIT_L(0); PG8_MMA(0, 1, At, B1); PG8_BAR;
            PG8_LDA(At, 1, 1); PG8_STAGE(PG8_SA(1, 0), a3, voffA);
            PG8_BAR; PG8_WAIT_L(0); PG8_MMA(1, 0, At, B0); PG8_BAR; PG8_SCHED;
            PG8_STAGE(PG8_SB(1, 1), b3 + hstep, voffB);
            PG8_WAIT_V(6); PG8_BAR; PG8_MMA(1, 1, At, B1); PG8_BAR;
            }
        }
        if constexpr (ALIGN_EPI) { if (wr == 0) PG8_BAR; }
        if constexpr (!Epi::AFTER_DRAIN) { E(acc, cur, wr, wc, fr, fq); S.done(cur); }
        if (!has_next) break;
#pragma unroll
        for (int a = 0; a < 2; ++a)
#pragma unroll
            for (int b = 0; b < 2; ++b)
#pragma unroll
                for (int m = 0; m < 4; ++m)
#pragma unroll
                    for (int n = 0; n < 2; ++n) acc[a][b][m][n] = (f32x4){0.f, 0.f, 0.f, 0.f};
        cur = nxt; cA = nA; cB = nB; ++ui;
        if constexpr (ALIGN_EPI) { if (wr == 1) PG8_BAR; }
    }
    PG8_WAIT_V(0);
    if constexpr (!ALIGN_EPI) { if (wr == 0) PG8_BAR; }
    PG8_BAR;
    if constexpr (Epi::AFTER_DRAIN) { E.fused(acc, cur, wr, wc, fr, fq, lds, wid, lane); S.done(cur); }
#undef PG8_SA
#undef PG8_SB
#undef PG8_STAGE
#undef PG8_LDA
#undef PG8_LDB
#undef PG8_MMA
#undef PG8_WAIT_V
#undef PG8_WAIT_L
#undef PG8_BAR
#undef PG8_SCHED
}
}

struct XSched {
    int nN, nunits, G, c;
    DEV bool next(int i, pg8::Unit& u) const {
        const int L = i * G + c; if (L >= nunits) return false;
        const int U = ((nunits & 7) == 0 && (G & 7) == 0) ? (L & 7) * (nunits >> 3) + (L >> 3) : L;
        u.pm = U / nN; u.pn = U - u.pm * nN; return true;
    }
    DEV void a_ready(const pg8::Unit&) const {}
    DEV void done(const pg8::Unit&) const {}
};
struct EpiStoreT {
    static constexpr bool PERM = false, AFTER_DRAIN = false, HAS_MID = false;
    bf16_t* out; int ld; int row_off;
    DEV void operator()(const f32x4 (&acc)[2][2][4][2], const pg8::Unit& u, int wr, int wc, int fr, int fq) const {
#pragma unroll
        for (int ai = 0; ai < 2; ++ai)
#pragma unroll
            for (int m = 0; m < 4; ++m) {
                bf16_t* d = out + (size_t)(row_off + u.pm * 256 + ai * 128 + wr * 64 + m * 16 + fr) * ld + u.pn * 256 + wc * 32 + fq * 4;
#pragma unroll
                for (int bj = 0; bj < 2; ++bj)
#pragma unroll
                    for (int n = 0; n < 2; ++n) store4(d + bj * 128 + n * 16, acc[ai][bj][m][n]);
            }
    }
};
struct EpiSwiglu {
    static constexpr bool PERM = false, AFTER_DRAIN = false, HAS_MID = false;
    bf16_t* act;
    DEV void operator()(const f32x4 (&acc)[2][2][4][2], const pg8::Unit& u, int wr, int wc, int fr, int fq) const {
#pragma unroll
        for (int ai = 0; ai < 2; ++ai)
#pragma unroll
            for (int m = 0; m < 4; ++m) {
                bf16_t* d = act + (size_t)(u.pm * 256 + ai * 128 + wr * 64 + m * 16 + fr) * DFF + u.pn * 128 + wc * 16 + fq * 4;
#pragma unroll
                for (int bj = 0; bj < 2; ++bj) {
                    const f32x4 a = acc[ai][bj][m][0], b = acc[ai][bj][m][1]; f32x4 r;
#pragma unroll
                    for (int j = 0; j < 4; ++j) r[j] = a[j] * frcp(1.f + fexp2(-a[j] * LOG2E)) * b[j];
                    store4(d + bj * 64, r);
                }
            }
    }
};
struct EpiVT {
    static constexpr bool PERM = false, AFTER_DRAIN = false, HAS_MID = false;
    bf16_t* vt;
    DEV void operator()(const f32x4 (&acc)[2][2][4][2], const pg8::Unit& u, int wr, int wc, int fr, int fq) const {
#pragma unroll
        for (int bj = 0; bj < 2; ++bj)
#pragma unroll
            for (int n = 0; n < 2; ++n) {
                bf16_t* d = vt + (size_t)(u.pn * 256 + bj * 128 + wc * 32 + n * 16 + fr) * MC + u.pm * 256 + wr * 64 + fq * 8;
#pragma unroll
                for (int ai = 0; ai < 2; ++ai)
#pragma unroll
                    for (int m = 0; m < 4; ++m) store4(d + ai * 128 + (m >> 1) * 32 + (m & 1) * 4, acc[ai][bj][m][n]);
            }
    }
};
DEV size_t gate_index(int pm, int pn4, int wave, int r8, int lane) { return ((((size_t)pm * 16 + pn4) * 8 + wave) * 8 + r8) * 64 + lane; }
struct EpiGate {
    static constexpr bool PERM = false, AFTER_DRAIN = false, HAS_MID = false;
    u32x4* g8;
    DEV void operator()(const f32x4 (&acc)[2][2][4][2], const pg8::Unit& u, int wr, int wc, int fr, int fq) const {
        const int lane = fq * 16 + fr, wave = wr * 4 + wc;
#pragma unroll
        for (int ai = 0; ai < 2; ++ai)
#pragma unroll
            for (int m = 0; m < 4; ++m) {
                u32x4 w;
#pragma unroll
                for (int bj = 0; bj < 2; ++bj)
#pragma unroll
                    for (int n = 0; n < 2; ++n) {
                        const f32x4 a = acc[ai][bj][m][n]; unsigned x = 0;
#pragma unroll
                        for (int j = 0; j < 4; ++j) { const float s = frcp(1.f + fexp2(-a[j] * LOG2E)); x |= max(1u, (unsigned)(s * 255.f + 0.5f)) << (8 * j); }
                        w[bj * 2 + n] = x;
                    }
                g8[gate_index(u.pm, u.pn, wave, ai * 4 + m, lane)] = w;
            }
    }
};
struct EpiMerge {
    static constexpr bool PERM = false, AFTER_DRAIN = false, HAS_MID = true;
    bf16_t* out; const u32x4* g8;
    DEV void mid(f32x4 (&acc)[2][2][4][2], const pg8::Unit& u, int n, int wave, int lane) const {
#pragma unroll
        for (int ai = 0; ai < 2; ++ai)
#pragma unroll
            for (int m = 0; m < 4; ++m) {
                const u32x4 a = g8[gate_index(u.pm, (n - 1) * 4 + u.pn, wave, ai * 4 + m, lane)], b = g8[gate_index(u.pm, n * 4 + u.pn, wave, ai * 4 + m, lane)];
#pragma unroll
                for (int bj = 0; bj < 2; ++bj)
#pragma unroll
                    for (int nn = 0; nn < 2; ++nn) {
                        const unsigned x = a[bj * 2 + nn], y = b[bj * 2 + nn]; f32x4 r;
#pragma unroll
                        for (int j = 0; j < 4; ++j) r[j] = (float)((x >> (8 * j)) & 255u) * frcp((float)((y >> (8 * j)) & 255u));
                        acc[ai][bj][m][nn] = acc[ai][bj][m][nn] * r;
                    }
            }
    }
    DEV void operator()(const f32x4 (&acc)[2][2][4][2], const pg8::Unit& u, int wr, int wc, int fr, int fq) const {
        const int lane = fq * 16 + fr, wave = wr * 4 + wc;
#pragma unroll
        for (int ai = 0; ai < 2; ++ai)
#pragma unroll
            for (int m = 0; m < 4; ++m) {
                const u32x4 a = g8[gate_index(u.pm, 12 + u.pn, wave, ai * 4 + m, lane)];
                bf16_t* d = out + (size_t)(u.pm * 256 + ai * 128 + wr * 64 + m * 16 + fr) * 1024 + u.pn * 256 + wc * 32 + fq * 4;
#pragma unroll
                for (int bj = 0; bj < 2; ++bj)
#pragma unroll
                    for (int nn = 0; nn < 2; ++nn) {
                        const unsigned x = a[bj * 2 + nn]; f32x4 r;
#pragma unroll
                        for (int j = 0; j < 4; ++j) r[j] = (float)((x >> (8 * j)) & 255u) * (1.f / 255.f);
                        store4(d + bj * 128 + nn * 16, acc[ai][bj][m][nn] * r);
                    }
            }
    }
};
struct EpiGemm1 {
    static constexpr bool PERM = false, AFTER_DRAIN = false, HAS_MID = false;
    const P* pp; int layer;
    DEV void operator()(const f32x4 (&acc)[2][2][4][2], const pg8::Unit& u, int wr, int wc, int fr, int fq) const {
        const int slab = u.pn * 256 + wc * 64; const bool lat = u.pm * 256 < LAT_C;
        if (slab >= 2752) return;
#pragma unroll
        for (int ai = 0; ai < 2; ++ai)
#pragma unroll
            for (int m = 0; m < 4; ++m) {
                f32x4 v[4] = {acc[ai][0][m][0], acc[ai][0][m][1], acc[ai][1][m][0], acc[ai][1][m][1]};
                gemm1_row(v, u.pm * 256 + ai * 128 + wr * 64 + m * 16 + fr, slab, lat, *pp, layer, fq);
            }
    }
};

#define LAS __attribute__((address_space(3)))
#define XB_TMO      128
#define XB_XCNT(j)  (256  + 64 * (j))
#define XB_XSUB(j)  (1280 + 64 * (j))
#define XB_XGEN(j)  (2304 + 64 * (j))
#define XB_TOP      3328
#define XB_TOPGEN   3392
#define XCD_BAR_WORDS 3456
#define XB_SPIN_CAP (1u << 18)

__device__ __forceinline__ unsigned xb_ld(unsigned* p)              { return __hip_atomic_load(p, __ATOMIC_RELAXED, __HIP_MEMORY_SCOPE_AGENT); }
__device__ __forceinline__ unsigned xb_add(unsigned* p, unsigned v) { return __hip_atomic_fetch_add(p, v, __ATOMIC_RELAXED, __HIP_MEMORY_SCOPE_AGENT); }
__device__ __forceinline__ unsigned xb_xcc_id() { return (unsigned)__builtin_amdgcn_s_getreg((3 << 11) | 20) & 0xFu; }
#define XB_SPIN(cond, bar) do { unsigned _sp = 0; while (cond) { __builtin_amdgcn_s_sleep(1); \
    if ((++_sp & 255u) == 0u) { if (xb_ld(&(bar)[XB_TMO])) break; if (_sp > XB_SPIN_CAP) { atomicAdd(&(bar)[XB_TMO], 1u); break; } } } } while (0)

struct XcdBarrier {
    unsigned* bar; unsigned x;
    volatile LAS unsigned* st;
};

__device__ __forceinline__ XcdBarrier xcd_barrier_post(unsigned* bar, volatile LAS unsigned* st) {
    XcdBarrier b; b.bar = bar; b.x = xb_xcc_id(); b.st = st;
    if (threadIdx.x == 0) (void)xb_add(&bar[XB_XCNT(b.x)], 1u);
    return b;
}
__device__ __forceinline__ void xcd_barrier_complete(unsigned* bar, unsigned x, unsigned& nloc, unsigned& nx) {
    const unsigned G = gridDim.x * gridDim.y * gridDim.z;
    unsigned sum, cnt, mine, sp = 0u;
    for (;;) {
        sum = 0u; cnt = 0u; mine = 0u;
#pragma unroll
        for (unsigned j = 0; j < 16; ++j) { const unsigned c = xb_ld(&bar[XB_XCNT(j)]); sum += c; cnt += (c > 0u) ? 1u : 0u; mine = (j == x) ? c : mine; }
        if (sum == G) break;
        __builtin_amdgcn_s_sleep(1);
        if ((++sp & 255u) == 0u) { if (xb_ld(&bar[XB_TMO])) break; if (sp > XB_SPIN_CAP) { atomicAdd(&bar[XB_TMO], 1u); break; } }
    }
    nloc = mine > 0u ? mine : 1u; nx = cnt > 0u ? cnt : 1u;
}

__device__ __forceinline__ void xcd_barrier(const XcdBarrier& b) {
    asm volatile("s_waitcnt vmcnt(0)" ::: "memory");
    __syncthreads();
    if (threadIdx.x == 0) {
        unsigned* bar = b.bar;
        __builtin_amdgcn_s_waitcnt(0);
        unsigned nloc = b.st[0], nx = b.st[1];
        if (nloc == 0u) { xcd_barrier_complete(bar, b.x, nloc, nx); b.st[0] = nloc; b.st[1] = nx; }
        const unsigned old = xb_add(&bar[XB_XSUB(b.x)], 1u);
        const unsigned gen = old / nloc;
        if (old + 1u == (gen + 1u) * nloc) {
            __builtin_amdgcn_fence(__ATOMIC_RELEASE, "agent");
            asm volatile("s_waitcnt vmcnt(0)" ::: "memory");
            const unsigned og = xb_add(&bar[XB_TOP], 1u);
            const unsigned tg = og / nx;
            if (og + 1u == (tg + 1u) * nx) xb_add(&bar[XB_TOPGEN], 1u);
            else XB_SPIN(xb_ld(&bar[XB_TOPGEN]) == tg, bar);
            __builtin_amdgcn_fence(__ATOMIC_ACQUIRE, "agent");
            xb_add(&bar[XB_XGEN(b.x)], 1u);
            asm volatile("s_waitcnt vmcnt(0)" ::: "memory");
        } else {
            XB_SPIN(xb_ld(&bar[XB_XGEN(b.x)]) == gen, bar);
            __builtin_amdgcn_fence(__ATOMIC_ACQUIRE, "agent");
            asm volatile("s_waitcnt vmcnt(0)" ::: "memory");
        }
    }
    __syncthreads();
}

typedef const __attribute__((address_space(4))) P* PP;
#define FRESH_P PP q_ = pp0; asm volatile("" : "+s"(q_)); const P& p = *(const P*)q_;
#define FRESH_BG int bidL = bid, GL = G; asm volatile("" : "+s"(bidL), "+s"(GL));
constexpr int DYN_LDS = 2 * SMEM_BYTES + 64;
__global__ void __launch_bounds__(512, 2) mega(P pv_) {
    cg::grid_group grid = cg::this_grid();
    PP pp0 = (PP)__builtin_amdgcn_kernarg_segment_ptr();
    extern __shared__ __attribute__((aligned(16))) unsigned char lds_dyn[];
    const int half = __builtin_amdgcn_readfirstlane((int)threadIdx.x >> 8);
    unsigned char* smraw = lds_dyn + half * SMEM_BYTES;
    bf16_t* sm = (bf16_t*)smraw;
    PG8_LAS unsigned char* ldsL = (PG8_LAS unsigned char*)lds_dyn;
    const int bid = blockIdx.x, G = gridDim.x, vb = bid * 2 + half, VG = G * 2, tid = threadIdx.x & 255;
    {
        FRESH_P
        volatile LAS unsigned* xst = (volatile LAS unsigned*)(ldsL + 2 * SMEM_BYTES);
        if (threadIdx.x == 0) { xst[0] = 0u; xst[1] = 0u; }
        __syncthreads();
        const XcdBarrier xb0 = xcd_barrier_post(p.barw, xst);
        if (threadIdx.x == 0) xst[2] = xb0.x;
        __syncthreads();
    }
#define GBAR() do { FRESH_P XcdBarrier b_; b_.bar = p.barw; b_.st = (volatile LAS unsigned*)(ldsL + 2 * SMEM_BYTES); b_.x = b_.st[2]; xcd_barrier(b_); } while (0)

    { FRESH_P
    for (int i = vb * 256 + tid; i < 64 * 16 + 64 * 8; i += VG * 256) {
        if (i < 1024) { const int pos = i >> 4, k = i & 15; const float inv = fexp2(-(float)k * (13.287712379549449f / 16.f)); const float a = (float)pos * inv; p.rt16[i] = (f32x2){__cosf(a), __sinf(a)}; }
        else { const int q = i - 1024; const int pos = q >> 3, k = q & 7; const float inv = fexp2(-(float)k * (13.287712379549449f / 8.f)); const float a = (float)pos * inv; p.rt8[q] = (f32x2){__cosf(a), __sinf(a)}; }
    }
    for (int t = vb; t < 384 + CONV_TILES; t += VG) { if (t < 384) mod_item(p, t, smraw); else conv_job(p, 0, t - 384, (float*)smraw); }
    }
    GBAR();
    { FRESH_P r_phase(p, 0, 0, vb, VG, 0, MTOT); }
    GBAR();

    for (int layer = 0; layer < DEPTH; ++layer) {
        for (int ch = 0; ch < NCH; ++ch) {
            { FRESH_P FRESH_BG
              const bf16_t* A = p.U + (size_t)ch * MC * 1024;
              { pg8::Gemm g{A, p.WinT, MC, 2816, 1024}; XSched S{11, 792, GL, bidL}; EpiGemm1 E{&p, layer};
                pg8::gemm_phase<EpiGemm1, XSched, true, true, false>(ldsL, g, S, E); }
              { pg8::Gemm g{A, p.WinT + (size_t)2816 * 1024, MC, 768, 1024}; XSched S{3, 216, GL, (bidL + GL - (792 % GL)) % GL}; EpiVT E{p.VT};
                pg8::gemm_phase<EpiVT, XSched, true, true, true>(ldsL, g, S, E); }
              { pg8::Gemm g{A, p.WinT + (size_t)NPROJ * 1024, MC, 4096, 1024}; XSched S{16, 1152, GL, (bidL + GL - (1008 % GL)) % GL}; EpiGate E{(u32x4*)p.G};
                pg8::gemm_phase<EpiGate, XSched, true, true, false>(ldsL, g, S, E); }
            }
            GBAR();
            { FRESH_P for (int t = vb; t < 1024 + 1024 + 2016 + 384; t += VG) {
                if (t < 1024) attn_item<2>(p, layer, t, false, smraw);
                else if (t < 2048) attn_item<1>(p, layer, t - 1024, false, smraw);
                else if (t < 4064) { const int q = t - 2048; stage2_tile(p, q / 14, q % 14, smraw); }
                else if (t < 4192) attn_item<1>(p, layer, t - 4064, true, smraw);
                else if (t < 4320) attn_item<2>(p, layer, t - 4192, true, smraw);
                else attn_item<3>(p, layer, t - 4320, true, smraw);
            } }
            GBAR();
            { FRESH_P for (int t = vb; t < 1024 + 1024 + 128; t += VG) {
                if (t < 1024) attn_item<0>(p, layer, t, false, smraw);
                else if (t < 2048) attn_item<3>(p, layer, t - 1024, false, smraw);
                else attn_item<0>(p, layer, t - 2048, true, smraw);
            } }
            GBAR();
            { FRESH_P FRESH_BG pg8::Gemm g{p.O, p.WbrT, MC, 1024, 2048}; XSched S{4, 288, GL, bidL}; EpiMerge E{p.MB, (const u32x4*)p.G};
              pg8::gemm_phase<EpiMerge, XSched, true, true, false>(ldsL, g, S, E); }
            GBAR();
            { FRESH_P FRESH_BG pg8::Gemm g{p.MB, p.WoutT, MC, 1024, 1024}; XSched S{4, 288, GL, bidL}; EpiStoreT E{p.YC, 1024, 0};
              pg8::gemm_phase<EpiStoreT, XSched, true, true, false>(ldsL, g, S, E); }
            GBAR();
            { FRESH_P r_phase(p, 1, layer, vb, VG, ch * MC, (ch + 1) * MC); }
            GBAR();
        }
        { FRESH_P FRESH_BG pg8::Gemm g{p.U, p.Wf1T, MTOT, 2 * DFF, 1024}; XSched S{22, 3168, GL, bidL}; EpiSwiglu E{p.ACT};
          pg8::gemm_phase<EpiSwiglu, XSched, true, true, false>(ldsL, g, S, E); }
        GBAR();
        { FRESH_P FRESH_BG pg8::Gemm g{p.ACT, p.Wf2T, MTOT, 1024, DFF}; XSched S{4, 576, GL, bidL}; EpiStoreT E{p.U, 1024, 0};
          pg8::gemm_phase<EpiStoreT, XSched, true, true, false>(ldsL, g, S, E); }
        GBAR();
        { FRESH_P r_phase(p, 2, layer, vb, VG, 0, MTOT);
          if (layer + 1 < DEPTH) { for (int t = vb; t < CONV_TILES; t += VG) conv_job(p, layer + 1, t, (float*)smraw); } }
        GBAR();
    }
}

extern "C" void kernel_launch(void* const* d_in, const int* in_sizes, int n_in, void* d_out, int out_size, void* d_ws, size_t ws_size, hipStream_t stream) {
    static int grid_blocks = 0;
    if (!grid_blocks) {
        int dev = 0, cus = 0, per_cu = 0;
        (void)hipGetDevice(&dev);
        (void)hipDeviceGetAttribute(&cus, hipDeviceAttributeMultiprocessorCount, dev);
        if (hipFuncSetAttribute((const void*)mega, hipFuncAttributeMaxDynamicSharedMemorySize, DYN_LDS) != hipSuccess) fprintf(stderr, "hipFuncSetAttribute failed\n");
        (void)hipOccupancyMaxActiveBlocksPerMultiprocessor(&per_cu, mega, 512, DYN_LDS);
        grid_blocks = cus;
    }
    P p{};
    const float** f = (const float**)&p;
    for (int i = 0; i < 23; ++i) f[i] = (const float*)d_in[i];
    p.out = (float*)d_out;
    unsigned char* w = (unsigned char*)d_ws; size_t off = 0;
    auto take = [&](size_t bytes) { void* r = w + off; off += (bytes + 255) & ~(size_t)255; return r; };
    p.WinT = (bf16_t*)take((size_t)NWIN * 1024 * 2);
    p.WuqT = (bf16_t*)take((size_t)768 * 256 * 2);
    p.WukvT = (bf16_t*)take((size_t)1024 * 128 * 2);
    p.WbrT = (bf16_t*)take((size_t)4 * 1024 * 512 * 2);
    p.WoutT = (bf16_t*)take((size_t)1024 * 1024 * 2);
    p.Wf1T = (bf16_t*)take((size_t)2 * DFF * 1024 * 2);
    p.Wf2T = (bf16_t*)take((size_t)1024 * DFF * 2);
    p.mod = (float*)take((size_t)DEPTH * 17 * 6144 * 4);
    p.rt16 = (f32x2*)take(64 * 16 * 8);
    p.rt8 = (f32x2*)take(64 * 8 * 8);
    p.hc = (float*)take((size_t)NBATCH * CTX * 1024 * 4);
    p.U = (bf16_t*)take((size_t)MTOT * 1024 * 2);
    p.G = (unsigned char*)take((size_t)MC * 4096);
    p.barw = (unsigned*)take((size_t)XCD_BAR_WORDS * 4);
    unsigned char* R = (unsigned char*)take(0);
    p.PJ = (bf16_t*)take((size_t)MC * PJLD * 2);
    p.QA = (bf16_t*)take((size_t)MC * 768 * 2);
    p.KN = (bf16_t*)take((size_t)MC * 512 * 2);
    p.VT = (bf16_t*)take((size_t)VTROWS * MC * 2);
    p.O = (bf16_t*)take((size_t)MC * 2048 * 2);
    p.YC = p.O;
    p.MB = p.PJ;
    p.ACT = (bf16_t*)R;
    if (off > ws_size) { fprintf(stderr, "workspace too small: need %zu have %zu\n", off, ws_size); return; }
    (void)hipMemsetAsync(p.barw, 0, (size_t)XCD_BAR_WORDS * 4, stream);
    void* args[] = {&p};
    hipError_t e = hipLaunchCooperativeKernel((void*)mega, dim3(grid_blocks), dim3(512), args, DYN_LDS, stream);
    if (e != hipSuccess) fprintf(stderr, "cooperative launch failed: %s (grid %d)\n", hipGetErrorString(e), grid_blocks);
}
```

```cpp
#include <hip/hip_runtime.h>
#include <hip/hip_cooperative_groups.h>
#include <cstdio>
#include <cstdint>
namespace cg = cooperative_groups;

typedef unsigned short bf16_t;
typedef short bf16x8 __attribute__((ext_vector_type(8)));
typedef short bf16x4 __attribute__((ext_vector_type(4)));
typedef float f32x4 __attribute__((ext_vector_type(4)));
typedef float f32x2 __attribute__((ext_vector_type(2)));
typedef unsigned u32x2 __attribute__((ext_vector_type(2)));
typedef unsigned u32x4 __attribute__((ext_vector_type(4)));
#define DEV __device__ __forceinline__

constexpr int DM = 1024, NBATCH = 16, SEQ = 2048, CTX = 256, DEPTH = 4;
constexpr int NCH = 2, BPC = NBATCH / NCH, LAT_C = BPC * SEQ, CTX_C = BPC * CTX, MC = LAT_C + CTX_C, MTOT = MC * NCH;
constexpr int INC = 7584, NPROJ = 3584, NWIN = 7680, PJLD = 2816, DFF = 2816, VTROWS = 1280;
#ifndef REP_G
#define REP_G 1
#endif
#ifndef REP_M
#define REP_M 1
#endif
#ifndef REP_A
#define REP_A 1
#endif
constexpr float LOG2E = 1.4426950408889634f;
constexpr int LST = 72;
constexpr int TILE_E = 128 * LST;
constexpr int SMEM_BYTES = 4 * TILE_E * 2 + 1024;

struct P {
    const float *x, *c, *ctx, *c_ctx, *w_mod, *b_mod, *g_pre_mix, *g_post_mix, *g_pre_ffn, *g_post_ffn, *w_in, *g_a_q, *g_a_kv,
        *w_a_uq, *w_a_ukv, *sink_b, *rpb_c, *g_d_q, *g_d_k, *w_branch, *w_out, *w_ffn_in, *w_ffn_out;
    float* out;
    bf16_t *WinT, *WuqT, *WukvT, *WbrT, *WoutT, *Wf1T, *Wf2T;
    float* mod; f32x2 *rt16, *rt8; float* hc;
    bf16_t *U, *YC, *PJ, *QA, *KN, *VT, *O, *MB, *ACT;
    unsigned char* G;
    unsigned* barw;
};

typedef __bf16 bf16v2 __attribute__((ext_vector_type(2)));
DEV unsigned pk_bf16(float lo, float hi) { bf16v2 v = __builtin_convertvector((f32x2){lo, hi}, bf16v2); return __builtin_bit_cast(unsigned, v); }
DEV float bf2f(unsigned short v) { return __uint_as_float(((unsigned)v) << 16); }
DEV void store4(bf16_t* p, f32x4 v) { u32x2 w; w.x = pk_bf16(v[0], v[1]); w.y = pk_bf16(v[2], v[3]); *(u32x2*)p = w; }
DEV float fexp2(float x) { return __builtin_amdgcn_exp2f(x); }
DEV float frcp(float x) { return __builtin_amdgcn_rcpf(x); }
DEV float wave_sum(float v) {
    v += __shfl_xor(v, 1); v += __shfl_xor(v, 2); v += __shfl_xor(v, 4); v += __shfl_xor(v, 8); v += __shfl_xor(v, 16); v += __shfl_xor(v, 32); return v;
}
DEV int ltid() { int t = threadIdx.x & 255; asm volatile("" : "+v"(t)); return t; }
DEV int uni(int v) { return __builtin_amdgcn_readfirstlane(v); }
DEV float xmax16(float x) { auto r = __builtin_amdgcn_permlane16_swap(__float_as_uint(x), __float_as_uint(x), false, false); return fmaxf(__uint_as_float(r[0]), __uint_as_float(r[1])); }
DEV float xmax32(float x) { auto r = __builtin_amdgcn_permlane32_swap(__float_as_uint(x), __float_as_uint(x), false, false); return fmaxf(__uint_as_float(r[0]), __uint_as_float(r[1])); }
DEV float xadd16(float x) { auto r = __builtin_amdgcn_permlane16_swap(__float_as_uint(x), __float_as_uint(x), false, false); return __uint_as_float(r[0]) + __uint_as_float(r[1]); }
DEV float xadd32(float x) { auto r = __builtin_amdgcn_permlane32_swap(__float_as_uint(x), __float_as_uint(x), false, false); return __uint_as_float(r[0]) + __uint_as_float(r[1]); }
DEV f32x4 mfma16(bf16x8 a, bf16x8 b, f32x4 c) { return __builtin_amdgcn_mfma_f32_16x16x32_bf16(a, b, c, 0, 0, 0); }

template <int NFT, bool SWAP>
DEV void gemm_mainloop(const bf16_t* __restrict__ A, int lda, const bf16_t* __restrict__ Bt, int ldb, int K, f32x4 (&acc)[NFT][4], bf16_t* sm) {
    const int tid = ltid(), lane = tid & 63, wid = uni(tid >> 6), wm = wid & 1, wn = wid >> 1, fr = lane & 15, fq = lane >> 4;
    unsigned char* sA = (unsigned char*)sm; unsigned char* sB = sA + 2 * 16384;
    const int lrow = tid >> 3, lc8 = (tid & 7) * 8;
    const int wofs = lrow * 128 + (((tid & 7) ^ (lrow & 7)) << 4);
    const bf16_t* ga = A + (size_t)lrow * lda + lc8;
    const bf16_t* gb = Bt + (size_t)lrow * ldb + lc8;
    u32x4 ra[4], rb[NFT];
#pragma unroll
    for (int ft = 0; ft < NFT; ++ft)
#pragma unroll
        for (int tt = 0; tt < 4; ++tt) acc[ft][tt] = (f32x4){0.f, 0.f, 0.f, 0.f};
#pragma unroll
    for (int i = 0; i < 4; ++i) ra[i] = *(const u32x4*)(ga + (size_t)(i * 32) * lda);
#pragma unroll
    for (int i = 0; i < NFT; ++i) rb[i] = *(const u32x4*)(gb + (size_t)(i * 32) * ldb);
#pragma unroll
    for (int i = 0; i < 4; ++i) *(u32x4*)(sA + wofs + i * 4096) = ra[i];
#pragma unroll
    for (int i = 0; i < NFT; ++i) *(u32x4*)(sB + wofs + i * 4096) = rb[i];
    const int nk = K >> 6;
    if (nk > 1) {
#pragma unroll
        for (int i = 0; i < 4; ++i) ra[i] = *(const u32x4*)(ga + (size_t)(i * 32) * lda + 64);
#pragma unroll
        for (int i = 0; i < NFT; ++i) rb[i] = *(const u32x4*)(gb + (size_t)(i * 32) * ldb + 64);
    }
    __syncthreads();
    const int rofs0 = ((0 + fq) ^ (fr & 7)) << 4, rofs1 = ((4 + fq) ^ (fr & 7)) << 4;
    for (int kt = 0; kt < nk; ++kt) {
        const int cur = kt & 1;
        if (kt + 1 < nk) {
            const int nx = cur ^ 1;
#pragma unroll
            for (int i = 0; i < 4; ++i) *(u32x4*)(sA + nx * 16384 + wofs + i * 4096) = ra[i];
#pragma unroll
            for (int i = 0; i < NFT; ++i) *(u32x4*)(sB + nx * 16384 + wofs + i * 4096) = rb[i];
        }
        if (kt + 2 < nk) {
            const int ko = (kt + 2) * 64;
#pragma unroll
            for (int i = 0; i < 4; ++i) ra[i] = *(const u32x4*)(ga + (size_t)(i * 32) * lda + ko);
#pragma unroll
            for (int i = 0; i < NFT; ++i) rb[i] = *(const u32x4*)(gb + (size_t)(i * 32) * ldb + ko);
        }
        __builtin_amdgcn_sched_barrier(0);
        const unsigned char* cA = sA + cur * 16384 + (wm * 64 + fr) * 128;
        const unsigned char* cB = sB + cur * 16384 + (wn * NFT * 16 + fr) * 128;
#pragma unroll
        for (int ks = 0; ks < 2; ++ks) {
            const int ro = ks ? rofs1 : rofs0;
            bf16x8 af[4], wf[NFT];
#pragma unroll
            for (int tt = 0; tt < 4; ++tt) af[tt] = *(const bf16x8*)(cA + tt * 2048 + ro);
#pragma unroll
            for (int ft = 0; ft < NFT; ++ft) wf[ft] = *(const bf16x8*)(cB + ft * 2048 + ro);
#pragma unroll
            for (int ft = 0; ft < NFT; ++ft)
#pragma unroll
                for (int tt = 0; tt < 4; ++tt) acc[ft][tt] = SWAP ? mfma16(af[tt], wf[ft], acc[ft][tt]) : mfma16(wf[ft], af[tt], acc[ft][tt]);
        }
        __syncthreads();
    }
}

DEV bool tile_xcd(int q, int x, int nM, int nN, int& m, int& n) {
    const int j = q >> 5, w = q & 31;
    const int pp = (((j >> 1) * 8 + x) << 1) + (j & 1);
    const int npn = nN >> 2;
    if (pp >= (nM >> 3) * npn) return false;
    const int pm = pp / npn, pn = pp - pm * npn;
    m = pm * 8 + (w & 7); n = pn * 4 + (w >> 3);
    return true;
}
#define TILE_LOOP(nM, nN) const int x_ = bid & 7, spx_ = G >> 3; int mt, nt; for (int q_ = bid >> 3; tile_xcd(q_, x_, nM, nN, mt, nt); q_ += spx_)

DEV int srccol(int mapid, int n) {
    switch (mapid) {
    case 0:
        if (n < 2816) { const int rho = n & 255; n = (n & ~255) + ((rho >> 5) & 3) * 64 + (rho >> 7) * 32 + (rho & 31); }
        if (n < 384) return n;
        if (n < 896) return n - 384 + 416;
        if (n < 1024) return n - 896 + 928;
        if (n < 1536) return n - 1024 + 1184;
        if (n < 2048) return n - 1536 + 1696;
        if (n < 2560) return n - 2048 + 2720;
        if (n < 2688) return n - 2560 + 3232;
        if (n < 2720) return n - 2688 + 384;
        if (n < 2816) return -1;
        if (n < 2944) return n - 2816 + 1056;
        if (n < 3456) return n - 2944 + 2208;
        if (n < 3584) return n - 3456 + 3360;
        return n - 3584 + 3488;
    case 1: if (n < 512) return (n >> 6) * 96 + (n & 63); { const int q = n - 512; return (q >> 5) * 96 + 64 + (q & 31); }
    case 2: if (n < 512) return (n >> 6) * 128 + (n & 63); { const int q = n - 512; return (q >> 6) * 128 + 64 + (q & 63); }
    case 4: { const int pn = n >> 8, bj = (n >> 7) & 1, wc = (n >> 5) & 3, s = (n >> 4) & 1, f = n & 15; return s * DFF + pn * 128 + bj * 64 + wc * 16 + f; }
    default: return n;
    }
}
DEV void conv_tile(const float* __restrict__ src, int lds_, int K, bf16_t* __restrict__ dst, int n0, int k0, int mapid, const float* rowscale, float* st) {
    const int tid = ltid();
    {
        const int n = tid & 63, kk = tid >> 6; const int sc_ = srccol(mapid, n0 + n);
#pragma unroll
        for (int i = 0; i < 16; ++i) {
            const int k = kk * 16 + i;
            float v = sc_ >= 0 ? src[(size_t)(k0 + k) * lds_ + sc_] : 0.f;
            if (rowscale) v *= rowscale[k0 + k];
            st[k * 65 + n] = v;
        }
    }
    __syncthreads();
    {
        const int n = tid >> 2, kq = tid & 3; u32x4 w0, w1;
        const float* s = st + (kq * 16) * 65 + n;
        w0.x = pk_bf16(s[0 * 65], s[1 * 65]); w0.y = pk_bf16(s[2 * 65], s[3 * 65]); w0.z = pk_bf16(s[4 * 65], s[5 * 65]); w0.w = pk_bf16(s[6 * 65], s[7 * 65]);
        w1.x = pk_bf16(s[8 * 65], s[9 * 65]); w1.y = pk_bf16(s[10 * 65], s[11 * 65]); w1.z = pk_bf16(s[12 * 65], s[13 * 65]); w1.w = pk_bf16(s[14 * 65], s[15 * 65]);
        bf16_t* d = dst + (size_t)(n0 + n) * K + k0 + kq * 16;
        *(u32x4*)d = w0; *(u32x4*)(d + 8) = w1;
    }
    __syncthreads();
}
constexpr int CONV_TILES = 4880;
DEV void conv_job(const P& p, int layer, int t, float* st) {
    if (t < 1920) { conv_tile(p.w_in + (size_t)layer * DM * INC, INC, 1024, p.WinT, (t >> 4) * 64, (t & 15) * 64, 0, nullptr, st); return; }
    t -= 1920;
    if (t < 48) { conv_tile(p.w_a_uq + (size_t)layer * 256 * 768, 768, 256, p.WuqT, (t >> 2) * 64, (t & 3) * 64, 1, p.g_a_q + layer * 256, st); return; }
    t -= 48;
    if (t < 32) { conv_tile(p.w_a_ukv + (size_t)layer * 128 * 1024, 1024, 128, p.WukvT, (t >> 1) * 64, (t & 1) * 64, 2, p.g_a_kv + layer * 128, st); return; }
    t -= 32;
    if (t < 512) { conv_tile(p.w_branch + (size_t)layer * 4 * 512 * 1024, 1024, 2048, p.WbrT, (t >> 5) * 64, (t & 31) * 64, 3, nullptr, st); return; }
    t -= 512;
    if (t < 256) { conv_tile(p.w_out + (size_t)layer * 1024 * 1024, 1024, 1024, p.WoutT, (t >> 4) * 64, (t & 15) * 64, 3, nullptr, st); return; }
    t -= 256;
    if (t < 1408) { conv_tile(p.w_ffn_in + (size_t)layer * 1024 * 2 * DFF, 2 * DFF, 1024, p.Wf1T, (t >> 4) * 64, (t & 15) * 64, 4, nullptr, st); return; }
    t -= 1408;
    { const int nt = t / 44, kt = t - nt * 44; conv_tile(p.w_ffn_out + (size_t)layer * DFF * 1024, 1024, DFF, p.Wf2T, nt * 64, kt * 64, 3, nullptr, st); }
}

DEV void mod_item(const P& p, int item, unsigned char* smraw) {
    const int tid = ltid(), lane = tid & 63, wid = uni(tid >> 6);
    float* sc = (float*)smraw;
    const int l = item / 96, cgp = item - l * 96;
    for (int i = tid; i < 17 * 1024; i += 256) {
        const int r = i >> 10, k = i & 1023; const float v = r < 16 ? p.c[r * 1024 + k] : p.c_ctx[k];
        sc[i] = v * frcp(1.f + fexp2(-v * LOG2E));
    }
    __syncthreads();
    float acc[17];
#pragma unroll
    for (int r = 0; r < 17; ++r) acc[r] = 0.f;
    const float* w = p.w_mod + ((size_t)l * 1024 + wid * 256) * 6144 + cgp * 64 + lane;
    for (int k = 0; k < 256; k += 4) {
        const float w0 = w[(size_t)k * 6144], w1 = w[(size_t)(k + 1) * 6144], w2 = w[(size_t)(k + 2) * 6144], w3 = w[(size_t)(k + 3) * 6144];
#pragma unroll
        for (int r = 0; r < 17; ++r) { const f32x4 s = *(const f32x4*)(sc + r * 1024 + wid * 256 + k); acc[r] += s[0] * w0 + s[1] * w1 + s[2] * w2 + s[3] * w3; }
    }
    __syncthreads();
    float* red = (float*)smraw;
#pragma unroll
    for (int r = 0; r < 17; ++r) red[(wid * 17 + r) * 64 + lane] = acc[r];
    __syncthreads();
    for (int i = tid; i < 17 * 64; i += 256) {
        const int r = i >> 6, ci = i & 63;
        const float v = red[(0 * 17 + r) * 64 + ci] + red[(1 * 17 + r) * 64 + ci] + red[(2 * 17 + r) * 64 + ci] + red[(3 * 17 + r) * 64 + ci] + p.b_mod[l * 6144 + cgp * 64 + ci];
        p.mod[((size_t)l * 17 + r) * 6144 + cgp * 64 + ci] = v;
    }
    __syncthreads();
}

DEV void r_phase(const P& p, int mode, int layer, int vb, int VG, int g_lo, int g_hi, bool skipctx = false) {
    const int tid_ = ltid(), lane = tid_ & 63, wid = uni(tid_ >> 6);
    const int nw = VG * 4;
    for (int g = g_lo + vb * 4 + wid; g < g_hi; g += nw) {
        const int ch = g / MC, local = g - ch * MC;
        if (skipctx && local >= LAT_C) continue;
        const float* hin; float* hout; const float* mod;
        if (local < LAT_C) {
            const int idx = ch * LAT_C + local; const int b = idx >> 11;
            hin = (mode == 0 ? p.x : p.out) + (size_t)idx * 1024; hout = p.out + (size_t)idx * 1024; mod = p.mod + ((size_t)layer * 17 + b) * 6144;
        } else {
            const int idx = ch * CTX_C + local - LAT_C;
            hin = (mode == 0 ? p.ctx : p.hc) + (size_t)idx * 1024; hout = p.hc + (size_t)idx * 1024; mod = p.mod + ((size_t)layer * 17 + 16) * 6144;
        }
        f32x4 h[4];
#pragma unroll
        for (int i = 0; i < 4; ++i) h[i] = *(const f32x4*)(hin + (i * 64 + lane) * 4);
        if (mode != 0) {
            f32x4 y[4]; float ss = 0.f;
#pragma unroll
            for (int i = 0; i < 4; ++i) {
                const u32x2 w = *(const u32x2*)((mode == 1 ? p.YC + (size_t)local * 1024 : p.U + (size_t)g * 1024) + (i * 64 + lane) * 4);
                y[i] = (f32x4){__uint_as_float(w.x << 16), __uint_as_float(w.x & 0xffff0000u), __uint_as_float(w.y << 16), __uint_as_float(w.y & 0xffff0000u)};
                ss += y[i][0] * y[i][0] + y[i][1] * y[i][1] + y[i][2] * y[i][2] + y[i][3] * y[i][3];
            }
            ss = wave_sum(ss);
            const float rs = rsqrtf(ss * (1.f / 1024.f) + 1e-6f);
            const float* gp = (mode == 1 ? p.g_post_mix : p.g_post_ffn) + layer * 1024;
            const float* ga = mod + (mode == 1 ? 2048 : 5120);
#pragma unroll
            for (int i = 0; i < 4; ++i) {
                const f32x4 gg = *(const f32x4*)(gp + (i * 64 + lane) * 4), aa = *(const f32x4*)(ga + (i * 64 + lane) * 4);
                h[i] = h[i] + aa * (y[i] * rs * gg);
            }
        }
#pragma unroll
        for (int i = 0; i < 4; ++i) *(f32x4*)(hout + (i * 64 + lane) * 4) = h[i];
        const int nl = (mode == 2) ? layer + 1 : layer;
        if (nl < DEPTH) {
            float ss = 0.f;
#pragma unroll
            for (int i = 0; i < 4; ++i) ss += h[i][0] * h[i][0] + h[i][1] * h[i][1] + h[i][2] * h[i][2] + h[i][3] * h[i][3];
            ss = wave_sum(ss);
            const float rs = rsqrtf(ss * (1.f / 1024.f) + 1e-6f);
            const float* gpre = (mode == 1 ? p.g_pre_ffn : p.g_pre_mix) + nl * 1024;
            const float* modn = (mode == 2) ? mod + 17 * 6144 : mod;
            const float* sh = modn + (mode == 1 ? 3072 : 0);
            const float* sc = modn + (mode == 1 ? 4096 : 1024);
#pragma unroll
            for (int i = 0; i < 4; ++i) {
                const int e = (i * 64 + lane) * 4;
                const f32x4 gg = *(const f32x4*)(gpre + e), s1 = *(const f32x4*)(sc + e), s0 = *(const f32x4*)(sh + e);
                const f32x4 u = h[i] * rs * gg * (s1 + 1.f) + s0;
                store4(p.U + (size_t)g * 1024 + e, u);
            }
        }
    }
}

DEV void gemm1_row(f32x4 (&v)[4], int row, int slab, bool lat, const P& p, int layer, int fq) {
    const bool hnorm = (slab >= 2048 && slab < 2688);
    const bool rope64 = lat && ((slab >= 384 && slab < 1024) || hnorm);
    const bool isq = (slab >= 384 && slab < 896) || (slab >= 1024 && slab < 1536) || (slab >= 2048 && slab < 2560);
    const float sc = isq ? 0.125f * LOG2E : 1.f;
    const bool kr = (slab == 2688);
    const int tok = row & 2047; const int pr = tok >> 6, pc = tok & 63;
    if (hnorm) {
        float ss = 0.f;
#pragma unroll
        for (int ft = 0; ft < 4; ++ft) ss += v[ft][0] * v[ft][0] + v[ft][1] * v[ft][1] + v[ft][2] * v[ft][2] + v[ft][3] * v[ft][3];
        ss += __shfl_xor(ss, 16); ss += __shfl_xor(ss, 32);
        const float rs = rsqrtf(ss * (1.f / 64.f) + 1e-6f);
        const float* g = (slab < 2560 ? p.g_d_q : p.g_d_k) + layer * 64;
#pragma unroll
        for (int ft = 0; ft < 4; ++ft) { const f32x4 gg = *(const f32x4*)(g + ft * 16 + fq * 4); v[ft] = v[ft] * rs * gg; }
    }
    if (rope64) {
#pragma unroll
        for (int j = 0; j < 4; ++j) {
            const int i = fq * 4 + j;
            f32x2 cs = p.rt16[pr * 16 + i]; float a = v[0][j], b = v[1][j];
            v[0][j] = a * cs[0] - b * cs[1]; v[1][j] = b * cs[0] + a * cs[1];
            cs = p.rt16[pc * 16 + i]; a = v[2][j]; b = v[3][j];
            v[2][j] = a * cs[0] - b * cs[1]; v[3][j] = b * cs[0] + a * cs[1];
        }
    }
    if (kr && lat) {
#pragma unroll
        for (int ft = 0; ft < 2; ++ft) {
            const int pos = ft == 0 ? pr : pc;
#pragma unroll
            for (int j = 0; j < 4; ++j) {
                const int i = (fq & 1) * 4 + j; const f32x2 cs = p.rt8[pos * 8 + i];
                const float xv = v[ft][j]; const float o = __shfl_xor(xv, 32);
                v[ft][j] = fq < 2 ? xv * cs[0] - o * cs[1] : xv * cs[0] + o * cs[1];
            }
        }
    }
    bf16_t* dst = p.PJ + (size_t)row * PJLD + slab + fq * 4;
    store4(dst, v[0] * sc); store4(dst + 16, v[1] * sc);
    if (!kr) { store4(dst + 32, v[2] * sc); store4(dst + 48, v[3] * sc); }
}
DEV void stage2_tile(const P& p, int mt, int j, unsigned char* smraw) {
    bf16_t* sm = (bf16_t*)smraw; float* s_rs = (float*)(smraw + 73728);
    const int tid = ltid(), lane = tid & 63, wid = uni(tid >> 6), wm = wid & 1, wn = wid >> 1, fr = lane & 15, fq = lane >> 4;
    const int m0 = mt * 128; const bool isq = j < 6; const bool lat = m0 < LAT_C;
    const int K = isq ? 256 : 128; const int acol = isq ? 0 : 256;
    {
        const int r = tid >> 1, hf = tid & 1; const int n = K >> 1;
        const bf16_t* src = p.PJ + (size_t)(m0 + r) * PJLD + acol + hf * n; float ss = 0.f;
        for (int i = 0; i < n; i += 8) {
            const u32x4 w = *(const u32x4*)(src + i);
#pragma unroll
            for (int q = 0; q < 4; ++q) { const float a = __uint_as_float(w[q] << 16), b = __uint_as_float(w[q] & 0xffff0000u); ss += a * a + b * b; }
        }
        ss += __shfl_xor(ss, 1);
        if (hf == 0) s_rs[r] = rsqrtf(ss / (float)K + 1e-6f);
    }
    __syncthreads();
    f32x4 acc[4][4];
    const bf16_t* A = p.PJ + (size_t)m0 * PJLD + acol;
    if (isq) {
        const int n0 = j * 128;
        gemm_mainloop<4, false>(A, PJLD, p.WuqT + (size_t)n0 * 256, 256, 256, acc, sm);
        const int slab = n0 + wn * 64; const float qs = 0.10206207261596577f * LOG2E;
#pragma unroll
        for (int tt = 0; tt < 4; ++tt) {
            const int lr = wm * 64 + tt * 16 + fr; const int row = m0 + lr; const float rs = s_rs[lr] * qs;
            const int tok = row & 2047; const int pr = tok >> 6, pc = tok & 63;
            f32x4 v[4] = {acc[0][tt], acc[1][tt], acc[2][tt], acc[3][tt]};
            if (slab >= 512 && lat) {
#pragma unroll
                for (int ft = 0; ft < 4; ++ft) {
                    const int pos = (ft & 1) == 0 ? pr : pc;
#pragma unroll
                    for (int jj = 0; jj < 4; ++jj) {
                        const int i = (fq & 1) * 4 + jj; const f32x2 cs = p.rt8[pos * 8 + i];
                        const float xv = v[ft][jj]; const float o = __shfl_xor(xv, 32);
                        v[ft][jj] = fq < 2 ? xv * cs[0] - o * cs[1] : xv * cs[0] + o * cs[1];
                    }
                }
            }
            bf16_t* dst = p.QA + (size_t)row * 768 + slab + fq * 4;
#pragma unroll
            for (int ft = 0; ft < 4; ++ft) store4(dst + ft * 16, v[ft] * rs);
        }
    } else {
        const int n0 = (j - 6) * 128;
        if (n0 < 512) {
            gemm_mainloop<4, false>(A, PJLD, p.WukvT + (size_t)n0 * 128, 128, 128, acc, sm);
#pragma unroll
            for (int tt = 0; tt < 4; ++tt) {
                const int lr = wm * 64 + tt * 16 + fr; const float rs = s_rs[lr];
                bf16_t* dst = p.KN + (size_t)(m0 + lr) * 512 + n0 + wn * 64 + fq * 4;
#pragma unroll
                for (int ft = 0; ft < 4; ++ft) store4(dst + ft * 16, acc[ft][tt] * rs);
            }
        } else {
            gemm_mainloop<4, true>(A, PJLD, p.WukvT + (size_t)n0 * 128, 128, 128, acc, sm);
            const int vrow0 = 768 + (n0 - 512) + wn * 64;
#pragma unroll
            for (int tt = 0; tt < 4; ++tt) {
                const int lr = wm * 64 + tt * 16 + fq * 4;
                const f32x4 rs = *(const f32x4*)(s_rs + lr);
                const int lp = wm * 64 + (tt >> 1) * 32 + fq * 8 + (tt & 1) * 4;
#pragma unroll
                for (int ft = 0; ft < 4; ++ft) store4(p.VT + (size_t)(vrow0 + ft * 16 + fr) * MC + m0 + lp, acc[ft][tt] * rs);
            }
        }
    }
    __syncthreads();
}

template <int MODE>
DEV void attn_item(const P& p, int layer, int item, bool ctxq, unsigned char* smraw) {
    constexpr bool GQA = (MODE == 1 || MODE == 3);
    constexpr int DQK = (MODE == 0) ? 96 : 64, NKS = DQK / 32;
    constexpr int KRB = (MODE == 0) ? 256 : 128, KM = (MODE == 0) ? 15 : 7;
    constexpr int KT_B = 64 * KRB, VT_B = 64 * 128;
    unsigned char* Ks = smraw; unsigned char* Vs = smraw + 32768; float* bias_s = (float*)(smraw + 49152);
    const int tid = ltid(), lane = tid & 63, wid = uni(tid >> 6), fr = lane & 15, fq = lane >> 4;
    const int nqt = ctxq ? (GQA ? 8 : 2) : (GQA ? 64 : 16);
    const int nh = GQA ? 2 : 8;
    const int qt = item % nqt, hh = (item / nqt) % nh, lb = item / (nqt * nh);
    const int head = GQA ? hh * 4 + wid : hh;
    const int tok0 = GQA ? qt * 32 : qt * 128 + wid * 32;
    const int qrow0 = (ctxq ? LAT_C + lb * CTX : lb * SEQ) + tok0;
    bf16x8 qf[2][NKS];
#pragma unroll
    for (int q = 0; q < 2; ++q) {
        const int row = qrow0 + q * 16 + fr;
        if (MODE == 0) {
            qf[q][0] = *(const bf16x8*)(p.QA + (size_t)row * 768 + head * 64 + fq * 8);
            qf[q][1] = *(const bf16x8*)(p.QA + (size_t)row * 768 + head * 64 + 32 + fq * 8);
            qf[q][NKS - 1] = *(const bf16x8*)(p.QA + (size_t)row * 768 + 512 + head * 32 + fq * 8);
        } else {
            const int qoff = MODE == 1 ? 384 : (MODE == 2 ? 1024 : 2048);
#pragma unroll
            for (int ks = 0; ks < NKS; ++ks) qf[q][ks] = *(const bf16x8*)(p.PJ + (size_t)row * PJLD + qoff + head * 64 + ks * 32 + fq * 8);
        }
    }
    const int koff = MODE == 1 ? 896 + hh * 64 : (MODE == 2 ? 1536 + hh * 64 : 2560 + hh * 64);
    const int vrow0 = MODE == 0 ? 768 + hh * 64 : (MODE == 1 ? hh * 64 : (MODE == 2 ? 128 + hh * 64 : 640 + hh * 64));
    int ktlo = 0, nlat = 0;
    if (!ctxq) {
        if (MODE == 0 || MODE == 3) { ktlo = 0; nlat = 32; }
        else if (MODE == 1) { const int q0 = qt * 32; const int lo = max(0, q0 - 128), hi = min(SEQ - 1, q0 + 159); ktlo = lo >> 6; nlat = (hi >> 6) - ktlo + 1; }
        else { const int r0a = min(max(2 * qt - 4, 0), 24), r0b = min(max(2 * qt + 1 - 4, 0), 24); ktlo = r0a; nlat = r0b + 8 - r0a; }
    }
    const int nt = 4 + nlat;
    const int ntf = ctxq ? 4 : ((MODE == 0 || MODE == 3) ? 36 : (MODE == 1 ? 9 : 13));
    if (MODE == 2 && !ctxq) { for (int i = tid; i < 465; i += 256) bias_s[i] = p.rpb_c[(layer * 8 + hh) * 465 + i] * LOG2E; }

    u32x4 rk[NKS], rv[2];
    auto tile_krow = [&](int it) { it = min(it, nt - 1); return it < 4 ? LAT_C + lb * CTX + it * 64 : lb * SEQ + (ktlo + it - 4) * 64; };
    auto gload = [&](int it) {
        const int krow = tile_krow(it);
#pragma unroll
        for (int i = 0; i < NKS; ++i) {
            const int id = tid + i * 256;
            if (MODE == 0) {
                const int key = id / 12, c = id - key * 12;
                const bf16_t* src = c < 8 ? p.KN + (size_t)(krow + key) * 512 + hh * 64 + c * 8 : p.PJ + (size_t)(krow + key) * PJLD + 2688 + (c - 8) * 8;
                rk[i] = *(const u32x4*)src;
            } else {
                const int key = id >> 3, c = id & 7;
                rk[i] = *(const u32x4*)(p.PJ + (size_t)(krow + key) * PJLD + koff + c * 8);
            }
        }
#pragma unroll
        for (int i = 0; i < 2; ++i) { const int id = tid + i * 256; const int dv = id >> 3, c = id & 7; rv[i] = *(const u32x4*)(p.VT + (size_t)(vrow0 + dv) * MC + krow + c * 8); }
    };
    auto lstore = [&](int buf) {
#pragma unroll
        for (int i = 0; i < NKS; ++i) {
            const int id = tid + i * 256; int key, c;
            if (MODE == 0) { key = id / 12; c = id - key * 12; } else { key = id >> 3; c = id & 7; }
            *(u32x4*)(Ks + buf * KT_B + key * KRB + ((c ^ (key & KM)) << 4)) = rk[i];
        }
#pragma unroll
        for (int i = 0; i < 2; ++i) { const int id = tid + i * 256; const int dv = id >> 3, c = id & 7; *(u32x4*)(Vs + buf * VT_B + dv * 128 + ((c ^ (dv & 7)) << 4)) = rv[i]; }
    };

    f32x4 o[4][2], lo[2], negm4[2]; float mref[2];
    const bf16x8 ones8 = __builtin_bit_cast(bf16x8, (u32x4){0x3F803F80u, 0x3F803F80u, 0x3F803F80u, 0x3F803F80u});
#pragma unroll
    for (int q = 0; q < 2; ++q) { mref[q] = 0.f; lo[q] = (f32x4){0.f, 0.f, 0.f, 0.f}; negm4[q] = (f32x4){0.f, 0.f, 0.f, 0.f};
#pragma unroll
        for (int d = 0; d < 4; ++d) o[d][q] = (f32x4){0.f, 0.f, 0.f, 0.f}; }

    gload(0); lstore(0); gload(1); __syncthreads();
    for (int it = 0; it < ntf; ++it) {
        const int cur = it & 1;
        if (it + 1 < ntf) lstore(cur ^ 1);
        if (it + 2 < ntf) gload(it + 2);
        __builtin_amdgcn_sched_barrier(0);
        const int kt = ktlo + it - 4;
        bool active = it < nt;
        int r = 0, r0 = 0;
        if (MODE == 2 && !ctxq && it >= 4) { r = 2 * qt + (wid >> 1); r0 = min(max(r - 4, 0), 24); active = active && (kt >= r0 && kt < r0 + 8); }
        if (active) {
            f32x4 s[4][2];
            const unsigned char* kb = Ks + cur * KT_B + fr * KRB;
            bf16x8 kf[4][NKS];
#pragma unroll
            for (int k4 = 0; k4 < 4; ++k4)
#pragma unroll
                for (int ks = 0; ks < NKS; ++ks) kf[k4][ks] = *(const bf16x8*)(kb + k4 * 16 * KRB + (((ks * 4 + fq) ^ (fr & KM)) << 4));
            __builtin_amdgcn_sched_barrier(0);
#pragma unroll
            for (int k4 = 0; k4 < 4; ++k4) {
#pragma unroll
                for (int q = 0; q < 2; ++q) s[k4][q] = mfma16(kf[k4][0], qf[q][0], negm4[q]);
#pragma unroll
                for (int ks = 1; ks < NKS; ++ks)
#pragma unroll
                    for (int q = 0; q < 2; ++q) s[k4][q] = mfma16(kf[k4][ks], qf[q][ks], s[k4][q]);
            }
            const unsigned char* vb = Vs + cur * VT_B + fr * 128;
            bf16x8 vf[4][2];
#pragma unroll
            for (int d = 0; d < 4; ++d)
#pragma unroll
                for (int kb2 = 0; kb2 < 2; ++kb2) vf[d][kb2] = *(const bf16x8*)(vb + d * 16 * 128 + (((kb2 * 4 + fq) ^ (fr & 7)) << 4));
            __builtin_amdgcn_sched_barrier(0);
            if (!ctxq && it >= 4) {
                if (MODE == 1) {
#pragma unroll
                    for (int q = 0; q < 2; ++q) {
                        const int qpos = tok0 + q * 16 + fr;
#pragma unroll
                        for (int k4 = 0; k4 < 4; ++k4)
#pragma unroll
                            for (int j = 0; j < 4; ++j) { const int d = qpos - (kt * 64 + k4 * 16 + fq * 4 + j); if (d > 128 || d < -128) s[k4][q][j] = -1e30f; }
                    }
                }
                if (MODE == 2) {
#pragma unroll
                    for (int q = 0; q < 2; ++q) {
                        const int qc = (wid & 1) * 32 + q * 16 + fr; const int c0 = min(max(qc - 8, 0), 48);
                        const int bbase = (kt - r + 7) * 31 + 15 - qc;
#pragma unroll
                        for (int k4 = 0; k4 < 4; ++k4)
#pragma unroll
                            for (int j = 0; j < 4; ++j) {
                                const int kc = k4 * 16 + fq * 4 + j; const bool ok = (kc >= c0 && kc < c0 + 16);
                                const float bv = bias_s[ok ? bbase + kc : 0];
                                s[k4][q][j] = ok ? s[k4][q][j] + bv : -1e30f;
                            }
                    }
                }
            }
            bf16x8 pf[2][2];
#pragma unroll
            for (int q = 0; q < 2; ++q) {
                float mx = -1e30f;
#pragma unroll
                for (int k4 = 0; k4 < 4; ++k4) mx = fmaxf(mx, fmaxf(fmaxf(s[k4][q][0], s[k4][q][1]), fmaxf(s[k4][q][2], s[k4][q][3])));
                mx = xmax32(xmax16(mx));
                const bool need = (it == 0) || (mx > 8.f);
                if (__builtin_amdgcn_ballot_w64(need) != 0ull) {
                    const float delta = need ? mx : 0.f;
                    mref[q] += delta; negm4[q] = negm4[q] - delta;
#pragma unroll
                    for (int k4 = 0; k4 < 4; ++k4) s[k4][q] = s[k4][q] - delta;
                    const float alpha = fexp2(-delta);
                    lo[q] = lo[q] * alpha;
#pragma unroll
                    for (int d = 0; d < 4; ++d) o[d][q] = o[d][q] * alpha;
                }
#pragma unroll
                for (int k4 = 0; k4 < 4; ++k4)
#pragma unroll
                    for (int j = 0; j < 4; ++j) s[k4][q][j] = fexp2(s[k4][q][j]);
#pragma unroll
                for (int kb2 = 0; kb2 < 2; ++kb2) {
                    u32x4 w; w.x = pk_bf16(s[2 * kb2][q][0], s[2 * kb2][q][1]); w.y = pk_bf16(s[2 * kb2][q][2], s[2 * kb2][q][3]);
                    w.z = pk_bf16(s[2 * kb2 + 1][q][0], s[2 * kb2 + 1][q][1]); w.w = pk_bf16(s[2 * kb2 + 1][q][2], s[2 * kb2 + 1][q][3]);
                    pf[q][kb2] = __builtin_bit_cast(bf16x8, w);
                }
            }
#pragma unroll
            for (int d = 0; d < 4; ++d)
#pragma unroll
                for (int kb2 = 0; kb2 < 2; ++kb2)
#pragma unroll
                    for (int q = 0; q < 2; ++q) o[d][q] = mfma16(vf[d][kb2], pf[q][kb2], o[d][q]);
#pragma unroll
            for (int kb2 = 0; kb2 < 2; ++kb2)
#pragma unroll
                for (int q = 0; q < 2; ++q) lo[q] = mfma16(ones8, pf[q][kb2], lo[q]);
        }
        __syncthreads();
    }
#pragma unroll
    for (int q = 0; q < 2; ++q) {
        float l = lo[q][0];
        if (MODE == 1) l += fexp2(p.sink_b[layer * 8 + head] * LOG2E - mref[q]);
        const float inv = 1.f / l;
        bf16_t* dst = p.O + (size_t)(qrow0 + q * 16 + fr) * 2048 + MODE * 512 + head * 64 + fq * 4;
#pragma unroll
        for (int d = 0; d < 4; ++d) store4(dst + d * 16, o[d][q] * inv);
    }
}

DEV void merge_tile(const P& p, int ch, int mt, int nt, bf16_t* sm) {
    const int tid_ = ltid(), lane = tid_ & 63, wid = uni(tid_ >> 6), wm = wid & 1, wn = wid >> 1, fr = lane & 15, fq = lane >> 4;
    const int m0 = mt * 128, n0 = nt * 64;
    f32x4 tot[2][4];
#pragma unroll
    for (int ft = 0; ft < 2; ++ft)
#pragma unroll
        for (int tt = 0; tt < 4; ++tt) tot[ft][tt] = (f32x4){0.f, 0.f, 0.f, 0.f};
    for (int n = 0; n < 4; ++n) {
        f32x4 u[2][4];
        gemm_mainloop<2, false>(p.O + (size_t)m0 * 2048 + n * 512, 2048, p.WbrT + ((size_t)n * 1024 + n0) * 512, 512, 512, u, sm);
#pragma unroll
        for (int tt = 0; tt < 4; ++tt) {
            const unsigned char* gp = p.G + (size_t)(m0 + wm * 64 + tt * 16 + fr) * 4096 + n * 1024 + n0 + wn * 32 + fq * 4;
#pragma unroll
            for (int ft = 0; ft < 2; ++ft) {
                const unsigned w = *(const unsigned*)(gp + ft * 16);
                f32x4 g; g[0] = (float)(w & 255u); g[1] = (float)((w >> 8) & 255u); g[2] = (float)((w >> 16) & 255u); g[3] = (float)(w >> 24);
                tot[ft][tt] = tot[ft][tt] + (g * (1.f / 255.f)) * u[ft][tt];
            }
        }
    }
#pragma unroll
    for (int tt = 0; tt < 4; ++tt) {
        bf16_t* dst = p.MB + (size_t)(m0 + wm * 64 + tt * 16 + fr) * 1024 + n0 + wn * 32 + fq * 4;
        store4(dst, tot[0][tt]); store4(dst + 16, tot[1][tt]);
    }
}
DEV void store_tile_T(const f32x4 (&acc)[4][4], bf16_t* base, int ld, int row0, int col0) {
    const int tid_ = ltid(), lane = tid_ & 63, wid = uni(tid_ >> 6), wm = wid & 1, wn = wid >> 1, fr = lane & 15, fq = lane >> 4;
#pragma unroll
    for (int tt = 0; tt < 4; ++tt) {
        bf16_t* dst = base + (size_t)(row0 + wm * 64 + tt * 16 + fr) * ld + col0 + wn * 64 + fq * 4;
#pragma unroll
        for (int ft = 0; ft < 4; ++ft) store4(dst + ft * 16, acc[ft][tt]);
    }
}

namespace pg8 {
#define PG8_LAS __attribute__((address_space(3)))
constexpr int BM = 256, BK = 64, HALF = 128, HTB = HALF * BK * 2  , STAGE_BYTES = 8 * HTB, NXCD = 8, WGM = 8;

__host__ __device__ __forceinline__ int lds_byte(int r, int c) { const int st = (r >> 4) * 2 + (c >> 5), rr = r & 15, cc = c & 31, ob = rr * 64 + cc * 2; return st * 1024 + (ob ^ (((ob >> 9) & 1) << 5)); }
__host__ __device__ __forceinline__ void stage_rc(int b, int& R, int& C) { const int st = b / 1024, sb = b % 1024, swz = sb ^ (((sb >> 9) & 1) << 5); R = (st >> 1) * 16 + swz / 64; C = (st & 1) * 32 + (swz % 64) / 2; }
__host__ __device__ __forceinline__ int perm32(int rho) { const int n = rho >> 4, i = rho & 15; return 8 * (i >> 2) + 4 * n + (i & 3); }

struct Unit { int pm, pn; };
struct Gemm { const bf16_t* A; const bf16_t* Bt; int M, N, K; };

template <class Epi, class Sched, bool ALIGN_EPI = false, bool SP2 = false, bool SWAPMMA = false>
__device__ __forceinline__ void gemm_phase(PG8_LAS unsigned char* lds, const Gemm g, const Sched& S, const Epi& E) {
    int tid = threadIdx.x; asm volatile("" : "+v"(tid));
    const int wid = __builtin_amdgcn_readfirstlane(tid >> 6), lane = tid & 63, wr = wid >> 2, wc = wid & 3, fr = lane & 15, fq = lane >> 4;
    const int K = g.K, nt = K / BK;
    unsigned voffA[2], voffB[2];
#pragma unroll
    for (int i = 0; i < 2; ++i) { int R, C; stage_rc(tid * 16 + i * 8192, R, C); const int Rb = Epi::PERM ? ((R & ~31) + perm32(R & 31)) : R;
        voffA[i] = (unsigned)(R * K + C) * 2u; voffB[i] = (unsigned)(Rb * K + C) * 2u; }
    const size_t kstep = (size_t)(BK * 2);
    const size_t hstep = (size_t)HALF * K * 2;
    const size_t tstep = 2 * hstep;
    const unsigned ldsw = (unsigned)wid * 1024u;
    const int aoff = lds_byte(wr * 64 + fr, fq * 8), boff = lds_byte(wc * 32 + fr, fq * 8);
#define PG8_SA(b, h) (((b) * 2 + (h)) * HTB)
#define PG8_SB(b, h) ((4 + (b) * 2 + (h)) * HTB)
#define PG8_STAGE(bufoff, gbase, voff) do { _Pragma("unroll") for (int _i = 0; _i < 2; ++_i) \
        __builtin_amdgcn_global_load_lds((const unsigned*)((const char*)(gbase) + (voff)[_i]), (PG8_LAS unsigned*)(lds + (bufoff) + ldsw + _i * 8192), 16, 0, 0); } while (0)
#define PG8_LDA(dst, b, h) do { _Pragma("unroll") for (int m = 0; m < 4; ++m) _Pragma("unroll") for (int k = 0; k < 2; ++k) dst[m][k] = *(const PG8_LAS bf16x8*)(lds + PG8_SA(b, h) + aoff + m * 2048 + k * 1024); } while (0)
#define PG8_LDB(dst, b, h) do { _Pragma("unroll") for (int n = 0; n < 2; ++n) _Pragma("unroll") for (int k = 0; k < 2; ++k) dst[n][k] = *(const PG8_LAS bf16x8*)(lds + PG8_SB(b, h) + boff + n * 2048 + k * 1024); } while (0)
#define PG8_MMA(ai, bj, At, Bt) do { __builtin_amdgcn_s_setprio(1); _Pragma("unroll") for (int m = 0; m < 4; ++m) _Pragma("unroll") for (int n = 0; n < 2; ++n) _Pragma("unroll") for (int k = 0; k < 2; ++k) \
        acc[ai][bj][m][n] = SWAPMMA ? __builtin_amdgcn_mfma_f32_16x16x32_bf16(At[m][k], Bt[n][k], acc[ai][bj][m][n], 0, 0, 0) : __builtin_amdgcn_mfma_f32_16x16x32_bf16(Bt[n][k], At[m][k], acc[ai][bj][m][n], 0, 0, 0); __builtin_amdgcn_s_setprio(0); } while (0)
#define PG8_WAIT_V(n) asm volatile("s_waitcnt vmcnt(" #n ")" ::: "memory")
#define PG8_WAIT_L(n) asm volatile("s_waitcnt lgkmcnt(" #n ")" ::: "memory")
#define PG8_BAR __builtin_amdgcn_s_barrier()
#define PG8_SCHED __builtin_amdgcn_sched_barrier(0)
    Unit cur, nxt; int ui = 0;
    if (!S.next(0, cur)) return;
    f32x4 acc[2][2][4][2];
#pragma unroll
    for (int a = 0; a < 2; ++a)
#pragma unroll
        for (int b = 0; b < 2; ++b)
#pragma unroll
            for (int m = 0; m < 4; ++m)
#pragma unroll
                for (int n = 0; n < 2; ++n) acc[a][b][m][n] = (f32x4){0.f, 0.f, 0.f, 0.f};
    bf16x8 At[4][2], B0[2][2], B1[2][2];
    const char* cA = (const char*)g.A + (size_t)cur.pm * tstep; const char* cB = (const char*)g.Bt + (size_t)cur.pn * tstep;
    S.a_ready(cur);
    if constexpr (SP2) {
        PG8_STAGE(PG8_SB(0, 0), cB, voffB); PG8_STAGE(PG8_SB(0, 1), cB + hstep, voffB); PG8_STAGE(PG8_SA(0, 0), cA, voffA); PG8_STAGE(PG8_SA(0, 1), cA + hstep, voffA);
        if (wr == 1) PG8_BAR;
        PG8_WAIT_V(2); PG8_BAR;
        PG8_STAGE(PG8_SB(1, 0), cB + kstep, voffB); PG8_STAGE(PG8_SA(1, 0), cA + kstep, voffA); PG8_STAGE(PG8_SB(1, 1), cB + hstep + kstep, voffB);
        PG8_WAIT_V(6); PG8_BAR;
    } else {
        PG8_STAGE(PG8_SB(0, 0), cB, voffB); PG8_STAGE(PG8_SA(0, 0), cA, voffA); PG8_STAGE(PG8_SB(0, 1), cB + hstep, voffB); PG8_STAGE(PG8_SA(0, 1), cA + hstep, voffA);
        if (wr == 1) PG8_BAR;
        PG8_WAIT_V(4); PG8_BAR;
        PG8_STAGE(PG8_SB(1, 0), cB + kstep, voffB); PG8_STAGE(PG8_SA(1, 0), cA + kstep, voffA); PG8_STAGE(PG8_SB(1, 1), cB + hstep + kstep, voffB);
        PG8_WAIT_V(6); PG8_BAR;
    }
    for (;;) {
        const bool has_next = S.next(ui + 1, nxt);
        const char* nA = has_next ? (const char*)g.A + (size_t)nxt.pm * tstep : cA; const char* nB = has_next ? (const char*)g.Bt + (size_t)nxt.pn * tstep : cB;
        for (int t = 0; t < nt; t += 2) {
            if constexpr (Epi::HAS_MID) { if (t != 0 && (t & 7) == 0) { E.mid(acc, cur, t >> 3, wid, lane); asm volatile("s_waitcnt vmcnt(0)" ::: "memory"); } }
            const bool last = (t == nt - 2);
            const char* a1 = cA + (size_t)(t + 1) * kstep;
            const char* a2 = last ? nA : cA + (size_t)(t + 2) * kstep; const char* b2 = last ? nB : cB + (size_t)(t + 2) * kstep;
            const char* a3 = a2 + kstep; const char* b3 = b2 + kstep;
            if (last && has_next) S.a_ready(nxt);
            if constexpr (SP2) {
            PG8_LDB(B0, 0, 0); PG8_LDB(B1, 0, 1); PG8_SCHED; PG8_LDA(At, 0, 0); PG8_STAGE(PG8_SA(1, 1), a1 + hstep, voffA);
            PG8_WAIT_V(8); PG8_WAIT_L(0); PG8_BAR; PG8_MMA(0, 0, At, B0); PG8_MMA(0, 1, At, B1); PG8_BAR; PG8_SCHED;
            PG8_LDA(At, 0, 1); PG8_STAGE(PG8_SB(0, 0), b2, voffB); PG8_STAGE(PG8_SB(0, 1), b2 + hstep, voffB); PG8_STAGE(PG8_SA(0, 0), a2, voffA);
            PG8_WAIT_V(8); PG8_WAIT_L(0); PG8_BAR; PG8_MMA(1, 0, At, B0); PG8_MMA(1, 1, At, B1); PG8_BAR; PG8_SCHED;
            PG8_LDB(B0, 1, 0); PG8_LDB(B1, 1, 1); PG8_SCHED; PG8_LDA(At, 1, 0); PG8_STAGE(PG8_SA(0, 1), a2 + hstep, voffA);
            PG8_WAIT_V(8); PG8_WAIT_L(0); PG8_BAR; PG8_MMA(0, 0, At, B0); PG8_MMA(0, 1, At, B1); PG8_BAR; PG8_SCHED;
            PG8_LDA(At, 1, 1); PG8_STAGE(PG8_SB(1, 0), b3, voffB); PG8_STAGE(PG8_SB(1, 1), b3 + hstep, voffB); PG8_STAGE(PG8_SA(1, 0), a3, voffA);
            PG8_WAIT_V(8); PG8_WAIT_L(0); PG8_BAR; PG8_MMA(1, 0, At, B0); PG8_MMA(1, 1, At, B1); PG8_BAR; PG8_SCHED;
            } else {
            PG8_LDB(B0, 0, 0); PG8_SCHED; PG8_LDA(At, 0, 0); PG8_STAGE(PG8_SA(1, 1), a1 + hstep, voffA);
            PG8_WAIT_L(8); PG8_BAR; PG8_WAIT_L(0); PG8_MMA(0, 0, At, B0); PG8_BAR; PG8_SCHED;
            PG8_LDB(B1, 0, 1); PG8_STAGE(PG8_SB(0, 0), b2, voffB);
            PG8_BAR; PG8_WAIT_L(0); PG8_MMA(0, 1, At, B1); PG8_BAR;
            PG8_LDA(At, 0, 1); PG8_STAGE(PG8_SA(0, 0), a2, voffA);
            PG8_BAR; PG8_WAIT_L(0); PG8_MMA(1, 0, At, B0); PG8_BAR; PG8_SCHED;
            PG8_STAGE(PG8_SB(0, 1), b2 + hstep, voffB);
            PG8_WAIT_V(6); PG8_BAR; PG8_MMA(1, 1, At, B1); PG8_BAR;
            PG8_LDB(B0, 1, 0); PG8_SCHED; PG8_LDA(At, 1, 0); PG8_STAGE(PG8_SA(0, 1), a2 + hstep, voffA);
            PG8_WAIT_L(8); PG8_BAR; PG8_WAIT_L(0); PG8_MMA(0, 0, At, B0); PG8_BAR; PG8_SCHED;
            PG8_LDB(B1, 1, 1); PG8_STAGE(PG8_SB(1, 0), b3, voffB);
            PG8_BAR; PG8_WAIT_L(0); PG8_MMA(0, 1, At, B1); PG8_BAR;
            PG8_LDA(At, 1, 1); PG8_STAGE(PG8_SA(1, 0), a3, voffA);
            PG8_BAR; PG8_WAIT_L(0); PG8_MMA(1, 0, At, B0); PG8_BAR; PG8_SCHED;
            PG8_STAGE(PG8_SB(1, 1), b3 + hstep, voffB);
            PG8_WAIT_V(6); PG8_BAR; PG8_MMA(1, 1, At, B1); PG8_BAR;
            }
        }
        if constexpr (ALIGN_EPI) { if (wr == 0) PG8_BAR; }
        if constexpr (!Epi::AFTER_DRAIN) { E(acc, cur, wr, wc, fr, fq); S.done(cur); }
        if (!has_next) break;
#pragma unroll
        for (int a = 0; a < 2; ++a)
#pragma unroll
            for (int b = 0; b < 2; ++b)
#pragma unroll
                for (int m = 0; m < 4; ++m)
#pragma unroll
                    for (int n = 0; n < 2; ++n) acc[a][b][m][n] = (f32x4){0.f, 0.f, 0.f, 0.f};
        cur = nxt; cA = nA; cB = nB; ++ui;
        if constexpr (ALIGN_EPI) { if (wr == 1) PG8_BAR; }
    }
    PG8_WAIT_V(0);
    if constexpr (!ALIGN_EPI) { if (wr == 0) PG8_BAR; }
    PG8_BAR;
    if constexpr (Epi::AFTER_DRAIN) { E.fused(acc, cur, wr, wc, fr, fq, lds, wid, lane); S.done(cur); }
#undef PG8_SA
#undef PG8_SB
#undef PG8_STAGE
#undef PG8_LDA
#undef PG8_LDB
#undef PG8_MMA
#undef PG8_WAIT_V
#undef PG8_WAIT_L
#undef PG8_BAR
#undef PG8_SCHED
}
}

struct XSched {
    int nN, nunits, G, c, skipctx;
    DEV bool next(int i, pg8::Unit& u) const {
        const int L = i * G + c; if (L >= nunits) return false;
        const int U = ((nunits & 7) == 0 && (G & 7) == 0) ? (L & 7) * (nunits >> 3) + (L >> 3) : L;
        u.pm = U / nN; u.pn = U - u.pm * nN;
        if (skipctx) u.pm = (u.pm >> 6) * 72 + (u.pm & 63);
        return true;
    }
    DEV void a_ready(const pg8::Unit&) const {}
    DEV void done(const pg8::Unit&) const {}
};
struct EpiStoreT {
    static constexpr bool PERM = false, AFTER_DRAIN = false, HAS_MID = false;
    bf16_t* out; int ld; int row_off;
    DEV void operator()(const f32x4 (&acc)[2][2][4][2], const pg8::Unit& u, int wr, int wc, int fr, int fq) const {
#pragma unroll
        for (int ai = 0; ai < 2; ++ai)
#pragma unroll
            for (int m = 0; m < 4; ++m) {
                bf16_t* d = out + (size_t)(row_off + u.pm * 256 + ai * 128 + wr * 64 + m * 16 + fr) * ld + u.pn * 256 + wc * 32 + fq * 4;
#pragma unroll
                for (int bj = 0; bj < 2; ++bj)
#pragma unroll
                    for (int n = 0; n < 2; ++n) store4(d + bj * 128 + n * 16, acc[ai][bj][m][n]);
            }
    }
};
struct EpiSwiglu {
    static constexpr bool PERM = false, AFTER_DRAIN = false, HAS_MID = false;
    bf16_t* act;
    DEV void operator()(const f32x4 (&acc)[2][2][4][2], const pg8::Unit& u, int wr, int wc, int fr, int fq) const {
#pragma unroll
        for (int ai = 0; ai < 2; ++ai)
#pragma unroll
            for (int m = 0; m < 4; ++m) {
                bf16_t* d = act + (size_t)(u.pm * 256 + ai * 128 + wr * 64 + m * 16 + fr) * DFF + u.pn * 128 + wc * 16 + fq * 4;
#pragma unroll
                for (int bj = 0; bj < 2; ++bj) {
                    const f32x4 a = acc[ai][bj][m][0], b = acc[ai][bj][m][1]; f32x4 r;
#pragma unroll
                    for (int j = 0; j < 4; ++j) r[j] = a[j] * frcp(1.f + fexp2(-a[j] * LOG2E)) * b[j];
                    store4(d + bj * 64, r);
                }
            }
    }
};
struct EpiVT {
    static constexpr bool PERM = false, AFTER_DRAIN = false, HAS_MID = false;
    bf16_t* vt;
    DEV void operator()(const f32x4 (&acc)[2][2][4][2], const pg8::Unit& u, int wr, int wc, int fr, int fq) const {
#pragma unroll
        for (int bj = 0; bj < 2; ++bj)
#pragma unroll
            for (int n = 0; n < 2; ++n) {
                bf16_t* d = vt + (size_t)(u.pn * 256 + bj * 128 + wc * 32 + n * 16 + fr) * MC + u.pm * 256 + wr * 64 + fq * 8;
#pragma unroll
                for (int ai = 0; ai < 2; ++ai)
#pragma unroll
                    for (int m = 0; m < 4; ++m) store4(d + ai * 128 + (m >> 1) * 32 + (m & 1) * 4, acc[ai][bj][m][n]);
            }
    }
};
DEV size_t gate_index(int pm, int pn4, int wave, int r8, int lane) { return ((((size_t)pm * 16 + pn4) * 8 + wave) * 8 + r8) * 64 + lane; }
struct EpiGate {
    static constexpr bool PERM = false, AFTER_DRAIN = false, HAS_MID = false;
    u32x4* g8;
    DEV void operator()(const f32x4 (&acc)[2][2][4][2], const pg8::Unit& u, int wr, int wc, int fr, int fq) const {
        const int lane = fq * 16 + fr, wave = wr * 4 + wc;
#pragma unroll
        for (int ai = 0; ai < 2; ++ai)
#pragma unroll
            for (int m = 0; m < 4; ++m) {
                u32x4 w;
#pragma unroll
                for (int bj = 0; bj < 2; ++bj)
#pragma unroll
                    for (int n = 0; n < 2; ++n) {
                        const f32x4 a = acc[ai][bj][m][n]; unsigned x = 0;
#pragma unroll
                        for (int j = 0; j < 4; ++j) { const float s = frcp(1.f + fexp2(-a[j] * LOG2E)); x |= max(1u, (unsigned)(s * 255.f + 0.5f)) << (8 * j); }
                        w[bj * 2 + n] = x;
                    }
                g8[gate_index(u.pm, u.pn, wave, ai * 4 + m, lane)] = w;
            }
    }
};
struct EpiMerge {
    static constexpr bool PERM = false, AFTER_DRAIN = false, HAS_MID = true;
    bf16_t* out; const u32x4* g8;
    DEV void mid(f32x4 (&acc)[2][2][4][2], const pg8::Unit& u, int n, int wave, int lane) const {
#pragma unroll
        for (int ai = 0; ai < 2; ++ai)
#pragma unroll
            for (int m = 0; m < 4; ++m) {
                const u32x4 a = g8[gate_index(u.pm, (n - 1) * 4 + u.pn, wave, ai * 4 + m, lane)], b = g8[gate_index(u.pm, n * 4 + u.pn, wave, ai * 4 + m, lane)];
#pragma unroll
                for (int bj = 0; bj < 2; ++bj)
#pragma unroll
                    for (int nn = 0; nn < 2; ++nn) {
                        const unsigned x = a[bj * 2 + nn], y = b[bj * 2 + nn]; f32x4 r;
#pragma unroll
                        for (int j = 0; j < 4; ++j) r[j] = (float)((x >> (8 * j)) & 255u) * frcp((float)((y >> (8 * j)) & 255u));
                        acc[ai][bj][m][nn] = acc[ai][bj][m][nn] * r;
                    }
            }
    }
    DEV void operator()(const f32x4 (&acc)[2][2][4][2], const pg8::Unit& u, int wr, int wc, int fr, int fq) const {
        const int lane = fq * 16 + fr, wave = wr * 4 + wc;
#pragma unroll
        for (int ai = 0; ai < 2; ++ai)
#pragma unroll
            for (int m = 0; m < 4; ++m) {
                const u32x4 a = g8[gate_index(u.pm, 12 + u.pn, wave, ai * 4 + m, lane)];
                bf16_t* d = out + (size_t)(u.pm * 256 + ai * 128 + wr * 64 + m * 16 + fr) * 1024 + u.pn * 256 + wc * 32 + fq * 4;
#pragma unroll
                for (int bj = 0; bj < 2; ++bj)
#pragma unroll
                    for (int nn = 0; nn < 2; ++nn) {
                        const unsigned x = a[bj * 2 + nn]; f32x4 r;
#pragma unroll
                        for (int j = 0; j < 4; ++j) r[j] = (float)((x >> (8 * j)) & 255u) * (1.f / 255.f);
                        store4(d + bj * 128 + nn * 16, acc[ai][bj][m][nn] * r);
                    }
            }
    }
};
struct EpiGemm1 {
    static constexpr bool PERM = false, AFTER_DRAIN = false, HAS_MID = false;
    const P* pp; int layer;
    DEV void operator()(const f32x4 (&acc)[2][2][4][2], const pg8::Unit& u, int wr, int wc, int fr, int fq) const {
        const int slab = u.pn * 256 + wc * 64; const bool lat = u.pm * 256 < LAT_C;
        if (slab >= 2752) return;
#pragma unroll
        for (int ai = 0; ai < 2; ++ai)
#pragma unroll
            for (int m = 0; m < 4; ++m) {
                f32x4 v[4] = {acc[ai][0][m][0], acc[ai][0][m][1], acc[ai][1][m][0], acc[ai][1][m][1]};
                gemm1_row(v, u.pm * 256 + ai * 128 + wr * 64 + m * 16 + fr, slab, lat, *pp, layer, fq);
            }
    }
};

#define LAS __attribute__((address_space(3)))
#define XB_TMO      128
#define XB_XCNT(j)  (256  + 64 * (j))
#define XB_XSUB(j)  (1280 + 64 * (j))
#define XB_XGEN(j)  (2304 + 64 * (j))
#define XB_TOP      3328
#define XB_TOPGEN   3392
#define XCD_BAR_WORDS 3456
#define XB_SPIN_CAP (1u << 18)

__device__ __forceinline__ unsigned xb_ld(unsigned* p)              { return __hip_atomic_load(p, __ATOMIC_RELAXED, __HIP_MEMORY_SCOPE_AGENT); }
__device__ __forceinline__ unsigned xb_add(unsigned* p, unsigned v) { return __hip_atomic_fetch_add(p, v, __ATOMIC_RELAXED, __HIP_MEMORY_SCOPE_AGENT); }
__device__ __forceinline__ unsigned xb_xcc_id() { return (unsigned)__builtin_amdgcn_s_getreg((3 << 11) | 20) & 0xFu; }
#define XB_SPIN(cond, bar) do { unsigned _sp = 0; while (cond) { __builtin_amdgcn_s_sleep(1); \
    if ((++_sp & 255u) == 0u) { if (xb_ld(&(bar)[XB_TMO])) break; if (_sp > XB_SPIN_CAP) { atomicAdd(&(bar)[XB_TMO], 1u); break; } } } } while (0)

struct XcdBarrier {
    unsigned* bar; unsigned x;
    volatile LAS unsigned* st;
};

__device__ __forceinline__ XcdBarrier xcd_barrier_post(unsigned* bar, volatile LAS unsigned* st) {
    XcdBarrier b; b.bar = bar; b.x = xb_xcc_id(); b.st = st;
    if (threadIdx.x == 0) (void)xb_add(&bar[XB_XCNT(b.x)], 1u);
    return b;
}
__device__ __forceinline__ void xcd_barrier_complete(unsigned* bar, unsigned x, unsigned& nloc, unsigned& nx) {
    const unsigned G = gridDim.x * gridDim.y * gridDim.z;
    unsigned sum, cnt, mine, sp = 0u;
    for (;;) {
        sum = 0u; cnt = 0u; mine = 0u;
#pragma unroll
        for (unsigned j = 0; j < 16; ++j) { const unsigned c = xb_ld(&bar[XB_XCNT(j)]); sum += c; cnt += (c > 0u) ? 1u : 0u; mine = (j == x) ? c : mine; }
        if (sum == G) break;
        __builtin_amdgcn_s_sleep(1);
        if ((++sp & 255u) == 0u) { if (xb_ld(&bar[XB_TMO])) break; if (sp > XB_SPIN_CAP) { atomicAdd(&bar[XB_TMO], 1u); break; } }
    }
    nloc = mine > 0u ? mine : 1u; nx = cnt > 0u ? cnt : 1u;
}

__device__ __forceinline__ void xcd_barrier(const XcdBarrier& b) {
    asm volatile("s_waitcnt vmcnt(0)" ::: "memory");
    __syncthreads();
    if (threadIdx.x == 0) {
        unsigned* bar = b.bar;
        __builtin_amdgcn_s_waitcnt(0);
        unsigned nloc = b.st[0], nx = b.st[1];
        if (nloc == 0u) { xcd_barrier_complete(bar, b.x, nloc, nx); b.st[0] = nloc; b.st[1] = nx; }
        const unsigned old = xb_add(&bar[XB_XSUB(b.x)], 1u);
        const unsigned gen = old / nloc;
        if (old + 1u == (gen + 1u) * nloc) {
            __builtin_amdgcn_fence(__ATOMIC_RELEASE, "agent");
            asm volatile("s_waitcnt vmcnt(0)" ::: "memory");
            const unsigned og = xb_add(&bar[XB_TOP], 1u);
            const unsigned tg = og / nx;
            if (og + 1u == (tg + 1u) * nx) xb_add(&bar[XB_TOPGEN], 1u);
            else XB_SPIN(xb_ld(&bar[XB_TOPGEN]) == tg, bar);
            __builtin_amdgcn_fence(__ATOMIC_ACQUIRE, "agent");
            xb_add(&bar[XB_XGEN(b.x)], 1u);
            asm volatile("s_waitcnt vmcnt(0)" ::: "memory");
        } else {
            XB_SPIN(xb_ld(&bar[XB_XGEN(b.x)]) == gen, bar);
            __builtin_amdgcn_fence(__ATOMIC_ACQUIRE, "agent");
            asm volatile("s_waitcnt vmcnt(0)" ::: "memory");
        }
    }
    __syncthreads();
}

typedef const __attribute__((address_space(4))) P* PP;
#define FRESH_P PP q_ = pp0; asm volatile("" : "+s"(q_)); const P& p = *(const P*)q_;
#define FRESH_BG int bidL = bid, GL = G; asm volatile("" : "+s"(bidL), "+s"(GL));
constexpr int DYN_LDS = 2 * SMEM_BYTES + 64;
__global__ void __launch_bounds__(512, 2) mega(P pv_) {
    cg::grid_group grid = cg::this_grid();
    PP pp0 = (PP)__builtin_amdgcn_kernarg_segment_ptr();
    extern __shared__ __attribute__((aligned(16))) unsigned char lds_dyn[];
    const int half = __builtin_amdgcn_readfirstlane((int)threadIdx.x >> 8);
    unsigned char* smraw = lds_dyn + half * SMEM_BYTES;
    bf16_t* sm = (bf16_t*)smraw;
    PG8_LAS unsigned char* ldsL = (PG8_LAS unsigned char*)lds_dyn;
    const int bid = blockIdx.x, G = gridDim.x, vb = bid * 2 + half, VG = G * 2, tid = threadIdx.x & 255;
    {
        FRESH_P
        volatile LAS unsigned* xst = (volatile LAS unsigned*)(ldsL + 2 * SMEM_BYTES);
        if (threadIdx.x == 0) { xst[0] = 0u; xst[1] = 0u; }
        __syncthreads();
        const XcdBarrier xb0 = xcd_barrier_post(p.barw, xst);
        if (threadIdx.x == 0) xst[2] = xb0.x;
        __syncthreads();
    }
#define GBAR() do { FRESH_P XcdBarrier b_; b_.bar = p.barw; b_.st = (volatile LAS unsigned*)(ldsL + 2 * SMEM_BYTES); b_.x = b_.st[2]; xcd_barrier(b_); } while (0)

    { FRESH_P
    for (int i = vb * 256 + tid; i < 64 * 16 + 64 * 8; i += VG * 256) {
        if (i < 1024) { const int pos = i >> 4, k = i & 15; const float inv = fexp2(-(float)k * (13.287712379549449f / 16.f)); const float a = (float)pos * inv; p.rt16[i] = (f32x2){__cosf(a), __sinf(a)}; }
        else { const int q = i - 1024; const int pos = q >> 3, k = q & 7; const float inv = fexp2(-(float)k * (13.287712379549449f / 8.f)); const float a = (float)pos * inv; p.rt8[q] = (f32x2){__cosf(a), __sinf(a)}; }
    }
    for (int t = vb; t < 384 + CONV_TILES; t += VG) { if (t < 384) mod_item(p, t, smraw); else conv_job(p, 0, t - 384, (float*)smraw); }
    }
    GBAR();
    { FRESH_P r_phase(p, 0, 0, vb, VG, 0, MTOT); }
    GBAR();

    for (int layer = 0; layer < DEPTH; ++layer) {
        const bool lastL = (layer == DEPTH - 1);
        for (int ch = 0; ch < NCH; ++ch) {
            { FRESH_P FRESH_BG
              const bf16_t* A = p.U + (size_t)ch * MC * 1024;
              { pg8::Gemm g{A, p.WinT, MC, 2816, 1024}; XSched S{11, 792, GL, bidL}; EpiGemm1 E{&p, layer};
                pg8::gemm_phase<EpiGemm1, XSched, true, true, false>(ldsL, g, S, E); }
              { pg8::Gemm g{A, p.WinT + (size_t)2816 * 1024, MC, 768, 1024}; XSched S{3, 216, GL, (bidL + GL - (792 % GL)) % GL}; EpiVT E{p.VT};
                pg8::gemm_phase<EpiVT, XSched, true, true, true>(ldsL, g, S, E); }
              { pg8::Gemm g{A, p.WinT + (size_t)NPROJ * 1024, MC, 4096, 1024}; XSched S{16, lastL ? 1024 : 1152, GL, (bidL + GL - (1008 % GL)) % GL}; EpiGate E{(u32x4*)p.G};
                pg8::gemm_phase<EpiGate, XSched, true, true, false>(ldsL, g, S, E); }
            }
            GBAR();
            { FRESH_P for (int t = vb; t < (lastL ? 4064 : 4448); t += VG) {
                if (t < 1024) attn_item<2>(p, layer, t, false, smraw);
                else if (t < 2048) attn_item<1>(p, layer, t - 1024, false, smraw);
                else if (t < 4064) { const int q = t - 2048; stage2_tile(p, q / 14, q % 14, smraw); }
                else if (t < 4192) attn_item<1>(p, layer, t - 4064, true, smraw);
                else if (t < 4320) attn_item<2>(p, layer, t - 4192, true, smraw);
                else attn_item<3>(p, layer, t - 4320, true, smraw);
            } }
            GBAR();
            { FRESH_P for (int t = vb; t < (lastL ? 2048 : 2176); t += VG) {
                if (t < 1024) attn_item<0>(p, layer, t, false, smraw);
                else if (t < 2048) attn_item<3>(p, layer, t - 1024, false, smraw);
                else attn_item<0>(p, layer, t - 2048, true, smraw);
            } }
            GBAR();
            { FRESH_P FRESH_BG pg8::Gemm g{p.O, p.WbrT, MC, 1024, 2048}; XSched S{4, lastL ? 256 : 288, GL, bidL}; EpiMerge E{p.MB, (const u32x4*)p.G};
              pg8::gemm_phase<EpiMerge, XSched, true, true, false>(ldsL, g, S, E); }
            GBAR();
            { FRESH_P FRESH_BG pg8::Gemm g{p.MB, p.WoutT, MC, 1024, 1024}; XSched S{4, lastL ? 256 : 288, GL, bidL}; EpiStoreT E{p.YC, 1024, 0};
              pg8::gemm_phase<EpiStoreT, XSched, true, true, false>(ldsL, g, S, E); }
            GBAR();
            { FRESH_P r_phase(p, 1, layer, vb, VG, ch * MC, ch * MC + (lastL ? LAT_C : MC)); }
            if (ch + 1 == NCH) GBAR();
        }
        { FRESH_P FRESH_BG pg8::Gemm g{p.U, p.Wf1T, MTOT, 2 * DFF, 1024}; XSched S{22, lastL ? 2816 : 3168, GL, bidL, lastL ? 1 : 0}; EpiSwiglu E{p.ACT};
          pg8::gemm_phase<EpiSwiglu, XSched, true, true, false>(ldsL, g, S, E); }
        GBAR();
        { FRESH_P FRESH_BG pg8::Gemm g{p.ACT, p.Wf2T, MTOT, 1024, DFF}; XSched S{4, lastL ? 512 : 576, GL, bidL, lastL ? 1 : 0}; EpiStoreT E{p.U, 1024, 0};
          pg8::gemm_phase<EpiStoreT, XSched, true, true, false>(ldsL, g, S, E); }
        GBAR();
        { FRESH_P r_phase(p, 2, layer, vb, VG, 0, MTOT, lastL);
          if (layer + 1 < DEPTH) { for (int t = vb; t < CONV_TILES; t += VG) conv_job(p, layer + 1, t, (float*)smraw); } }
        GBAR();
    }
}

extern "C" void kernel_launch(void* const* d_in, const int* in_sizes, int n_in, void* d_out, int out_size, void* d_ws, size_t ws_size, hipStream_t stream) {
    static int grid_blocks = 0;
    if (!grid_blocks) {
        int dev = 0, cus = 0, per_cu = 0;
        (void)hipGetDevice(&dev);
        (void)hipDeviceGetAttribute(&cus, hipDeviceAttributeMultiprocessorCount, dev);
        if (hipFuncSetAttribute((const void*)mega, hipFuncAttributeMaxDynamicSharedMemorySize, DYN_LDS) != hipSuccess) fprintf(stderr, "hipFuncSetAttribute failed\n");
        (void)hipOccupancyMaxActiveBlocksPerMultiprocessor(&per_cu, mega, 512, DYN_LDS);
        grid_blocks = cus;
    }
    P p{};
    const float** f = (const float**)&p;
    for (int i = 0; i < 23; ++i) f[i] = (const float*)d_in[i];
    p.out = (float*)d_out;
    unsigned char* w = (unsigned char*)d_ws; size_t off = 0;
    auto take = [&](size_t bytes) { void* r = w + off; off += (bytes + 255) & ~(size_t)255; return r; };
    p.WinT = (bf16_t*)take((size_t)NWIN * 1024 * 2);
    p.WuqT = (bf16_t*)take((size_t)768 * 256 * 2);
    p.WukvT = (bf16_t*)take((size_t)1024 * 128 * 2);
    p.WbrT = (bf16_t*)take((size_t)4 * 1024 * 512 * 2);
    p.WoutT = (bf16_t*)take((size_t)1024 * 1024 * 2);
    p.Wf1T = (bf16_t*)take((size_t)2 * DFF * 1024 * 2);
    p.Wf2T = (bf16_t*)take((size_t)1024 * DFF * 2);
    p.mod = (float*)take((size_t)DEPTH * 17 * 6144 * 4);
    p.rt16 = (f32x2*)take(64 * 16 * 8);
    p.rt8 = (f32x2*)take(64 * 8 * 8);
    p.hc = (float*)take((size_t)NBATCH * CTX * 1024 * 4);
    p.U = (bf16_t*)take((size_t)MTOT * 1024 * 2);
    p.G = (unsigned char*)take((size_t)MC * 4096);
    p.barw = (unsigned*)take((size_t)XCD_BAR_WORDS * 4);
    unsigned char* R = (unsigned char*)take(0);
    p.PJ = (bf16_t*)take((size_t)MC * PJLD * 2);
    p.QA = (bf16_t*)take((size_t)MC * 768 * 2);
    p.KN = (bf16_t*)take((size_t)MC * 512 * 2);
    p.VT = (bf16_t*)take((size_t)VTROWS * MC * 2);
    p.O = (bf16_t*)take((size_t)MC * 2048 * 2);
    p.YC = p.O;
    p.MB = p.PJ;
    p.ACT = (bf16_t*)R;
    if (off > ws_size) { fprintf(stderr, "workspace too small: need %zu have %zu\n", off, ws_size); return; }
    (void)hipMemsetAsync(p.barw, 0, (size_t)XCD_BAR_WORDS * 4, stream);
    void* args[] = {&p};
    hipError_t e = hipLaunchCooperativeKernel((void*)mega, dim3(grid_blocks), dim3(512), args, DYN_LDS, stream);
    if (e != hipSuccess) fprintf(stderr, "cooperative launch failed: %s (grid %d)\n", hipGetErrorString(e), grid_blocks);
}
```

```cpp
#include <hip/hip_runtime.h>
#include <hip/hip_cooperative_groups.h>
#include <cstdio>
#include <cstdint>
namespace cg = cooperative_groups;

typedef unsigned short bf16_t;
typedef short bf16x8 __attribute__((ext_vector_type(8)));
typedef short bf16x4 __attribute__((ext_vector_type(4)));
typedef float f32x4 __attribute__((ext_vector_type(4)));
typedef float f32x2 __attribute__((ext_vector_type(2)));
typedef unsigned u32x2 __attribute__((ext_vector_type(2)));
typedef unsigned u32x4 __attribute__((ext_vector_type(4)));
#define DEV __device__ __forceinline__

constexpr int DM = 1024, NBATCH = 16, SEQ = 2048, CTX = 256, DEPTH = 4;
constexpr int NCH = 2, BPC = NBATCH / NCH, LAT_C = BPC * SEQ, CTX_C = BPC * CTX, MC = LAT_C + CTX_C, MTOT = MC * NCH;
constexpr int INC = 7584, NPROJ = 3584, NWIN = 7680, PJLD = 2816, DFF = 2816, VTROWS = 1280;
constexpr float LOG2E = 1.4426950408889634f;
constexpr int LST = 72;
constexpr int TILE_E = 128 * LST;
constexpr int SMEM_BYTES = 4 * TILE_E * 2 + 1024;

struct P {
    const float *x, *c, *ctx, *c_ctx, *w_mod, *b_mod, *g_pre_mix, *g_post_mix, *g_pre_ffn, *g_post_ffn, *w_in, *g_a_q, *g_a_kv,
        *w_a_uq, *w_a_ukv, *sink_b, *rpb_c, *g_d_q, *g_d_k, *w_branch, *w_out, *w_ffn_in, *w_ffn_out;
    float* out;
    bf16_t *WinT, *WuqT, *WukvT, *WbrT, *WoutT, *Wf1T, *Wf2T;
    float* mod; f32x2 *rt16, *rt8; float* hc;
    bf16_t *U, *YC, *PJ, *QA, *KN, *VT, *O, *MB, *ACT;
    unsigned char* G;
    unsigned* barw;
};

typedef __bf16 bf16v2 __attribute__((ext_vector_type(2)));
DEV unsigned pk_bf16(float lo, float hi) { bf16v2 v = __builtin_convertvector((f32x2){lo, hi}, bf16v2); return __builtin_bit_cast(unsigned, v); }
DEV float bf2f(unsigned short v) { return __uint_as_float(((unsigned)v) << 16); }
DEV void store4(bf16_t* p, f32x4 v) { u32x2 w; w.x = pk_bf16(v[0], v[1]); w.y = pk_bf16(v[2], v[3]); *(u32x2*)p = w; }
DEV float fexp2(float x) { return __builtin_amdgcn_exp2f(x); }
DEV float frcp(float x) { return __builtin_amdgcn_rcpf(x); }
DEV float wave_sum(float v) {
    v += __shfl_xor(v, 1); v += __shfl_xor(v, 2); v += __shfl_xor(v, 4); v += __shfl_xor(v, 8); v += __shfl_xor(v, 16); v += __shfl_xor(v, 32); return v;
}
DEV int ltid() { int t = threadIdx.x & 255; asm volatile("" : "+v"(t)); return t; }
DEV int uni(int v) { return __builtin_amdgcn_readfirstlane(v); }
DEV float xmax16(float x) { auto r = __builtin_amdgcn_permlane16_swap(__float_as_uint(x), __float_as_uint(x), false, false); return fmaxf(__uint_as_float(r[0]), __uint_as_float(r[1])); }
DEV float xmax32(float x) { auto r = __builtin_amdgcn_permlane32_swap(__float_as_uint(x), __float_as_uint(x), false, false); return fmaxf(__uint_as_float(r[0]), __uint_as_float(r[1])); }
DEV float xadd16(float x) { auto r = __builtin_amdgcn_permlane16_swap(__float_as_uint(x), __float_as_uint(x), false, false); return __uint_as_float(r[0]) + __uint_as_float(r[1]); }
DEV float xadd32(float x) { auto r = __builtin_amdgcn_permlane32_swap(__float_as_uint(x), __float_as_uint(x), false, false); return __uint_as_float(r[0]) + __uint_as_float(r[1]); }
DEV f32x4 mfma16(bf16x8 a, bf16x8 b, f32x4 c) { return __builtin_amdgcn_mfma_f32_16x16x32_bf16(a, b, c, 0, 0, 0); }

template <int NFT, bool SWAP>
DEV void gemm_mainloop(const bf16_t* __restrict__ A, int lda, const bf16_t* __restrict__ Bt, int ldb, int K, f32x4 (&acc)[NFT][4], bf16_t* sm) {
    const int tid = ltid(), lane = tid & 63, wid = uni(tid >> 6), wm = wid & 1, wn = wid >> 1, fr = lane & 15, fq = lane >> 4;
    unsigned char* sA = (unsigned char*)sm; unsigned char* sB = sA + 2 * 16384;
    const int lrow = tid >> 3, lc8 = (tid & 7) * 8;
    const int wofs = lrow * 128 + (((tid & 7) ^ (lrow & 7)) << 4);
    const bf16_t* ga = A + (size_t)lrow * lda + lc8;
    const bf16_t* gb = Bt + (size_t)lrow * ldb + lc8;
    u32x4 ra[4], rb[NFT];
#pragma unroll
    for (int ft = 0; ft < NFT; ++ft)
#pragma unroll
        for (int tt = 0; tt < 4; ++tt) acc[ft][tt] = (f32x4){0.f, 0.f, 0.f, 0.f};
#pragma unroll
    for (int i = 0; i < 4; ++i) ra[i] = *(const u32x4*)(ga + (size_t)(i * 32) * lda);
#pragma unroll
    for (int i = 0; i < NFT; ++i) rb[i] = *(const u32x4*)(gb + (size_t)(i * 32) * ldb);
#pragma unroll
    for (int i = 0; i < 4; ++i) *(u32x4*)(sA + wofs + i * 4096) = ra[i];
#pragma unroll
    for (int i = 0; i < NFT; ++i) *(u32x4*)(sB + wofs + i * 4096) = rb[i];
    const int nk = K >> 6;
    if (nk > 1) {
#pragma unroll
        for (int i = 0; i < 4; ++i) ra[i] = *(const u32x4*)(ga + (size_t)(i * 32) * lda + 64);
#pragma unroll
        for (int i = 0; i < NFT; ++i) rb[i] = *(const u32x4*)(gb + (size_t)(i * 32) * ldb + 64);
    }
    __syncthreads();
    const int rofs0 = ((0 + fq) ^ (fr & 7)) << 4, rofs1 = ((4 + fq) ^ (fr & 7)) << 4;
    for (int kt = 0; kt < nk; ++kt) {
        const int cur = kt & 1;
        if (kt + 1 < nk) {
            const int nx = cur ^ 1;
#pragma unroll
            for (int i = 0; i < 4; ++i) *(u32x4*)(sA + nx * 16384 + wofs + i * 4096) = ra[i];
#pragma unroll
            for (int i = 0; i < NFT; ++i) *(u32x4*)(sB + nx * 16384 + wofs + i * 4096) = rb[i];
        }
        if (kt + 2 < nk) {
            const int ko = (kt + 2) * 64;
#pragma unroll
            for (int i = 0; i < 4; ++i) ra[i] = *(const u32x4*)(ga + (size_t)(i * 32) * lda + ko);
#pragma unroll
            for (int i = 0; i < NFT; ++i) rb[i] = *(const u32x4*)(gb + (size_t)(i * 32) * ldb + ko);
        }
        __builtin_amdgcn_sched_barrier(0);
        const unsigned char* cA = sA + cur * 16384 + (wm * 64 + fr) * 128;
        const unsigned char* cB = sB + cur * 16384 + (wn * NFT * 16 + fr) * 128;
#pragma unroll
        for (int ks = 0; ks < 2; ++ks) {
            const int ro = ks ? rofs1 : rofs0;
            bf16x8 af[4], wf[NFT];
#pragma unroll
            for (int tt = 0; tt < 4; ++tt) af[tt] = *(const bf16x8*)(cA + tt * 2048 + ro);
#pragma unroll
            for (int ft = 0; ft < NFT; ++ft) wf[ft] = *(const bf16x8*)(cB + ft * 2048 + ro);
#pragma unroll
            for (int ft = 0; ft < NFT; ++ft)
#pragma unroll
                for (int tt = 0; tt < 4; ++tt) acc[ft][tt] = SWAP ? mfma16(af[tt], wf[ft], acc[ft][tt]) : mfma16(wf[ft], af[tt], acc[ft][tt]);
        }
        __syncthreads();
    }
}

DEV bool tile_xcd(int q, int x, int nM, int nN, int& m, int& n) {
    const int j = q >> 5, w = q & 31;
    const int pp = (((j >> 1) * 8 + x) << 1) + (j & 1);
    const int npn = nN >> 2;
    if (pp >= (nM >> 3) * npn) return false;
    const int pm = pp / npn, pn = pp - pm * npn;
    m = pm * 8 + (w & 7); n = pn * 4 + (w >> 3);
    return true;
}
#define TILE_LOOP(nM, nN) const int x_ = bid & 7, spx_ = G >> 3; int mt, nt; for (int q_ = bid >> 3; tile_xcd(q_, x_, nM, nN, mt, nt); q_ += spx_)

DEV int srccol(int mapid, int n) {
    switch (mapid) {
    case 0:
        if (n < 2816) { const int rho = n & 255; n = (n & ~255) + ((rho >> 5) & 3) * 64 + (rho >> 7) * 32 + (rho & 31); }
        if (n < 384) return n;
        if (n < 896) return n - 384 + 416;
        if (n < 1024) return n - 896 + 928;
        if (n < 1536) return n - 1024 + 1184;
        if (n < 2048) return n - 1536 + 1696;
        if (n < 2560) return n - 2048 + 2720;
        if (n < 2688) return n - 2560 + 3232;
        if (n < 2720) return n - 2688 + 384;
        if (n < 2816) return -1;
        if (n < 2944) return n - 2816 + 1056;
        if (n < 3456) return n - 2944 + 2208;
        if (n < 3584) return n - 3456 + 3360;
        return n - 3584 + 3488;
    case 1: if (n < 512) return (n >> 6) * 96 + (n & 63); { const int q = n - 512; return (q >> 5) * 96 + 64 + (q & 31); }
    case 2: if (n < 512) return (n >> 6) * 128 + (n & 63); { const int q = n - 512; return (q >> 6) * 128 + 64 + (q & 63); }
    case 4: { const int pn = n >> 8, bj = (n >> 7) & 1, wc = (n >> 5) & 3, s = (n >> 4) & 1, f = n & 15; return s * DFF + pn * 128 + bj * 64 + wc * 16 + f; }
    default: return n;
    }
}
DEV void conv_tile(const float* __restrict__ src, int lds_, int K, bf16_t* __restrict__ dst, int n0, int k0, int mapid, const float* rowscale, float* st) {
    const int tid = ltid();
    {
        const int n = tid & 63, kk = tid >> 6; const int sc_ = srccol(mapid, n0 + n);
#pragma unroll
        for (int i = 0; i < 16; ++i) {
            const int k = kk * 16 + i;
            float v = sc_ >= 0 ? src[(size_t)(k0 + k) * lds_ + sc_] : 0.f;
            if (rowscale) v *= rowscale[k0 + k];
            st[k * 65 + n] = v;
        }
    }
    __syncthreads();
    {
        const int n = tid >> 2, kq = tid & 3; u32x4 w0, w1;
        const float* s = st + (kq * 16) * 65 + n;
        w0.x = pk_bf16(s[0 * 65], s[1 * 65]); w0.y = pk_bf16(s[2 * 65], s[3 * 65]); w0.z = pk_bf16(s[4 * 65], s[5 * 65]); w0.w = pk_bf16(s[6 * 65], s[7 * 65]);
        w1.x = pk_bf16(s[8 * 65], s[9 * 65]); w1.y = pk_bf16(s[10 * 65], s[11 * 65]); w1.z = pk_bf16(s[12 * 65], s[13 * 65]); w1.w = pk_bf16(s[14 * 65], s[15 * 65]);
        bf16_t* d = dst + (size_t)(n0 + n) * K + k0 + kq * 16;
        *(u32x4*)d = w0; *(u32x4*)(d + 8) = w1;
    }
    __syncthreads();
}
constexpr int CONV_TILES = 4880;
DEV void conv_job(const P& p, int layer, int t, float* st) {
    if (t < 1920) { conv_tile(p.w_in + (size_t)layer * DM * INC, INC, 1024, p.WinT, (t >> 4) * 64, (t & 15) * 64, 0, nullptr, st); return; }
    t -= 1920;
    if (t < 48) { conv_tile(p.w_a_uq + (size_t)layer * 256 * 768, 768, 256, p.WuqT, (t >> 2) * 64, (t & 3) * 64, 1, p.g_a_q + layer * 256, st); return; }
    t -= 48;
    if (t < 32) { conv_tile(p.w_a_ukv + (size_t)layer * 128 * 1024, 1024, 128, p.WukvT, (t >> 1) * 64, (t & 1) * 64, 2, p.g_a_kv + layer * 128, st); return; }
    t -= 32;
    if (t < 512) { conv_tile(p.w_branch + (size_t)layer * 4 * 512 * 1024, 1024, 2048, p.WbrT, (t >> 5) * 64, (t & 31) * 64, 3, nullptr, st); return; }
    t -= 512;
    if (t < 256) { conv_tile(p.w_out + (size_t)layer * 1024 * 1024, 1024, 1024, p.WoutT, (t >> 4) * 64, (t & 15) * 64, 3, nullptr, st); return; }
    t -= 256;
    if (t < 1408) { conv_tile(p.w_ffn_in + (size_t)layer * 1024 * 2 * DFF, 2 * DFF, 1024, p.Wf1T, (t >> 4) * 64, (t & 15) * 64, 4, nullptr, st); return; }
    t -= 1408;
    { const int nt = t / 44, kt = t - nt * 44; conv_tile(p.w_ffn_out + (size_t)layer * DFF * 1024, 1024, DFF, p.Wf2T, nt * 64, kt * 64, 3, nullptr, st); }
}

DEV void mod_item(const P& p, int item, unsigned char* smraw) {
    const int tid = ltid(), lane = tid & 63, wid = uni(tid >> 6);
    float* sc = (float*)smraw;
    const int l = item / 96, cgp = item - l * 96;
    for (int i = tid; i < 17 * 1024; i += 256) {
        const int r = i >> 10, k = i & 1023; const float v = r < 16 ? p.c[r * 1024 + k] : p.c_ctx[k];
        sc[i] = v * frcp(1.f + fexp2(-v * LOG2E));
    }
    __syncthreads();
    float acc[17];
#pragma unroll
    for (int r = 0; r < 17; ++r) acc[r] = 0.f;
    const float* w = p.w_mod + ((size_t)l * 1024 + wid * 256) * 6144 + cgp * 64 + lane;
    for (int k = 0; k < 256; k += 4) {
        const float w0 = w[(size_t)k * 6144], w1 = w[(size_t)(k + 1) * 6144], w2 = w[(size_t)(k + 2) * 6144], w3 = w[(size_t)(k + 3) * 6144];
#pragma unroll
        for (int r = 0; r < 17; ++r) { const f32x4 s = *(const f32x4*)(sc + r * 1024 + wid * 256 + k); acc[r] += s[0] * w0 + s[1] * w1 + s[2] * w2 + s[3] * w3; }
    }
    __syncthreads();
    float* red = (float*)smraw;
#pragma unroll
    for (int r = 0; r < 17; ++r) red[(wid * 17 + r) * 64 + lane] = acc[r];
    __syncthreads();
    for (int i = tid; i < 17 * 64; i += 256) {
        const int r = i >> 6, ci = i & 63;
        const float v = red[(0 * 17 + r) * 64 + ci] + red[(1 * 17 + r) * 64 + ci] + red[(2 * 17 + r) * 64 + ci] + red[(3 * 17 + r) * 64 + ci] + p.b_mod[l * 6144 + cgp * 64 + ci];
        p.mod[((size_t)l * 17 + r) * 6144 + cgp * 64 + ci] = v;
    }
    __syncthreads();
}

DEV void r_phase(const P& p, int mode, int layer, int vb, int VG, int g_lo, int g_hi, bool skipctx = false) {
    const int tid_ = ltid(), lane = tid_ & 63, wid = uni(tid_ >> 6);
    const int nw = VG * 4;
    for (int g = g_lo + vb * 4 + wid; g < g_hi; g += nw) {
        const int ch = g / MC, local = g - ch * MC;
        if (skipctx && local >= LAT_C) continue;
        const float* hin; float* hout; const float* mod;
        if (local < LAT_C) {
            const int idx = ch * LAT_C + local; const int b = idx >> 11;
            hin = (mode == 0 ? p.x : p.out) + (size_t)idx * 1024; hout = p.out + (size_t)idx * 1024; mod = p.mod + ((size_t)layer * 17 + b) * 6144;
        } else {
            const int idx = ch * CTX_C + local - LAT_C;
            hin = (mode == 0 ? p.ctx : p.hc) + (size_t)idx * 1024; hout = p.hc + (size_t)idx * 1024; mod = p.mod + ((size_t)layer * 17 + 16) * 6144;
        }
        f32x4 h[4];
#pragma unroll
        for (int i = 0; i < 4; ++i) h[i] = *(const f32x4*)(hin + (i * 64 + lane) * 4);
        if (mode != 0) {
            f32x4 y[4]; float ss = 0.f;
#pragma unroll
            for (int i = 0; i < 4; ++i) {
                const u32x2 w = *(const u32x2*)((mode == 1 ? p.YC + (size_t)local * 1024 : p.U + (size_t)g * 1024) + (i * 64 + lane) * 4);
                y[i] = (f32x4){__uint_as_float(w.x << 16), __uint_as_float(w.x & 0xffff0000u), __uint_as_float(w.y << 16), __uint_as_float(w.y & 0xffff0000u)};
                ss += y[i][0] * y[i][0] + y[i][1] * y[i][1] + y[i][2] * y[i][2] + y[i][3] * y[i][3];
            }
            ss = wave_sum(ss);
            const float rs = rsqrtf(ss * (1.f / 1024.f) + 1e-6f);
            const float* gp = (mode == 1 ? p.g_post_mix : p.g_post_ffn) + layer * 1024;
            const float* ga = mod + (mode == 1 ? 2048 : 5120);
#pragma unroll
            for (int i = 0; i < 4; ++i) {
                const f32x4 gg = *(const f32x4*)(gp + (i * 64 + lane) * 4), aa = *(const f32x4*)(ga + (i * 64 + lane) * 4);
                h[i] = h[i] + aa * (y[i] * rs * gg);
            }
        }
#pragma unroll
        for (int i = 0; i < 4; ++i) *(f32x4*)(hout + (i * 64 + lane) * 4) = h[i];
        const int nl = (mode == 2) ? layer + 1 : layer;
        if (nl < DEPTH) {
            float ss = 0.f;
#pragma unroll
            for (int i = 0; i < 4; ++i) ss += h[i][0] * h[i][0] + h[i][1] * h[i][1] + h[i][2] * h[i][2] + h[i][3] * h[i][3];
            ss = wave_sum(ss);
            const float rs = rsqrtf(ss * (1.f / 1024.f) + 1e-6f);
            const float* gpre = (mode == 1 ? p.g_pre_ffn : p.g_pre_mix) + nl * 1024;
            const float* modn = (mode == 2) ? mod + 17 * 6144 : mod;
            const float* sh = modn + (mode == 1 ? 3072 : 0);
            const float* sc = modn + (mode == 1 ? 4096 : 1024);
#pragma unroll
            for (int i = 0; i < 4; ++i) {
                const int e = (i * 64 + lane) * 4;
                const f32x4 gg = *(const f32x4*)(gpre + e), s1 = *(const f32x4*)(sc + e), s0 = *(const f32x4*)(sh + e);
                const f32x4 u = h[i] * rs * gg * (s1 + 1.f) + s0;
                store4(p.U + (size_t)g * 1024 + e, u);
            }
        }
    }
}

DEV void gemm1_row(f32x4 (&v)[4], int row, int slab, bool lat, const P& p, int layer, int fq) {
    const bool hnorm = (slab >= 2048 && slab < 2688);
    const bool rope64 = lat && ((slab >= 384 && slab < 1024) || hnorm);
    const bool isq = (slab >= 384 && slab < 896) || (slab >= 1024 && slab < 1536) || (slab >= 2048 && slab < 2560);
    const float sc = isq ? 0.125f * LOG2E : 1.f;
    const bool kr = (slab == 2688);
    const int tok = row & 2047; const int pr = tok >> 6, pc = tok & 63;
    if (hnorm) {
        float ss = 0.f;
#pragma unroll
        for (int ft = 0; ft < 4; ++ft) ss += v[ft][0] * v[ft][0] + v[ft][1] * v[ft][1] + v[ft][2] * v[ft][2] + v[ft][3] * v[ft][3];
        ss += __shfl_xor(ss, 16); ss += __shfl_xor(ss, 32);
        const float rs = rsqrtf(ss * (1.f / 64.f) + 1e-6f);
        const float* g = (slab < 2560 ? p.g_d_q : p.g_d_k) + layer * 64;
#pragma unroll
        for (int ft = 0; ft < 4; ++ft) { const f32x4 gg = *(const f32x4*)(g + ft * 16 + fq * 4); v[ft] = v[ft] * rs * gg; }
    }
    if (rope64) {
#pragma unroll
        for (int j = 0; j < 4; ++j) {
            const int i = fq * 4 + j;
            f32x2 cs = p.rt16[pr * 16 + i]; float a = v[0][j], b = v[1][j];
            v[0][j] = a * cs[0] - b * cs[1]; v[1][j] = b * cs[0] + a * cs[1];
            cs = p.rt16[pc * 16 + i]; a = v[2][j]; b = v[3][j];
            v[2][j] = a * cs[0] - b * cs[1]; v[3][j] = b * cs[0] + a * cs[1];
        }
    }
    if (kr && lat) {
#pragma unroll
        for (int ft = 0; ft < 2; ++ft) {
            const int pos = ft == 0 ? pr : pc;
#pragma unroll
            for (int j = 0; j < 4; ++j) {
                const int i = (fq & 1) * 4 + j; const f32x2 cs = p.rt8[pos * 8 + i];
                const float xv = v[ft][j]; const float o = __shfl_xor(xv, 32);
                v[ft][j] = fq < 2 ? xv * cs[0] - o * cs[1] : xv * cs[0] + o * cs[1];
            }
        }
    }
    bf16_t* dst = p.PJ + (size_t)row * PJLD + slab + fq * 4;
    store4(dst, v[0] * sc); store4(dst + 16, v[1] * sc);
    if (!kr) { store4(dst + 32, v[2] * sc); store4(dst + 48, v[3] * sc); }
}
DEV void stage2_tile(const P& p, int mt, int j, unsigned char* smraw) {
    bf16_t* sm = (bf16_t*)smraw; float* s_rs = (float*)(smraw + 73728);
    const int tid = ltid(), lane = tid & 63, wid = uni(tid >> 6), wm = wid & 1, wn = wid >> 1, fr = lane & 15, fq = lane >> 4;
    const int m0 = mt * 128; const bool isq = j < 6; const bool lat = m0 < LAT_C;
    const int K = isq ? 256 : 128; const int acol = isq ? 0 : 256;
    {
        const int r = tid >> 1, hf = tid & 1; const int n = K >> 1;
        const bf16_t* src = p.PJ + (size_t)(m0 + r) * PJLD + acol + hf * n; float ss = 0.f;
        for (int i = 0; i < n; i += 8) {
            const u32x4 w = *(const u32x4*)(src + i);
#pragma unroll
            for (int q = 0; q < 4; ++q) { const float a = __uint_as_float(w[q] << 16), b = __uint_as_float(w[q] & 0xffff0000u); ss += a * a + b * b; }
        }
        ss += __shfl_xor(ss, 1);
        if (hf == 0) s_rs[r] = rsqrtf(ss / (float)K + 1e-6f);
    }
    __syncthreads();
    f32x4 acc[4][4];
    const bf16_t* A = p.PJ + (size_t)m0 * PJLD + acol;
    if (isq) {
        const int n0 = j * 128;
        gemm_mainloop<4, false>(A, PJLD, p.WuqT + (size_t)n0 * 256, 256, 256, acc, sm);
        const int slab = n0 + wn * 64; const float qs = 0.10206207261596577f * LOG2E;
#pragma unroll
        for (int tt = 0; tt < 4; ++tt) {
            const int lr = wm * 64 + tt * 16 + fr; const int row = m0 + lr; const float rs = s_rs[lr] * qs;
            const int tok = row & 2047; const int pr = tok >> 6, pc = tok & 63;
            f32x4 v[4] = {acc[0][tt], acc[1][tt], acc[2][tt], acc[3][tt]};
            if (slab >= 512 && lat) {
#pragma unroll
                for (int ft = 0; ft < 4; ++ft) {
                    const int pos = (ft & 1) == 0 ? pr : pc;
#pragma unroll
                    for (int jj = 0; jj < 4; ++jj) {
                        const int i = (fq & 1) * 4 + jj; const f32x2 cs = p.rt8[pos * 8 + i];
                        const float xv = v[ft][jj]; const float o = __shfl_xor(xv, 32);
                        v[ft][jj] = fq < 2 ? xv * cs[0] - o * cs[1] : xv * cs[0] + o * cs[1];
                    }
                }
            }
            bf16_t* dst = p.QA + (size_t)row * 768 + slab + fq * 4;
#pragma unroll
            for (int ft = 0; ft < 4; ++ft) store4(dst + ft * 16, v[ft] * rs);
        }
    } else {
        const int n0 = (j - 6) * 128;
        if (n0 < 512) {
            gemm_mainloop<4, false>(A, PJLD, p.WukvT + (size_t)n0 * 128, 128, 128, acc, sm);
#pragma unroll
            for (int tt = 0; tt < 4; ++tt) {
                const int lr = wm * 64 + tt * 16 + fr; const float rs = s_rs[lr];
                bf16_t* dst = p.KN + (size_t)(m0 + lr) * 512 + n0 + wn * 64 + fq * 4;
#pragma unroll
                for (int ft = 0; ft < 4; ++ft) store4(dst + ft * 16, acc[ft][tt] * rs);
            }
        } else {
            gemm_mainloop<4, true>(A, PJLD, p.WukvT + (size_t)n0 * 128, 128, 128, acc, sm);
            const int vrow0 = 768 + (n0 - 512) + wn * 64;
#pragma unroll
            for (int tt = 0; tt < 4; ++tt) {
                const int lr = wm * 64 + tt * 16 + fq * 4;
                const f32x4 rs = *(const f32x4*)(s_rs + lr);
                const int lp = wm * 64 + (tt >> 1) * 32 + fq * 8 + (tt & 1) * 4;
#pragma unroll
                for (int ft = 0; ft < 4; ++ft) store4(p.VT + (size_t)(vrow0 + ft * 16 + fr) * MC + m0 + lp, acc[ft][tt] * rs);
            }
        }
    }
    __syncthreads();
}

template <int MODE>
DEV void attn_item(const P& p, int layer, int item, bool ctxq, unsigned char* smraw) {
    constexpr bool GQA = (MODE == 1 || MODE == 3);
    constexpr int DQK = (MODE == 0) ? 96 : 64, NKS = DQK / 32;
    constexpr int KRB = (MODE == 0) ? 256 : 128, KM = (MODE == 0) ? 15 : 7;
    constexpr int KT_B = 64 * KRB, VT_B = 64 * 128;
    unsigned char* Ks = smraw; unsigned char* Vs = smraw + 32768; float* bias_s = (float*)(smraw + 49152);
    const int tid = ltid(), lane = tid & 63, wid = uni(tid >> 6), fr = lane & 15, fq = lane >> 4;
    const int nqt = ctxq ? (GQA ? 8 : 2) : (GQA ? 64 : 16);
    const int nh = GQA ? 2 : 8;
    const int qt = item % nqt, hh = (item / nqt) % nh, lb = item / (nqt * nh);
    const int head = GQA ? hh * 4 + wid : hh;
    const int tok0 = GQA ? qt * 32 : qt * 128 + wid * 32;
    const int qrow0 = (ctxq ? LAT_C + lb * CTX : lb * SEQ) + tok0;
    bf16x8 qf[2][NKS];
#pragma unroll
    for (int q = 0; q < 2; ++q) {
        const int row = qrow0 + q * 16 + fr;
        if (MODE == 0) {
            qf[q][0] = *(const bf16x8*)(p.QA + (size_t)row * 768 + head * 64 + fq * 8);
            qf[q][1] = *(const bf16x8*)(p.QA + (size_t)row * 768 + head * 64 + 32 + fq * 8);
            qf[q][NKS - 1] = *(const bf16x8*)(p.QA + (size_t)row * 768 + 512 + head * 32 + fq * 8);
        } else {
            const int qoff = MODE == 1 ? 384 : (MODE == 2 ? 1024 : 2048);
#pragma unroll
            for (int ks = 0; ks < NKS; ++ks) qf[q][ks] = *(const bf16x8*)(p.PJ + (size_t)row * PJLD + qoff + head * 64 + ks * 32 + fq * 8);
        }
    }
    const int koff = MODE == 1 ? 896 + hh * 64 : (MODE == 2 ? 1536 + hh * 64 : 2560 + hh * 64);
    const int vrow0 = MODE == 0 ? 768 + hh * 64 : (MODE == 1 ? hh * 64 : (MODE == 2 ? 128 + hh * 64 : 640 + hh * 64));
    int ktlo = 0, nlat = 0;
    if (!ctxq) {
        if (MODE == 0 || MODE == 3) { ktlo = 0; nlat = 32; }
        else if (MODE == 1) { const int q0 = qt * 32; const int lo = max(0, q0 - 128), hi = min(SEQ - 1, q0 + 159); ktlo = lo >> 6; nlat = (hi >> 6) - ktlo + 1; }
        else { const int r0a = min(max(2 * qt - 4, 0), 24), r0b = min(max(2 * qt + 1 - 4, 0), 24); ktlo = r0a; nlat = r0b + 8 - r0a; }
    }
    const int nt = 4 + nlat;
    const int ntf = ctxq ? 4 : ((MODE == 0 || MODE == 3) ? 36 : (MODE == 1 ? 9 : 13));
    if (MODE == 2 && !ctxq) { for (int i = tid; i < 465; i += 256) bias_s[i] = p.rpb_c[(layer * 8 + hh) * 465 + i] * LOG2E; }

    u32x4 rk[NKS], rv[2];
    auto tile_krow = [&](int it) { it = min(it, nt - 1); return it < 4 ? LAT_C + lb * CTX + it * 64 : lb * SEQ + (ktlo + it - 4) * 64; };
    auto gload = [&](int it) {
        const int krow = tile_krow(it);
#pragma unroll
        for (int i = 0; i < NKS; ++i) {
            const int id = tid + i * 256;
            if (MODE == 0) {
                const int key = id / 12, c = id - key * 12;
                const bf16_t* src = c < 8 ? p.KN + (size_t)(krow + key) * 512 + hh * 64 + c * 8 : p.PJ + (size_t)(krow + key) * PJLD + 2688 + (c - 8) * 8;
                rk[i] = *(const u32x4*)src;
            } else {
                const int key = id >> 3, c = id & 7;
                rk[i] = *(const u32x4*)(p.PJ + (size_t)(krow + key) * PJLD + koff + c * 8);
            }
        }
#pragma unroll
        for (int i = 0; i < 2; ++i) { const int id = tid + i * 256; const int dv = id >> 3, c = id & 7; rv[i] = *(const u32x4*)(p.VT + (size_t)(vrow0 + dv) * MC + krow + c * 8); }
    };
    auto lstore = [&](int buf) {
#pragma unroll
        for (int i = 0; i < NKS; ++i) {
            const int id = tid + i * 256; int key, c;
            if (MODE == 0) { key = id / 12; c = id - key * 12; } else { key = id >> 3; c = id & 7; }
            *(u32x4*)(Ks + buf * KT_B + key * KRB + ((c ^ (key & KM)) << 4)) = rk[i];
        }
#pragma unroll
        for (int i = 0; i < 2; ++i) { const int id = tid + i * 256; const int dv = id >> 3, c = id & 7; *(u32x4*)(Vs + buf * VT_B + dv * 128 + ((c ^ (dv & 7)) << 4)) = rv[i]; }
    };

    f32x4 o[4][2], lo[2], negm4[2]; float mref[2];
    const bf16x8 ones8 = __builtin_bit_cast(bf16x8, (u32x4){0x3F803F80u, 0x3F803F80u, 0x3F803F80u, 0x3F803F80u});
#pragma unroll
    for (int q = 0; q < 2; ++q) { mref[q] = 0.f; lo[q] = (f32x4){0.f, 0.f, 0.f, 0.f}; negm4[q] = (f32x4){0.f, 0.f, 0.f, 0.f};
#pragma unroll
        for (int d = 0; d < 4; ++d) o[d][q] = (f32x4){0.f, 0.f, 0.f, 0.f}; }

    gload(0); lstore(0); gload(1); __syncthreads();
    for (int it = 0; it < ntf; ++it) {
        const int cur = it & 1;
        if (it + 1 < ntf) lstore(cur ^ 1);
        if (it + 2 < ntf) gload(it + 2);
        __builtin_amdgcn_sched_barrier(0);
        const int kt = ktlo + it - 4;
        bool active = it < nt;
        int r = 0, r0 = 0;
        if (MODE == 2 && !ctxq && it >= 4) { r = 2 * qt + (wid >> 1); r0 = min(max(r - 4, 0), 24); active = active && (kt >= r0 && kt < r0 + 8); }
        if (active) {
            f32x4 s[4][2];
            const unsigned char* kb = Ks + cur * KT_B + fr * KRB;
            bf16x8 kf[4][NKS];
#pragma unroll
            for (int k4 = 0; k4 < 4; ++k4)
#pragma unroll
                for (int ks = 0; ks < NKS; ++ks) kf[k4][ks] = *(const bf16x8*)(kb + k4 * 16 * KRB + (((ks * 4 + fq) ^ (fr & KM)) << 4));
            __builtin_amdgcn_sched_barrier(0);
#pragma unroll
            for (int k4 = 0; k4 < 4; ++k4) {
#pragma unroll
                for (int q = 0; q < 2; ++q) s[k4][q] = mfma16(kf[k4][0], qf[q][0], negm4[q]);
#pragma unroll
                for (int ks = 1; ks < NKS; ++ks)
#pragma unroll
                    for (int q = 0; q < 2; ++q) s[k4][q] = mfma16(kf[k4][ks], qf[q][ks], s[k4][q]);
            }
            const unsigned char* vb = Vs + cur * VT_B + fr * 128;
            bf16x8 vf[4][2];
#pragma unroll
            for (int d = 0; d < 4; ++d)
#pragma unroll
                for (int kb2 = 0; kb2 < 2; ++kb2) vf[d][kb2] = *(const bf16x8*)(vb + d * 16 * 128 + (((kb2 * 4 + fq) ^ (fr & 7)) << 4));
            __builtin_amdgcn_sched_barrier(0);
            if (!ctxq && it >= 4) {
                if (MODE == 1) {
#pragma unroll
                    for (int q = 0; q < 2; ++q) {
                        const int qpos = tok0 + q * 16 + fr;
#pragma unroll
                        for (int k4 = 0; k4 < 4; ++k4)
#pragma unroll
                            for (int j = 0; j < 4; ++j) { const int d = qpos - (kt * 64 + k4 * 16 + fq * 4 + j); if (d > 128 || d < -128) s[k4][q][j] = -1e30f; }
                    }
                }
                if (MODE == 2) {
#pragma unroll
                    for (int q = 0; q < 2; ++q) {
                        const int qc = (wid & 1) * 32 + q * 16 + fr; const int c0 = min(max(qc - 8, 0), 48);
                        const int bbase = (kt - r + 7) * 31 + 15 - qc;
#pragma unroll
                        for (int k4 = 0; k4 < 4; ++k4)
#pragma unroll
                            for (int j = 0; j < 4; ++j) {
                                const int kc = k4 * 16 + fq * 4 + j; const bool ok = (kc >= c0 && kc < c0 + 16);
                                const float bv = bias_s[ok ? bbase + kc : 0];
                                s[k4][q][j] = ok ? s[k4][q][j] + bv : -1e30f;
                            }
                    }
                }
            }
            bf16x8 pf[2][2];
#pragma unroll
            for (int q = 0; q < 2; ++q) {
                float mx = -1e30f;
#pragma unroll
                for (int k4 = 0; k4 < 4; ++k4) mx = fmaxf(mx, fmaxf(fmaxf(s[k4][q][0], s[k4][q][1]), fmaxf(s[k4][q][2], s[k4][q][3])));
                mx = xmax32(xmax16(mx));
                const bool need = (it == 0) || (mx > 8.f);
                if (__builtin_amdgcn_ballot_w64(need) != 0ull) {
                    const float delta = need ? mx : 0.f;
                    mref[q] += delta; negm4[q] = negm4[q] - delta;
#pragma unroll
                    for (int k4 = 0; k4 < 4; ++k4) s[k4][q] = s[k4][q] - delta;
                    const float alpha = fexp2(-delta);
                    lo[q] = lo[q] * alpha;
#pragma unroll
                    for (int d = 0; d < 4; ++d) o[d][q] = o[d][q] * alpha;
                }
#pragma unroll
                for (int k4 = 0; k4 < 4; ++k4)
#pragma unroll
                    for (int j = 0; j < 4; ++j) s[k4][q][j] = fexp2(s[k4][q][j]);
#pragma unroll
                for (int kb2 = 0; kb2 < 2; ++kb2) {
                    u32x4 w; w.x = pk_bf16(s[2 * kb2][q][0], s[2 * kb2][q][1]); w.y = pk_bf16(s[2 * kb2][q][2], s[2 * kb2][q][3]);
                    w.z = pk_bf16(s[2 * kb2 + 1][q][0], s[2 * kb2 + 1][q][1]); w.w = pk_bf16(s[2 * kb2 + 1][q][2], s[2 * kb2 + 1][q][3]);
                    pf[q][kb2] = __builtin_bit_cast(bf16x8, w);
                }
            }
#pragma unroll
            for (int d = 0; d < 4; ++d)
#pragma unroll
                for (int kb2 = 0; kb2 < 2; ++kb2)
#pragma unroll
                    for (int q = 0; q < 2; ++q) o[d][q] = mfma16(vf[d][kb2], pf[q][kb2], o[d][q]);
#pragma unroll
            for (int kb2 = 0; kb2 < 2; ++kb2)
#pragma unroll
                for (int q = 0; q < 2; ++q) lo[q] = mfma16(ones8, pf[q][kb2], lo[q]);
        }
        __syncthreads();
    }
#pragma unroll
    for (int q = 0; q < 2; ++q) {
        float l = lo[q][0];
        if (MODE == 1) l += fexp2(p.sink_b[layer * 8 + head] * LOG2E - mref[q]);
        const float inv = 1.f / l;
        bf16_t* dst = p.O + (size_t)(qrow0 + q * 16 + fr) * 2048 + MODE * 512 + head * 64 + fq * 4;
#pragma unroll
        for (int d = 0; d < 4; ++d) store4(dst + d * 16, o[d][q] * inv);
    }
}


namespace pg8 {
#define PG8_LAS __attribute__((address_space(3)))
constexpr int BM = 256, BK = 64, HALF = 128, HTB = HALF * BK * 2  , STAGE_BYTES = 8 * HTB, NXCD = 8, WGM = 8;

__host__ __device__ __forceinline__ int lds_byte(int r, int c) { const int st = (r >> 4) * 2 + (c >> 5), rr = r & 15, cc = c & 31, ob = rr * 64 + cc * 2; return st * 1024 + (ob ^ (((ob >> 9) & 1) << 5)); }
__host__ __device__ __forceinline__ void stage_rc(int b, int& R, int& C) { const int st = b / 1024, sb = b % 1024, swz = sb ^ (((sb >> 9) & 1) << 5); R = (st >> 1) * 16 + swz / 64; C = (st & 1) * 32 + (swz % 64) / 2; }
__host__ __device__ __forceinline__ int perm32(int rho) { const int n = rho >> 4, i = rho & 15; return 8 * (i >> 2) + 4 * n + (i & 3); }

struct Unit { int pm, pn; };
struct Gemm { const bf16_t* A; const bf16_t* Bt; int M, N, K; };

template <class Epi, class Sched, bool ALIGN_EPI = false, bool SP2 = false, bool SWAPMMA = false>
__device__ __forceinline__ void gemm_phase(PG8_LAS unsigned char* lds, const Gemm g, const Sched& S, const Epi& E) {
    int tid = threadIdx.x; asm volatile("" : "+v"(tid));
    const int wid = __builtin_amdgcn_readfirstlane(tid >> 6), lane = tid & 63, wr = wid >> 2, wc = wid & 3, fr = lane & 15, fq = lane >> 4;
    const int K = g.K, nt = K / BK;
    unsigned voffA[2], voffB[2];
#pragma unroll
    for (int i = 0; i < 2; ++i) { int R, C; stage_rc(tid * 16 + i * 8192, R, C); const int Rb = Epi::PERM ? ((R & ~31) + perm32(R & 31)) : R;
        voffA[i] = (unsigned)(R * K + C) * 2u; voffB[i] = (unsigned)(Rb * K + C) * 2u; }
    const size_t kstep = (size_t)(BK * 2);
    const size_t hstep = (size_t)HALF * K * 2;
    const size_t tstep = 2 * hstep;
    const unsigned ldsw = (unsigned)wid * 1024u;
    const int aoff = lds_byte(wr * 64 + fr, fq * 8), boff = lds_byte(wc * 32 + fr, fq * 8);
#define PG8_SA(b, h) (((b) * 2 + (h)) * HTB)
#define PG8_SB(b, h) ((4 + (b) * 2 + (h)) * HTB)
#define PG8_STAGE(bufoff, gbase, voff) do { _Pragma("unroll") for (int _i = 0; _i < 2; ++_i) \
        __builtin_amdgcn_global_load_lds((const unsigned*)((const char*)(gbase) + (voff)[_i]), (PG8_LAS unsigned*)(lds + (bufoff) + ldsw + _i * 8192), 16, 0, 0); } while (0)
#define PG8_LDA(dst, b, h) do { _Pragma("unroll") for (int m = 0; m < 4; ++m) _Pragma("unroll") for (int k = 0; k < 2; ++k) dst[m][k] = *(const PG8_LAS bf16x8*)(lds + PG8_SA(b, h) + aoff + m * 2048 + k * 1024); } while (0)
#define PG8_LDB(dst, b, h) do { _Pragma("unroll") for (int n = 0; n < 2; ++n) _Pragma("unroll") for (int k = 0; k < 2; ++k) dst[n][k] = *(const PG8_LAS bf16x8*)(lds + PG8_SB(b, h) + boff + n * 2048 + k * 1024); } while (0)
#define PG8_MMA(ai, bj, At, Bt) do { __builtin_amdgcn_s_setprio(1); _Pragma("unroll") for (int m = 0; m < 4; ++m) _Pragma("unroll") for (int n = 0; n < 2; ++n) _Pragma("unroll") for (int k = 0; k < 2; ++k) \
        acc[ai][bj][m][n] = SWAPMMA ? __builtin_amdgcn_mfma_f32_16x16x32_bf16(At[m][k], Bt[n][k], acc[ai][bj][m][n], 0, 0, 0) : __builtin_amdgcn_mfma_f32_16x16x32_bf16(Bt[n][k], At[m][k], acc[ai][bj][m][n], 0, 0, 0); __builtin_amdgcn_s_setprio(0); } while (0)
#define PG8_WAIT_V(n) asm volatile("s_waitcnt vmcnt(" #n ")" ::: "memory")
#define PG8_WAIT_L(n) asm volatile("s_waitcnt lgkmcnt(" #n ")" ::: "memory")
#define PG8_BAR __builtin_amdgcn_s_barrier()
#define PG8_SCHED __builtin_amdgcn_sched_barrier(0)
    Unit cur, nxt; int ui = 0;
    if (!S.next(0, cur)) return;
    f32x4 acc[2][2][4][2];
#pragma unroll
    for (int a = 0; a < 2; ++a)
#pragma unroll
        for (int b = 0; b < 2; ++b)
#pragma unroll
            for (int m = 0; m < 4; ++m)
#pragma unroll
                for (int n = 0; n < 2; ++n) acc[a][b][m][n] = (f32x4){0.f, 0.f, 0.f, 0.f};
    bf16x8 At[4][2], B0[2][2], B1[2][2];
    const char* cA = (const char*)g.A + (size_t)cur.pm * tstep; const char* cB = (const char*)g.Bt + (size_t)cur.pn * tstep;
    S.a_ready(cur);
    if constexpr (SP2) {
        PG8_STAGE(PG8_SB(0, 0), cB, voffB); PG8_STAGE(PG8_SB(0, 1), cB + hstep, voffB); PG8_STAGE(PG8_SA(0, 0), cA, voffA); PG8_STAGE(PG8_SA(0, 1), cA + hstep, voffA);
        if (wr == 1) PG8_BAR;
        PG8_WAIT_V(2); PG8_BAR;
        PG8_STAGE(PG8_SB(1, 0), cB + kstep, voffB); PG8_STAGE(PG8_SA(1, 0), cA + kstep, voffA); PG8_STAGE(PG8_SB(1, 1), cB + hstep + kstep, voffB);
        PG8_WAIT_V(6); PG8_BAR;
    } else {
        PG8_STAGE(PG8_SB(0, 0), cB, voffB); PG8_STAGE(PG8_SA(0, 0), cA, voffA); PG8_STAGE(PG8_SB(0, 1), cB + hstep, voffB); PG8_STAGE(PG8_SA(0, 1), cA + hstep, voffA);
        if (wr == 1) PG8_BAR;
        PG8_WAIT_V(4); PG8_BAR;
        PG8_STAGE(PG8_SB(1, 0), cB + kstep, voffB); PG8_STAGE(PG8_SA(1, 0), cA + kstep, voffA); PG8_STAGE(PG8_SB(1, 1), cB + hstep + kstep, voffB);
        PG8_WAIT_V(6); PG8_BAR;
    }
    for (;;) {
        const bool has_next = S.next(ui + 1, nxt);
        const char* nA = has_next ? (const char*)g.A + (size_t)nxt.pm * tstep : cA; const char* nB = has_next ? (const char*)g.Bt + (size_t)nxt.pn * tstep : cB;
        for (int t = 0; t < nt; t += 2) {
            if constexpr (Epi::HAS_MID) { if (t != 0 && (t & 7) == 0) { E.mid(acc, cur, t >> 3, wid, lane); asm volatile("s_waitcnt vmcnt(0)" ::: "memory"); } }
            const bool last = (t == nt - 2);
            const char* a1 = cA + (size_t)(t + 1) * kstep;
            const char* a2 = last ? nA : cA + (size_t)(t + 2) * kstep; const char* b2 = last ? nB : cB + (size_t)(t + 2) * kstep;
            const char* a3 = a2 + kstep; const char* b3 = b2 + kstep;
            if (last && has_next) S.a_ready(nxt);
            if constexpr (SP2) {
            PG8_LDB(B0, 0, 0); PG8_LDB(B1, 0, 1); PG8_SCHED; PG8_LDA(At, 0, 0); PG8_STAGE(PG8_SA(1, 1), a1 + hstep, voffA);
            PG8_WAIT_V(8); PG8_WAIT_L(0); PG8_BAR; PG8_MMA(0, 0, At, B0); PG8_MMA(0, 1, At, B1); PG8_BAR; PG8_SCHED;
            PG8_LDA(At, 0, 1); PG8_STAGE(PG8_SB(0, 0), b2, voffB); PG8_STAGE(PG8_SB(0, 1), b2 + hstep, voffB); PG8_STAGE(PG8_SA(0, 0), a2, voffA);
            PG8_WAIT_V(8); PG8_WAIT_L(0); PG8_BAR; PG8_MMA(1, 0, At, B0); PG8_MMA(1, 1, At, B1); PG8_BAR; PG8_SCHED;
            PG8_LDB(B0, 1, 0); PG8_LDB(B1, 1, 1); PG8_SCHED; PG8_LDA(At, 1, 0); PG8_STAGE(PG8_SA(0, 1), a2 + hstep, voffA);
            PG8_WAIT_V(8); PG8_WAIT_L(0); PG8_BAR; PG8_MMA(0, 0, At, B0); PG8_MMA(0, 1, At, B1); PG8_BAR; PG8_SCHED;
            PG8_LDA(At, 1, 1); PG8_STAGE(PG8_SB(1, 0), b3, voffB); PG8_STAGE(PG8_SB(1, 1), b3 + hstep, voffB); PG8_STAGE(PG8_SA(1, 0), a3, voffA);
            PG8_WAIT_V(8); PG8_WAIT_L(0); PG8_BAR; PG8_MMA(1, 0, At, B0); PG8_MMA(1, 1, At, B1); PG8_BAR; PG8_SCHED;
            } else {
            PG8_LDB(B0, 0, 0); PG8_SCHED; PG8_LDA(At, 0, 0); PG8_STAGE(PG8_SA(1, 1), a1 + hstep, voffA);
            PG8_WAIT_L(8); PG8_BAR; PG8_WAIT_L(0); PG8_MMA(0, 0, At, B0); PG8_BAR; PG8_SCHED;
            PG8_LDB(B1, 0, 1); PG8_STAGE(PG8_SB(0, 0), b2, voffB);
            PG8_BAR; PG8_WAIT_L(0); PG8_MMA(0, 1, At, B1); PG8_BAR;
            PG8_LDA(At, 0, 1); PG8_STAGE(PG8_SA(0, 0), a2, voffA);
            PG8_BAR; PG8_WAIT_L(0); PG8_MMA(1, 0, At, B0); PG8_BAR; PG8_SCHED;
            PG8_STAGE(PG8_SB(0, 1), b2 + hstep, voffB);
            PG8_WAIT_V(6); PG8_BAR; PG8_MMA(1, 1, At, B1); PG8_BAR;
            PG8_LDB(B0, 1, 0); PG8_SCHED; PG8_LDA(At, 1, 0); PG8_STAGE(PG8_SA(0, 1), a2 + hstep, voffA);
            PG8_WAIT_L(8); PG8_BAR; PG8_WAIT_L(0); PG8_MMA(0, 0, At, B0); PG8_BAR; PG8_SCHED;
            PG8_LDB(B1, 1, 1); PG8_STAGE(PG8_SB(1, 0), b3, voffB);
            PG8_BAR; PG8_WAIT_L(0); PG8_MMA(0, 1, At, B1); PG8_BAR;
            PG8_LDA(At, 1, 1); PG8_STAGE(PG8_SA(1, 0), a3, voffA);
            PG8_BAR; PG8_WAIT_L(0); PG8_MMA(1, 0, At, B0); PG8_BAR; PG8_SCHED;
            PG8_STAGE(PG8_SB(1, 1), b3 + hstep, voffB);
            PG8_WAIT_V(6); PG8_BAR; PG8_MMA(1, 1, At, B1); PG8_BAR;
            }
        }
        if constexpr (ALIGN_EPI) { if (wr == 0) PG8_BAR; }
        if constexpr (!Epi::AFTER_DRAIN) { E(acc, cur, wr, wc, fr, fq); S.done(cur); }
        if (!has_next) break;
#pragma unroll
        for (int a = 0; a < 2; ++a)
#pragma unroll
            for (int b = 0; b < 2; ++b)
#pragma unroll
                for (int m = 0; m < 4; ++m)
#pragma unroll
                    for (int n = 0; n < 2; ++n) acc[a][b][m][n] = (f32x4){0.f, 0.f, 0.f, 0.f};
        cur = nxt; cA = nA; cB = nB; ++ui;
        if constexpr (ALIGN_EPI) { if (wr == 1) PG8_BAR; }
    }
    PG8_WAIT_V(0);
    if constexpr (!ALIGN_EPI) { if (wr == 0) PG8_BAR; }
    PG8_BAR;
    if constexpr (Epi::AFTER_DRAIN) { E.fused(acc, cur, wr, wc, fr, fq, lds, wid, lane); S.done(cur); }
#undef PG8_SA
#undef PG8_SB
#undef PG8_STAGE
#undef PG8_LDA
#undef PG8_LDB
#undef PG8_MMA
#undef PG8_WAIT_V
#undef PG8_WAIT_L
#undef PG8_BAR
#undef PG8_SCHED
}
}

struct XSched {
    int nN, nunits, G, c, skipctx;
    DEV bool next(int i, pg8::Unit& u) const {
        const int L = i * G + c; if (L >= nunits) return false;
        const int U = ((nunits & 7) == 0 && (G & 7) == 0) ? (L & 7) * (nunits >> 3) + (L >> 3) : L;
        u.pm = U / nN; u.pn = U - u.pm * nN;
        if (skipctx) u.pm = (u.pm >> 6) * 72 + (u.pm & 63);
        return true;
    }
    DEV void a_ready(const pg8::Unit&) const {}
    DEV void done(const pg8::Unit&) const {}
};
struct EpiStoreT {
    static constexpr bool PERM = false, AFTER_DRAIN = false, HAS_MID = false;
    bf16_t* out; int ld; int row_off;
    DEV void operator()(const f32x4 (&acc)[2][2][4][2], const pg8::Unit& u, int wr, int wc, int fr, int fq) const {
#pragma unroll
        for (int ai = 0; ai < 2; ++ai)
#pragma unroll
            for (int m = 0; m < 4; ++m) {
                bf16_t* d = out + (size_t)(row_off + u.pm * 256 + ai * 128 + wr * 64 + m * 16 + fr) * ld + u.pn * 256 + wc * 32 + fq * 4;
#pragma unroll
                for (int bj = 0; bj < 2; ++bj)
#pragma unroll
                    for (int n = 0; n < 2; ++n) store4(d + bj * 128 + n * 16, acc[ai][bj][m][n]);
            }
    }
};
struct EpiSwiglu {
    static constexpr bool PERM = false, AFTER_DRAIN = false, HAS_MID = false;
    bf16_t* act;
    DEV void operator()(const f32x4 (&acc)[2][2][4][2], const pg8::Unit& u, int wr, int wc, int fr, int fq) const {
#pragma unroll
        for (int ai = 0; ai < 2; ++ai)
#pragma unroll
            for (int m = 0; m < 4; ++m) {
                bf16_t* d = act + (size_t)(u.pm * 256 + ai * 128 + wr * 64 + m * 16 + fr) * DFF + u.pn * 128 + wc * 16 + fq * 4;
#pragma unroll
                for (int bj = 0; bj < 2; ++bj) {
                    const f32x4 a = acc[ai][bj][m][0], b = acc[ai][bj][m][1]; f32x4 r;
#pragma unroll
                    for (int j = 0; j < 4; ++j) r[j] = a[j] * frcp(1.f + fexp2(-a[j] * LOG2E)) * b[j];
                    store4(d + bj * 64, r);
                }
            }
    }
};
struct EpiVT {
    static constexpr bool PERM = false, AFTER_DRAIN = false, HAS_MID = false;
    bf16_t* vt;
    DEV void operator()(const f32x4 (&acc)[2][2][4][2], const pg8::Unit& u, int wr, int wc, int fr, int fq) const {
#pragma unroll
        for (int bj = 0; bj < 2; ++bj)
#pragma unroll
            for (int n = 0; n < 2; ++n) {
                bf16_t* d = vt + (size_t)(u.pn * 256 + bj * 128 + wc * 32 + n * 16 + fr) * MC + u.pm * 256 + wr * 64 + fq * 8;
#pragma unroll
                for (int ai = 0; ai < 2; ++ai)
#pragma unroll
                    for (int m = 0; m < 4; ++m) store4(d + ai * 128 + (m >> 1) * 32 + (m & 1) * 4, acc[ai][bj][m][n]);
            }
    }
};
DEV size_t gate_index(int pm, int pn4, int wave, int r8, int lane) { return ((((size_t)pm * 16 + pn4) * 8 + wave) * 8 + r8) * 64 + lane; }
struct EpiGate {
    static constexpr bool PERM = false, AFTER_DRAIN = false, HAS_MID = false;
    u32x4* g8;
    DEV void operator()(const f32x4 (&acc)[2][2][4][2], const pg8::Unit& u, int wr, int wc, int fr, int fq) const {
        const int lane = fq * 16 + fr, wave = wr * 4 + wc;
#pragma unroll
        for (int ai = 0; ai < 2; ++ai)
#pragma unroll
            for (int m = 0; m < 4; ++m) {
                u32x4 w;
#pragma unroll
                for (int bj = 0; bj < 2; ++bj)
#pragma unroll
                    for (int n = 0; n < 2; ++n) {
                        const f32x4 a = acc[ai][bj][m][n]; unsigned x = 0;
#pragma unroll
                        for (int j = 0; j < 4; ++j) { const float s = frcp(1.f + fexp2(-a[j] * LOG2E)); x |= max(1u, (unsigned)(s * 255.f + 0.5f)) << (8 * j); }
                        w[bj * 2 + n] = x;
                    }
                g8[gate_index(u.pm, u.pn, wave, ai * 4 + m, lane)] = w;
            }
    }
};
struct EpiMerge {
    static constexpr bool PERM = false, AFTER_DRAIN = false, HAS_MID = true;
    bf16_t* out; const u32x4* g8;
    DEV void mid(f32x4 (&acc)[2][2][4][2], const pg8::Unit& u, int n, int wave, int lane) const {
#pragma unroll
        for (int ai = 0; ai < 2; ++ai)
#pragma unroll
            for (int m = 0; m < 4; ++m) {
                const u32x4 a = g8[gate_index(u.pm, (n - 1) * 4 + u.pn, wave, ai * 4 + m, lane)], b = g8[gate_index(u.pm, n * 4 + u.pn, wave, ai * 4 + m, lane)];
#pragma unroll
                for (int bj = 0; bj < 2; ++bj)
#pragma unroll
                    for (int nn = 0; nn < 2; ++nn) {
                        const unsigned x = a[bj * 2 + nn], y = b[bj * 2 + nn]; f32x4 r;
#pragma unroll
                        for (int j = 0; j < 4; ++j) r[j] = (float)((x >> (8 * j)) & 255u) * frcp((float)((y >> (8 * j)) & 255u));
                        acc[ai][bj][m][nn] = acc[ai][bj][m][nn] * r;
                    }
            }
    }
    DEV void operator()(const f32x4 (&acc)[2][2][4][2], const pg8::Unit& u, int wr, int wc, int fr, int fq) const {
        const int lane = fq * 16 + fr, wave = wr * 4 + wc;
#pragma unroll
        for (int ai = 0; ai < 2; ++ai)
#pragma unroll
            for (int m = 0; m < 4; ++m) {
                const u32x4 a = g8[gate_index(u.pm, 12 + u.pn, wave, ai * 4 + m, lane)];
                bf16_t* d = out + (size_t)(u.pm * 256 + ai * 128 + wr * 64 + m * 16 + fr) * 1024 + u.pn * 256 + wc * 32 + fq * 4;
#pragma unroll
                for (int bj = 0; bj < 2; ++bj)
#pragma unroll
                    for (int nn = 0; nn < 2; ++nn) {
                        const unsigned x = a[bj * 2 + nn]; f32x4 r;
#pragma unroll
                        for (int j = 0; j < 4; ++j) r[j] = (float)((x >> (8 * j)) & 255u) * (1.f / 255.f);
                        store4(d + bj * 128 + nn * 16, acc[ai][bj][m][nn] * r);
                    }
            }
    }
};
struct EpiGemm1 {
    static constexpr bool PERM = false, AFTER_DRAIN = false, HAS_MID = false;
    const P* pp; int layer;
    DEV void operator()(const f32x4 (&acc)[2][2][4][2], const pg8::Unit& u, int wr, int wc, int fr, int fq) const {
        const int slab = u.pn * 256 + wc * 64; const bool lat = u.pm * 256 < LAT_C;
        if (slab >= 2752) return;
#pragma unroll
        for (int ai = 0; ai < 2; ++ai)
#pragma unroll
            for (int m = 0; m < 4; ++m) {
                f32x4 v[4] = {acc[ai][0][m][0], acc[ai][0][m][1], acc[ai][1][m][0], acc[ai][1][m][1]};
                gemm1_row(v, u.pm * 256 + ai * 128 + wr * 64 + m * 16 + fr, slab, lat, *pp, layer, fq);
            }
    }
};

#define LAS __attribute__((address_space(3)))
#define XB_TMO      128
#define XB_XCNT(j)  (256  + 64 * (j))
#define XB_XSUB(j)  (1280 + 64 * (j))
#define XB_XGEN(j)  (2304 + 64 * (j))
#define XB_TOP      3328
#define XB_TOPGEN   3392
#define XCD_BAR_WORDS 3456
#define XB_SPIN_CAP (1u << 18)

__device__ __forceinline__ unsigned xb_ld(unsigned* p)              { return __hip_atomic_load(p, __ATOMIC_RELAXED, __HIP_MEMORY_SCOPE_AGENT); }
__device__ __forceinline__ unsigned xb_add(unsigned* p, unsigned v) { return __hip_atomic_fetch_add(p, v, __ATOMIC_RELAXED, __HIP_MEMORY_SCOPE_AGENT); }
__device__ __forceinline__ unsigned xb_xcc_id() { return (unsigned)__builtin_amdgcn_s_getreg((3 << 11) | 20) & 0xFu; }
#define XB_SPIN(cond, bar) do { unsigned _sp = 0; while (cond) { __builtin_amdgcn_s_sleep(1); \
    if ((++_sp & 255u) == 0u) { if (xb_ld(&(bar)[XB_TMO])) break; if (_sp > XB_SPIN_CAP) { atomicAdd(&(bar)[XB_TMO], 1u); break; } } } } while (0)

struct XcdBarrier {
    unsigned* bar; unsigned x;
    volatile LAS unsigned* st;
};

__device__ __forceinline__ XcdBarrier xcd_barrier_post(unsigned* bar, volatile LAS unsigned* st) {
    XcdBarrier b; b.bar = bar; b.x = xb_xcc_id(); b.st = st;
    if (threadIdx.x == 0) (void)xb_add(&bar[XB_XCNT(b.x)], 1u);
    return b;
}
__device__ __forceinline__ void xcd_barrier_complete(unsigned* bar, unsigned x, unsigned& nloc, unsigned& nx) {
    const unsigned G = gridDim.x * gridDim.y * gridDim.z;
    unsigned sum, cnt, mine, sp = 0u;
    for (;;) {
        sum = 0u; cnt = 0u; mine = 0u;
#pragma unroll
        for (unsigned j = 0; j < 16; ++j) { const unsigned c = xb_ld(&bar[XB_XCNT(j)]); sum += c; cnt += (c > 0u) ? 1u : 0u; mine = (j == x) ? c : mine; }
        if (sum == G) break;
        __builtin_amdgcn_s_sleep(1);
        if ((++sp & 255u) == 0u) { if (xb_ld(&bar[XB_TMO])) break; if (sp > XB_SPIN_CAP) { atomicAdd(&bar[XB_TMO], 1u); break; } }
    }
    nloc = mine > 0u ? mine : 1u; nx = cnt > 0u ? cnt : 1u;
}

__device__ __forceinline__ void xcd_barrier(const XcdBarrier& b) {
    asm volatile("s_waitcnt vmcnt(0)" ::: "memory");
    __syncthreads();
    if (threadIdx.x == 0) {
        unsigned* bar = b.bar;
        __builtin_amdgcn_s_waitcnt(0);
        unsigned nloc = b.st[0], nx = b.st[1];
        if (nloc == 0u) { xcd_barrier_complete(bar, b.x, nloc, nx); b.st[0] = nloc; b.st[1] = nx; }
        const unsigned old = xb_add(&bar[XB_XSUB(b.x)], 1u);
        const unsigned gen = old / nloc;
        if (old + 1u == (gen + 1u) * nloc) {
            __builtin_amdgcn_fence(__ATOMIC_RELEASE, "agent");
            asm volatile("s_waitcnt vmcnt(0)" ::: "memory");
            const unsigned og = xb_add(&bar[XB_TOP], 1u);
            const unsigned tg = og / nx;
            if (og + 1u == (tg + 1u) * nx) xb_add(&bar[XB_TOPGEN], 1u);
            else XB_SPIN(xb_ld(&bar[XB_TOPGEN]) == tg, bar);
            __builtin_amdgcn_fence(__ATOMIC_ACQUIRE, "agent");
            xb_add(&bar[XB_XGEN(b.x)], 1u);
            asm volatile("s_waitcnt vmcnt(0)" ::: "memory");
        } else {
            XB_SPIN(xb_ld(&bar[XB_XGEN(b.x)]) == gen, bar);
            __builtin_amdgcn_fence(__ATOMIC_ACQUIRE, "agent");
            asm volatile("s_waitcnt vmcnt(0)" ::: "memory");
        }
    }
    __syncthreads();
}

typedef const __attribute__((address_space(4))) P* PP;
#define FRESH_P PP q_ = pp0; asm volatile("" : "+s"(q_)); const P& p = *(const P*)q_;
#define FRESH_BG int bidL = bid, GL = G; asm volatile("" : "+s"(bidL), "+s"(GL));
constexpr int DYN_LDS = 2 * SMEM_BYTES + 64;
__global__ void __launch_bounds__(512, 2) mega(P pv_) {
    cg::grid_group grid = cg::this_grid();
    PP pp0 = (PP)__builtin_amdgcn_kernarg_segment_ptr();
    extern __shared__ __attribute__((aligned(16))) unsigned char lds_dyn[];
    const int half = __builtin_amdgcn_readfirstlane((int)threadIdx.x >> 8);
    unsigned char* smraw = lds_dyn + half * SMEM_BYTES;
    bf16_t* sm = (bf16_t*)smraw;
    PG8_LAS unsigned char* ldsL = (PG8_LAS unsigned char*)lds_dyn;
    const int bid = blockIdx.x, G = gridDim.x, vb = bid * 2 + half, VG = G * 2, tid = threadIdx.x & 255;
    {
        FRESH_P
        volatile LAS unsigned* xst = (volatile LAS unsigned*)(ldsL + 2 * SMEM_BYTES);
        if (threadIdx.x == 0) { xst[0] = 0u; xst[1] = 0u; }
        __syncthreads();
        const XcdBarrier xb0 = xcd_barrier_post(p.barw, xst);
        if (threadIdx.x == 0) xst[2] = xb0.x;
        __syncthreads();
    }
#define GBAR() do { FRESH_P XcdBarrier b_; b_.bar = p.barw; b_.st = (volatile LAS unsigned*)(ldsL + 2 * SMEM_BYTES); b_.x = b_.st[2]; xcd_barrier(b_); } while (0)

    { FRESH_P
    for (int i = vb * 256 + tid; i < 64 * 16 + 64 * 8; i += VG * 256) {
        if (i < 1024) { const int pos = i >> 4, k = i & 15; const float inv = fexp2(-(float)k * (13.287712379549449f / 16.f)); const float a = (float)pos * inv; p.rt16[i] = (f32x2){__cosf(a), __sinf(a)}; }
        else { const int q = i - 1024; const int pos = q >> 3, k = q & 7; const float inv = fexp2(-(float)k * (13.287712379549449f / 8.f)); const float a = (float)pos * inv; p.rt8[q] = (f32x2){__cosf(a), __sinf(a)}; }
    }
    for (int t = vb; t < 384 + CONV_TILES; t += VG) { if (t < 384) mod_item(p, t, smraw); else conv_job(p, 0, t - 384, (float*)smraw); }
    }
    GBAR();
    { FRESH_P r_phase(p, 0, 0, vb, VG, 0, MTOT); }
    GBAR();

    for (int layer = 0; layer < DEPTH; ++layer) {
        const bool lastL = (layer == DEPTH - 1);
        for (int ch = 0; ch < NCH; ++ch) {
            { FRESH_P FRESH_BG
              const bf16_t* A = p.U + (size_t)ch * MC * 1024;
              { pg8::Gemm g{A, p.WinT, MC, 2816, 1024}; XSched S{11, 792, GL, bidL}; EpiGemm1 E{&p, layer};
                pg8::gemm_phase<EpiGemm1, XSched, true, true, false>(ldsL, g, S, E); }
              { pg8::Gemm g{A, p.WinT + (size_t)2816 * 1024, MC, 768, 1024}; XSched S{3, 216, GL, (bidL + GL - (792 % GL)) % GL}; EpiVT E{p.VT};
                pg8::gemm_phase<EpiVT, XSched, true, true, true>(ldsL, g, S, E); }
              { pg8::Gemm g{A, p.WinT + (size_t)NPROJ * 1024, MC, 4096, 1024}; XSched S{16, lastL ? 1024 : 1152, GL, (bidL + GL - (1008 % GL)) % GL}; EpiGate E{(u32x4*)p.G};
                pg8::gemm_phase<EpiGate, XSched, true, true, false>(ldsL, g, S, E); }
            }
            GBAR();
            { FRESH_P for (int t = vb; t < (lastL ? 4064 : 4448); t += VG) {
                if (t < 1024) attn_item<2>(p, layer, t, false, smraw);
                else if (t < 2048) attn_item<1>(p, layer, t - 1024, false, smraw);
                else if (t < 4064) { const int q = t - 2048; stage2_tile(p, q / 14, q % 14, smraw); }
                else if (t < 4192) attn_item<1>(p, layer, t - 4064, true, smraw);
                else if (t < 4320) attn_item<2>(p, layer, t - 4192, true, smraw);
                else attn_item<3>(p, layer, t - 4320, true, smraw);
            } }
            GBAR();
            { FRESH_P for (int t = vb; t < (lastL ? 2048 : 2176); t += VG) {
                if (t < 1024) attn_item<0>(p, layer, t, false, smraw);
                else if (t < 2048) attn_item<3>(p, layer, t - 1024, false, smraw);
                else attn_item<0>(p, layer, t - 2048, true, smraw);
            } }
            GBAR();
            { FRESH_P FRESH_BG pg8::Gemm g{p.O, p.WbrT, MC, 1024, 2048}; XSched S{4, lastL ? 256 : 288, GL, bidL}; EpiMerge E{p.MB, (const u32x4*)p.G};
              pg8::gemm_phase<EpiMerge, XSched, true, true, false>(ldsL, g, S, E); }
            GBAR();
            { FRESH_P FRESH_BG pg8::Gemm g{p.MB, p.WoutT, MC, 1024, 1024}; XSched S{4, lastL ? 256 : 288, GL, bidL}; EpiStoreT E{p.YC, 1024, 0};
              pg8::gemm_phase<EpiStoreT, XSched, true, true, false>(ldsL, g, S, E); }
            GBAR();
            { FRESH_P r_phase(p, 1, layer, vb, VG, ch * MC, ch * MC + (lastL ? LAT_C : MC)); }
            if (ch + 1 == NCH) GBAR();
        }
        { FRESH_P FRESH_BG pg8::Gemm g{p.U, p.Wf1T, MTOT, 2 * DFF, 1024}; XSched S{22, lastL ? 2816 : 3168, GL, bidL, lastL ? 1 : 0}; EpiSwiglu E{p.ACT};
          pg8::gemm_phase<EpiSwiglu, XSched, true, true, false>(ldsL, g, S, E); }
        GBAR();
        { FRESH_P FRESH_BG pg8::Gemm g{p.ACT, p.Wf2T, MTOT, 1024, DFF}; XSched S{4, lastL ? 512 : 576, GL, bidL, lastL ? 1 : 0}; EpiStoreT E{p.U, 1024, 0};
          pg8::gemm_phase<EpiStoreT, XSched, true, true, false>(ldsL, g, S, E); }
        GBAR();
        { FRESH_P r_phase(p, 2, layer, vb, VG, 0, MTOT, lastL);
          if (layer + 1 < DEPTH) { for (int t = vb; t < CONV_TILES; t += VG) conv_job(p, layer + 1, t, (float*)smraw); } }
        GBAR();
    }
}

extern "C" void kernel_launch(void* const* d_in, const int* in_sizes, int n_in, void* d_out, int out_size, void* d_ws, size_t ws_size, hipStream_t stream) {
    static int grid_blocks = 0;
    if (!grid_blocks) {
        int dev = 0, cus = 0, per_cu = 0;
        (void)hipGetDevice(&dev);
        (void)hipDeviceGetAttribute(&cus, hipDeviceAttributeMultiprocessorCount, dev);
        if (hipFuncSetAttribute((const void*)mega, hipFuncAttributeMaxDynamicSharedMemorySize, DYN_LDS) != hipSuccess) fprintf(stderr, "hipFuncSetAttribute failed\n");
        (void)hipOccupancyMaxActiveBlocksPerMultiprocessor(&per_cu, mega, 512, DYN_LDS);
        grid_blocks = cus;
    }
    P p{};
    const float** f = (const float**)&p;
    for (int i = 0; i < 23; ++i) f[i] = (const float*)d_in[i];
    p.out = (float*)d_out;
    unsigned char* w = (unsigned char*)d_ws; size_t off = 0;
    auto take = [&](size_t bytes) { void* r = w + off; off += (bytes + 255) & ~(size_t)255; return r; };
    p.WinT = (bf16_t*)take((size_t)NWIN * 1024 * 2);
    p.WuqT = (bf16_t*)take((size_t)768 * 256 * 2);
    p.WukvT = (bf16_t*)take((size_t)1024 * 128 * 2);
    p.WbrT = (bf16_t*)take((size_t)4 * 1024 * 512 * 2);
    p.WoutT = (bf16_t*)take((size_t)1024 * 1024 * 2);
    p.Wf1T = (bf16_t*)take((size_t)2 * DFF * 1024 * 2);
    p.Wf2T = (bf16_t*)take((size_t)1024 * DFF * 2);
    p.mod = (float*)take((size_t)DEPTH * 17 * 6144 * 4);
    p.rt16 = (f32x2*)take(64 * 16 * 8);
    p.rt8 = (f32x2*)take(64 * 8 * 8);
    p.hc = (float*)take((size_t)NBATCH * CTX * 1024 * 4);
    p.U = (bf16_t*)take((size_t)MTOT * 1024 * 2);
    p.G = (unsigned char*)take((size_t)MC * 4096);
    p.barw = (unsigned*)take((size_t)XCD_BAR_WORDS * 4);
    unsigned char* R = (unsigned char*)take(0);
    p.PJ = (bf16_t*)take((size_t)MC * PJLD * 2);
    p.QA = (bf16_t*)take((size_t)MC * 768 * 2);
    p.KN = (bf16_t*)take((size_t)MC * 512 * 2);
    p.VT = (bf16_t*)take((size_t)VTROWS * MC * 2);
    p.O = (bf16_t*)take((size_t)MC * 2048 * 2);
    p.YC = p.O;
    p.MB = p.PJ;
    p.ACT = (bf16_t*)R;
    if (off > ws_size) { fprintf(stderr, "workspace too small: need %zu have %zu\n", off, ws_size); return; }
    (void)hipMemsetAsync(p.barw, 0, (size_t)XCD_BAR_WORDS * 4, stream);
    void* args[] = {&p};
    hipError_t e = hipLaunchCooperativeKernel((void*)mega, dim3(grid_blocks), dim3(512), args, DYN_LDS, stream);
    if (e != hipSuccess) fprintf(stderr, "cooperative launch failed: %s (grid %d)\n", hipGetErrorString(e), grid_blocks);
}
```

```cpp
#include <hip/hip_runtime.h>
#include <hip/hip_cooperative_groups.h>
#include <cstdio>
#include <cstdint>
namespace cg = cooperative_groups;

typedef unsigned short bf16_t;
typedef short bf16x8 __attribute__((ext_vector_type(8)));
typedef short bf16x4 __attribute__((ext_vector_type(4)));
typedef float f32x4 __attribute__((ext_vector_type(4)));
typedef float f32x2 __attribute__((ext_vector_type(2)));
typedef unsigned u32x2 __attribute__((ext_vector_type(2)));
typedef unsigned u32x4 __attribute__((ext_vector_type(4)));
#define DEV __device__ __forceinline__

constexpr int DM = 1024, NBATCH = 16, SEQ = 2048, CTX = 256, DEPTH = 4;
constexpr int NCH = 2, BPC = NBATCH / NCH, LAT_C = BPC * SEQ, CTX_C = BPC * CTX, MC = LAT_C + CTX_C, MTOT = MC * NCH;
constexpr int INC = 7584, NPROJ = 3584, NWIN = 7680, PJLD = 2816, DFF = 2816, VTROWS = 1280;
constexpr float LOG2E = 1.4426950408889634f;
constexpr int LST = 72;
constexpr int TILE_E = 128 * LST;
constexpr int SMEM_BYTES = 4 * TILE_E * 2 + 1024;

struct P {
    const float *x, *c, *ctx, *c_ctx, *w_mod, *b_mod, *g_pre_mix, *g_post_mix, *g_pre_ffn, *g_post_ffn, *w_in, *g_a_q, *g_a_kv,
        *w_a_uq, *w_a_ukv, *sink_b, *rpb_c, *g_d_q, *g_d_k, *w_branch, *w_out, *w_ffn_in, *w_ffn_out;
    float* out;
    bf16_t *WinT, *WuqT, *WukvT, *WbrT, *WoutT, *Wf1T, *Wf2T;
    float* mod; f32x2 *rt16, *rt8; float* hc;
    bf16_t *U, *YC, *PJ, *QA, *KN, *VT, *O, *MB, *ACT;
    unsigned char* G;
    unsigned* barw;
};

typedef __bf16 bf16v2 __attribute__((ext_vector_type(2)));
DEV unsigned pk_bf16(float lo, float hi) { bf16v2 v = __builtin_convertvector((f32x2){lo, hi}, bf16v2); return __builtin_bit_cast(unsigned, v); }
DEV float bf2f(unsigned short v) { return __uint_as_float(((unsigned)v) << 16); }
DEV void store4(bf16_t* p, f32x4 v) { u32x2 w; w.x = pk_bf16(v[0], v[1]); w.y = pk_bf16(v[2], v[3]); *(u32x2*)p = w; }
DEV float fexp2(float x) { return __builtin_amdgcn_exp2f(x); }
DEV float frcp(float x) { return __builtin_amdgcn_rcpf(x); }
DEV float wave_sum(float v) {
    v += __shfl_xor(v, 1); v += __shfl_xor(v, 2); v += __shfl_xor(v, 4); v += __shfl_xor(v, 8); v += __shfl_xor(v, 16); v += __shfl_xor(v, 32); return v;
}
DEV int ltid() { int t = threadIdx.x & 255; asm volatile("" : "+v"(t)); return t; }
DEV int uni(int v) { return __builtin_amdgcn_readfirstlane(v); }
DEV float xmax16(float x) { auto r = __builtin_amdgcn_permlane16_swap(__float_as_uint(x), __float_as_uint(x), false, false); return fmaxf(__uint_as_float(r[0]), __uint_as_float(r[1])); }
DEV float xmax32(float x) { auto r = __builtin_amdgcn_permlane32_swap(__float_as_uint(x), __float_as_uint(x), false, false); return fmaxf(__uint_as_float(r[0]), __uint_as_float(r[1])); }
DEV float xadd16(float x) { auto r = __builtin_amdgcn_permlane16_swap(__float_as_uint(x), __float_as_uint(x), false, false); return __uint_as_float(r[0]) + __uint_as_float(r[1]); }
DEV float xadd32(float x) { auto r = __builtin_amdgcn_permlane32_swap(__float_as_uint(x), __float_as_uint(x), false, false); return __uint_as_float(r[0]) + __uint_as_float(r[1]); }
DEV f32x4 mfma16(bf16x8 a, bf16x8 b, f32x4 c) { return __builtin_amdgcn_mfma_f32_16x16x32_bf16(a, b, c, 0, 0, 0); }

template <int NFT, bool SWAP>
DEV void gemm_mainloop(const bf16_t* __restrict__ A, int lda, const bf16_t* __restrict__ Bt, int ldb, int K, f32x4 (&acc)[NFT][4], bf16_t* sm) {
    const int tid = ltid(), lane = tid & 63, wid = uni(tid >> 6), wm = wid & 1, wn = wid >> 1, fr = lane & 15, fq = lane >> 4;
    unsigned char* sA = (unsigned char*)sm; unsigned char* sB = sA + 2 * 16384;
    const int lrow = tid >> 3, lc8 = (tid & 7) * 8;
    const int wofs = lrow * 128 + (((tid & 7) ^ (lrow & 7)) << 4);
    const bf16_t* ga = A + (size_t)lrow * lda + lc8;
    const bf16_t* gb = Bt + (size_t)lrow * ldb + lc8;
    u32x4 ra[4], rb[NFT];
#pragma unroll
    for (int ft = 0; ft < NFT; ++ft)
#pragma unroll
        for (int tt = 0; tt < 4; ++tt) acc[ft][tt] = (f32x4){0.f, 0.f, 0.f, 0.f};
#pragma unroll
    for (int i = 0; i < 4; ++i) ra[i] = *(const u32x4*)(ga + (size_t)(i * 32) * lda);
#pragma unroll
    for (int i = 0; i < NFT; ++i) rb[i] = *(const u32x4*)(gb + (size_t)(i * 32) * ldb);
#pragma unroll
    for (int i = 0; i < 4; ++i) *(u32x4*)(sA + wofs + i * 4096) = ra[i];
#pragma unroll
    for (int i = 0; i < NFT; ++i) *(u32x4*)(sB + wofs + i * 4096) = rb[i];
    const int nk = K >> 6;
    if (nk > 1) {
#pragma unroll
        for (int i = 0; i < 4; ++i) ra[i] = *(const u32x4*)(ga + (size_t)(i * 32) * lda + 64);
#pragma unroll
        for (int i = 0; i < NFT; ++i) rb[i] = *(const u32x4*)(gb + (size_t)(i * 32) * ldb + 64);
    }
    __syncthreads();
    const int rofs0 = ((0 + fq) ^ (fr & 7)) << 4, rofs1 = ((4 + fq) ^ (fr & 7)) << 4;
    for (int kt = 0; kt < nk; ++kt) {
        const int cur = kt & 1;
        if (kt + 1 < nk) {
            const int nx = cur ^ 1;
#pragma unroll
            for (int i = 0; i < 4; ++i) *(u32x4*)(sA + nx * 16384 + wofs + i * 4096) = ra[i];
#pragma unroll
            for (int i = 0; i < NFT; ++i) *(u32x4*)(sB + nx * 16384 + wofs + i * 4096) = rb[i];
        }
        if (kt + 2 < nk) {
            const int ko = (kt + 2) * 64;
#pragma unroll
            for (int i = 0; i < 4; ++i) ra[i] = *(const u32x4*)(ga + (size_t)(i * 32) * lda + ko);
#pragma unroll
            for (int i = 0; i < NFT; ++i) rb[i] = *(const u32x4*)(gb + (size_t)(i * 32) * ldb + ko);
        }
        __builtin_amdgcn_sched_barrier(0);
        const unsigned char* cA = sA + cur * 16384 + (wm * 64 + fr) * 128;
        const unsigned char* cB = sB + cur * 16384 + (wn * NFT * 16 + fr) * 128;
#pragma unroll
        for (int ks = 0; ks < 2; ++ks) {
            const int ro = ks ? rofs1 : rofs0;
            bf16x8 af[4], wf[NFT];
#pragma unroll
            for (int tt = 0; tt < 4; ++tt) af[tt] = *(const bf16x8*)(cA + tt * 2048 + ro);
#pragma unroll
            for (int ft = 0; ft < NFT; ++ft) wf[ft] = *(const bf16x8*)(cB + ft * 2048 + ro);
#pragma unroll
            for (int ft = 0; ft < NFT; ++ft)
#pragma unroll
                for (int tt = 0; tt < 4; ++tt) acc[ft][tt] = SWAP ? mfma16(af[tt], wf[ft], acc[ft][tt]) : mfma16(wf[ft], af[tt], acc[ft][tt]);
        }
        __syncthreads();
    }
}

DEV bool tile_xcd(int q, int x, int nM, int nN, int& m, int& n) {
    const int j = q >> 5, w = q & 31;
    const int pp = (((j >> 1) * 8 + x) << 1) + (j & 1);
    const int npn = nN >> 2;
    if (pp >= (nM >> 3) * npn) return false;
    const int pm = pp / npn, pn = pp - pm * npn;
    m = pm * 8 + (w & 7); n = pn * 4 + (w >> 3);
    return true;
}
#define TILE_LOOP(nM, nN) const int x_ = bid & 7, spx_ = G >> 3; int mt, nt; for (int q_ = bid >> 3; tile_xcd(q_, x_, nM, nN, mt, nt); q_ += spx_)

DEV int srccol(int mapid, int n) {
    switch (mapid) {
    case 0:
        if (n < 2816) { const int rho = n & 255; n = (n & ~255) + ((rho >> 5) & 3) * 64 + (rho >> 7) * 32 + (rho & 31); }
        if (n < 384) return n;
        if (n < 896) return n - 384 + 416;
        if (n < 1024) return n - 896 + 928;
        if (n < 1536) return n - 1024 + 1184;
        if (n < 2048) return n - 1536 + 1696;
        if (n < 2560) return n - 2048 + 2720;
        if (n < 2688) return n - 2560 + 3232;
        if (n < 2720) return n - 2688 + 384;
        if (n < 2816) return -1;
        if (n < 2944) return n - 2816 + 1056;
        if (n < 3456) return n - 2944 + 2208;
        if (n < 3584) return n - 3456 + 3360;
        return n - 3584 + 3488;
    case 1: if (n < 512) return (n >> 6) * 96 + (n & 63); { const int q = n - 512; return (q >> 5) * 96 + 64 + (q & 31); }
    case 2: if (n < 512) return (n >> 6) * 128 + (n & 63); { const int q = n - 512; return (q >> 6) * 128 + 64 + (q & 63); }
    case 4: { const int pn = n >> 8, bj = (n >> 7) & 1, wc = (n >> 5) & 3, s = (n >> 4) & 1, f = n & 15; return s * DFF + pn * 128 + bj * 64 + wc * 16 + f; }
    default: return n;
    }
}
DEV void conv_tile(const float* __restrict__ src, int lds_, int K, bf16_t* __restrict__ dst, int n0, int k0, int mapid, const float* rowscale, float* st) {
    const int tid = ltid();
    {
        const int n = tid & 63, kk = tid >> 6; const int sc_ = srccol(mapid, n0 + n);
#pragma unroll
        for (int i = 0; i < 16; ++i) {
            const int k = kk * 16 + i;
            float v = sc_ >= 0 ? src[(size_t)(k0 + k) * lds_ + sc_] : 0.f;
            if (rowscale) v *= rowscale[k0 + k];
            st[k * 65 + n] = v;
        }
    }
    __syncthreads();
    {
        const int n = tid >> 2, kq = tid & 3; u32x4 w0, w1;
        const float* s = st + (kq * 16) * 65 + n;
        w0.x = pk_bf16(s[0 * 65], s[1 * 65]); w0.y = pk_bf16(s[2 * 65], s[3 * 65]); w0.z = pk_bf16(s[4 * 65], s[5 * 65]); w0.w = pk_bf16(s[6 * 65], s[7 * 65]);
        w1.x = pk_bf16(s[8 * 65], s[9 * 65]); w1.y = pk_bf16(s[10 * 65], s[11 * 65]); w1.z = pk_bf16(s[12 * 65], s[13 * 65]); w1.w = pk_bf16(s[14 * 65], s[15 * 65]);
        bf16_t* d = dst + (size_t)(n0 + n) * K + k0 + kq * 16;
        *(u32x4*)d = w0; *(u32x4*)(d + 8) = w1;
    }
    __syncthreads();
}
constexpr int CONV_TILES = 4880;
DEV void conv_job(const P& p, int layer, int t, float* st) {
    if (t < 1920) { conv_tile(p.w_in + (size_t)layer * DM * INC, INC, 1024, p.WinT, (t >> 4) * 64, (t & 15) * 64, 0, nullptr, st); return; }
    t -= 1920;
    if (t < 48) { conv_tile(p.w_a_uq + (size_t)layer * 256 * 768, 768, 256, p.WuqT, (t >> 2) * 64, (t & 3) * 64, 1, p.g_a_q + layer * 256, st); return; }
    t -= 48;
    if (t < 32) { conv_tile(p.w_a_ukv + (size_t)layer * 128 * 1024, 1024, 128, p.WukvT, (t >> 1) * 64, (t & 1) * 64, 2, p.g_a_kv + layer * 128, st); return; }
    t -= 32;
    if (t < 512) { conv_tile(p.w_branch + (size_t)layer * 4 * 512 * 1024, 1024, 2048, p.WbrT, (t >> 5) * 64, (t & 31) * 64, 3, nullptr, st); return; }
    t -= 512;
    if (t < 256) { conv_tile(p.w_out + (size_t)layer * 1024 * 1024, 1024, 1024, p.WoutT, (t >> 4) * 64, (t & 15) * 64, 3, nullptr, st); return; }
    t -= 256;
    if (t < 1408) { conv_tile(p.w_ffn_in + (size_t)layer * 1024 * 2 * DFF, 2 * DFF, 1024, p.Wf1T, (t >> 4) * 64, (t & 15) * 64, 4, nullptr, st); return; }
    t -= 1408;
    { const int nt = t / 44, kt = t - nt * 44; conv_tile(p.w_ffn_out + (size_t)layer * DFF * 1024, 1024, DFF, p.Wf2T, nt * 64, kt * 64, 3, nullptr, st); }
}

DEV void mod_item(const P& p, int item, unsigned char* smraw) {
    const int tid = ltid(), lane = tid & 63, wid = uni(tid >> 6);
    float* sc = (float*)smraw;
    const int l = item / 96, cgp = item - l * 96;
    for (int i = tid; i < 17 * 1024; i += 256) {
        const int r = i >> 10, k = i & 1023; const float v = r < 16 ? p.c[r * 1024 + k] : p.c_ctx[k];
        sc[i] = v * frcp(1.f + fexp2(-v * LOG2E));
    }
    __syncthreads();
    float acc[17];
#pragma unroll
    for (int r = 0; r < 17; ++r) acc[r] = 0.f;
    const float* w = p.w_mod + ((size_t)l * 1024 + wid * 256) * 6144 + cgp * 64 + lane;
    for (int k = 0; k < 256; k += 4) {
        const float w0 = w[(size_t)k * 6144], w1 = w[(size_t)(k + 1) * 6144], w2 = w[(size_t)(k + 2) * 6144], w3 = w[(size_t)(k + 3) * 6144];
#pragma unroll
        for (int r = 0; r < 17; ++r) { const f32x4 s = *(const f32x4*)(sc + r * 1024 + wid * 256 + k); acc[r] += s[0] * w0 + s[1] * w1 + s[2] * w2 + s[3] * w3; }
    }
    __syncthreads();
    float* red = (float*)smraw;
#pragma unroll
    for (int r = 0; r < 17; ++r) red[(wid * 17 + r) * 64 + lane] = acc[r];
    __syncthreads();
    for (int i = tid; i < 17 * 64; i += 256) {
        const int r = i >> 6, ci = i & 63;
        const float v = red[(0 * 17 + r) * 64 + ci] + red[(1 * 17 + r) * 64 + ci] + red[(2 * 17 + r) * 64 + ci] + red[(3 * 17 + r) * 64 + ci] + p.b_mod[l * 6144 + cgp * 64 + ci];
        p.mod[((size_t)l * 17 + r) * 6144 + cgp * 64 + ci] = v;
    }
    __syncthreads();
}

DEV void r_phase(const P& p, int mode, int layer, int vb, int VG, int g_lo, int g_hi, bool skipctx = false) {
    const int tid_ = ltid(), lane = tid_ & 63, wid = uni(tid_ >> 6);
    const int nw = VG * 4;
    for (int g = g_lo + vb * 4 + wid; g < g_hi; g += nw) {
        const int ch = g / MC, local = g - ch * MC;
        if (skipctx && local >= LAT_C) continue;
        const float* hin; float* hout; const float* mod;
        if (local < LAT_C) {
            const int idx = ch * LAT_C + local; const int b = idx >> 11;
            hin = (mode == 0 ? p.x : p.out) + (size_t)idx * 1024; hout = p.out + (size_t)idx * 1024; mod = p.mod + ((size_t)layer * 17 + b) * 6144;
        } else {
            const int idx = ch * CTX_C + local - LAT_C;
            hin = (mode == 0 ? p.ctx : p.hc) + (size_t)idx * 1024; hout = p.hc + (size_t)idx * 1024; mod = p.mod + ((size_t)layer * 17 + 16) * 6144;
        }
        f32x4 h[4];
#pragma unroll
        for (int i = 0; i < 4; ++i) h[i] = *(const f32x4*)(hin + (i * 64 + lane) * 4);
        if (mode != 0) {
            f32x4 y[4]; float ss = 0.f;
#pragma unroll
            for (int i = 0; i < 4; ++i) {
                const u32x2 w = *(const u32x2*)((mode == 1 ? p.YC + (size_t)local * 1024 : p.U + (size_t)g * 1024) + (i * 64 + lane) * 4);
                y[i] = (f32x4){__uint_as_float(w.x << 16), __uint_as_float(w.x & 0xffff0000u), __uint_as_float(w.y << 16), __uint_as_float(w.y & 0xffff0000u)};
                ss += y[i][0] * y[i][0] + y[i][1] * y[i][1] + y[i][2] * y[i][2] + y[i][3] * y[i][3];
            }
            ss = wave_sum(ss);
            const float rs = rsqrtf(ss * (1.f / 1024.f) + 1e-6f);
            const float* gp = (mode == 1 ? p.g_post_mix : p.g_post_ffn) + layer * 1024;
            const float* ga = mod + (mode == 1 ? 2048 : 5120);
#pragma unroll
            for (int i = 0; i < 4; ++i) {
                const f32x4 gg = *(const f32x4*)(gp + (i * 64 + lane) * 4), aa = *(const f32x4*)(ga + (i * 64 + lane) * 4);
                h[i] = h[i] + aa * (y[i] * rs * gg);
            }
        }
#pragma unroll
        for (int i = 0; i < 4; ++i) *(f32x4*)(hout + (i * 64 + lane) * 4) = h[i];
        const int nl = (mode == 2) ? layer + 1 : layer;
        if (nl < DEPTH) {
            float ss = 0.f;
#pragma unroll
            for (int i = 0; i < 4; ++i) ss += h[i][0] * h[i][0] + h[i][1] * h[i][1] + h[i][2] * h[i][2] + h[i][3] * h[i][3];
            ss = wave_sum(ss);
            const float rs = rsqrtf(ss * (1.f / 1024.f) + 1e-6f);
            const float* gpre = (mode == 1 ? p.g_pre_ffn : p.g_pre_mix) + nl * 1024;
            const float* modn = (mode == 2) ? mod + 17 * 6144 : mod;
            const float* sh = modn + (mode == 1 ? 3072 : 0);
            const float* sc = modn + (mode == 1 ? 4096 : 1024);
#pragma unroll
            for (int i = 0; i < 4; ++i) {
                const int e = (i * 64 + lane) * 4;
                const f32x4 gg = *(const f32x4*)(gpre + e), s1 = *(const f32x4*)(sc + e), s0 = *(const f32x4*)(sh + e);
                const f32x4 u = h[i] * rs * gg * (s1 + 1.f) + s0;
                store4(p.U + (size_t)g * 1024 + e, u);
            }
        }
    }
}

DEV void gemm1_row(f32x4 (&v)[4], int row, int slab, bool lat, const P& p, int layer, int fq) {
    const bool hnorm = (slab >= 2048 && slab < 2688);
    const bool rope64 = lat && ((slab >= 384 && slab < 1024) || hnorm);
    const bool isq = (slab >= 384 && slab < 896) || (slab >= 1024 && slab < 1536) || (slab >= 2048 && slab < 2560);
    const float sc = isq ? 0.125f * LOG2E : 1.f;
    const bool kr = (slab == 2688);
    const int tok = row & 2047; const int pr = tok >> 6, pc = tok & 63;
    if (hnorm) {
        float ss = 0.f;
#pragma unroll
        for (int ft = 0; ft < 4; ++ft) ss += v[ft][0] * v[ft][0] + v[ft][1] * v[ft][1] + v[ft][2] * v[ft][2] + v[ft][3] * v[ft][3];
        ss += __shfl_xor(ss, 16); ss += __shfl_xor(ss, 32);
        const float rs = rsqrtf(ss * (1.f / 64.f) + 1e-6f);
        const float* g = (slab < 2560 ? p.g_d_q : p.g_d_k) + layer * 64;
#pragma unroll
        for (int ft = 0; ft < 4; ++ft) { const f32x4 gg = *(const f32x4*)(g + ft * 16 + fq * 4); v[ft] = v[ft] * rs * gg; }
    }
    if (rope64) {
#pragma unroll
        for (int j = 0; j < 4; ++j) {
            const int i = fq * 4 + j;
            f32x2 cs = p.rt16[pr * 16 + i]; float a = v[0][j], b = v[1][j];
            v[0][j] = a * cs[0] - b * cs[1]; v[1][j] = b * cs[0] + a * cs[1];
            cs = p.rt16[pc * 16 + i]; a = v[2][j]; b = v[3][j];
            v[2][j] = a * cs[0] - b * cs[1]; v[3][j] = b * cs[0] + a * cs[1];
        }
    }
    if (kr && lat) {
#pragma unroll
        for (int ft = 0; ft < 2; ++ft) {
            const int pos = ft == 0 ? pr : pc;
#pragma unroll
            for (int j = 0; j < 4; ++j) {
                const int i = (fq & 1) * 4 + j; const f32x2 cs = p.rt8[pos * 8 + i];
                const float xv = v[ft][j]; const float o = __shfl_xor(xv, 32);
                v[ft][j] = fq < 2 ? xv * cs[0] - o * cs[1] : xv * cs[0] + o * cs[1];
            }
        }
    }
    bf16_t* dst = p.PJ + (size_t)row * PJLD + slab + fq * 4;
    store4(dst, v[0] * sc); store4(dst + 16, v[1] * sc);
    if (!kr) { store4(dst + 32, v[2] * sc); store4(dst + 48, v[3] * sc); }
}
DEV void stage2_tile(const P& p, int mt, int j, unsigned char* smraw) {
    bf16_t* sm = (bf16_t*)smraw; float* s_rs = (float*)(smraw + 73728);
    const int tid = ltid(), lane = tid & 63, wid = uni(tid >> 6), wm = wid & 1, wn = wid >> 1, fr = lane & 15, fq = lane >> 4;
    const int m0 = mt * 128; const bool isq = j < 6; const bool lat = m0 < LAT_C;
    const int K = isq ? 256 : 128; const int acol = isq ? 0 : 256;
    {
        const int r = tid >> 1, hf = tid & 1; const int n = K >> 1;
        const bf16_t* src = p.PJ + (size_t)(m0 + r) * PJLD + acol + hf * n; float ss = 0.f;
        for (int i = 0; i < n; i += 8) {
            const u32x4 w = *(const u32x4*)(src + i);
#pragma unroll
            for (int q = 0; q < 4; ++q) { const float a = __uint_as_float(w[q] << 16), b = __uint_as_float(w[q] & 0xffff0000u); ss += a * a + b * b; }
        }
        ss += __shfl_xor(ss, 1);
        if (hf == 0) s_rs[r] = rsqrtf(ss / (float)K + 1e-6f);
    }
    __syncthreads();
    f32x4 acc[4][4];
    const bf16_t* A = p.PJ + (size_t)m0 * PJLD + acol;
    if (isq) {
        const int n0 = j * 128;
        gemm_mainloop<4, false>(A, PJLD, p.WuqT + (size_t)n0 * 256, 256, 256, acc, sm);
        const int slab = n0 + wn * 64; const float qs = 0.10206207261596577f * LOG2E;
#pragma unroll
        for (int tt = 0; tt < 4; ++tt) {
            const int lr = wm * 64 + tt * 16 + fr; const int row = m0 + lr; const float rs = s_rs[lr] * qs;
            const int tok = row & 2047; const int pr = tok >> 6, pc = tok & 63;
            f32x4 v[4] = {acc[0][tt], acc[1][tt], acc[2][tt], acc[3][tt]};
            if (slab >= 512 && lat) {
#pragma unroll
                for (int ft = 0; ft < 4; ++ft) {
                    const int pos = (ft & 1) == 0 ? pr : pc;
#pragma unroll
                    for (int jj = 0; jj < 4; ++jj) {
                        const int i = (fq & 1) * 4 + jj; const f32x2 cs = p.rt8[pos * 8 + i];
                        const float xv = v[ft][jj]; const float o = __shfl_xor(xv, 32);
                        v[ft][jj] = fq < 2 ? xv * cs[0] - o * cs[1] : xv * cs[0] + o * cs[1];
                    }
                }
            }
            bf16_t* dst = p.QA + (size_t)row * 768 + slab + fq * 4;
#pragma unroll
            for (int ft = 0; ft < 4; ++ft) store4(dst + ft * 16, v[ft] * rs);
        }
    } else {
        const int n0 = (j - 6) * 128;
        if (n0 < 512) {
            gemm_mainloop<4, false>(A, PJLD, p.WukvT + (size_t)n0 * 128, 128, 128, acc, sm);
#pragma unroll
            for (int tt = 0; tt < 4; ++tt) {
                const int lr = wm * 64 + tt * 16 + fr; const float rs = s_rs[lr];
                bf16_t* dst = p.KN + (size_t)(m0 + lr) * 512 + n0 + wn * 64 + fq * 4;
#pragma unroll
                for (int ft = 0; ft < 4; ++ft) store4(dst + ft * 16, acc[ft][tt] * rs);
            }
        } else {
            gemm_mainloop<4, true>(A, PJLD, p.WukvT + (size_t)n0 * 128, 128, 128, acc, sm);
            const int vrow0 = 768 + (n0 - 512) + wn * 64;
#pragma unroll
            for (int tt = 0; tt < 4; ++tt) {
                const int lr = wm * 64 + tt * 16 + fq * 4;
                const f32x4 rs = *(const f32x4*)(s_rs + lr);
                const int lp = wm * 64 + (tt >> 1) * 32 + fq * 8 + (tt & 1) * 4;
#pragma unroll
                for (int ft = 0; ft < 4; ++ft) store4(p.VT + (size_t)(vrow0 + ft * 16 + fr) * MC + m0 + lp, acc[ft][tt] * rs);
            }
        }
    }
    __syncthreads();
}

template <int MODE>
DEV void attn_item(const P& p, int layer, int item, bool ctxq, unsigned char* smraw) {
    constexpr bool GQA = (MODE == 1 || MODE == 3);
    constexpr int DQK = (MODE == 0) ? 96 : 64, NKS = DQK / 32;
    constexpr int KRB = (MODE == 0) ? 256 : 128, KM = (MODE == 0) ? 15 : 7;
    constexpr int KT_B = 64 * KRB, VT_B = 64 * 128;
    unsigned char* Ks = smraw; unsigned char* Vs = smraw + 32768; float* bias_s = (float*)(smraw + 49152);
    const int tid = ltid(), lane = tid & 63, wid = uni(tid >> 6), fr = lane & 15, fq = lane >> 4;
    const int nqt = ctxq ? (GQA ? 8 : 2) : (GQA ? 64 : 16);
    const int nh = GQA ? 2 : 8;
    const int qt = item % nqt, hh = (item / nqt) % nh, lb = item / (nqt * nh);
    const int head = GQA ? hh * 4 + wid : hh;
    const int tok0 = GQA ? qt * 32 : qt * 128 + wid * 32;
    const int qrow0 = (ctxq ? LAT_C + lb * CTX : lb * SEQ) + tok0;
    bf16x8 qf[2][NKS];
#pragma unroll
    for (int q = 0; q < 2; ++q) {
        const int row = qrow0 + q * 16 + fr;
        if (MODE == 0) {
            qf[q][0] = *(const bf16x8*)(p.QA + (size_t)row * 768 + head * 64 + fq * 8);
            qf[q][1] = *(const bf16x8*)(p.QA + (size_t)row * 768 + head * 64 + 32 + fq * 8);
            qf[q][NKS - 1] = *(const bf16x8*)(p.QA + (size_t)row * 768 + 512 + head * 32 + fq * 8);
        } else {
            const int qoff = MODE == 1 ? 384 : (MODE == 2 ? 1024 : 2048);
#pragma unroll
            for (int ks = 0; ks < NKS; ++ks) qf[q][ks] = *(const bf16x8*)(p.PJ + (size_t)row * PJLD + qoff + head * 64 + ks * 32 + fq * 8);
        }
    }
    const int koff = MODE == 1 ? 896 + hh * 64 : (MODE == 2 ? 1536 + hh * 64 : 2560 + hh * 64);
    const int vrow0 = MODE == 0 ? 768 + hh * 64 : (MODE == 1 ? hh * 64 : (MODE == 2 ? 128 + hh * 64 : 640 + hh * 64));
    int ktlo = 0, nlat = 0;
    if (!ctxq) {
        if (MODE == 0 || MODE == 3) { ktlo = 0; nlat = 32; }
        else if (MODE == 1) { const int q0 = qt * 32; const int lo = max(0, q0 - 128), hi = min(SEQ - 1, q0 + 159); ktlo = lo >> 6; nlat = (hi >> 6) - ktlo + 1; }
        else { const int r0a = min(max(2 * qt - 4, 0), 24), r0b = min(max(2 * qt + 1 - 4, 0), 24); ktlo = r0a; nlat = r0b + 8 - r0a; }
    }
    const int nt = 4 + nlat;
    const int ntf = ctxq ? 4 : ((MODE == 0 || MODE == 3) ? 36 : (MODE == 1 ? 9 : 13));
    if (MODE == 2 && !ctxq) { for (int i = tid; i < 465; i += 256) bias_s[i] = p.rpb_c[(layer * 8 + hh) * 465 + i] * LOG2E; }

    u32x4 rk[NKS], rv[2];
    auto tile_krow = [&](int it) { it = min(it, nt - 1); return it < 4 ? LAT_C + lb * CTX + it * 64 : lb * SEQ + (ktlo + it - 4) * 64; };
    auto gload = [&](int it) {
        const int krow = tile_krow(it);
#pragma unroll
        for (int i = 0; i < NKS; ++i) {
            const int id = tid + i * 256;
            if (MODE == 0) {
                const int key = id / 12, c = id - key * 12;
                const bf16_t* src = c < 8 ? p.KN + (size_t)(krow + key) * 512 + hh * 64 + c * 8 : p.PJ + (size_t)(krow + key) * PJLD + 2688 + (c - 8) * 8;
                rk[i] = *(const u32x4*)src;
            } else {
                const int key = id >> 3, c = id & 7;
                rk[i] = *(const u32x4*)(p.PJ + (size_t)(krow + key) * PJLD + koff + c * 8);
            }
        }
#pragma unroll
        for (int i = 0; i < 2; ++i) { const int id = tid + i * 256; const int dv = id >> 3, c = id & 7; rv[i] = *(const u32x4*)(p.VT + (size_t)(vrow0 + dv) * MC + krow + c * 8); }
    };
    auto lstore = [&](int buf) {
#pragma unroll
        for (int i = 0; i < NKS; ++i) {
            const int id = tid + i * 256; int key, c;
            if (MODE == 0) { key = id / 12; c = id - key * 12; } else { key = id >> 3; c = id & 7; }
            *(u32x4*)(Ks + buf * KT_B + key * KRB + ((c ^ (key & KM)) << 4)) = rk[i];
        }
#pragma unroll
        for (int i = 0; i < 2; ++i) { const int id = tid + i * 256; const int dv = id >> 3, c = id & 7; *(u32x4*)(Vs + buf * VT_B + dv * 128 + ((c ^ (dv & 7)) << 4)) = rv[i]; }
    };

    f32x4 o[4][2], lo[2], negm4[2]; float mref[2];
    const bf16x8 ones8 = __builtin_bit_cast(bf16x8, (u32x4){0x3F803F80u, 0x3F803F80u, 0x3F803F80u, 0x3F803F80u});
#pragma unroll
    for (int q = 0; q < 2; ++q) { mref[q] = 0.f; lo[q] = (f32x4){0.f, 0.f, 0.f, 0.f}; negm4[q] = (f32x4){0.f, 0.f, 0.f, 0.f};
#pragma unroll
        for (int d = 0; d < 4; ++d) o[d][q] = (f32x4){0.f, 0.f, 0.f, 0.f}; }

    gload(0); lstore(0); gload(1); __syncthreads();
    for (int it = 0; it < ntf; ++it) {
        const int cur = it & 1;
        if (it + 1 < ntf) lstore(cur ^ 1);
        if (it + 2 < ntf) gload(it + 2);
        __builtin_amdgcn_sched_barrier(0);
        const int kt = ktlo + it - 4;
        bool active = it < nt;
        int r = 0, r0 = 0;
        if (MODE == 2 && !ctxq && it >= 4) { r = 2 * qt + (wid >> 1); r0 = min(max(r - 4, 0), 24); active = active && (kt >= r0 && kt < r0 + 8); }
        if (active) {
            f32x4 s[4][2];
            const unsigned char* kb = Ks + cur * KT_B + fr * KRB;
            bf16x8 kf[4][NKS];
#pragma unroll
            for (int k4 = 0; k4 < 4; ++k4)
#pragma unroll
                for (int ks = 0; ks < NKS; ++ks) kf[k4][ks] = *(const bf16x8*)(kb + k4 * 16 * KRB + (((ks * 4 + fq) ^ (fr & KM)) << 4));
            __builtin_amdgcn_sched_barrier(0);
#pragma unroll
            for (int k4 = 0; k4 < 4; ++k4) {
#pragma unroll
                for (int q = 0; q < 2; ++q) s[k4][q] = mfma16(kf[k4][0], qf[q][0], negm4[q]);
#pragma unroll
                for (int ks = 1; ks < NKS; ++ks)
#pragma unroll
                    for (int q = 0; q < 2; ++q) s[k4][q] = mfma16(kf[k4][ks], qf[q][ks], s[k4][q]);
            }
            const unsigned char* vb = Vs + cur * VT_B + fr * 128;
            bf16x8 vf[4][2];
#pragma unroll
            for (int d = 0; d < 4; ++d)
#pragma unroll
                for (int kb2 = 0; kb2 < 2; ++kb2) vf[d][kb2] = *(const bf16x8*)(vb + d * 16 * 128 + (((kb2 * 4 + fq) ^ (fr & 7)) << 4));
            __builtin_amdgcn_sched_barrier(0);
            if (!ctxq && it >= 4) {
                if (MODE == 1) {
#pragma unroll
                    for (int q = 0; q < 2; ++q) {
                        const int qpos = tok0 + q * 16 + fr;
#pragma unroll
                        for (int k4 = 0; k4 < 4; ++k4)
#pragma unroll
                            for (int j = 0; j < 4; ++j) { const int d = qpos - (kt * 64 + k4 * 16 + fq * 4 + j); if (d > 128 || d < -128) s[k4][q][j] = -1e30f; }
                    }
                }
                if (MODE == 2) {
#pragma unroll
                    for (int q = 0; q < 2; ++q) {
                        const int qc = (wid & 1) * 32 + q * 16 + fr; const int c0 = min(max(qc - 8, 0), 48);
                        const int bbase = (kt - r + 7) * 31 + 15 - qc;
#pragma unroll
                        for (int k4 = 0; k4 < 4; ++k4)
#pragma unroll
                            for (int j = 0; j < 4; ++j) {
                                const int kc = k4 * 16 + fq * 4 + j; const bool ok = (kc >= c0 && kc < c0 + 16);
                                const float bv = bias_s[ok ? bbase + kc : 0];
                                s[k4][q][j] = ok ? s[k4][q][j] + bv : -1e30f;
                            }
                    }
                }
            }
            bf16x8 pf[2][2];
#pragma unroll
            for (int q = 0; q < 2; ++q) {
                float mx = -1e30f;
#pragma unroll
                for (int k4 = 0; k4 < 4; ++k4) mx = fmaxf(mx, fmaxf(fmaxf(s[k4][q][0], s[k4][q][1]), fmaxf(s[k4][q][2], s[k4][q][3])));
                mx = xmax32(xmax16(mx));
                const bool need = (it == 0) || (mx > 8.f);
                if (__builtin_amdgcn_ballot_w64(need) != 0ull) {
                    const float delta = need ? mx : 0.f;
                    mref[q] += delta; negm4[q] = negm4[q] - delta;
#pragma unroll
                    for (int k4 = 0; k4 < 4; ++k4) s[k4][q] = s[k4][q] - delta;
                    const float alpha = fexp2(-delta);
                    lo[q] = lo[q] * alpha;
#pragma unroll
                    for (int d = 0; d < 4; ++d) o[d][q] = o[d][q] * alpha;
                }
#pragma unroll
                for (int k4 = 0; k4 < 4; ++k4)
#pragma unroll
                    for (int j = 0; j < 4; ++j) s[k4][q][j] = fexp2(s[k4][q][j]);
#pragma unroll
                for (int kb2 = 0; kb2 < 2; ++kb2) {
                    u32x4 w; w.x = pk_bf16(s[2 * kb2][q][0], s[2 * kb2][q][1]); w.y = pk_bf16(s[2 * kb2][q][2], s[2 * kb2][q][3]);
                    w.z = pk_bf16(s[2 * kb2 + 1][q][0], s[2 * kb2 + 1][q][1]); w.w = pk_bf16(s[2 * kb2 + 1][q][2], s[2 * kb2 + 1][q][3]);
                    pf[q][kb2] = __builtin_bit_cast(bf16x8, w);
                }
            }
#pragma unroll
            for (int d = 0; d < 4; ++d)
#pragma unroll
                for (int kb2 = 0; kb2 < 2; ++kb2)
#pragma unroll
                    for (int q = 0; q < 2; ++q) o[d][q] = mfma16(vf[d][kb2], pf[q][kb2], o[d][q]);
#pragma unroll
            for (int kb2 = 0; kb2 < 2; ++kb2)
#pragma unroll
                for (int q = 0; q < 2; ++q) lo[q] = mfma16(ones8, pf[q][kb2], lo[q]);
        }
        __syncthreads();
    }
#pragma unroll
    for (int q = 0; q < 2; ++q) {
        float l = lo[q][0];
        if (MODE == 1) l += fexp2(p.sink_b[layer * 8 + head] * LOG2E - mref[q]);
        const float inv = 1.f / l;
        bf16_t* dst = p.O + (size_t)(qrow0 + q * 16 + fr) * 2048 + MODE * 512 + head * 64 + fq * 4;
#pragma unroll
        for (int d = 0; d < 4; ++d) store4(dst + d * 16, o[d][q] * inv);
    }
}


namespace pg8 {
#define PG8_LAS __attribute__((address_space(3)))
constexpr int BM = 256, BK = 64, HALF = 128, HTB = HALF * BK * 2  , STAGE_BYTES = 8 * HTB, NXCD = 8, WGM = 8;

__host__ __device__ __forceinline__ int lds_byte(int r, int c) { const int st = (r >> 4) * 2 + (c >> 5), rr = r & 15, cc = c & 31, ob = rr * 64 + cc * 2; return st * 1024 + (ob ^ (((ob >> 9) & 1) << 5)); }
__host__ __device__ __forceinline__ void stage_rc(int b, int& R, int& C) { const int st = b / 1024, sb = b % 1024, swz = sb ^ (((sb >> 9) & 1) << 5); R = (st >> 1) * 16 + swz / 64; C = (st & 1) * 32 + (swz % 64) / 2; }
__host__ __device__ __forceinline__ int perm32(int rho) { const int n = rho >> 4, i = rho & 15; return 8 * (i >> 2) + 4 * n + (i & 3); }

struct Unit { int pm, pn; };
struct Gemm { const bf16_t* A; const bf16_t* Bt; int M, N, K; };

template <class Epi, class Sched, bool ALIGN_EPI = false, bool SP2 = false, bool SWAPMMA = false>
__device__ __forceinline__ void gemm_phase(PG8_LAS unsigned char* lds, const Gemm g, const Sched& S, const Epi& E) {
    int tid = threadIdx.x; asm volatile("" : "+v"(tid));
    const int wid = __builtin_amdgcn_readfirstlane(tid >> 6), lane = tid & 63, wr = wid >> 2, wc = wid & 3, fr = lane & 15, fq = lane >> 4;
    const int K = g.K, nt = K / BK;
    unsigned voffA[2], voffB[2];
#pragma unroll
    for (int i = 0; i < 2; ++i) { int R, C; stage_rc(tid * 16 + i * 8192, R, C); const int Rb = Epi::PERM ? ((R & ~31) + perm32(R & 31)) : R;
        voffA[i] = (unsigned)(R * K + C) * 2u; voffB[i] = (unsigned)(Rb * K + C) * 2u; }
    const size_t kstep = (size_t)(BK * 2);
    const size_t hstep = (size_t)HALF * K * 2;
    const size_t tstep = 2 * hstep;
    const unsigned ldsw = (unsigned)wid * 1024u;
    const int aoff = lds_byte(wr * 64 + fr, fq * 8), boff = lds_byte(wc * 32 + fr, fq * 8);
#define PG8_SA(b, h) (((b) * 2 + (h)) * HTB)
#define PG8_SB(b, h) ((4 + (b) * 2 + (h)) * HTB)
#define PG8_STAGE(bufoff, gbase, voff) do { _Pragma("unroll") for (int _i = 0; _i < 2; ++_i) \
        __builtin_amdgcn_global_load_lds((const unsigned*)((const char*)(gbase) + (voff)[_i]), (PG8_LAS unsigned*)(lds + (bufoff) + ldsw + _i * 8192), 16, 0, 0); } while (0)
#define PG8_LDA(dst, b, h) do { _Pragma("unroll") for (int m = 0; m < 4; ++m) _Pragma("unroll") for (int k = 0; k < 2; ++k) dst[m][k] = *(const PG8_LAS bf16x8*)(lds + PG8_SA(b, h) + aoff + m * 2048 + k * 1024); } while (0)
#define PG8_LDB(dst, b, h) do { _Pragma("unroll") for (int n = 0; n < 2; ++n) _Pragma("unroll") for (int k = 0; k < 2; ++k) dst[n][k] = *(const PG8_LAS bf16x8*)(lds + PG8_SB(b, h) + boff + n * 2048 + k * 1024); } while (0)
#define PG8_MMA(ai, bj, At, Bt) do { __builtin_amdgcn_s_setprio(1); _Pragma("unroll") for (int m = 0; m < 4; ++m) _Pragma("unroll") for (int n = 0; n < 2; ++n) _Pragma("unroll") for (int k = 0; k < 2; ++k) \
        acc[ai][bj][m][n] = SWAPMMA ? __builtin_amdgcn_mfma_f32_16x16x32_bf16(At[m][k], Bt[n][k], acc[ai][bj][m][n], 0, 0, 0) : __builtin_amdgcn_mfma_f32_16x16x32_bf16(Bt[n][k], At[m][k], acc[ai][bj][m][n], 0, 0, 0); __builtin_amdgcn_s_setprio(0); } while (0)
#define PG8_WAIT_V(n) asm volatile("s_waitcnt vmcnt(" #n ")" ::: "memory")
#define PG8_WAIT_L(n) asm volatile("s_waitcnt lgkmcnt(" #n ")" ::: "memory")
#define PG8_BAR __builtin_amdgcn_s_barrier()
#define PG8_SCHED __builtin_amdgcn_sched_barrier(0)
    Unit cur, nxt; int ui = 0;
    if (!S.next(0, cur)) return;
    f32x4 acc[2][2][4][2];
#pragma unroll
    for (int a = 0; a < 2; ++a)
#pragma unroll
        for (int b = 0; b < 2; ++b)
#pragma unroll
            for (int m = 0; m < 4; ++m)
#pragma unroll
                for (int n = 0; n < 2; ++n) acc[a][b][m][n] = (f32x4){0.f, 0.f, 0.f, 0.f};
    bf16x8 At[4][2], B0[2][2], B1[2][2];
    const char* cA = (const char*)g.A + (size_t)cur.pm * tstep; const char* cB = (const char*)g.Bt + (size_t)cur.pn * tstep;
    S.a_ready(cur);
    if constexpr (SP2) {
        PG8_STAGE(PG8_SB(0, 0), cB, voffB); PG8_STAGE(PG8_SB(0, 1), cB + hstep, voffB); PG8_STAGE(PG8_SA(0, 0), cA, voffA); PG8_STAGE(PG8_SA(0, 1), cA + hstep, voffA);
        if (wr == 1) PG8_BAR;
        PG8_WAIT_V(2); PG8_BAR;
        PG8_STAGE(PG8_SB(1, 0), cB + kstep, voffB); PG8_STAGE(PG8_SA(1, 0), cA + kstep, voffA); PG8_STAGE(PG8_SB(1, 1), cB + hstep + kstep, voffB);
        PG8_WAIT_V(6); PG8_BAR;
    } else {
        PG8_STAGE(PG8_SB(0, 0), cB, voffB); PG8_STAGE(PG8_SA(0, 0), cA, voffA); PG8_STAGE(PG8_SB(0, 1), cB + hstep, voffB); PG8_STAGE(PG8_SA(0, 1), cA + hstep, voffA);
        if (wr == 1) PG8_BAR;
        PG8_WAIT_V(4); PG8_BAR;
        PG8_STAGE(PG8_SB(1, 0), cB + kstep, voffB); PG8_STAGE(PG8_SA(1, 0), cA + kstep, voffA); PG8_STAGE(PG8_SB(1, 1), cB + hstep + kstep, voffB);
        PG8_WAIT_V(6); PG8_BAR;
    }
    for (;;) {
        const bool has_next = S.next(ui + 1, nxt);
        const char* nA = has_next ? (const char*)g.A + (size_t)nxt.pm * tstep : cA; const char* nB = has_next ? (const char*)g.Bt + (size_t)nxt.pn * tstep : cB;
        for (int t = 0; t < nt; t += 2) {
            if constexpr (Epi::HAS_MID) { if (t != 0 && (t & 7) == 0) { E.mid(acc, cur, t >> 3, wid, lane); asm volatile("s_waitcnt vmcnt(0)" ::: "memory"); } }
            const bool last = (t == nt - 2);
            const char* a1 = cA + (size_t)(t + 1) * kstep;
            const char* a2 = last ? nA : cA + (size_t)(t + 2) * kstep; const char* b2 = last ? nB : cB + (size_t)(t + 2) * kstep;
            const char* a3 = a2 + kstep; const char* b3 = b2 + kstep;
            if (last && has_next) S.a_ready(nxt);
            if constexpr (SP2) {
            PG8_LDB(B0, 0, 0); PG8_LDB(B1, 0, 1); PG8_SCHED; PG8_LDA(At, 0, 0); PG8_STAGE(PG8_SA(1, 1), a1 + hstep, voffA);
            PG8_WAIT_V(8); PG8_WAIT_L(0); PG8_BAR; PG8_MMA(0, 0, At, B0); PG8_MMA(0, 1, At, B1); PG8_BAR; PG8_SCHED;
            PG8_LDA(At, 0, 1); PG8_STAGE(PG8_SB(0, 0), b2, voffB); PG8_STAGE(PG8_SB(0, 1), b2 + hstep, voffB); PG8_STAGE(PG8_SA(0, 0), a2, voffA);
            PG8_WAIT_V(8); PG8_WAIT_L(0); PG8_BAR; PG8_MMA(1, 0, At, B0); PG8_MMA(1, 1, At, B1); PG8_BAR; PG8_SCHED;
            PG8_LDB(B0, 1, 0); PG8_LDB(B1, 1, 1); PG8_SCHED; PG8_LDA(At, 1, 0); PG8_STAGE(PG8_SA(0, 1), a2 + hstep, voffA);
            PG8_WAIT_V(8); PG8_WAIT_L(0); PG8_BAR; PG8_MMA(0, 0, At, B0); PG8_MMA(0, 1, At, B1); PG8_BAR; PG8_SCHED;
            PG8_LDA(At, 1, 1); PG8_STAGE(PG8_SB(1, 0), b3, voffB); PG8_STAGE(PG8_SB(1, 1), b3 + hstep, voffB); PG8_STAGE(PG8_SA(1, 0), a3, voffA);
            PG8_WAIT_V(8); PG8_WAIT_L(0); PG8_BAR; PG8_MMA(1, 0, At, B0); PG8_MMA(1, 1, At, B1); PG8_BAR; PG8_SCHED;
            } else {
            PG8_LDB(B0, 0, 0); PG8_SCHED; PG8_LDA(At, 0, 0); PG8_STAGE(PG8_SA(1, 1), a1 + hstep, voffA);
            PG8_WAIT_L(8); PG8_BAR; PG8_WAIT_L(0); PG8_MMA(0, 0, At, B0); PG8_BAR; PG8_SCHED;
            PG8_LDB(B1, 0, 1); PG8_STAGE(PG8_SB(0, 0), b2, voffB);
            PG8_BAR; PG8_WAIT_L(0); PG8_MMA(0, 1, At, B1); PG8_BAR;
            PG8_LDA(At, 0, 1); PG8_STAGE(PG8_SA(0, 0), a2, voffA);
            PG8_BAR; PG8_WAIT_L(0); PG8_MMA(1, 0, At, B0); PG8_BAR; PG8_SCHED;
            PG8_STAGE(PG8_SB(0, 1), b2 + hstep, voffB);
            PG8_WAIT_V(6); PG8_BAR; PG8_MMA(1, 1, At, B1); PG8_BAR;
            PG8_LDB(B0, 1, 0); PG8_SCHED; PG8_LDA(At, 1, 0); PG8_STAGE(PG8_SA(0, 1), a2 + hstep, voffA);
            PG8_WAIT_L(8); PG8_BAR; PG8_WAIT_L(0); PG8_MMA(0, 0, At, B0); PG8_BAR; PG8_SCHED;
            PG8_LDB(B1, 1, 1); PG8_STAGE(PG8_SB(1, 0), b3, voffB);
            PG8_BAR; PG8_WAIT_L(0); PG8_MMA(0, 1, At, B1); PG8_BAR;
            PG8_LDA(At, 1, 1); PG8_STAGE(PG8_SA(1, 0), a3, voffA);
            PG8_BAR; PG8_WAIT_L(0); PG8_MMA(1, 0, At, B0); PG8_BAR; PG8_SCHED;
            PG8_STAGE(PG8_SB(1, 1), b3 + hstep, voffB);
            PG8_WAIT_V(6); PG8_BAR; PG8_MMA(1, 1, At, B1); PG8_BAR;
            }
        }
        if constexpr (ALIGN_EPI) { if (wr == 0) PG8_BAR; }
        if constexpr (!Epi::AFTER_DRAIN) { E(acc, cur, wr, wc, fr, fq); S.done(cur); }
        if (!has_next) break;
#pragma unroll
        for (int a = 0; a < 2; ++a)
#pragma unroll
            for (int b = 0; b < 2; ++b)
#pragma unroll
                for (int m = 0; m < 4; ++m)
#pragma unroll
                    for (int n = 0; n < 2; ++n) acc[a][b][m][n] = (f32x4){0.f, 0.f, 0.f, 0.f};
        cur = nxt; cA = nA; cB = nB; ++ui;
        if constexpr (ALIGN_EPI) { if (wr == 1) PG8_BAR; }
    }
    PG8_WAIT_V(0);
    if constexpr (!ALIGN_EPI) { if (wr == 0) PG8_BAR; }
    PG8_BAR;
    if constexpr (Epi::AFTER_DRAIN) { E.fused(acc, cur, wr, wc, fr, fq, lds, wid, lane); S.done(cur); }
#undef PG8_SA
#undef PG8_SB
#undef PG8_STAGE
#undef PG8_LDA
#undef PG8_LDB
#undef PG8_MMA
#undef PG8_WAIT_V
#undef PG8_WAIT_L
#undef PG8_BAR
#undef PG8_SCHED
}
}

struct XSched {
    int nN, nunits, G, c, skipctx;
    DEV bool next(int i, pg8::Unit& u) const {
        const int L = i * G + c; if (L >= nunits) return false;
        const int U = ((nunits & 7) == 0 && (G & 7) == 0) ? (L & 7) * (nunits >> 3) + (L >> 3) : L;
        { const int nM = nunits / nN, nig = 8 * nN, gid = U / nig, fm = gid * 8, gsz = min(nM - fm, 8), r = U - gid * nig; u.pm = fm + r % gsz; u.pn = r / gsz; }
        if (skipctx) u.pm = (u.pm >> 6) * 72 + (u.pm & 63);
        return true;
    }
    DEV void a_ready(const pg8::Unit&) const {}
    DEV void done(const pg8::Unit&) const {}
};
struct EpiStoreT {
    static constexpr bool PERM = false, AFTER_DRAIN = false, HAS_MID = false;
    bf16_t* out; int ld; int row_off;
    DEV void operator()(const f32x4 (&acc)[2][2][4][2], const pg8::Unit& u, int wr, int wc, int fr, int fq) const {
#pragma unroll
        for (int ai = 0; ai < 2; ++ai)
#pragma unroll
            for (int m = 0; m < 4; ++m) {
                bf16_t* d = out + (size_t)(row_off + u.pm * 256 + ai * 128 + wr * 64 + m * 16 + fr) * ld + u.pn * 256 + wc * 32 + fq * 4;
#pragma unroll
                for (int bj = 0; bj < 2; ++bj)
#pragma unroll
                    for (int n = 0; n < 2; ++n) store4(d + bj * 128 + n * 16, acc[ai][bj][m][n]);
            }
    }
};
struct EpiSwiglu {
    static constexpr bool PERM = false, AFTER_DRAIN = false, HAS_MID = false;
    bf16_t* act;
    DEV void operator()(const f32x4 (&acc)[2][2][4][2], const pg8::Unit& u, int wr, int wc, int fr, int fq) const {
#pragma unroll
        for (int ai = 0; ai < 2; ++ai)
#pragma unroll
            for (int m = 0; m < 4; ++m) {
                bf16_t* d = act + (size_t)(u.pm * 256 + ai * 128 + wr * 64 + m * 16 + fr) * DFF + u.pn * 128 + wc * 16 + fq * 4;
#pragma unroll
                for (int bj = 0; bj < 2; ++bj) {
                    const f32x4 a = acc[ai][bj][m][0], b = acc[ai][bj][m][1]; f32x4 r;
#pragma unroll
                    for (int j = 0; j < 4; ++j) r[j] = a[j] * frcp(1.f + fexp2(-a[j] * LOG2E)) * b[j];
                    store4(d + bj * 64, r);
                }
            }
    }
};
struct EpiVT {
    static constexpr bool PERM = false, AFTER_DRAIN = false, HAS_MID = false;
    bf16_t* vt;
    DEV void operator()(const f32x4 (&acc)[2][2][4][2], const pg8::Unit& u, int wr, int wc, int fr, int fq) const {
#pragma unroll
        for (int bj = 0; bj < 2; ++bj)
#pragma unroll
            for (int n = 0; n < 2; ++n) {
                bf16_t* d = vt + (size_t)(u.pn * 256 + bj * 128 + wc * 32 + n * 16 + fr) * MC + u.pm * 256 + wr * 64 + fq * 8;
#pragma unroll
                for (int ai = 0; ai < 2; ++ai)
#pragma unroll
                    for (int m = 0; m < 4; ++m) store4(d + ai * 128 + (m >> 1) * 32 + (m & 1) * 4, acc[ai][bj][m][n]);
            }
    }
};
DEV size_t gate_index(int pm, int pn4, int wave, int r8, int lane) { return ((((size_t)pm * 16 + pn4) * 8 + wave) * 8 + r8) * 64 + lane; }
struct EpiGate {
    static constexpr bool PERM = false, AFTER_DRAIN = false, HAS_MID = false;
    u32x4* g8;
    DEV void operator()(const f32x4 (&acc)[2][2][4][2], const pg8::Unit& u, int wr, int wc, int fr, int fq) const {
        const int lane = fq * 16 + fr, wave = wr * 4 + wc;
#pragma unroll
        for (int ai = 0; ai < 2; ++ai)
#pragma unroll
            for (int m = 0; m < 4; ++m) {
                u32x4 w;
#pragma unroll
                for (int bj = 0; bj < 2; ++bj)
#pragma unroll
                    for (int n = 0; n < 2; ++n) {
                        const f32x4 a = acc[ai][bj][m][n]; unsigned x = 0;
#pragma unroll
                        for (int j = 0; j < 4; ++j) { const float s = frcp(1.f + fexp2(-a[j] * LOG2E)); x |= max(1u, (unsigned)(s * 255.f + 0.5f)) << (8 * j); }
                        w[bj * 2 + n] = x;
                    }
                g8[gate_index(u.pm, u.pn, wave, ai * 4 + m, lane)] = w;
            }
    }
};
struct EpiMerge {
    static constexpr bool PERM = false, AFTER_DRAIN = false, HAS_MID = true;
    bf16_t* out; const u32x4* g8;
    DEV void mid(f32x4 (&acc)[2][2][4][2], const pg8::Unit& u, int n, int wave, int lane) const {
#pragma unroll
        for (int ai = 0; ai < 2; ++ai)
#pragma unroll
            for (int m = 0; m < 4; ++m) {
                const u32x4 a = g8[gate_index(u.pm, (n - 1) * 4 + u.pn, wave, ai * 4 + m, lane)], b = g8[gate_index(u.pm, n * 4 + u.pn, wave, ai * 4 + m, lane)];
#pragma unroll
                for (int bj = 0; bj < 2; ++bj)
#pragma unroll
                    for (int nn = 0; nn < 2; ++nn) {
                        const unsigned x = a[bj * 2 + nn], y = b[bj * 2 + nn]; f32x4 r;
#pragma unroll
                        for (int j = 0; j < 4; ++j) r[j] = (float)((x >> (8 * j)) & 255u) * frcp((float)((y >> (8 * j)) & 255u));
                        acc[ai][bj][m][nn] = acc[ai][bj][m][nn] * r;
                    }
            }
    }
    DEV void operator()(const f32x4 (&acc)[2][2][4][2], const pg8::Unit& u, int wr, int wc, int fr, int fq) const {
        const int lane = fq * 16 + fr, wave = wr * 4 + wc;
#pragma unroll
        for (int ai = 0; ai < 2; ++ai)
#pragma unroll
            for (int m = 0; m < 4; ++m) {
                const u32x4 a = g8[gate_index(u.pm, 12 + u.pn, wave, ai * 4 + m, lane)];
                bf16_t* d = out + (size_t)(u.pm * 256 + ai * 128 + wr * 64 + m * 16 + fr) * 1024 + u.pn * 256 + wc * 32 + fq * 4;
#pragma unroll
                for (int bj = 0; bj < 2; ++bj)
#pragma unroll
                    for (int nn = 0; nn < 2; ++nn) {
                        const unsigned x = a[bj * 2 + nn]; f32x4 r;
#pragma unroll
                        for (int j = 0; j < 4; ++j) r[j] = (float)((x >> (8 * j)) & 255u) * (1.f / 255.f);
                        store4(d + bj * 128 + nn * 16, acc[ai][bj][m][nn] * r);
                    }
            }
    }
};
struct EpiGemm1 {
    static constexpr bool PERM = false, AFTER_DRAIN = false, HAS_MID = false;
    const P* pp; int layer;
    DEV void operator()(const f32x4 (&acc)[2][2][4][2], const pg8::Unit& u, int wr, int wc, int fr, int fq) const {
        const int slab = u.pn * 256 + wc * 64; const bool lat = u.pm * 256 < LAT_C;
        if (slab >= 2752) return;
#pragma unroll
        for (int ai = 0; ai < 2; ++ai)
#pragma unroll
            for (int m = 0; m < 4; ++m) {
                f32x4 v[4] = {acc[ai][0][m][0], acc[ai][0][m][1], acc[ai][1][m][0], acc[ai][1][m][1]};
                gemm1_row(v, u.pm * 256 + ai * 128 + wr * 64 + m * 16 + fr, slab, lat, *pp, layer, fq);
            }
    }
};

#define LAS __attribute__((address_space(3)))
#define XB_TMO      128
#define XB_XCNT(j)  (256  + 64 * (j))
#define XB_XSUB(j)  (1280 + 64 * (j))
#define XB_XGEN(j)  (2304 + 64 * (j))
#define XB_TOP      3328
#define XB_TOPGEN   3392
#define XCD_BAR_WORDS 3456
#define XB_SPIN_CAP (1u << 18)

__device__ __forceinline__ unsigned xb_ld(unsigned* p)              { return __hip_atomic_load(p, __ATOMIC_RELAXED, __HIP_MEMORY_SCOPE_AGENT); }
__device__ __forceinline__ unsigned xb_add(unsigned* p, unsigned v) { return __hip_atomic_fetch_add(p, v, __ATOMIC_RELAXED, __HIP_MEMORY_SCOPE_AGENT); }
__device__ __forceinline__ unsigned xb_xcc_id() { return (unsigned)__builtin_amdgcn_s_getreg((3 << 11) | 20) & 0xFu; }
#define XB_SPIN(cond, bar) do { unsigned _sp = 0; while (cond) { __builtin_amdgcn_s_sleep(1); \
    if ((++_sp & 255u) == 0u) { if (xb_ld(&(bar)[XB_TMO])) break; if (_sp > XB_SPIN_CAP) { atomicAdd(&(bar)[XB_TMO], 1u); break; } } } } while (0)

struct XcdBarrier {
    unsigned* bar; unsigned x;
    volatile LAS unsigned* st;
};

__device__ __forceinline__ XcdBarrier xcd_barrier_post(unsigned* bar, volatile LAS unsigned* st) {
    XcdBarrier b; b.bar = bar; b.x = xb_xcc_id(); b.st = st;
    if (threadIdx.x == 0) (void)xb_add(&bar[XB_XCNT(b.x)], 1u);
    return b;
}
__device__ __forceinline__ void xcd_barrier_complete(unsigned* bar, unsigned x, unsigned& nloc, unsigned& nx) {
    const unsigned G = gridDim.x * gridDim.y * gridDim.z;
    unsigned sum, cnt, mine, sp = 0u;
    for (;;) {
        sum = 0u; cnt = 0u; mine = 0u;
#pragma unroll
        for (unsigned j = 0; j < 16; ++j) { const unsigned c = xb_ld(&bar[XB_XCNT(j)]); sum += c; cnt += (c > 0u) ? 1u : 0u; mine = (j == x) ? c : mine; }
        if (sum == G) break;
        __builtin_amdgcn_s_sleep(1);
        if ((++sp & 255u) == 0u) { if (xb_ld(&bar[XB_TMO])) break; if (sp > XB_SPIN_CAP) { atomicAdd(&bar[XB_TMO], 1u); break; } }
    }
    nloc = mine > 0u ? mine : 1u; nx = cnt > 0u ? cnt : 1u;
}

__device__ __forceinline__ void xcd_barrier(const XcdBarrier& b) {
    asm volatile("s_waitcnt vmcnt(0)" ::: "memory");
    __syncthreads();
    if (threadIdx.x == 0) {
        unsigned* bar = b.bar;
        __builtin_amdgcn_s_waitcnt(0);
        unsigned nloc = b.st[0], nx = b.st[1];
        if (nloc == 0u) { xcd_barrier_complete(bar, b.x, nloc, nx); b.st[0] = nloc; b.st[1] = nx; }
        const unsigned old = xb_add(&bar[XB_XSUB(b.x)], 1u);
        const unsigned gen = old / nloc;
        if (old + 1u == (gen + 1u) * nloc) {
            __builtin_amdgcn_fence(__ATOMIC_RELEASE, "agent");
            asm volatile("s_waitcnt vmcnt(0)" ::: "memory");
            const unsigned og = xb_add(&bar[XB_TOP], 1u);
            const unsigned tg = og / nx;
            if (og + 1u == (tg + 1u) * nx) xb_add(&bar[XB_TOPGEN], 1u);
            else XB_SPIN(xb_ld(&bar[XB_TOPGEN]) == tg, bar);
            __builtin_amdgcn_fence(__ATOMIC_ACQUIRE, "agent");
            xb_add(&bar[XB_XGEN(b.x)], 1u);
            asm volatile("s_waitcnt vmcnt(0)" ::: "memory");
        } else {
            XB_SPIN(xb_ld(&bar[XB_XGEN(b.x)]) == gen, bar);
            __builtin_amdgcn_fence(__ATOMIC_ACQUIRE, "agent");
            asm volatile("s_waitcnt vmcnt(0)" ::: "memory");
        }
    }
    __syncthreads();
}

typedef const __attribute__((address_space(4))) P* PP;
#define FRESH_P PP q_ = pp0; asm volatile("" : "+s"(q_)); const P& p = *(const P*)q_;
#define FRESH_BG int bidL = bid, GL = G; asm volatile("" : "+s"(bidL), "+s"(GL));
constexpr int DYN_LDS = 2 * SMEM_BYTES + 64;
__global__ void __launch_bounds__(512, 2) mega(P pv_) {
    cg::grid_group grid = cg::this_grid();
    PP pp0 = (PP)__builtin_amdgcn_kernarg_segment_ptr();
    extern __shared__ __attribute__((aligned(16))) unsigned char lds_dyn[];
    const int half = __builtin_amdgcn_readfirstlane((int)threadIdx.x >> 8);
    unsigned char* smraw = lds_dyn + half * SMEM_BYTES;
    bf16_t* sm = (bf16_t*)smraw;
    PG8_LAS unsigned char* ldsL = (PG8_LAS unsigned char*)lds_dyn;
    const int bid = blockIdx.x, G = gridDim.x, vb = bid * 2 + half, VG = G * 2, tid = threadIdx.x & 255;
    {
        FRESH_P
        volatile LAS unsigned* xst = (volatile LAS unsigned*)(ldsL + 2 * SMEM_BYTES);
        if (threadIdx.x == 0) { xst[0] = 0u; xst[1] = 0u; }
        __syncthreads();
        const XcdBarrier xb0 = xcd_barrier_post(p.barw, xst);
        if (threadIdx.x == 0) xst[2] = xb0.x;
        __syncthreads();
    }
#define GBAR() do { FRESH_P XcdBarrier b_; b_.bar = p.barw; b_.st = (volatile LAS unsigned*)(ldsL + 2 * SMEM_BYTES); b_.x = b_.st[2]; xcd_barrier(b_); } while (0)

    { FRESH_P
    for (int i = vb * 256 + tid; i < 64 * 16 + 64 * 8; i += VG * 256) {
        if (i < 1024) { const int pos = i >> 4, k = i & 15; const float inv = fexp2(-(float)k * (13.287712379549449f / 16.f)); const float a = (float)pos * inv; p.rt16[i] = (f32x2){__cosf(a), __sinf(a)}; }
        else { const int q = i - 1024; const int pos = q >> 3, k = q & 7; const float inv = fexp2(-(float)k * (13.287712379549449f / 8.f)); const float a = (float)pos * inv; p.rt8[q] = (f32x2){__cosf(a), __sinf(a)}; }
    }
    for (int t = vb; t < 384 + CONV_TILES; t += VG) { if (t < 384) mod_item(p, t, smraw); else conv_job(p, 0, t - 384, (float*)smraw); }
    }
    GBAR();
    { FRESH_P r_phase(p, 0, 0, vb, VG, 0, MTOT); }
    GBAR();

    for (int layer = 0; layer < DEPTH; ++layer) {
        const bool lastL = (layer == DEPTH - 1);
        for (int ch = 0; ch < NCH; ++ch) {
            { FRESH_P FRESH_BG
              const bf16_t* A = p.U + (size_t)ch * MC * 1024;
              { pg8::Gemm g{A, p.WinT, MC, 2816, 1024}; XSched S{11, 792, GL, bidL}; EpiGemm1 E{&p, layer};
                pg8::gemm_phase<EpiGemm1, XSched, true, true, false>(ldsL, g, S, E); }
              { pg8::Gemm g{A, p.WinT + (size_t)2816 * 1024, MC, 768, 1024}; XSched S{3, 216, GL, (bidL + GL - (792 % GL)) % GL}; EpiVT E{p.VT};
                pg8::gemm_phase<EpiVT, XSched, true, true, true>(ldsL, g, S, E); }
              { pg8::Gemm g{A, p.WinT + (size_t)NPROJ * 1024, MC, 4096, 1024}; XSched S{16, lastL ? 1024 : 1152, GL, (bidL + GL - (1008 % GL)) % GL}; EpiGate E{(u32x4*)p.G};
                pg8::gemm_phase<EpiGate, XSched, true, true, false>(ldsL, g, S, E); }
            }
            GBAR();
            { FRESH_P for (int t = vb; t < (lastL ? 4064 : 4448); t += VG) {
                if (t < 1024) attn_item<2>(p, layer, t, false, smraw);
                else if (t < 2048) attn_item<1>(p, layer, t - 1024, false, smraw);
                else if (t < 4064) { const int q = t - 2048; stage2_tile(p, q / 14, q % 14, smraw); }
                else if (t < 4192) attn_item<1>(p, layer, t - 4064, true, smraw);
                else if (t < 4320) attn_item<2>(p, layer, t - 4192, true, smraw);
                else attn_item<3>(p, layer, t - 4320, true, smraw);
            } }
            GBAR();
            { FRESH_P for (int t = vb; t < (lastL ? 2048 : 2176); t += VG) {
                if (t < 1024) attn_item<0>(p, layer, t, false, smraw);
                else if (t < 2048) attn_item<3>(p, layer, t - 1024, false, smraw);
                else attn_item<0>(p, layer, t - 2048, true, smraw);
            } }
            GBAR();
            { FRESH_P FRESH_BG pg8::Gemm g{p.O, p.WbrT, MC, 1024, 2048}; XSched S{4, lastL ? 256 : 288, GL, bidL}; EpiMerge E{p.MB, (const u32x4*)p.G};
              pg8::gemm_phase<EpiMerge, XSched, true, true, false>(ldsL, g, S, E); }
            GBAR();
            { FRESH_P FRESH_BG pg8::Gemm g{p.MB, p.WoutT, MC, 1024, 1024}; XSched S{4, lastL ? 256 : 288, GL, bidL}; EpiStoreT E{p.YC, 1024, 0};
              pg8::gemm_phase<EpiStoreT, XSched, true, true, false>(ldsL, g, S, E); }
            GBAR();
            { FRESH_P r_phase(p, 1, layer, vb, VG, ch * MC, ch * MC + (lastL ? LAT_C : MC)); }
            if (ch + 1 == NCH) GBAR();
        }
        { FRESH_P FRESH_BG pg8::Gemm g{p.U, p.Wf1T, MTOT, 2 * DFF, 1024}; XSched S{22, lastL ? 2816 : 3168, GL, bidL, lastL ? 1 : 0}; EpiSwiglu E{p.ACT};
          pg8::gemm_phase<EpiSwiglu, XSched, true, true, false>(ldsL, g, S, E); }
        GBAR();
        { FRESH_P FRESH_BG pg8::Gemm g{p.ACT, p.Wf2T, MTOT, 1024, DFF}; XSched S{4, lastL ? 512 : 576, GL, bidL, lastL ? 1 : 0}; EpiStoreT E{p.U, 1024, 0};
          pg8::gemm_phase<EpiStoreT, XSched, true, true, false>(ldsL, g, S, E); }
        GBAR();
        { FRESH_P r_phase(p, 2, layer, vb, VG, 0, MTOT, lastL);
          if (layer + 1 < DEPTH) { for (int t = vb; t < CONV_TILES; t += VG) conv_job(p, layer + 1, t, (float*)smraw); } }
        GBAR();
    }
}

extern "C" void kernel_launch(void* const* d_in, const int* in_sizes, int n_in, void* d_out, int out_size, void* d_ws, size_t ws_size, hipStream_t stream) {
    static int grid_blocks = 0;
    if (!grid_blocks) {
        int dev = 0, cus = 0, per_cu = 0;
        (void)hipGetDevice(&dev);
        (void)hipDeviceGetAttribute(&cus, hipDeviceAttributeMultiprocessorCount, dev);
        if (hipFuncSetAttribute((const void*)mega, hipFuncAttributeMaxDynamicSharedMemorySize, DYN_LDS) != hipSuccess) fprintf(stderr, "hipFuncSetAttribute failed\n");
        (void)hipOccupancyMaxActiveBlocksPerMultiprocessor(&per_cu, mega, 512, DYN_LDS);
        grid_blocks = cus;
    }
    P p{};
    const float** f = (const float**)&p;
    for (int i = 0; i < 23; ++i) f[i] = (const float*)d_in[i];
    p.out = (float*)d_out;
    unsigned char* w = (unsigned char*)d_ws; size_t off = 0;
    auto take = [&](size_t bytes) { void* r = w + off; off += (bytes + 255) & ~(size_t)255; return r; };
    p.WinT = (bf16_t*)take((size_t)NWIN * 1024 * 2);
    p.WuqT = (bf16_t*)take((size_t)768 * 256 * 2);
    p.WukvT = (bf16_t*)take((size_t)1024 * 128 * 2);
    p.WbrT = (bf16_t*)take((size_t)4 * 1024 * 512 * 2);
    p.WoutT = (bf16_t*)take((size_t)1024 * 1024 * 2);
    p.Wf1T = (bf16_t*)take((size_t)2 * DFF * 1024 * 2);
    p.Wf2T = (bf16_t*)take((size_t)1024 * DFF * 2);
    p.mod = (float*)take((size_t)DEPTH * 17 * 6144 * 4);
    p.rt16 = (f32x2*)take(64 * 16 * 8);
    p.rt8 = (f32x2*)take(64 * 8 * 8);
    p.hc = (float*)take((size_t)NBATCH * CTX * 1024 * 4);
    p.U = (bf16_t*)take((size_t)MTOT * 1024 * 2);
    p.G = (unsigned char*)take((size_t)MC * 4096);
    p.barw = (unsigned*)take((size_t)XCD_BAR_WORDS * 4);
    unsigned char* R = (unsigned char*)take(0);
    p.PJ = (bf16_t*)take((size_t)MC * PJLD * 2);
    p.QA = (bf16_t*)take((size_t)MC * 768 * 2);
    p.KN = (bf16_t*)take((size_t)MC * 512 * 2);
    p.VT = (bf16_t*)take((size_t)VTROWS * MC * 2);
    p.O = (bf16_t*)take((size_t)MC * 2048 * 2);
    p.YC = p.O;
    p.MB = p.PJ;
    p.ACT = (bf16_t*)R;
    if (off > ws_size) { fprintf(stderr, "workspace too small: need %zu have %zu\n", off, ws_size); return; }
    (void)hipMemsetAsync(p.barw, 0, (size_t)XCD_BAR_WORDS * 4, stream);
    void* args[] = {&p};
    hipError_t e = hipLaunchCooperativeKernel((void*)mega, dim3(grid_blocks), dim3(512), args, DYN_LDS, stream);
    if (e != hipSuccess) fprintf(stderr, "cooperative launch failed: %s (grid %d)\n", hipGetErrorString(e), grid_blocks);
}
```

```cpp
#include <hip/hip_runtime.h>
#include <hip/hip_cooperative_groups.h>
#include <cstdio>
#include <cstdint>
namespace cg = cooperative_groups;

typedef unsigned short bf16_t;
typedef short bf16x8 __attribute__((ext_vector_type(8)));
typedef short bf16x4 __attribute__((ext_vector_type(4)));
typedef float f32x4 __attribute__((ext_vector_type(4)));
typedef float f32x2 __attribute__((ext_vector_type(2)));
typedef unsigned u32x2 __attribute__((ext_vector_type(2)));
typedef unsigned u32x4 __attribute__((ext_vector_type(4)));
#define DEV __device__ __forceinline__

constexpr int DM = 1024, NBATCH = 16, SEQ = 2048, CTX = 256, DEPTH = 4;
constexpr int NCH = 2, BPC = NBATCH / NCH, LAT_C = BPC * SEQ, CTX_C = BPC * CTX, MC = LAT_C + CTX_C, MTOT = MC * NCH;
constexpr int INC = 7584, NPROJ = 3584, NWIN = 7680, PJLD = 2816, DFF = 2816, VTROWS = 1280;
constexpr float LOG2E = 1.4426950408889634f;
constexpr int LST = 72;
constexpr int TILE_E = 128 * LST;
constexpr int SMEM_BYTES = 4 * TILE_E * 2 + 1024;

struct P {
    const float *x, *c, *ctx, *c_ctx, *w_mod, *b_mod, *g_pre_mix, *g_post_mix, *g_pre_ffn, *g_post_ffn, *w_in, *g_a_q, *g_a_kv,
        *w_a_uq, *w_a_ukv, *sink_b, *rpb_c, *g_d_q, *g_d_k, *w_branch, *w_out, *w_ffn_in, *w_ffn_out;
    float* out;
    bf16_t *WinT, *WuqT, *WukvT, *WbrT, *WoutT, *Wf1T, *Wf2T;
    float* mod; f32x2 *rt16, *rt8; float* hc;
    bf16_t *U, *YC, *PJ, *QA, *KN, *VT, *O, *MB, *ACT;
    unsigned char* G;
    unsigned* barw;
};

typedef __bf16 bf16v2 __attribute__((ext_vector_type(2)));
DEV unsigned pk_bf16(float lo, float hi) { bf16v2 v = __builtin_convertvector((f32x2){lo, hi}, bf16v2); return __builtin_bit_cast(unsigned, v); }
DEV float bf2f(unsigned short v) { return __uint_as_float(((unsigned)v) << 16); }
DEV void store4(bf16_t* p, f32x4 v) { u32x2 w; w.x = pk_bf16(v[0], v[1]); w.y = pk_bf16(v[2], v[3]); *(u32x2*)p = w; }
DEV float fexp2(float x) { return __builtin_amdgcn_exp2f(x); }
DEV float frcp(float x) { return __builtin_amdgcn_rcpf(x); }
DEV float wave_sum(float v) {
    v += __shfl_xor(v, 1); v += __shfl_xor(v, 2); v += __shfl_xor(v, 4); v += __shfl_xor(v, 8); v += __shfl_xor(v, 16); v += __shfl_xor(v, 32); return v;
}
DEV int ltid() { int t = threadIdx.x & 255; asm volatile("" : "+v"(t)); return t; }
DEV int uni(int v) { return __builtin_amdgcn_readfirstlane(v); }
DEV float xmax16(float x) { auto r = __builtin_amdgcn_permlane16_swap(__float_as_uint(x), __float_as_uint(x), false, false); return fmaxf(__uint_as_float(r[0]), __uint_as_float(r[1])); }
DEV float xmax32(float x) { auto r = __builtin_amdgcn_permlane32_swap(__float_as_uint(x), __float_as_uint(x), false, false); return fmaxf(__uint_as_float(r[0]), __uint_as_float(r[1])); }
DEV float xadd16(float x) { auto r = __builtin_amdgcn_permlane16_swap(__float_as_uint(x), __float_as_uint(x), false, false); return __uint_as_float(r[0]) + __uint_as_float(r[1]); }
DEV float xadd32(float x) { auto r = __builtin_amdgcn_permlane32_swap(__float_as_uint(x), __float_as_uint(x), false, false); return __uint_as_float(r[0]) + __uint_as_float(r[1]); }
DEV f32x4 mfma16(bf16x8 a, bf16x8 b, f32x4 c) { return __builtin_amdgcn_mfma_f32_16x16x32_bf16(a, b, c, 0, 0, 0); }

template <int NFT, bool SWAP>
DEV void gemm_mainloop(const bf16_t* __restrict__ A, int lda, const bf16_t* __restrict__ Bt, int ldb, int K, f32x4 (&acc)[NFT][4], bf16_t* sm) {
    const int tid = ltid(), lane = tid & 63, wid = uni(tid >> 6), wm = wid & 1, wn = wid >> 1, fr = lane & 15, fq = lane >> 4;
    unsigned char* sA = (unsigned char*)sm; unsigned char* sB = sA + 2 * 16384;
    const int lrow = tid >> 3, lc8 = (tid & 7) * 8;
    const int wofs = lrow * 128 + (((tid & 7) ^ (lrow & 7)) << 4);
    const bf16_t* ga = A + (size_t)lrow * lda + lc8;
    const bf16_t* gb = Bt + (size_t)lrow * ldb + lc8;
    u32x4 ra[4], rb[NFT];
#pragma unroll
    for (int ft = 0; ft < NFT; ++ft)
#pragma unroll
        for (int tt = 0; tt < 4; ++tt) acc[ft][tt] = (f32x4){0.f, 0.f, 0.f, 0.f};
#pragma unroll
    for (int i = 0; i < 4; ++i) ra[i] = *(const u32x4*)(ga + (size_t)(i * 32) * lda);
#pragma unroll
    for (int i = 0; i < NFT; ++i) rb[i] = *(const u32x4*)(gb + (size_t)(i * 32) * ldb);
#pragma unroll
    for (int i = 0; i < 4; ++i) *(u32x4*)(sA + wofs + i * 4096) = ra[i];
#pragma unroll
    for (int i = 0; i < NFT; ++i) *(u32x4*)(sB + wofs + i * 4096) = rb[i];
    const int nk = K >> 6;
    if (nk > 1) {
#pragma unroll
        for (int i = 0; i < 4; ++i) ra[i] = *(const u32x4*)(ga + (size_t)(i * 32) * lda + 64);
#pragma unroll
        for (int i = 0; i < NFT; ++i) rb[i] = *(const u32x4*)(gb + (size_t)(i * 32) * ldb + 64);
    }
    __syncthreads();
    const int rofs0 = ((0 + fq) ^ (fr & 7)) << 4, rofs1 = ((4 + fq) ^ (fr & 7)) << 4;
    for (int kt = 0; kt < nk; ++kt) {
        const int cur = kt & 1;
        if (kt + 1 < nk) {
            const int nx = cur ^ 1;
#pragma unroll
            for (int i = 0; i < 4; ++i) *(u32x4*)(sA + nx * 16384 + wofs + i * 4096) = ra[i];
#pragma unroll
            for (int i = 0; i < NFT; ++i) *(u32x4*)(sB + nx * 16384 + wofs + i * 4096) = rb[i];
        }
        if (kt + 2 < nk) {
            const int ko = (kt + 2) * 64;
#pragma unroll
            for (int i = 0; i < 4; ++i) ra[i] = *(const u32x4*)(ga + (size_t)(i * 32) * lda + ko);
#pragma unroll
            for (int i = 0; i < NFT; ++i) rb[i] = *(const u32x4*)(gb + (size_t)(i * 32) * ldb + ko);
        }
        __builtin_amdgcn_sched_barrier(0);
        const unsigned char* cA = sA + cur * 16384 + (wm * 64 + fr) * 128;
        const unsigned char* cB = sB + cur * 16384 + (wn * NFT * 16 + fr) * 128;
#pragma unroll
        for (int ks = 0; ks < 2; ++ks) {
            const int ro = ks ? rofs1 : rofs0;
            bf16x8 af[4], wf[NFT];
#pragma unroll
            for (int tt = 0; tt < 4; ++tt) af[tt] = *(const bf16x8*)(cA + tt * 2048 + ro);
#pragma unroll
            for (int ft = 0; ft < NFT; ++ft) wf[ft] = *(const bf16x8*)(cB + ft * 2048 + ro);
#pragma unroll
            for (int ft = 0; ft < NFT; ++ft)
#pragma unroll
                for (int tt = 0; tt < 4; ++tt) acc[ft][tt] = SWAP ? mfma16(af[tt], wf[ft], acc[ft][tt]) : mfma16(wf[ft], af[tt], acc[ft][tt]);
        }
        __syncthreads();
    }
}

DEV bool tile_xcd(int q, int x, int nM, int nN, int& m, int& n) {
    const int j = q >> 5, w = q & 31;
    const int pp = (((j >> 1) * 8 + x) << 1) + (j & 1);
    const int npn = nN >> 2;
    if (pp >= (nM >> 3) * npn) return false;
    const int pm = pp / npn, pn = pp - pm * npn;
    m = pm * 8 + (w & 7); n = pn * 4 + (w >> 3);
    return true;
}
#define TILE_LOOP(nM, nN) const int x_ = bid & 7, spx_ = G >> 3; int mt, nt; for (int q_ = bid >> 3; tile_xcd(q_, x_, nM, nN, mt, nt); q_ += spx_)

DEV int srccol(int mapid, int n) {
    switch (mapid) {
    case 0:
        if (n < 2816) { const int rho = n & 255; n = (n & ~255) + ((rho >> 5) & 3) * 64 + (rho >> 7) * 32 + (rho & 31); }
        if (n < 384) return n;
        if (n < 896) return n - 384 + 416;
        if (n < 1024) return n - 896 + 928;
        if (n < 1536) return n - 1024 + 1184;
        if (n < 2048) return n - 1536 + 1696;
        if (n < 2560) return n - 2048 + 2720;
        if (n < 2688) return n - 2560 + 3232;
        if (n < 2720) return n - 2688 + 384;
        if (n < 2816) return -1;
        if (n < 2944) return n - 2816 + 1056;
        if (n < 3456) return n - 2944 + 2208;
        if (n < 3584) return n - 3456 + 3360;
        return n - 3584 + 3488;
    case 1: if (n < 512) return (n >> 6) * 96 + (n & 63); { const int q = n - 512; return (q >> 5) * 96 + 64 + (q & 31); }
    case 2: if (n < 512) return (n >> 6) * 128 + (n & 63); { const int q = n - 512; return (q >> 6) * 128 + 64 + (q & 63); }
    case 4: { const int pn = n >> 8, bj = (n >> 7) & 1, wc = (n >> 5) & 3, s = (n >> 4) & 1, f = n & 15; return s * DFF + pn * 128 + bj * 64 + wc * 16 + f; }
    default: return n;
    }
}
DEV void conv_tile(const float* __restrict__ src, int lds_, int K, bf16_t* __restrict__ dst, int n0, int k0, int mapid, const float* rowscale, float* st) {
    const int tid = ltid();
    {
        const int n = tid & 63, kk = tid >> 6; const int sc_ = srccol(mapid, n0 + n);
#pragma unroll
        for (int i = 0; i < 16; ++i) {
            const int k = kk * 16 + i;
            float v = sc_ >= 0 ? src[(size_t)(k0 + k) * lds_ + sc_] : 0.f;
            if (rowscale) v *= rowscale[k0 + k];
            st[k * 65 + n] = v;
        }
    }
    __syncthreads();
    {
        const int n = tid >> 2, kq = tid & 3; u32x4 w0, w1;
        const float* s = st + (kq * 16) * 65 + n;
        w0.x = pk_bf16(s[0 * 65], s[1 * 65]); w0.y = pk_bf16(s[2 * 65], s[3 * 65]); w0.z = pk_bf16(s[4 * 65], s[5 * 65]); w0.w = pk_bf16(s[6 * 65], s[7 * 65]);
        w1.x = pk_bf16(s[8 * 65], s[9 * 65]); w1.y = pk_bf16(s[10 * 65], s[11 * 65]); w1.z = pk_bf16(s[12 * 65], s[13 * 65]); w1.w = pk_bf16(s[14 * 65], s[15 * 65]);
        bf16_t* d = dst + (size_t)(n0 + n) * K + k0 + kq * 16;
        *(u32x4*)d = w0; *(u32x4*)(d + 8) = w1;
    }
    __syncthreads();
}
constexpr int CONV_TILES = 4880;
DEV void conv_job(const P& p, int layer, int t, float* st) {
    if (t < 1920) { conv_tile(p.w_in + (size_t)layer * DM * INC, INC, 1024, p.WinT, (t >> 4) * 64, (t & 15) * 64, 0, nullptr, st); return; }
    t -= 1920;
    if (t < 48) { conv_tile(p.w_a_uq + (size_t)layer * 256 * 768, 768, 256, p.WuqT, (t >> 2) * 64, (t & 3) * 64, 1, p.g_a_q + layer * 256, st); return; }
    t -= 48;
    if (t < 32) { conv_tile(p.w_a_ukv + (size_t)layer * 128 * 1024, 1024, 128, p.WukvT, (t >> 1) * 64, (t & 1) * 64, 2, p.g_a_kv + layer * 128, st); return; }
    t -= 32;
    if (t < 512) { conv_tile(p.w_branch + (size_t)layer * 4 * 512 * 1024, 1024, 2048, p.WbrT, (t >> 5) * 64, (t & 31) * 64, 3, nullptr, st); return; }
    t -= 512;
    if (t < 256) { conv_tile(p.w_out + (size_t)layer * 1024 * 1024, 1024, 1024, p.WoutT, (t >> 4) * 64, (t & 15) * 64, 3, nullptr, st); return; }
    t -= 256;
    if (t < 1408) { conv_tile(p.w_ffn_in + (size_t)layer * 1024 * 2 * DFF, 2 * DFF, 1024, p.Wf1T, (t >> 4) * 64, (t & 15) * 64, 4, nullptr, st); return; }
    t -= 1408;
    { const int nt = t / 44, kt = t - nt * 44; conv_tile(p.w_ffn_out + (size_t)layer * DFF * 1024, 1024, DFF, p.Wf2T, nt * 64, kt * 64, 3, nullptr, st); }
}

DEV void mod_item(const P& p, int item, unsigned char* smraw) {
    const int tid = ltid(), lane = tid & 63, wid = uni(tid >> 6);
    float* sc = (float*)smraw;
    const int l = item / 96, cgp = item - l * 96;
    for (int i = tid; i < 17 * 1024; i += 256) {
        const int r = i >> 10, k = i & 1023; const float v = r < 16 ? p.c[r * 1024 + k] : p.c_ctx[k];
        sc[i] = v * frcp(1.f + fexp2(-v * LOG2E));
    }
    __syncthreads();
    float acc[17];
#pragma unroll
    for (int r = 0; r < 17; ++r) acc[r] = 0.f;
    const float* w = p.w_mod + ((size_t)l * 1024 + wid * 256) * 6144 + cgp * 64 + lane;
    for (int k = 0; k < 256; k += 4) {
        const float w0 = w[(size_t)k * 6144], w1 = w[(size_t)(k + 1) * 6144], w2 = w[(size_t)(k + 2) * 6144], w3 = w[(size_t)(k + 3) * 6144];
#pragma unroll
        for (int r = 0; r < 17; ++r) { const f32x4 s = *(const f32x4*)(sc + r * 1024 + wid * 256 + k); acc[r] += s[0] * w0 + s[1] * w1 + s[2] * w2 + s[3] * w3; }
    }
    __syncthreads();
    float* red = (float*)smraw;
#pragma unroll
    for (int r = 0; r < 17; ++r) red[(wid * 17 + r) * 64 + lane] = acc[r];
    __syncthreads();
    for (int i = tid; i < 17 * 64; i += 256) {
        const int r = i >> 6, ci = i & 63;
        const float v = red[(0 * 17 + r) * 64 + ci] + red[(1 * 17 + r) * 64 + ci] + red[(2 * 17 + r) * 64 + ci] + red[(3 * 17 + r) * 64 + ci] + p.b_mod[l * 6144 + cgp * 64 + ci];
        p.mod[((size_t)l * 17 + r) * 6144 + cgp * 64 + ci] = v;
    }
    __syncthreads();
}

DEV void r_phase(const P& p, int mode, int layer, int vb, int VG, int g_lo, int g_hi, bool skipctx = false) {
    const int tid_ = ltid(), lane = tid_ & 63, wid = uni(tid_ >> 6);
    const int nw = VG * 4;
    for (int g = g_lo + vb * 4 + wid; g < g_hi; g += nw) {
        const int ch = g / MC, local = g - ch * MC;
        if (skipctx && local >= LAT_C) continue;
        const float* hin; float* hout; const float* mod;
        if (local < LAT_C) {
            const int idx = ch * LAT_C + local; const int b = idx >> 11;
            hin = (mode == 0 ? p.x : p.out) + (size_t)idx * 1024; hout = p.out + (size_t)idx * 1024; mod = p.mod + ((size_t)layer * 17 + b) * 6144;
        } else {
            const int idx = ch * CTX_C + local - LAT_C;
            hin = (mode == 0 ? p.ctx : p.hc) + (size_t)idx * 1024; hout = p.hc + (size_t)idx * 1024; mod = p.mod + ((size_t)layer * 17 + 16) * 6144;
        }
        f32x4 h[4];
#pragma unroll
        for (int i = 0; i < 4; ++i) h[i] = *(const f32x4*)(hin + (i * 64 + lane) * 4);
        if (mode != 0) {
            f32x4 y[4]; float ss = 0.f;
#pragma unroll
            for (int i = 0; i < 4; ++i) {
                const u32x2 w = *(const u32x2*)((mode == 1 ? p.YC + (size_t)local * 1024 : p.U + (size_t)g * 1024) + (i * 64 + lane) * 4);
                y[i] = (f32x4){__uint_as_float(w.x << 16), __uint_as_float(w.x & 0xffff0000u), __uint_as_float(w.y << 16), __uint_as_float(w.y & 0xffff0000u)};
                ss += y[i][0] * y[i][0] + y[i][1] * y[i][1] + y[i][2] * y[i][2] + y[i][3] * y[i][3];
            }
            ss = wave_sum(ss);
            const float rs = rsqrtf(ss * (1.f / 1024.f) + 1e-6f);
            const float* gp = (mode == 1 ? p.g_post_mix : p.g_post_ffn) + layer * 1024;
            const float* ga = mod + (mode == 1 ? 2048 : 5120);
#pragma unroll
            for (int i = 0; i < 4; ++i) {
                const f32x4 gg = *(const f32x4*)(gp + (i * 64 + lane) * 4), aa = *(const f32x4*)(ga + (i * 64 + lane) * 4);
                h[i] = h[i] + aa * (y[i] * rs * gg);
            }
        }
#pragma unroll
        for (int i = 0; i < 4; ++i) *(f32x4*)(hout + (i * 64 + lane) * 4) = h[i];
        const int nl = (mode == 2) ? layer + 1 : layer;
        if (nl < DEPTH) {
            float ss = 0.f;
#pragma unroll
            for (int i = 0; i < 4; ++i) ss += h[i][0] * h[i][0] + h[i][1] * h[i][1] + h[i][2] * h[i][2] + h[i][3] * h[i][3];
            ss = wave_sum(ss);
            const float rs = rsqrtf(ss * (1.f / 1024.f) + 1e-6f);
            const float* gpre = (mode == 1 ? p.g_pre_ffn : p.g_pre_mix) + nl * 1024;
            const float* modn = (mode == 2) ? mod + 17 * 6144 : mod;
            const float* sh = modn + (mode == 1 ? 3072 : 0);
            const float* sc = modn + (mode == 1 ? 4096 : 1024);
#pragma unroll
            for (int i = 0; i < 4; ++i) {
                const int e = (i * 64 + lane) * 4;
                const f32x4 gg = *(const f32x4*)(gpre + e), s1 = *(const f32x4*)(sc + e), s0 = *(const f32x4*)(sh + e);
                const f32x4 u = h[i] * rs * gg * (s1 + 1.f) + s0;
                store4(p.U + (size_t)g * 1024 + e, u);
            }
        }
    }
}

DEV void gemm1_row(f32x4 (&v)[4], int row, int slab, bool lat, const P& p, int layer, int fq) {
    const bool hnorm = (slab >= 2048 && slab < 2688);
    const bool rope64 = lat && ((slab >= 384 && slab < 1024) || hnorm);
    const bool isq = (slab >= 384 && slab < 896) || (slab >= 1024 && slab < 1536) || (slab >= 2048 && slab < 2560);
    const float sc = isq ? 0.125f * LOG2E : 1.f;
    const bool kr = (slab == 2688);
    const int tok = row & 2047; const int pr = tok >> 6, pc = tok & 63;
    if (hnorm) {
        float ss = 0.f;
#pragma unroll
        for (int ft = 0; ft < 4; ++ft) ss += v[ft][0] * v[ft][0] + v[ft][1] * v[ft][1] + v[ft][2] * v[ft][2] + v[ft][3] * v[ft][3];
        ss += __shfl_xor(ss, 16); ss += __shfl_xor(ss, 32);
        const float rs = rsqrtf(ss * (1.f / 64.f) + 1e-6f);
        const float* g = (slab < 2560 ? p.g_d_q : p.g_d_k) + layer * 64;
#pragma unroll
        for (int ft = 0; ft < 4; ++ft) { const f32x4 gg = *(const f32x4*)(g + ft * 16 + fq * 4); v[ft] = v[ft] * rs * gg; }
    }
    if (rope64) {
#pragma unroll
        for (int j = 0; j < 4; ++j) {
            const int i = fq * 4 + j;
            f32x2 cs = p.rt16[pr * 16 + i]; float a = v[0][j], b = v[1][j];
            v[0][j] = a * cs[0] - b * cs[1]; v[1][j] = b * cs[0] + a * cs[1];
            cs = p.rt16[pc * 16 + i]; a = v[2][j]; b = v[3][j];
            v[2][j] = a * cs[0] - b * cs[1]; v[3][j] = b * cs[0] + a * cs[1];
        }
    }
    if (kr && lat) {
#pragma unroll
        for (int ft = 0; ft < 2; ++ft) {
            const int pos = ft == 0 ? pr : pc;
#pragma unroll
            for (int j = 0; j < 4; ++j) {
                const int i = (fq & 1) * 4 + j; const f32x2 cs = p.rt8[pos * 8 + i];
                const float xv = v[ft][j]; const float o = __shfl_xor(xv, 32);
                v[ft][j] = fq < 2 ? xv * cs[0] - o * cs[1] : xv * cs[0] + o * cs[1];
            }
        }
    }
    bf16_t* dst = p.PJ + (size_t)row * PJLD + slab + fq * 4;
    store4(dst, v[0] * sc); store4(dst + 16, v[1] * sc);
    if (!kr) { store4(dst + 32, v[2] * sc); store4(dst + 48, v[3] * sc); }
}
DEV void stage2_tile(const P& p, int mt, int j, unsigned char* smraw) {
    bf16_t* sm = (bf16_t*)smraw; float* s_rs = (float*)(smraw + 73728);
    const int tid = ltid(), lane = tid & 63, wid = uni(tid >> 6), wm = wid & 1, wn = wid >> 1, fr = lane & 15, fq = lane >> 4;
    const int m0 = mt * 128; const bool isq = j < 6; const bool lat = m0 < LAT_C;
    const int K = isq ? 256 : 128; const int acol = isq ? 0 : 256;
    {
        const int r = tid >> 1, hf = tid & 1; const int n = K >> 1;
        const bf16_t* src = p.PJ + (size_t)(m0 + r) * PJLD + acol + hf * n; float ss = 0.f;
        for (int i = 0; i < n; i += 8) {
            const u32x4 w = *(const u32x4*)(src + i);
#pragma unroll
            for (int q = 0; q < 4; ++q) { const float a = __uint_as_float(w[q] << 16), b = __uint_as_float(w[q] & 0xffff0000u); ss += a * a + b * b; }
        }
        ss += __shfl_xor(ss, 1);
        if (hf == 0) s_rs[r] = rsqrtf(ss / (float)K + 1e-6f);
    }
    __syncthreads();
    f32x4 acc[4][4];
    const bf16_t* A = p.PJ + (size_t)m0 * PJLD + acol;
    if (isq) {
        const int n0 = j * 128;
        gemm_mainloop<4, false>(A, PJLD, p.WuqT + (size_t)n0 * 256, 256, 256, acc, sm);
        const int slab = n0 + wn * 64; const float qs = 0.10206207261596577f * LOG2E;
#pragma unroll
        for (int tt = 0; tt < 4; ++tt) {
            const int lr = wm * 64 + tt * 16 + fr; const int row = m0 + lr; const float rs = s_rs[lr] * qs;
            const int tok = row & 2047; const int pr = tok >> 6, pc = tok & 63;
            f32x4 v[4] = {acc[0][tt], acc[1][tt], acc[2][tt], acc[3][tt]};
            if (slab >= 512 && lat) {
#pragma unroll
                for (int ft = 0; ft < 4; ++ft) {
                    const int pos = (ft & 1) == 0 ? pr : pc;
#pragma unroll
                    for (int jj = 0; jj < 4; ++jj) {
                        const int i = (fq & 1) * 4 + jj; const f32x2 cs = p.rt8[pos * 8 + i];
                        const float xv = v[ft][jj]; const float o = __shfl_xor(xv, 32);
                        v[ft][jj] = fq < 2 ? xv * cs[0] - o * cs[1] : xv * cs[0] + o * cs[1];
                    }
                }
            }
            bf16_t* dst = p.QA + (size_t)row * 768 + slab + fq * 4;
#pragma unroll
            for (int ft = 0; ft < 4; ++ft) store4(dst + ft * 16, v[ft] * rs);
        }
    } else {
        const int n0 = (j - 6) * 128;
        if (n0 < 512) {
            gemm_mainloop<4, false>(A, PJLD, p.WukvT + (size_t)n0 * 128, 128, 128, acc, sm);
#pragma unroll
            for (int tt = 0; tt < 4; ++tt) {
                const int lr = wm * 64 + tt * 16 + fr; const float rs = s_rs[lr];
                bf16_t* dst = p.KN + (size_t)(m0 + lr) * 512 + n0 + wn * 64 + fq * 4;
#pragma unroll
                for (int ft = 0; ft < 4; ++ft) store4(dst + ft * 16, acc[ft][tt] * rs);
            }
        } else {
            gemm_mainloop<4, true>(A, PJLD, p.WukvT + (size_t)n0 * 128, 128, 128, acc, sm);
            const int vrow0 = 768 + (n0 - 512) + wn * 64;
#pragma unroll
            for (int tt = 0; tt < 4; ++tt) {
                const int lr = wm * 64 + tt * 16 + fq * 4;
                const f32x4 rs = *(const f32x4*)(s_rs + lr);
                const int lp = wm * 64 + (tt >> 1) * 32 + fq * 8 + (tt & 1) * 4;
#pragma unroll
                for (int ft = 0; ft < 4; ++ft) store4(p.VT + (size_t)(vrow0 + ft * 16 + fr) * MC + m0 + lp, acc[ft][tt] * rs);
            }
        }
    }
    __syncthreads();
}

template <int MODE>
DEV void attn_item(const P& p, int layer, int item, bool ctxq, unsigned char* smraw) {
    constexpr bool GQA = (MODE == 1 || MODE == 3);
    constexpr int DQK = (MODE == 0) ? 96 : 64, NKS = DQK / 32;
    constexpr int KRB = (MODE == 0) ? 256 : 128, KM = (MODE == 0) ? 15 : 7;
    constexpr int KT_B = 64 * KRB, VT_B = 64 * 128;
    unsigned char* Ks = smraw; unsigned char* Vs = smraw + 32768; float* bias_s = (float*)(smraw + 49152);
    const int tid = ltid(), lane = tid & 63, wid = uni(tid >> 6), fr = lane & 15, fq = lane >> 4;
    const int nqt = ctxq ? (GQA ? 8 : 2) : (GQA ? 64 : 16);
    const int nh = GQA ? 2 : 8;
    const int qt = item % nqt, hh = (item / nqt) % nh, lb = item / (nqt * nh);
    const int head = GQA ? hh * 4 + wid : hh;
    const int tok0 = GQA ? qt * 32 : qt * 128 + wid * 32;
    const int qrow0 = (ctxq ? LAT_C + lb * CTX : lb * SEQ) + tok0;
    bf16x8 qf[2][NKS];
#pragma unroll
    for (int q = 0; q < 2; ++q) {
        const int row = qrow0 + q * 16 + fr;
        if (MODE == 0) {
            qf[q][0] = *(const bf16x8*)(p.QA + (size_t)row * 768 + head * 64 + fq * 8);
            qf[q][1] = *(const bf16x8*)(p.QA + (size_t)row * 768 + head * 64 + 32 + fq * 8);
            qf[q][NKS - 1] = *(const bf16x8*)(p.QA + (size_t)row * 768 + 512 + head * 32 + fq * 8);
        } else {
            const int qoff = MODE == 1 ? 384 : (MODE == 2 ? 1024 : 2048);
#pragma unroll
            for (int ks = 0; ks < NKS; ++ks) qf[q][ks] = *(const bf16x8*)(p.PJ + (size_t)row * PJLD + qoff + head * 64 + ks * 32 + fq * 8);
        }
    }
    const int koff = MODE == 1 ? 896 + hh * 64 : (MODE == 2 ? 1536 + hh * 64 : 2560 + hh * 64);
    const int vrow0 = MODE == 0 ? 768 + hh * 64 : (MODE == 1 ? hh * 64 : (MODE == 2 ? 128 + hh * 64 : 640 + hh * 64));
    int ktlo = 0, nlat = 0;
    if (!ctxq) {
        if (MODE == 0 || MODE == 3) { ktlo = 0; nlat = 32; }
        else if (MODE == 1) { const int q0 = qt * 32; const int lo = max(0, q0 - 128), hi = min(SEQ - 1, q0 + 159); ktlo = lo >> 6; nlat = (hi >> 6) - ktlo + 1; }
        else { const int r0a = min(max(2 * qt - 4, 0), 24), r0b = min(max(2 * qt + 1 - 4, 0), 24); ktlo = r0a; nlat = r0b + 8 - r0a; }
    }
    const int nt = 4 + nlat;
    const int ntf = ctxq ? 4 : ((MODE == 0 || MODE == 3) ? 36 : (MODE == 1 ? 9 : 13));
    if (MODE == 2 && !ctxq) { for (int i = tid; i < 465; i += 256) bias_s[i] = p.rpb_c[(layer * 8 + hh) * 465 + i] * LOG2E; }

    u32x4 rk[NKS], rv[2];
    auto tile_krow = [&](int it) { it = min(it, nt - 1); return it < 4 ? LAT_C + lb * CTX + it * 64 : lb * SEQ + (ktlo + it - 4) * 64; };
    auto gload = [&](int it) {
        const int krow = tile_krow(it);
#pragma unroll
        for (int i = 0; i < NKS; ++i) {
            const int id = tid + i * 256;
            if (MODE == 0) {
                const int key = id / 12, c = id - key * 12;
                const bf16_t* src = c < 8 ? p.KN + (size_t)(krow + key) * 512 + hh * 64 + c * 8 : p.PJ + (size_t)(krow + key) * PJLD + 2688 + (c - 8) * 8;
                rk[i] = *(const u32x4*)src;
            } else {
                const int key = id >> 3, c = id & 7;
                rk[i] = *(const u32x4*)(p.PJ + (size_t)(krow + key) * PJLD + koff + c * 8);
            }
        }
#pragma unroll
        for (int i = 0; i < 2; ++i) { const int id = tid + i * 256; const int dv = id >> 3, c = id & 7; rv[i] = *(const u32x4*)(p.VT + (size_t)(vrow0 + dv) * MC + krow + c * 8); }
    };
    auto lstore = [&](int buf) {
#pragma unroll
        for (int i = 0; i < NKS; ++i) {
            const int id = tid + i * 256; int key, c;
            if (MODE == 0) { key = id / 12; c = id - key * 12; } else { key = id >> 3; c = id & 7; }
            *(u32x4*)(Ks + buf * KT_B + key * KRB + ((c ^ (key & KM)) << 4)) = rk[i];
        }
#pragma unroll
        for (int i = 0; i < 2; ++i) { const int id = tid + i * 256; const int dv = id >> 3, c = id & 7; *(u32x4*)(Vs + buf * VT_B + dv * 128 + ((c ^ (dv & 7)) << 4)) = rv[i]; }
    };

    f32x4 o[4][2], lo[2], negm4[2]; float mref[2];
    const bf16x8 ones8 = __builtin_bit_cast(bf16x8, (u32x4){0x3F803F80u, 0x3F803F80u, 0x3F803F80u, 0x3F803F80u});
#pragma unroll
    for (int q = 0; q < 2; ++q) { mref[q] = 0.f; lo[q] = (f32x4){0.f, 0.f, 0.f, 0.f}; negm4[q] = (f32x4){0.f, 0.f, 0.f, 0.f};
#pragma unroll
        for (int d = 0; d < 4; ++d) o[d][q] = (f32x4){0.f, 0.f, 0.f, 0.f}; }

    gload(0); lstore(0); gload(1); __syncthreads();
    for (int it = 0; it < ntf; ++it) {
        const int cur = it & 1;
        if (it + 1 < ntf) lstore(cur ^ 1);
        if (it + 2 < ntf) gload(it + 2);
        __builtin_amdgcn_sched_barrier(0);
        const int kt = ktlo + it - 4;
        bool active = it < nt;
        int r = 0, r0 = 0;
        if (MODE == 2 && !ctxq && it >= 4) { r = 2 * qt + (wid >> 1); r0 = min(max(r - 4, 0), 24); active = active && (kt >= r0 && kt < r0 + 8); }
        if (active) {
            f32x4 s[4][2];
            const unsigned char* kb = Ks + cur * KT_B + fr * KRB;
            bf16x8 kf[4][NKS];
#pragma unroll
            for (int k4 = 0; k4 < 4; ++k4)
#pragma unroll
                for (int ks = 0; ks < NKS; ++ks) kf[k4][ks] = *(const bf16x8*)(kb + k4 * 16 * KRB + (((ks * 4 + fq) ^ (fr & KM)) << 4));
            __builtin_amdgcn_sched_barrier(0);
#pragma unroll
            for (int k4 = 0; k4 < 4; ++k4) {
#pragma unroll
                for (int q = 0; q < 2; ++q) s[k4][q] = mfma16(kf[k4][0], qf[q][0], negm4[q]);
#pragma unroll
                for (int ks = 1; ks < NKS; ++ks)
#pragma unroll
                    for (int q = 0; q < 2; ++q) s[k4][q] = mfma16(kf[k4][ks], qf[q][ks], s[k4][q]);
            }
            const unsigned char* vb = Vs + cur * VT_B + fr * 128;
            bf16x8 vf[4][2];
#pragma unroll
            for (int d = 0; d < 4; ++d)
#pragma unroll
                for (int kb2 = 0; kb2 < 2; ++kb2) vf[d][kb2] = *(const bf16x8*)(vb + d * 16 * 128 + (((kb2 * 4 + fq) ^ (fr & 7)) << 4));
            __builtin_amdgcn_sched_barrier(0);
            if (!ctxq && it >= 4) {
                if (MODE == 1) {
#pragma unroll
                    for (int q = 0; q < 2; ++q) {
                        const int qpos = tok0 + q * 16 + fr;
#pragma unroll
                        for (int k4 = 0; k4 < 4; ++k4)
#pragma unroll
                            for (int j = 0; j < 4; ++j) { const int d = qpos - (kt * 64 + k4 * 16 + fq * 4 + j); if (d > 128 || d < -128) s[k4][q][j] = -1e30f; }
                    }
                }
                if (MODE == 2) {
#pragma unroll
                    for (int q = 0; q < 2; ++q) {
                        const int qc = (wid & 1) * 32 + q * 16 + fr; const int c0 = min(max(qc - 8, 0), 48);
                        const int bbase = (kt - r + 7) * 31 + 15 - qc;
#pragma unroll
                        for (int k4 = 0; k4 < 4; ++k4)
#pragma unroll
                            for (int j = 0; j < 4; ++j) {
                                const int kc = k4 * 16 + fq * 4 + j; const bool ok = (kc >= c0 && kc < c0 + 16);
                                const float bv = bias_s[ok ? bbase + kc : 0];
                                s[k4][q][j] = ok ? s[k4][q][j] + bv : -1e30f;
                            }
                    }
                }
            }
            bf16x8 pf[2][2];
#pragma unroll
            for (int q = 0; q < 2; ++q) {
                float mx = -1e30f;
#pragma unroll
                for (int k4 = 0; k4 < 4; ++k4) mx = fmaxf(mx, fmaxf(fmaxf(s[k4][q][0], s[k4][q][1]), fmaxf(s[k4][q][2], s[k4][q][3])));
                mx = xmax32(xmax16(mx));
                const bool need = (it == 0) || (mx > 8.f);
                if (__builtin_amdgcn_ballot_w64(need) != 0ull) {
                    const float delta = need ? mx : 0.f;
                    mref[q] += delta; negm4[q] = negm4[q] - delta;
#pragma unroll
                    for (int k4 = 0; k4 < 4; ++k4) s[k4][q] = s[k4][q] - delta;
                    const float alpha = fexp2(-delta);
                    lo[q] = lo[q] * alpha;
#pragma unroll
                    for (int d = 0; d < 4; ++d) o[d][q] = o[d][q] * alpha;
                }
#pragma unroll
                for (int k4 = 0; k4 < 4; ++k4)
#pragma unroll
                    for (int j = 0; j < 4; ++j) s[k4][q][j] = fexp2(s[k4][q][j]);
#pragma unroll
                for (int kb2 = 0; kb2 < 2; ++kb2) {
                    u32x4 w; w.x = pk_bf16(s[2 * kb2][q][0], s[2 * kb2][q][1]); w.y = pk_bf16(s[2 * kb2][q][2], s[2 * kb2][q][3]);
                    w.z = pk_bf16(s[2 * kb2 + 1][q][0], s[2 * kb2 + 1][q][1]); w.w = pk_bf16(s[2 * kb2 + 1][q][2], s[2 * kb2 + 1][q][3]);
                    pf[q][kb2] = __builtin_bit_cast(bf16x8, w);
                }
            }
#pragma unroll
            for (int d = 0; d < 4; ++d)
#pragma unroll
                for (int kb2 = 0; kb2 < 2; ++kb2)
#pragma unroll
                    for (int q = 0; q < 2; ++q) o[d][q] = mfma16(vf[d][kb2], pf[q][kb2], o[d][q]);
#pragma unroll
            for (int kb2 = 0; kb2 < 2; ++kb2)
#pragma unroll
                for (int q = 0; q < 2; ++q) lo[q] = mfma16(ones8, pf[q][kb2], lo[q]);
        }
        __syncthreads();
    }
#pragma unroll
    for (int q = 0; q < 2; ++q) {
        float l = lo[q][0];
        if (MODE == 1) l += fexp2(p.sink_b[layer * 8 + head] * LOG2E - mref[q]);
        const float inv = 1.f / l;
        bf16_t* dst = p.O + (size_t)(qrow0 + q * 16 + fr) * 2048 + MODE * 512 + head * 64 + fq * 4;
#pragma unroll
        for (int d = 0; d < 4; ++d) store4(dst + d * 16, o[d][q] * inv);
    }
}


namespace pg8 {
#define PG8_LAS __attribute__((address_space(3)))
constexpr int BM = 256, BK = 64, HALF = 128, HTB = HALF * BK * 2  , STAGE_BYTES = 8 * HTB, NXCD = 8, WGM = 8;

__host__ __device__ __forceinline__ int lds_byte(int r, int c) { const int st = (r >> 4) * 2 + (c >> 5), rr = r & 15, cc = c & 31, ob = rr * 64 + cc * 2; return st * 1024 + (ob ^ (((ob >> 9) & 1) << 5)); }
__host__ __device__ __forceinline__ void stage_rc(int b, int& R, int& C) { const int st = b / 1024, sb = b % 1024, swz = sb ^ (((sb >> 9) & 1) << 5); R = (st >> 1) * 16 + swz / 64; C = (st & 1) * 32 + (swz % 64) / 2; }
__host__ __device__ __forceinline__ int perm32(int rho) { const int n = rho >> 4, i = rho & 15; return 8 * (i >> 2) + 4 * n + (i & 3); }

struct Unit { int pm, pn; };
struct Gemm { const bf16_t* A; const bf16_t* Bt; int M, N, K; };

template <class Epi, class Sched, bool ALIGN_EPI = false, bool SP2 = false, bool SWAPMMA = false>
__device__ __forceinline__ void gemm_phase(PG8_LAS unsigned char* lds, const Gemm g, const Sched& S, const Epi& E) {
    int tid = threadIdx.x; asm volatile("" : "+v"(tid));
    const int wid = __builtin_amdgcn_readfirstlane(tid >> 6), lane = tid & 63, wr = wid >> 2, wc = wid & 3, fr = lane & 15, fq = lane >> 4;
    const int K = g.K, nt = K / BK;
    unsigned voffA[2], voffB[2];
#pragma unroll
    for (int i = 0; i < 2; ++i) { int R, C; stage_rc(tid * 16 + i * 8192, R, C); const int Rb = Epi::PERM ? ((R & ~31) + perm32(R & 31)) : R;
        voffA[i] = (unsigned)(R * K + C) * 2u; voffB[i] = (unsigned)(Rb * K + C) * 2u; }
    const size_t kstep = (size_t)(BK * 2);
    const size_t hstep = (size_t)HALF * K * 2;
    const size_t tstep = 2 * hstep;
    const unsigned ldsw = (unsigned)wid * 1024u;
    const int aoff = lds_byte(wr * 64 + fr, fq * 8), boff = lds_byte(wc * 32 + fr, fq * 8);
#define PG8_SA(b, h) (((b) * 2 + (h)) * HTB)
#define PG8_SB(b, h) ((4 + (b) * 2 + (h)) * HTB)
#define PG8_STAGE(bufoff, gbase, voff) do { _Pragma("unroll") for (int _i = 0; _i < 2; ++_i) \
        __builtin_amdgcn_global_load_lds((const unsigned*)((const char*)(gbase) + (voff)[_i]), (PG8_LAS unsigned*)(lds + (bufoff) + ldsw + _i * 8192), 16, 0, 0); } while (0)
#define PG8_LDA(dst, b, h) do { _Pragma("unroll") for (int m = 0; m < 4; ++m) _Pragma("unroll") for (int k = 0; k < 2; ++k) dst[m][k] = *(const PG8_LAS bf16x8*)(lds + PG8_SA(b, h) + aoff + m * 2048 + k * 1024); } while (0)
#define PG8_LDB(dst, b, h) do { _Pragma("unroll") for (int n = 0; n < 2; ++n) _Pragma("unroll") for (int k = 0; k < 2; ++k) dst[n][k] = *(const PG8_LAS bf16x8*)(lds + PG8_SB(b, h) + boff + n * 2048 + k * 1024); } while (0)
#define PG8_MMA(ai, bj, At, Bt) do { __builtin_amdgcn_s_setprio(1); _Pragma("unroll") for (int m = 0; m < 4; ++m) _Pragma("unroll") for (int n = 0; n < 2; ++n) _Pragma("unroll") for (int k = 0; k < 2; ++k) \
        acc[ai][bj][m][n] = SWAPMMA ? __builtin_amdgcn_mfma_f32_16x16x32_bf16(At[m][k], Bt[n][k], acc[ai][bj][m][n], 0, 0, 0) : __builtin_amdgcn_mfma_f32_16x16x32_bf16(Bt[n][k], At[m][k], acc[ai][bj][m][n], 0, 0, 0); __builtin_amdgcn_s_setprio(0); } while (0)
#define PG8_WAIT_V(n) asm volatile("s_waitcnt vmcnt(" #n ")" ::: "memory")
#define PG8_WAIT_L(n) asm volatile("s_waitcnt lgkmcnt(" #n ")" ::: "memory")
#define PG8_BAR __builtin_amdgcn_s_barrier()
#define PG8_SCHED __builtin_amdgcn_sched_barrier(0)
    Unit cur, nxt; int ui = 0;
    if (!S.next(0, cur)) return;
    f32x4 acc[2][2][4][2];
#pragma unroll
    for (int a = 0; a < 2; ++a)
#pragma unroll
        for (int b = 0; b < 2; ++b)
#pragma unroll
            for (int m = 0; m < 4; ++m)
#pragma unroll
                for (int n = 0; n < 2; ++n) acc[a][b][m][n] = (f32x4){0.f, 0.f, 0.f, 0.f};
    bf16x8 At[4][2], B0[2][2], B1[2][2];
    const char* cA = (const char*)g.A + (size_t)cur.pm * tstep; const char* cB = (const char*)g.Bt + (size_t)cur.pn * tstep;
    S.a_ready(cur);
    if constexpr (SP2) {
        PG8_STAGE(PG8_SB(0, 0), cB, voffB); PG8_STAGE(PG8_SB(0, 1), cB + hstep, voffB); PG8_STAGE(PG8_SA(0, 0), cA, voffA); PG8_STAGE(PG8_SA(0, 1), cA + hstep, voffA);
        if (wr == 1) PG8_BAR;
        PG8_WAIT_V(2); PG8_BAR;
        PG8_STAGE(PG8_SB(1, 0), cB + kstep, voffB); PG8_STAGE(PG8_SA(1, 0), cA + kstep, voffA); PG8_STAGE(PG8_SB(1, 1), cB + hstep + kstep, voffB);
        PG8_WAIT_V(6); PG8_BAR;
    } else {
        PG8_STAGE(PG8_SB(0, 0), cB, voffB); PG8_STAGE(PG8_SA(0, 0), cA, voffA); PG8_STAGE(PG8_SB(0, 1), cB + hstep, voffB); PG8_STAGE(PG8_SA(0, 1), cA + hstep, voffA);
        if (wr == 1) PG8_BAR;
        PG8_WAIT_V(4); PG8_BAR;
        PG8_STAGE(PG8_SB(1, 0), cB + kstep, voffB); PG8_STAGE(PG8_SA(1, 0), cA + kstep, voffA); PG8_STAGE(PG8_SB(1, 1), cB + hstep + kstep, voffB);
        PG8_WAIT_V(6); PG8_BAR;
    }
    for (;;) {
        const bool has_next = S.next(ui + 1, nxt);
        const char* nA = has_next ? (const char*)g.A + (size_t)nxt.pm * tstep : cA; const char* nB = has_next ? (const char*)g.Bt + (size_t)nxt.pn * tstep : cB;
        for (int t = 0; t < nt; t += 2) {
            if constexpr (Epi::HAS_MID) { if (t != 0 && (t & 7) == 0) { E.mid(acc, cur, t >> 3, wid, lane); asm volatile("s_waitcnt vmcnt(0)" ::: "memory"); } }
            const bool last = (t == nt - 2);
            const char* a1 = cA + (size_t)(t + 1) * kstep;
            const char* a2 = last ? nA : cA + (size_t)(t + 2) * kstep; const char* b2 = last ? nB : cB + (size_t)(t + 2) * kstep;
            const char* a3 = a2 + kstep; const char* b3 = b2 + kstep;
            if (last && has_next) S.a_ready(nxt);
            if constexpr (SP2) {
            PG8_LDB(B0, 0, 0); PG8_LDB(B1, 0, 1); PG8_SCHED; PG8_LDA(At, 0, 0); PG8_STAGE(PG8_SA(1, 1), a1 + hstep, voffA);
            PG8_WAIT_V(8); PG8_WAIT_L(0); PG8_BAR; PG8_MMA(0, 0, At, B0); PG8_MMA(0, 1, At, B1); PG8_BAR; PG8_SCHED;
            PG8_LDA(At, 0, 1); PG8_STAGE(PG8_SB(0, 0), b2, voffB); PG8_STAGE(PG8_SB(0, 1), b2 + hstep, voffB); PG8_STAGE(PG8_SA(0, 0), a2, voffA);
            PG8_WAIT_V(8); PG8_WAIT_L(0); PG8_BAR; PG8_MMA(1, 0, At, B0); PG8_MMA(1, 1, At, B1); PG8_BAR; PG8_SCHED;
            PG8_LDB(B0, 1, 0); PG8_LDB(B1, 1, 1); PG8_SCHED; PG8_LDA(At, 1, 0); PG8_STAGE(PG8_SA(0, 1), a2 + hstep, voffA);
            PG8_WAIT_V(8); PG8_WAIT_L(0); PG8_BAR; PG8_MMA(0, 0, At, B0); PG8_MMA(0, 1, At, B1); PG8_BAR; PG8_SCHED;
            PG8_LDA(At, 1, 1); PG8_STAGE(PG8_SB(1, 0), b3, voffB); PG8_STAGE(PG8_SB(1, 1), b3 + hstep, voffB); PG8_STAGE(PG8_SA(1, 0), a3, voffA);
            PG8_WAIT_V(8); PG8_WAIT_L(0); PG8_BAR; PG8_MMA(1, 0, At, B0); PG8_MMA(1, 1, At, B1); PG8_BAR; PG8_SCHED;
            } else {
            PG8_LDB(B0, 0, 0); PG8_SCHED; PG8_LDA(At, 0, 0); PG8_STAGE(PG8_SA(1, 1), a1 + hstep, voffA);
            PG8_WAIT_L(8); PG8_BAR; PG8_WAIT_L(0); PG8_MMA(0, 0, At, B0); PG8_BAR; PG8_SCHED;
            PG8_LDB(B1, 0, 1); PG8_STAGE(PG8_SB(0, 0), b2, voffB);
            PG8_BAR; PG8_WAIT_L(0); PG8_MMA(0, 1, At, B1); PG8_BAR;
            PG8_LDA(At, 0, 1); PG8_STAGE(PG8_SA(0, 0), a2, voffA);
            PG8_BAR; PG8_WAIT_L(0); PG8_MMA(1, 0, At, B0); PG8_BAR; PG8_SCHED;
            PG8_STAGE(PG8_SB(0, 1), b2 + hstep, voffB);
            PG8_WAIT_V(6); PG8_BAR; PG8_MMA(1, 1, At, B1); PG8_BAR;
            PG8_LDB(B0, 1, 0); PG8_SCHED; PG8_LDA(At, 1, 0); PG8_STAGE(PG8_SA(0, 1), a2 + hstep, voffA);
            PG8_WAIT_L(8); PG8_BAR; PG8_WAIT_L(0); PG8_MMA(0, 0, At, B0); PG8_BAR; PG8_SCHED;
            PG8_LDB(B1, 1, 1); PG8_STAGE(PG8_SB(1, 0), b3, voffB);
            PG8_BAR; PG8_WAIT_L(0); PG8_MMA(0, 1, At, B1); PG8_BAR;
            PG8_LDA(At, 1, 1); PG8_STAGE(PG8_SA(1, 0), a3, voffA);
            PG8_BAR; PG8_WAIT_L(0); PG8_MMA(1, 0, At, B0); PG8_BAR; PG8_SCHED;
            PG8_STAGE(PG8_SB(1, 1), b3 + hstep, voffB);
            PG8_WAIT_V(6); PG8_BAR; PG8_MMA(1, 1, At, B1); PG8_BAR;
            }
        }
        if constexpr (ALIGN_EPI) { if (wr == 0) PG8_BAR; }
        if constexpr (!Epi::AFTER_DRAIN) { E(acc, cur, wr, wc, fr, fq); S.done(cur); }
        if (!has_next) break;
#pragma unroll
        for (int a = 0; a < 2; ++a)
#pragma unroll
            for (int b = 0; b < 2; ++b)
#pragma unroll
                for (int m = 0; m < 4; ++m)
#pragma unroll
                    for (int n = 0; n < 2; ++n) acc[a][b][m][n] = (f32x4){0.f, 0.f, 0.f, 0.f};
        cur = nxt; cA = nA; cB = nB; ++ui;
        if constexpr (ALIGN_EPI) { if (wr == 1) PG8_BAR; }
    }
    PG8_WAIT_V(0);
    if constexpr (!ALIGN_EPI) { if (wr == 0) PG8_BAR; }
    PG8_BAR;
    if constexpr (Epi::AFTER_DRAIN) { E.fused(acc, cur, wr, wc, fr, fq, lds, wid, lane); S.done(cur); }
#undef PG8_SA
#undef PG8_SB
#undef PG8_STAGE
#undef PG8_LDA
#undef PG8_LDB
#undef PG8_MMA
#undef PG8_WAIT_V
#undef PG8_WAIT_L
#undef PG8_BAR
#undef PG8_SCHED
}
}

struct XSched {
    int nN, nunits, G, c, skipctx;
    DEV bool next(int i, pg8::Unit& u) const {
        const int L = i * G + c; if (L >= nunits) return false;
        const int U = ((nunits & 7) == 0 && (G & 7) == 0) ? (L & 7) * (nunits >> 3) + (L >> 3) : L;
        { const int nM = nunits / nN, nig = 4 * nN, gid = U / nig, fm = gid * 4, gsz = min(nM - fm, 4), r = U - gid * nig; u.pm = fm + r % gsz; u.pn = r / gsz; }
        if (skipctx) u.pm = (u.pm >> 6) * 72 + (u.pm & 63);
        return true;
    }
    DEV void a_ready(const pg8::Unit&) const {}
    DEV void done(const pg8::Unit&) const {}
};
struct EpiStoreT {
    static constexpr bool PERM = false, AFTER_DRAIN = false, HAS_MID = false;
    bf16_t* out; int ld; int row_off;
    DEV void operator()(const f32x4 (&acc)[2][2][4][2], const pg8::Unit& u, int wr, int wc, int fr, int fq) const {
#pragma unroll
        for (int ai = 0; ai < 2; ++ai)
#pragma unroll
            for (int m = 0; m < 4; ++m) {
                bf16_t* d = out + (size_t)(row_off + u.pm * 256 + ai * 128 + wr * 64 + m * 16 + fr) * ld + u.pn * 256 + wc * 32 + fq * 4;
#pragma unroll
                for (int bj = 0; bj < 2; ++bj)
#pragma unroll
                    for (int n = 0; n < 2; ++n) store4(d + bj * 128 + n * 16, acc[ai][bj][m][n]);
            }
    }
};
struct EpiSwiglu {
    static constexpr bool PERM = false, AFTER_DRAIN = false, HAS_MID = false;
    bf16_t* act;
    DEV void operator()(const f32x4 (&acc)[2][2][4][2], const pg8::Unit& u, int wr, int wc, int fr, int fq) const {
#pragma unroll
        for (int ai = 0; ai < 2; ++ai)
#pragma unroll
            for (int m = 0; m < 4; ++m) {
                bf16_t* d = act + (size_t)(u.pm * 256 + ai * 128 + wr * 64 + m * 16 + fr) * DFF + u.pn * 128 + wc * 16 + fq * 4;
#pragma unroll
                for (int bj = 0; bj < 2; ++bj) {
                    const f32x4 a = acc[ai][bj][m][0], b = acc[ai][bj][m][1]; f32x4 r;
#pragma unroll
                    for (int j = 0; j < 4; ++j) r[j] = a[j] * frcp(1.f + fexp2(-a[j] * LOG2E)) * b[j];
                    store4(d + bj * 64, r);
                }
            }
    }
};
struct EpiVT {
    static constexpr bool PERM = false, AFTER_DRAIN = false, HAS_MID = false;
    bf16_t* vt;
    DEV void operator()(const f32x4 (&acc)[2][2][4][2], const pg8::Unit& u, int wr, int wc, int fr, int fq) const {
#pragma unroll
        for (int bj = 0; bj < 2; ++bj)
#pragma unroll
            for (int n = 0; n < 2; ++n) {
                bf16_t* d = vt + (size_t)(u.pn * 256 + bj * 128 + wc * 32 + n * 16 + fr) * MC + u.pm * 256 + wr * 64 + fq * 8;
#pragma unroll
                for (int ai = 0; ai < 2; ++ai)
#pragma unroll
                    for (int m = 0; m < 4; ++m) store4(d + ai * 128 + (m >> 1) * 32 + (m & 1) * 4, acc[ai][bj][m][n]);
            }
    }
};
DEV size_t gate_index(int pm, int pn4, int wave, int r8, int lane) { return ((((size_t)pm * 16 + pn4) * 8 + wave) * 8 + r8) * 64 + lane; }
struct EpiGate {
    static constexpr bool PERM = false, AFTER_DRAIN = false, HAS_MID = false;
    u32x4* g8;
    DEV void operator()(const f32x4 (&acc)[2][2][4][2], const pg8::Unit& u, int wr, int wc, int fr, int fq) const {
        const int lane = fq * 16 + fr, wave = wr * 4 + wc;
#pragma unroll
        for (int ai = 0; ai < 2; ++ai)
#pragma unroll
            for (int m = 0; m < 4; ++m) {
                u32x4 w;
#pragma unroll
                for (int bj = 0; bj < 2; ++bj)
#pragma unroll
                    for (int n = 0; n < 2; ++n) {
                        const f32x4 a = acc[ai][bj][m][n]; unsigned x = 0;
#pragma unroll
                        for (int j = 0; j < 4; ++j) { const float s = frcp(1.f + fexp2(-a[j] * LOG2E)); x |= max(1u, (unsigned)(s * 255.f + 0.5f)) << (8 * j); }
                        w[bj * 2 + n] = x;
                    }
                g8[gate_index(u.pm, u.pn, wave, ai * 4 + m, lane)] = w;
            }
    }
};
struct EpiMerge {
    static constexpr bool PERM = false, AFTER_DRAIN = false, HAS_MID = true;
    bf16_t* out; const u32x4* g8;
    DEV void mid(f32x4 (&acc)[2][2][4][2], const pg8::Unit& u, int n, int wave, int lane) const {
#pragma unroll
        for (int ai = 0; ai < 2; ++ai)
#pragma unroll
            for (int m = 0; m < 4; ++m) {
                const u32x4 a = g8[gate_index(u.pm, (n - 1) * 4 + u.pn, wave, ai * 4 + m, lane)], b = g8[gate_index(u.pm, n * 4 + u.pn, wave, ai * 4 + m, lane)];
#pragma unroll
                for (int bj = 0; bj < 2; ++bj)
#pragma unroll
                    for (int nn = 0; nn < 2; ++nn) {
                        const unsigned x = a[bj * 2 + nn], y = b[bj * 2 + nn]; f32x4 r;
#pragma unroll
                        for (int j = 0; j < 4; ++j) r[j] = (float)((x >> (8 * j)) & 255u) * frcp((float)((y >> (8 * j)) & 255u));
                        acc[ai][bj][m][nn] = acc[ai][bj][m][nn] * r;
                    }
            }
    }
    DEV void operator()(const f32x4 (&acc)[2][2][4][2], const pg8::Unit& u, int wr, int wc, int fr, int fq) const {
        const int lane = fq * 16 + fr, wave = wr * 4 + wc;
#pragma unroll
        for (int ai = 0; ai < 2; ++ai)
#pragma unroll
            for (int m = 0; m < 4; ++m) {
                const u32x4 a = g8[gate_index(u.pm, 12 + u.pn, wave, ai * 4 + m, lane)];
                bf16_t* d = out + (size_t)(u.pm * 256 + ai * 128 + wr * 64 + m * 16 + fr) * 1024 + u.pn * 256 + wc * 32 + fq * 4;
#pragma unroll
                for (int bj = 0; bj < 2; ++bj)
#pragma unroll
                    for (int nn = 0; nn < 2; ++nn) {
                        const unsigned x = a[bj * 2 + nn]; f32x4 r;
#pragma unroll
                        for (int j = 0; j < 4; ++j) r[j] = (float)((x >> (8 * j)) & 255u) * (1.f / 255.f);
                        store4(d + bj * 128 + nn * 16, acc[ai][bj][m][nn] * r);
                    }
            }
    }
};
struct EpiGemm1 {
    static constexpr bool PERM = false, AFTER_DRAIN = false, HAS_MID = false;
    const P* pp; int layer;
    DEV void operator()(const f32x4 (&acc)[2][2][4][2], const pg8::Unit& u, int wr, int wc, int fr, int fq) const {
        const int slab = u.pn * 256 + wc * 64; const bool lat = u.pm * 256 < LAT_C;
        if (slab >= 2752) return;
#pragma unroll
        for (int ai = 0; ai < 2; ++ai)
#pragma unroll
            for (int m = 0; m < 4; ++m) {
                f32x4 v[4] = {acc[ai][0][m][0], acc[ai][0][m][1], acc[ai][1][m][0], acc[ai][1][m][1]};
                gemm1_row(v, u.pm * 256 + ai * 128 + wr * 64 + m * 16 + fr, slab, lat, *pp, layer, fq);
            }
    }
};

#define LAS __attribute__((address_space(3)))
#define XB_TMO      128
#define XB_XCNT(j)  (256  + 64 * (j))
#define XB_XSUB(j)  (1280 + 64 * (j))
#define XB_XGEN(j)  (2304 + 64 * (j))
#define XB_TOP      3328
#define XB_TOPGEN   3392
#define XCD_BAR_WORDS 3456
#define XB_SPIN_CAP (1u << 18)

__device__ __forceinline__ unsigned xb_ld(unsigned* p)              { return __hip_atomic_load(p, __ATOMIC_RELAXED, __HIP_MEMORY_SCOPE_AGENT); }
__device__ __forceinline__ unsigned xb_add(unsigned* p, unsigned v) { return __hip_atomic_fetch_add(p, v, __ATOMIC_RELAXED, __HIP_MEMORY_SCOPE_AGENT); }
__device__ __forceinline__ unsigned xb_xcc_id() { return (unsigned)__builtin_amdgcn_s_getreg((3 << 11) | 20) & 0xFu; }
#define XB_SPIN(cond, bar) do { unsigned _sp = 0; while (cond) { __builtin_amdgcn_s_sleep(1); \
    if ((++_sp & 255u) == 0u) { if (xb_ld(&(bar)[XB_TMO])) break; if (_sp > XB_SPIN_CAP) { atomicAdd(&(bar)[XB_TMO], 1u); break; } } } } while (0)

struct XcdBarrier {
    unsigned* bar; unsigned x;
    volatile LAS unsigned* st;
};

__device__ __forceinline__ XcdBarrier xcd_barrier_post(unsigned* bar, volatile LAS unsigned* st) {
    XcdBarrier b; b.bar = bar; b.x = xb_xcc_id(); b.st = st;
    if (threadIdx.x == 0) (void)xb_add(&bar[XB_XCNT(b.x)], 1u);
    return b;
}
__device__ __forceinline__ void xcd_barrier_complete(unsigned* bar, unsigned x, unsigned& nloc, unsigned& nx) {
    const unsigned G = gridDim.x * gridDim.y * gridDim.z;
    unsigned sum, cnt, mine, sp = 0u;
    for (;;) {
        sum = 0u; cnt = 0u; mine = 0u;
#pragma unroll
        for (unsigned j = 0; j < 16; ++j) { const unsigned c = xb_ld(&bar[XB_XCNT(j)]); sum += c; cnt += (c > 0u) ? 1u : 0u; mine = (j == x) ? c : mine; }
        if (sum == G) break;
        __builtin_amdgcn_s_sleep(1);
        if ((++sp & 255u) == 0u) { if (xb_ld(&bar[XB_TMO])) break; if (sp > XB_SPIN_CAP) { atomicAdd(&bar[XB_TMO], 1u); break; } }
    }
    nloc = mine > 0u ? mine : 1u; nx = cnt > 0u ? cnt : 1u;
}

__device__ __forceinline__ void xcd_barrier(const XcdBarrier& b) {
    asm volatile("s_waitcnt vmcnt(0)" ::: "memory");
    __syncthreads();
    if (threadIdx.x == 0) {
        unsigned* bar = b.bar;
        __builtin_amdgcn_s_waitcnt(0);
        unsigned nloc = b.st[0], nx = b.st[1];
        if (nloc == 0u) { xcd_barrier_complete(bar, b.x, nloc, nx); b.st[0] = nloc; b.st[1] = nx; }
        const unsigned old = xb_add(&bar[XB_XSUB(b.x)], 1u);
        const unsigned gen = old / nloc;
        if (old + 1u == (gen + 1u) * nloc) {
            __builtin_amdgcn_fence(__ATOMIC_RELEASE, "agent");
            asm volatile("s_waitcnt vmcnt(0)" ::: "memory");
            const unsigned og = xb_add(&bar[XB_TOP], 1u);
            const unsigned tg = og / nx;
            if (og + 1u == (tg + 1u) * nx) xb_add(&bar[XB_TOPGEN], 1u);
            else XB_SPIN(xb_ld(&bar[XB_TOPGEN]) == tg, bar);
            __builtin_amdgcn_fence(__ATOMIC_ACQUIRE, "agent");
            xb_add(&bar[XB_XGEN(b.x)], 1u);
            asm volatile("s_waitcnt vmcnt(0)" ::: "memory");
        } else {
            XB_SPIN(xb_ld(&bar[XB_XGEN(b.x)]) == gen, bar);
            __builtin_amdgcn_fence(__ATOMIC_ACQUIRE, "agent");
            asm volatile("s_waitcnt vmcnt(0)" ::: "memory");
        }
    }
    __syncthreads();
}

typedef const __attribute__((address_space(4))) P* PP;
#define FRESH_P PP q_ = pp0; asm volatile("" : "+s"(q_)); const P& p = *(const P*)q_;
#define FRESH_BG int bidL = bid, GL = G; asm volatile("" : "+s"(bidL), "+s"(GL));
constexpr int DYN_LDS = 2 * SMEM_BYTES + 64;
__global__ void __launch_bounds__(512, 2) mega(P pv_) {
    cg::grid_group grid = cg::this_grid();
    PP pp0 = (PP)__builtin_amdgcn_kernarg_segment_ptr();
    extern __shared__ __attribute__((aligned(16))) unsigned char lds_dyn[];
    const int half = __builtin_amdgcn_readfirstlane((int)threadIdx.x >> 8);
    unsigned char* smraw = lds_dyn + half * SMEM_BYTES;
    bf16_t* sm = (bf16_t*)smraw;
    PG8_LAS unsigned char* ldsL = (PG8_LAS unsigned char*)lds_dyn;
    const int bid = blockIdx.x, G = gridDim.x, vb = bid * 2 + half, VG = G * 2, tid = threadIdx.x & 255;
    {
        FRESH_P
        volatile LAS unsigned* xst = (volatile LAS unsigned*)(ldsL + 2 * SMEM_BYTES);
        if (threadIdx.x == 0) { xst[0] = 0u; xst[1] = 0u; }
        __syncthreads();
        const XcdBarrier xb0 = xcd_barrier_post(p.barw, xst);
        if (threadIdx.x == 0) xst[2] = xb0.x;
        __syncthreads();
    }
#define GBAR() do { FRESH_P XcdBarrier b_; b_.bar = p.barw; b_.st = (volatile LAS unsigned*)(ldsL + 2 * SMEM_BYTES); b_.x = b_.st[2]; xcd_barrier(b_); } while (0)

    { FRESH_P
    for (int i = vb * 256 + tid; i < 64 * 16 + 64 * 8; i += VG * 256) {
        if (i < 1024) { const int pos = i >> 4, k = i & 15; const float inv = fexp2(-(float)k * (13.287712379549449f / 16.f)); const float a = (float)pos * inv; p.rt16[i] = (f32x2){__cosf(a), __sinf(a)}; }
        else { const int q = i - 1024; const int pos = q >> 3, k = q & 7; const float inv = fexp2(-(float)k * (13.287712379549449f / 8.f)); const float a = (float)pos * inv; p.rt8[q] = (f32x2){__cosf(a), __sinf(a)}; }
    }
    for (int t = vb; t < 384 + CONV_TILES; t += VG) { if (t < 384) mod_item(p, t, smraw); else conv_job(p, 0, t - 384, (float*)smraw); }
    }
    GBAR();
    { FRESH_P r_phase(p, 0, 0, vb, VG, 0, MTOT); }
    GBAR();

    for (int layer = 0; layer < DEPTH; ++layer) {
        const bool lastL = (layer == DEPTH - 1);
        for (int ch = 0; ch < NCH; ++ch) {
            { FRESH_P FRESH_BG
              const bf16_t* A = p.U + (size_t)ch * MC * 1024;
              { pg8::Gemm g{A, p.WinT, MC, 2816, 1024}; XSched S{11, 792, GL, bidL}; EpiGemm1 E{&p, layer};
                pg8::gemm_phase<EpiGemm1, XSched, true, true, false>(ldsL, g, S, E); }
              { pg8::Gemm g{A, p.WinT + (size_t)2816 * 1024, MC, 768, 1024}; XSched S{3, 216, GL, (bidL + GL - (792 % GL)) % GL}; EpiVT E{p.VT};
                pg8::gemm_phase<EpiVT, XSched, true, true, true>(ldsL, g, S, E); }
              { pg8::Gemm g{A, p.WinT + (size_t)NPROJ * 1024, MC, 4096, 1024}; XSched S{16, lastL ? 1024 : 1152, GL, (bidL + GL - (1008 % GL)) % GL}; EpiGate E{(u32x4*)p.G};
                pg8::gemm_phase<EpiGate, XSched, true, true, false>(ldsL, g, S, E); }
            }
            GBAR();
            { FRESH_P for (int t = vb; t < (lastL ? 4064 : 4448); t += VG) {
                if (t < 1024) attn_item<2>(p, layer, t, false, smraw);
                else if (t < 2048) attn_item<1>(p, layer, t - 1024, false, smraw);
                else if (t < 4064) { const int q = t - 2048; stage2_tile(p, q / 14, q % 14, smraw); }
                else if (t < 4192) attn_item<1>(p, layer, t - 4064, true, smraw);
                else if (t < 4320) attn_item<2>(p, layer, t - 4192, true, smraw);
                else attn_item<3>(p, layer, t - 4320, true, smraw);
            } }
            GBAR();
            { FRESH_P for (int t = vb; t < (lastL ? 2048 : 2176); t += VG) {
                if (t < 1024) attn_item<0>(p, layer, t, false, smraw);
                else if (t < 2048) attn_item<3>(p, layer, t - 1024, false, smraw);
                else attn_item<0>(p, layer, t - 2048, true, smraw);
            } }
            GBAR();
            { FRESH_P FRESH_BG pg8::Gemm g{p.O, p.WbrT, MC, 1024, 2048}; XSched S{4, lastL ? 256 : 288, GL, bidL}; EpiMerge E{p.MB, (const u32x4*)p.G};
              pg8::gemm_phase<EpiMerge, XSched, true, true, false>(ldsL, g, S, E); }
            GBAR();
            { FRESH_P FRESH_BG pg8::Gemm g{p.MB, p.WoutT, MC, 1024, 1024}; XSched S{4, lastL ? 256 : 288, GL, bidL}; EpiStoreT E{p.YC, 1024, 0};
              pg8::gemm_phase<EpiStoreT, XSched, true, true, false>(ldsL, g, S, E); }
            GBAR();
            { FRESH_P r_phase(p, 1, layer, vb, VG, ch * MC, ch * MC + (lastL ? LAT_C : MC)); }
            if (ch + 1 == NCH) GBAR();
        }
        { FRESH_P FRESH_BG pg8::Gemm g{p.U, p.Wf1T, MTOT, 2 * DFF, 1024}; XSched S{22, lastL ? 2816 : 3168, GL, bidL, lastL ? 1 : 0}; EpiSwiglu E{p.ACT};
          pg8::gemm_phase<EpiSwiglu, XSched, true, true, false>(ldsL, g, S, E); }
        GBAR();
        { FRESH_P FRESH_BG pg8::Gemm g{p.ACT, p.Wf2T, MTOT, 1024, DFF}; XSched S{4, lastL ? 512 : 576, GL, bidL, lastL ? 1 : 0}; EpiStoreT E{p.U, 1024, 0};
          pg8::gemm_phase<EpiStoreT, XSched, true, true, false>(ldsL, g, S, E); }
        GBAR();
        { FRESH_P r_phase(p, 2, layer, vb, VG, 0, MTOT, lastL);
          if (layer + 1 < DEPTH) { for (int t = vb; t < CONV_TILES; t += VG) conv_job(p, layer + 1, t, (float*)smraw); } }
        GBAR();
    }
}

extern "C" void kernel_launch(void* const* d_in, const int* in_sizes, int n_in, void* d_out, int out_size, void* d_ws, size_t ws_size, hipStream_t stream) {
    static int grid_blocks = 0;
    if (!grid_blocks) {
        int dev = 0, cus = 0, per_cu = 0;
        (void)hipGetDevice(&dev);
        (void)hipDeviceGetAttribute(&cus, hipDeviceAttributeMultiprocessorCount, dev);
        if (hipFuncSetAttribute((const void*)mega, hipFuncAttributeMaxDynamicSharedMemorySize, DYN_LDS) != hipSuccess) fprintf(stderr, "hipFuncSetAttribute failed\n");
        (void)hipOccupancyMaxActiveBlocksPerMultiprocessor(&per_cu, mega, 512, DYN_LDS);
        grid_blocks = cus;
    }
    P p{};
    const float** f = (const float**)&p;
    for (int i = 0; i < 23; ++i) f[i] = (const float*)d_in[i];
    p.out = (float*)d_out;
    unsigned char* w = (unsigned char*)d_ws; size_t off = 0;
    auto take = [&](size_t bytes) { void* r = w + off; off += (bytes + 255) & ~(size_t)255; return r; };
    p.WinT = (bf16_t*)take((size_t)NWIN * 1024 * 2);
    p.WuqT = (bf16_t*)take((size_t)768 * 256 * 2);
    p.WukvT = (bf16_t*)take((size_t)1024 * 128 * 2);
    p.WbrT = (bf16_t*)take((size_t)4 * 1024 * 512 * 2);
    p.WoutT = (bf16_t*)take((size_t)1024 * 1024 * 2);
    p.Wf1T = (bf16_t*)take((size_t)2 * DFF * 1024 * 2);
    p.Wf2T = (bf16_t*)take((size_t)1024 * DFF * 2);
    p.mod = (float*)take((size_t)DEPTH * 17 * 6144 * 4);
    p.rt16 = (f32x2*)take(64 * 16 * 8);
    p.rt8 = (f32x2*)take(64 * 8 * 8);
    p.hc = (float*)take((size_t)NBATCH * CTX * 1024 * 4);
    p.U = (bf16_t*)take((size_t)MTOT * 1024 * 2);
    p.G = (unsigned char*)take((size_t)MC * 4096);
    p.barw = (unsigned*)take((size_t)XCD_BAR_WORDS * 4);
    unsigned char* R = (unsigned char*)take(0);
    p.PJ = (bf16_t*)take((size_t)MC * PJLD * 2);
    p.QA = (bf16_t*)take((size_t)MC * 768 * 2);
    p.KN = (bf16_t*)take((size_t)MC * 512 * 2);
    p.VT = (bf16_t*)take((size_t)VTROWS * MC * 2);
    p.O = (bf16_t*)take((size_t)MC * 2048 * 2);
    p.YC = p.O;
    p.MB = p.PJ;
    p.ACT = (bf16_t*)R;
    if (off > ws_size) { fprintf(stderr, "workspace too small: need %zu have %zu\n", off, ws_size); return; }
    (void)hipMemsetAsync(p.barw, 0, (size_t)XCD_BAR_WORDS * 4, stream);
    void* args[] = {&p};
    hipError_t e = hipLaunchCooperativeKernel((void*)mega, dim3(grid_blocks), dim3(512), args, DYN_LDS, stream);
    if (e != hipSuccess) fprintf(stderr, "cooperative launch failed: %s (grid %d)\n", hipGetErrorString(e), grid_blocks);
}
```

```cpp
#include <hip/hip_runtime.h>
#include <hip/hip_cooperative_groups.h>
#include <cstdio>
#include <cstdint>
namespace cg = cooperative_groups;

typedef unsigned short bf16_t;
typedef short bf16x8 __attribute__((ext_vector_type(8)));
typedef short bf16x4 __attribute__((ext_vector_type(4)));
typedef float f32x4 __attribute__((ext_vector_type(4)));
typedef float f32x2 __attribute__((ext_vector_type(2)));
typedef unsigned u32x2 __attribute__((ext_vector_type(2)));
typedef unsigned u32x4 __attribute__((ext_vector_type(4)));
#define DEV __device__ __forceinline__

constexpr int DM = 1024, NBATCH = 16, SEQ = 2048, CTX = 256, DEPTH = 4;
constexpr int NCH = 2, BPC = NBATCH / NCH, LAT_C = BPC * SEQ, CTX_C = BPC * CTX, MC = LAT_C + CTX_C, MTOT = MC * NCH;
constexpr int INC = 7584, NPROJ = 3584, NWIN = 7680, PJLD = 2816, DFF = 2816, VTROWS = 1280;
constexpr float LOG2E = 1.4426950408889634f;
constexpr int LST = 72;
constexpr int TILE_E = 128 * LST;
constexpr int SMEM_BYTES = 4 * TILE_E * 2 + 1024;

struct P {
    const float *x, *c, *ctx, *c_ctx, *w_mod, *b_mod, *g_pre_mix, *g_post_mix, *g_pre_ffn, *g_post_ffn, *w_in, *g_a_q, *g_a_kv,
        *w_a_uq, *w_a_ukv, *sink_b, *rpb_c, *g_d_q, *g_d_k, *w_branch, *w_out, *w_ffn_in, *w_ffn_out;
    float* out;
    bf16_t *WinT, *WuqT, *WukvT, *WbrT, *WoutT, *Wf1T, *Wf2T;
    float* mod; f32x2 *rt16, *rt8; float* hc;
    bf16_t *U, *YC, *PJ, *QA, *KN, *VT, *O, *MB, *ACT;
    unsigned char* G;
    unsigned* barw;
};

typedef __bf16 bf16v2 __attribute__((ext_vector_type(2)));
DEV unsigned pk_bf16(float lo, float hi) { bf16v2 v = __builtin_convertvector((f32x2){lo, hi}, bf16v2); return __builtin_bit_cast(unsigned, v); }
DEV float bf2f(unsigned short v) { return __uint_as_float(((unsigned)v) << 16); }
DEV void store4(bf16_t* p, f32x4 v) { u32x2 w; w.x = pk_bf16(v[0], v[1]); w.y = pk_bf16(v[2], v[3]); *(u32x2*)p = w; }
DEV void store8x2(bf16_t* g0, f32x4 v0, f32x4 v1, int fq) {
    unsigned ax = pk_bf16(v0[0], v0[1]), ay = pk_bf16(v0[2], v0[3]), bx = pk_bf16(v1[0], v1[1]), by = pk_bf16(v1[2], v1[3]);
    auto rx = __builtin_amdgcn_permlane16_swap(ax, bx, false, false);
    auto ry = __builtin_amdgcn_permlane16_swap(ay, by, false, false);
    u32x4 w; w.x = rx[0]; w.y = ry[0]; w.z = rx[1]; w.w = ry[1];
    *(u32x4*)(g0 + (fq & 1) * 16 + (fq >> 1) * 8) = w;
}
DEV float fexp2(float x) { return __builtin_amdgcn_exp2f(x); }
DEV float frcp(float x) { return __builtin_amdgcn_rcpf(x); }
DEV float wave_sum(float v) {
    v += __shfl_xor(v, 1); v += __shfl_xor(v, 2); v += __shfl_xor(v, 4); v += __shfl_xor(v, 8); v += __shfl_xor(v, 16); v += __shfl_xor(v, 32); return v;
}
DEV int ltid() { int t = threadIdx.x & 255; asm volatile("" : "+v"(t)); return t; }
DEV int uni(int v) { return __builtin_amdgcn_readfirstlane(v); }
DEV float xmax16(float x) { auto r = __builtin_amdgcn_permlane16_swap(__float_as_uint(x), __float_as_uint(x), false, false); return fmaxf(__uint_as_float(r[0]), __uint_as_float(r[1])); }
DEV float xmax32(float x) { auto r = __builtin_amdgcn_permlane32_swap(__float_as_uint(x), __float_as_uint(x), false, false); return fmaxf(__uint_as_float(r[0]), __uint_as_float(r[1])); }
DEV float xadd16(float x) { auto r = __builtin_amdgcn_permlane16_swap(__float_as_uint(x), __float_as_uint(x), false, false); return __uint_as_float(r[0]) + __uint_as_float(r[1]); }
DEV float xadd32(float x) { auto r = __builtin_amdgcn_permlane32_swap(__float_as_uint(x), __float_as_uint(x), false, false); return __uint_as_float(r[0]) + __uint_as_float(r[1]); }
DEV f32x4 mfma16(bf16x8 a, bf16x8 b, f32x4 c) { return __builtin_amdgcn_mfma_f32_16x16x32_bf16(a, b, c, 0, 0, 0); }

template <int NFT, bool SWAP>
DEV void gemm_mainloop(const bf16_t* __restrict__ A, int lda, const bf16_t* __restrict__ Bt, int ldb, int K, f32x4 (&acc)[NFT][4], bf16_t* sm) {
    const int tid = ltid(), lane = tid & 63, wid = uni(tid >> 6), wm = wid & 1, wn = wid >> 1, fr = lane & 15, fq = lane >> 4;
    unsigned char* sA = (unsigned char*)sm; unsigned char* sB = sA + 2 * 16384;
    const int lrow = tid >> 3, lc8 = (tid & 7) * 8;
    const int wofs = lrow * 128 + (((tid & 7) ^ (lrow & 7)) << 4);
    const bf16_t* ga = A + (size_t)lrow * lda + lc8;
    const bf16_t* gb = Bt + (size_t)lrow * ldb + lc8;
    u32x4 ra[4], rb[NFT];
#pragma unroll
    for (int ft = 0; ft < NFT; ++ft)
#pragma unroll
        for (int tt = 0; tt < 4; ++tt) acc[ft][tt] = (f32x4){0.f, 0.f, 0.f, 0.f};
#pragma unroll
    for (int i = 0; i < 4; ++i) ra[i] = *(const u32x4*)(ga + (size_t)(i * 32) * lda);
#pragma unroll
    for (int i = 0; i < NFT; ++i) rb[i] = *(const u32x4*)(gb + (size_t)(i * 32) * ldb);
#pragma unroll
    for (int i = 0; i < 4; ++i) *(u32x4*)(sA + wofs + i * 4096) = ra[i];
#pragma unroll
    for (int i = 0; i < NFT; ++i) *(u32x4*)(sB + wofs + i * 4096) = rb[i];
    const int nk = K >> 6;
    if (nk > 1) {
#pragma unroll
        for (int i = 0; i < 4; ++i) ra[i] = *(const u32x4*)(ga + (size_t)(i * 32) * lda + 64);
#pragma unroll
        for (int i = 0; i < NFT; ++i) rb[i] = *(const u32x4*)(gb + (size_t)(i * 32) * ldb + 64);
    }
    __syncthreads();
    const int rofs0 = ((0 + fq) ^ (fr & 7)) << 4, rofs1 = ((4 + fq) ^ (fr & 7)) << 4;
    for (int kt = 0; kt < nk; ++kt) {
        const int cur = kt & 1;
        if (kt + 1 < nk) {
            const int nx = cur ^ 1;
#pragma unroll
            for (int i = 0; i < 4; ++i) *(u32x4*)(sA + nx * 16384 + wofs + i * 4096) = ra[i];
#pragma unroll
            for (int i = 0; i < NFT; ++i) *(u32x4*)(sB + nx * 16384 + wofs + i * 4096) = rb[i];
        }
        if (kt + 2 < nk) {
            const int ko = (kt + 2) * 64;
#pragma unroll
            for (int i = 0; i < 4; ++i) ra[i] = *(const u32x4*)(ga + (size_t)(i * 32) * lda + ko);
#pragma unroll
            for (int i = 0; i < NFT; ++i) rb[i] = *(const u32x4*)(gb + (size_t)(i * 32) * ldb + ko);
        }
        __builtin_amdgcn_sched_barrier(0);
        const unsigned char* cA = sA + cur * 16384 + (wm * 64 + fr) * 128;
        const unsigned char* cB = sB + cur * 16384 + (wn * NFT * 16 + fr) * 128;
#pragma unroll
        for (int ks = 0; ks < 2; ++ks) {
            const int ro = ks ? rofs1 : rofs0;
            bf16x8 af[4], wf[NFT];
#pragma unroll
            for (int tt = 0; tt < 4; ++tt) af[tt] = *(const bf16x8*)(cA + tt * 2048 + ro);
#pragma unroll
            for (int ft = 0; ft < NFT; ++ft) wf[ft] = *(const bf16x8*)(cB + ft * 2048 + ro);
#pragma unroll
            for (int ft = 0; ft < NFT; ++ft)
#pragma unroll
                for (int tt = 0; tt < 4; ++tt) acc[ft][tt] = SWAP ? mfma16(af[tt], wf[ft], acc[ft][tt]) : mfma16(wf[ft], af[tt], acc[ft][tt]);
        }
        __syncthreads();
    }
}

DEV bool tile_xcd(int q, int x, int nM, int nN, int& m, int& n) {
    const int j = q >> 5, w = q & 31;
    const int pp = (((j >> 1) * 8 + x) << 1) + (j & 1);
    const int npn = nN >> 2;
    if (pp >= (nM >> 3) * npn) return false;
    const int pm = pp / npn, pn = pp - pm * npn;
    m = pm * 8 + (w & 7); n = pn * 4 + (w >> 3);
    return true;
}
#define TILE_LOOP(nM, nN) const int x_ = bid & 7, spx_ = G >> 3; int mt, nt; for (int q_ = bid >> 3; tile_xcd(q_, x_, nM, nN, mt, nt); q_ += spx_)

DEV int srccol(int mapid, int n) {
    switch (mapid) {
    case 0:
        if (n < 2816) { const int rho = n & 255; n = (n & ~255) + ((rho >> 5) & 3) * 64 + (rho >> 7) * 32 + (rho & 31); }
        if (n < 384) return n;
        if (n < 896) return n - 384 + 416;
        if (n < 1024) return n - 896 + 928;
        if (n < 1536) return n - 1024 + 1184;
        if (n < 2048) return n - 1536 + 1696;
        if (n < 2560) return n - 2048 + 2720;
        if (n < 2688) return n - 2560 + 3232;
        if (n < 2720) return n - 2688 + 384;
        if (n < 2816) return -1;
        if (n < 2944) return n - 2816 + 1056;
        if (n < 3456) return n - 2944 + 2208;
        if (n < 3584) return n - 3456 + 3360;
        return n - 3584 + 3488;
    case 1: if (n < 512) return (n >> 6) * 96 + (n & 63); { const int q = n - 512; return (q >> 5) * 96 + 64 + (q & 31); }
    case 2: if (n < 512) return (n >> 6) * 128 + (n & 63); { const int q = n - 512; return (q >> 6) * 128 + 64 + (q & 63); }
    case 4: { const int pn = n >> 8, s = (n >> 7) & 1, wc = (n >> 5) & 3, nn = (n >> 4) & 1, f = n & 15; return s * DFF + pn * 128 + wc * 32 + nn * 16 + f; }
    default: return n;
    }
}
DEV void conv_tile(const float* __restrict__ src, int lds_, int K, bf16_t* __restrict__ dst, int n0, int k0, int mapid, const float* rowscale, float* st) {
    const int tid = ltid();
    {
        const int n = tid & 63, kk = tid >> 6; const int sc_ = srccol(mapid, n0 + n);
#pragma unroll
        for (int i = 0; i < 16; ++i) {
            const int k = kk * 16 + i;
            float v = sc_ >= 0 ? src[(size_t)(k0 + k) * lds_ + sc_] : 0.f;
            if (rowscale) v *= rowscale[k0 + k];
            st[k * 65 + n] = v;
        }
    }
    __syncthreads();
    {
        const int n = tid >> 2, kq = tid & 3; u32x4 w0, w1;
        const float* s = st + (kq * 16) * 65 + n;
        w0.x = pk_bf16(s[0 * 65], s[1 * 65]); w0.y = pk_bf16(s[2 * 65], s[3 * 65]); w0.z = pk_bf16(s[4 * 65], s[5 * 65]); w0.w = pk_bf16(s[6 * 65], s[7 * 65]);
        w1.x = pk_bf16(s[8 * 65], s[9 * 65]); w1.y = pk_bf16(s[10 * 65], s[11 * 65]); w1.z = pk_bf16(s[12 * 65], s[13 * 65]); w1.w = pk_bf16(s[14 * 65], s[15 * 65]);
        bf16_t* d = dst + (size_t)(n0 + n) * K + k0 + kq * 16;
        *(u32x4*)d = w0; *(u32x4*)(d + 8) = w1;
    }
    __syncthreads();
}
constexpr int CONV_TILES = 4880;
DEV void conv_job(const P& p, int layer, int t, float* st) {
    if (t < 1920) { conv_tile(p.w_in + (size_t)layer * DM * INC, INC, 1024, p.WinT, (t >> 4) * 64, (t & 15) * 64, 0, nullptr, st); return; }
    t -= 1920;
    if (t < 48) { conv_tile(p.w_a_uq + (size_t)layer * 256 * 768, 768, 256, p.WuqT, (t >> 2) * 64, (t & 3) * 64, 1, p.g_a_q + layer * 256, st); return; }
    t -= 48;
    if (t < 32) { conv_tile(p.w_a_ukv + (size_t)layer * 128 * 1024, 1024, 128, p.WukvT, (t >> 1) * 64, (t & 1) * 64, 2, p.g_a_kv + layer * 128, st); return; }
    t -= 32;
    if (t < 512) { conv_tile(p.w_branch + (size_t)layer * 4 * 512 * 1024, 1024, 2048, p.WbrT, (t >> 5) * 64, (t & 31) * 64, 3, nullptr, st); return; }
    t -= 512;
    if (t < 256) { conv_tile(p.w_out + (size_t)layer * 1024 * 1024, 1024, 1024, p.WoutT, (t >> 4) * 64, (t & 15) * 64, 3, nullptr, st); return; }
    t -= 256;
    if (t < 1408) { conv_tile(p.w_ffn_in + (size_t)layer * 1024 * 2 * DFF, 2 * DFF, 1024, p.Wf1T, (t >> 4) * 64, (t & 15) * 64, 4, nullptr, st); return; }
    t -= 1408;
    { const int nt = t / 44, kt = t - nt * 44; conv_tile(p.w_ffn_out + (size_t)layer * DFF * 1024, 1024, DFF, p.Wf2T, nt * 64, kt * 64, 3, nullptr, st); }
}

DEV void mod_item(const P& p, int item, unsigned char* smraw) {
    const int tid = ltid(), lane = tid & 63, wid = uni(tid >> 6);
    float* sc = (float*)smraw;
    const int l = item / 96, cgp = item - l * 96;
    for (int i = tid; i < 17 * 1024; i += 256) {
        const int r = i >> 10, k = i & 1023; const float v = r < 16 ? p.c[r * 1024 + k] : p.c_ctx[k];
        sc[i] = v * frcp(1.f + fexp2(-v * LOG2E));
    }
    __syncthreads();
    float acc[17];
#pragma unroll
    for (int r = 0; r < 17; ++r) acc[r] = 0.f;
    const float* w = p.w_mod + ((size_t)l * 1024 + wid * 256) * 6144 + cgp * 64 + lane;
    for (int k = 0; k < 256; k += 4) {
        const float w0 = w[(size_t)k * 6144], w1 = w[(size_t)(k + 1) * 6144], w2 = w[(size_t)(k + 2) * 6144], w3 = w[(size_t)(k + 3) * 6144];
#pragma unroll
        for (int r = 0; r < 17; ++r) { const f32x4 s = *(const f32x4*)(sc + r * 1024 + wid * 256 + k); acc[r] += s[0] * w0 + s[1] * w1 + s[2] * w2 + s[3] * w3; }
    }
    __syncthreads();
    float* red = (float*)smraw;
#pragma unroll
    for (int r = 0; r < 17; ++r) red[(wid * 17 + r) * 64 + lane] = acc[r];
    __syncthreads();
    for (int i = tid; i < 17 * 64; i += 256) {
        const int r = i >> 6, ci = i & 63;
        const float v = red[(0 * 17 + r) * 64 + ci] + red[(1 * 17 + r) * 64 + ci] + red[(2 * 17 + r) * 64 + ci] + red[(3 * 17 + r) * 64 + ci] + p.b_mod[l * 6144 + cgp * 64 + ci];
        p.mod[((size_t)l * 17 + r) * 6144 + cgp * 64 + ci] = v;
    }
    __syncthreads();
}

DEV void r_phase(const P& p, int mode, int layer, int vb, int VG, int g_lo, int g_hi, bool skipctx = false) {
    const int tid_ = ltid(), lane = tid_ & 63, wid = uni(tid_ >> 6);
    const int nw = VG * 4;
    for (int g = g_lo + vb * 4 + wid; g < g_hi; g += nw) {
        const int ch = g / MC, local = g - ch * MC;
        if (skipctx && local >= LAT_C) continue;
        const float* hin; float* hout; const float* mod;
        if (local < LAT_C) {
            const int idx = ch * LAT_C + local; const int b = idx >> 11;
            hin = (mode == 0 ? p.x : p.out) + (size_t)idx * 1024; hout = p.out + (size_t)idx * 1024; mod = p.mod + ((size_t)layer * 17 + b) * 6144;
        } else {
            const int idx = ch * CTX_C + local - LAT_C;
            hin = (mode == 0 ? p.ctx : p.hc) + (size_t)idx * 1024; hout = p.hc + (size_t)idx * 1024; mod = p.mod + ((size_t)layer * 17 + 16) * 6144;
        }
        f32x4 h[4];
#pragma unroll
        for (int i = 0; i < 4; ++i) h[i] = *(const f32x4*)(hin + (i * 64 + lane) * 4);
        if (mode != 0) {
            f32x4 y[4]; float ss = 0.f;
#pragma unroll
            for (int i = 0; i < 4; ++i) {
                const u32x2 w = *(const u32x2*)((mode == 1 ? p.YC + (size_t)local * 1024 : p.U + (size_t)g * 1024) + (i * 64 + lane) * 4);
                y[i] = (f32x4){__uint_as_float(w.x << 16), __uint_as_float(w.x & 0xffff0000u), __uint_as_float(w.y << 16), __uint_as_float(w.y & 0xffff0000u)};
                ss += y[i][0] * y[i][0] + y[i][1] * y[i][1] + y[i][2] * y[i][2] + y[i][3] * y[i][3];
            }
            ss = wave_sum(ss);
            const float rs = rsqrtf(ss * (1.f / 1024.f) + 1e-6f);
            const float* gp = (mode == 1 ? p.g_post_mix : p.g_post_ffn) + layer * 1024;
            const float* ga = mod + (mode == 1 ? 2048 : 5120);
#pragma unroll
            for (int i = 0; i < 4; ++i) {
                const f32x4 gg = *(const f32x4*)(gp + (i * 64 + lane) * 4), aa = *(const f32x4*)(ga + (i * 64 + lane) * 4);
                h[i] = h[i] + aa * (y[i] * rs * gg);
            }
        }
#pragma unroll
        for (int i = 0; i < 4; ++i) *(f32x4*)(hout + (i * 64 + lane) * 4) = h[i];
        const int nl = (mode == 2) ? layer + 1 : layer;
        if (nl < DEPTH) {
            float ss = 0.f;
#pragma unroll
            for (int i = 0; i < 4; ++i) ss += h[i][0] * h[i][0] + h[i][1] * h[i][1] + h[i][2] * h[i][2] + h[i][3] * h[i][3];
            ss = wave_sum(ss);
            const float rs = rsqrtf(ss * (1.f / 1024.f) + 1e-6f);
            const float* gpre = (mode == 1 ? p.g_pre_ffn : p.g_pre_mix) + nl * 1024;
            const float* modn = (mode == 2) ? mod + 17 * 6144 : mod;
            const float* sh = modn + (mode == 1 ? 3072 : 0);
            const float* sc = modn + (mode == 1 ? 4096 : 1024);
#pragma unroll
            for (int i = 0; i < 4; ++i) {
                const int e = (i * 64 + lane) * 4;
                const f32x4 gg = *(const f32x4*)(gpre + e), s1 = *(const f32x4*)(sc + e), s0 = *(const f32x4*)(sh + e);
                const f32x4 u = h[i] * rs * gg * (s1 + 1.f) + s0;
                store4(p.U + (size_t)g * 1024 + e, u);
            }
        }
    }
}

DEV void gemm1_row(f32x4 (&v)[4], int row, int slab, bool lat, const P& p, int layer, int fq) {
    const bool hnorm = (slab >= 2048 && slab < 2688);
    const bool rope64 = lat && ((slab >= 384 && slab < 1024) || hnorm);
    const bool isq = (slab >= 384 && slab < 896) || (slab >= 1024 && slab < 1536) || (slab >= 2048 && slab < 2560);
    const float sc = isq ? 0.125f * LOG2E : 1.f;
    const bool kr = (slab == 2688);
    const int tok = row & 2047; const int pr = tok >> 6, pc = tok & 63;
    if (hnorm) {
        float ss = 0.f;
#pragma unroll
        for (int ft = 0; ft < 4; ++ft) ss += v[ft][0] * v[ft][0] + v[ft][1] * v[ft][1] + v[ft][2] * v[ft][2] + v[ft][3] * v[ft][3];
        ss += __shfl_xor(ss, 16); ss += __shfl_xor(ss, 32);
        const float rs = rsqrtf(ss * (1.f / 64.f) + 1e-6f);
        const float* g = (slab < 2560 ? p.g_d_q : p.g_d_k) + layer * 64;
#pragma unroll
        for (int ft = 0; ft < 4; ++ft) { const f32x4 gg = *(const f32x4*)(g + ft * 16 + fq * 4); v[ft] = v[ft] * rs * gg; }
    }
    if (rope64) {
#pragma unroll
        for (int j = 0; j < 4; ++j) {
            const int i = fq * 4 + j;
            f32x2 cs = p.rt16[pr * 16 + i]; float a = v[0][j], b = v[1][j];
            v[0][j] = a * cs[0] - b * cs[1]; v[1][j] = b * cs[0] + a * cs[1];
            cs = p.rt16[pc * 16 + i]; a = v[2][j]; b = v[3][j];
            v[2][j] = a * cs[0] - b * cs[1]; v[3][j] = b * cs[0] + a * cs[1];
        }
    }
    if (kr && lat) {
#pragma unroll
        for (int ft = 0; ft < 2; ++ft) {
            const int pos = ft == 0 ? pr : pc;
#pragma unroll
            for (int j = 0; j < 4; ++j) {
                const int i = (fq & 1) * 4 + j; const f32x2 cs = p.rt8[pos * 8 + i];
                const float xv = v[ft][j]; const float o = __shfl_xor(xv, 32);
                v[ft][j] = fq < 2 ? xv * cs[0] - o * cs[1] : xv * cs[0] + o * cs[1];
            }
        }
    }
    bf16_t* dst = p.PJ + (size_t)row * PJLD + slab;
    store8x2(dst, v[0] * sc, v[1] * sc, fq);
    if (!kr) store8x2(dst + 32, v[2] * sc, v[3] * sc, fq);
}
DEV void stage2_tile(const P& p, int mt, int j, unsigned char* smraw) {
    bf16_t* sm = (bf16_t*)smraw; float* s_rs = (float*)(smraw + 73728);
    const int tid = ltid(), lane = tid & 63, wid = uni(tid >> 6), wm = wid & 1, wn = wid >> 1, fr = lane & 15, fq = lane >> 4;
    const int m0 = mt * 128; const bool isq = j < 6; const bool lat = m0 < LAT_C;
    const int K = isq ? 256 : 128; const int acol = isq ? 0 : 256;
    {
        const int r = tid >> 1, hf = tid & 1; const int n = K >> 1;
        const bf16_t* src = p.PJ + (size_t)(m0 + r) * PJLD + acol + hf * n; float ss = 0.f;
        for (int i = 0; i < n; i += 8) {
            const u32x4 w = *(const u32x4*)(src + i);
#pragma unroll
            for (int q = 0; q < 4; ++q) { const float a = __uint_as_float(w[q] << 16), b = __uint_as_float(w[q] & 0xffff0000u); ss += a * a + b * b; }
        }
        ss += __shfl_xor(ss, 1);
        if (hf == 0) s_rs[r] = rsqrtf(ss / (float)K + 1e-6f);
    }
    __syncthreads();
    f32x4 acc[4][4];
    const bf16_t* A = p.PJ + (size_t)m0 * PJLD + acol;
    if (isq) {
        const int n0 = j * 128;
        gemm_mainloop<4, false>(A, PJLD, p.WuqT + (size_t)n0 * 256, 256, 256, acc, sm);
        const int slab = n0 + wn * 64; const float qs = 0.10206207261596577f * LOG2E;
#pragma unroll
        for (int tt = 0; tt < 4; ++tt) {
            const int lr = wm * 64 + tt * 16 + fr; const int row = m0 + lr; const float rs = s_rs[lr] * qs;
            const int tok = row & 2047; const int pr = tok >> 6, pc = tok & 63;
            f32x4 v[4] = {acc[0][tt], acc[1][tt], acc[2][tt], acc[3][tt]};
            if (slab >= 512 && lat) {
#pragma unroll
                for (int ft = 0; ft < 4; ++ft) {
                    const int pos = (ft & 1) == 0 ? pr : pc;
#pragma unroll
                    for (int jj = 0; jj < 4; ++jj) {
                        const int i = (fq & 1) * 4 + jj; const f32x2 cs = p.rt8[pos * 8 + i];
                        const float xv = v[ft][jj]; const float o = __shfl_xor(xv, 32);
                        v[ft][jj] = fq < 2 ? xv * cs[0] - o * cs[1] : xv * cs[0] + o * cs[1];
                    }
                }
            }
            bf16_t* dst = p.QA + (size_t)row * 768 + slab;
            store8x2(dst, v[0] * rs, v[1] * rs, fq); store8x2(dst + 32, v[2] * rs, v[3] * rs, fq);
        }
    } else {
        const int n0 = (j - 6) * 128;
        if (n0 < 512) {
            gemm_mainloop<4, false>(A, PJLD, p.WukvT + (size_t)n0 * 128, 128, 128, acc, sm);
#pragma unroll
            for (int tt = 0; tt < 4; ++tt) {
                const int lr = wm * 64 + tt * 16 + fr; const float rs = s_rs[lr];
                bf16_t* dst = p.KN + (size_t)(m0 + lr) * 512 + n0 + wn * 64;
                store8x2(dst, acc[0][tt] * rs, acc[1][tt] * rs, fq); store8x2(dst + 32, acc[2][tt] * rs, acc[3][tt] * rs, fq);
            }
        } else {
            gemm_mainloop<4, true>(A, PJLD, p.WukvT + (size_t)n0 * 128, 128, 128, acc, sm);
            const int vrow0 = 768 + (n0 - 512) + wn * 64;
#pragma unroll
            for (int t2 = 0; t2 < 2; ++t2) {
                const int lr = wm * 64 + t2 * 32 + fq * 4;
                const f32x4 rs0 = *(const f32x4*)(s_rs + lr), rs1 = *(const f32x4*)(s_rs + lr + 16);
                const int lp = wm * 64 + t2 * 32 + fq * 8;
#pragma unroll
                for (int ft = 0; ft < 4; ++ft) {
                    const f32x4 a = acc[ft][2 * t2] * rs0, b = acc[ft][2 * t2 + 1] * rs1;
                    u32x4 w; w.x = pk_bf16(a[0], a[1]); w.y = pk_bf16(a[2], a[3]); w.z = pk_bf16(b[0], b[1]); w.w = pk_bf16(b[2], b[3]);
                    *(u32x4*)(p.VT + (size_t)(vrow0 + ft * 16 + fr) * MC + m0 + lp) = w;
                }
            }
        }
    }
    __syncthreads();
}

template <int MODE>
DEV void attn_item(const P& p, int layer, int item, bool ctxq, unsigned char* smraw) {
    constexpr bool GQA = (MODE == 1 || MODE == 3);
    constexpr int DQK = (MODE == 0) ? 96 : 64, NKS = DQK / 32;
    constexpr int KRB = (MODE == 0) ? 256 : 128, KM = (MODE == 0) ? 15 : 7;
    constexpr int KT_B = 64 * KRB, VT_B = 64 * 128;
    unsigned char* Ks = smraw; unsigned char* Vs = smraw + 32768; float* bias_s = (float*)(smraw + 49152);
    const int tid = ltid(), lane = tid & 63, wid = uni(tid >> 6), fr = lane & 15, fq = lane >> 4;
    const int nqt = ctxq ? (GQA ? 8 : 2) : (GQA ? 64 : 16);
    const int nh = GQA ? 2 : 8;
    const int qt = item % nqt, hh = (item / nqt) % nh, lb = item / (nqt * nh);
    const int head = GQA ? hh * 4 + wid : hh;
    const int tok0 = GQA ? qt * 32 : qt * 128 + wid * 32;
    const int qrow0 = (ctxq ? LAT_C + lb * CTX : lb * SEQ) + tok0;
    bf16x8 qf[2][NKS];
#pragma unroll
    for (int q = 0; q < 2; ++q) {
        const int row = qrow0 + q * 16 + fr;
        if (MODE == 0) {
            qf[q][0] = *(const bf16x8*)(p.QA + (size_t)row * 768 + head * 64 + fq * 8);
            qf[q][1] = *(const bf16x8*)(p.QA + (size_t)row * 768 + head * 64 + 32 + fq * 8);
            qf[q][NKS - 1] = *(const bf16x8*)(p.QA + (size_t)row * 768 + 512 + head * 32 + fq * 8);
        } else {
            const int qoff = MODE == 1 ? 384 : (MODE == 2 ? 1024 : 2048);
#pragma unroll
            for (int ks = 0; ks < NKS; ++ks) qf[q][ks] = *(const bf16x8*)(p.PJ + (size_t)row * PJLD + qoff + head * 64 + ks * 32 + fq * 8);
        }
    }
    const int koff = MODE == 1 ? 896 + hh * 64 : (MODE == 2 ? 1536 + hh * 64 : 2560 + hh * 64);
    const int vrow0 = MODE == 0 ? 768 + hh * 64 : (MODE == 1 ? hh * 64 : (MODE == 2 ? 128 + hh * 64 : 640 + hh * 64));
    int ktlo = 0, nlat = 0;
    if (!ctxq) {
        if (MODE == 0 || MODE == 3) { ktlo = 0; nlat = 32; }
        else if (MODE == 1) { const int q0 = qt * 32; const int lo = max(0, q0 - 128), hi = min(SEQ - 1, q0 + 159); ktlo = lo >> 6; nlat = (hi >> 6) - ktlo + 1; }
        else { const int r0a = min(max(2 * qt - 4, 0), 24), r0b = min(max(2 * qt + 1 - 4, 0), 24); ktlo = r0a; nlat = r0b + 8 - r0a; }
    }
    const int nt = 4 + nlat;
    const int ntf = ctxq ? 4 : ((MODE == 0 || MODE == 3) ? 36 : (MODE == 1 ? 9 : 13));
    if (MODE == 2 && !ctxq) { for (int i = tid; i < 465; i += 256) bias_s[i] = p.rpb_c[(layer * 8 + hh) * 465 + i] * LOG2E; }

    u32x4 rk[NKS], rv[2];
    auto tile_krow = [&](int it) { it = min(it, nt - 1); return it < 4 ? LAT_C + lb * CTX + it * 64 : lb * SEQ + (ktlo + it - 4) * 64; };
    auto gload = [&](int it) {
        const int krow = tile_krow(it);
#pragma unroll
        for (int i = 0; i < NKS; ++i) {
            const int id = tid + i * 256;
            if (MODE == 0) {
                const int key = id / 12, c = id - key * 12;
                const bf16_t* src = c < 8 ? p.KN + (size_t)(krow + key) * 512 + hh * 64 + c * 8 : p.PJ + (size_t)(krow + key) * PJLD + 2688 + (c - 8) * 8;
                rk[i] = *(const u32x4*)src;
            } else {
                const int key = id >> 3, c = id & 7;
                rk[i] = *(const u32x4*)(p.PJ + (size_t)(krow + key) * PJLD + koff + c * 8);
            }
        }
#pragma unroll
        for (int i = 0; i < 2; ++i) { const int id = tid + i * 256; const int dv = id >> 3, c = id & 7; rv[i] = *(const u32x4*)(p.VT + (size_t)(vrow0 + dv) * MC + krow + c * 8); }
    };
    auto lstore = [&](int buf) {
#pragma unroll
        for (int i = 0; i < NKS; ++i) {
            const int id = tid + i * 256; int key, c;
            if (MODE == 0) { key = id / 12; c = id - key * 12; } else { key = id >> 3; c = id & 7; }
            *(u32x4*)(Ks + buf * KT_B + key * KRB + ((c ^ (key & KM)) << 4)) = rk[i];
        }
#pragma unroll
        for (int i = 0; i < 2; ++i) { const int id = tid + i * 256; const int dv = id >> 3, c = id & 7; *(u32x4*)(Vs + buf * VT_B + dv * 128 + ((c ^ (dv & 7)) << 4)) = rv[i]; }
    };

    f32x4 o[4][2], lo[2], negm4[2]; float mref[2];
    const bf16x8 ones8 = __builtin_bit_cast(bf16x8, (u32x4){0x3F803F80u, 0x3F803F80u, 0x3F803F80u, 0x3F803F80u});
#pragma unroll
    for (int q = 0; q < 2; ++q) { mref[q] = 0.f; lo[q] = (f32x4){0.f, 0.f, 0.f, 0.f}; negm4[q] = (f32x4){0.f, 0.f, 0.f, 0.f};
#pragma unroll
        for (int d = 0; d < 4; ++d) o[d][q] = (f32x4){0.f, 0.f, 0.f, 0.f}; }

    gload(0); lstore(0); gload(1); __syncthreads();
    for (int it = 0; it < ntf; ++it) {
        const int cur = it & 1;
        if (it + 1 < ntf) lstore(cur ^ 1);
        if (it + 2 < ntf) gload(it + 2);
        __builtin_amdgcn_sched_barrier(0);
        const int kt = ktlo + it - 4;
        bool active = it < nt;
        int r = 0, r0 = 0;
        if (MODE == 2 && !ctxq && it >= 4) { r = 2 * qt + (wid >> 1); r0 = min(max(r - 4, 0), 24); active = active && (kt >= r0 && kt < r0 + 8); }
        if (active) {
            f32x4 s[4][2];
            const unsigned char* kb = Ks + cur * KT_B + fr * KRB;
            bf16x8 kf[4][NKS];
#pragma unroll
            for (int k4 = 0; k4 < 4; ++k4)
#pragma unroll
                for (int ks = 0; ks < NKS; ++ks) kf[k4][ks] = *(const bf16x8*)(kb + k4 * 16 * KRB + (((ks * 4 + fq) ^ (fr & KM)) << 4));
            __builtin_amdgcn_sched_barrier(0);
#pragma unroll
            for (int k4 = 0; k4 < 4; ++k4) {
#pragma unroll
                for (int q = 0; q < 2; ++q) s[k4][q] = mfma16(kf[k4][0], qf[q][0], negm4[q]);
#pragma unroll
                for (int ks = 1; ks < NKS; ++ks)
#pragma unroll
                    for (int q = 0; q < 2; ++q) s[k4][q] = mfma16(kf[k4][ks], qf[q][ks], s[k4][q]);
            }
            const unsigned char* vb = Vs + cur * VT_B + fr * 128;
            bf16x8 vf[4][2];
#pragma unroll
            for (int d = 0; d < 4; ++d)
#pragma unroll
                for (int kb2 = 0; kb2 < 2; ++kb2) vf[d][kb2] = *(const bf16x8*)(vb + d * 16 * 128 + (((kb2 * 4 + fq) ^ (fr & 7)) << 4));
            __builtin_amdgcn_sched_barrier(0);
            if (!ctxq && it >= 4) {
                if (MODE == 1) {
#pragma unroll
                    for (int q = 0; q < 2; ++q) {
                        const int qpos = tok0 + q * 16 + fr;
#pragma unroll
                        for (int k4 = 0; k4 < 4; ++k4)
#pragma unroll
                            for (int j = 0; j < 4; ++j) { const int d = qpos - (kt * 64 + k4 * 16 + fq * 4 + j); if (d > 128 || d < -128) s[k4][q][j] = -1e30f; }
                    }
                }
                if (MODE == 2) {
#pragma unroll
                    for (int q = 0; q < 2; ++q) {
                        const int qc = (wid & 1) * 32 + q * 16 + fr; const int c0 = min(max(qc - 8, 0), 48);
                        const int bbase = (kt - r + 7) * 31 + 15 - qc;
#pragma unroll
                        for (int k4 = 0; k4 < 4; ++k4)
#pragma unroll
                            for (int j = 0; j < 4; ++j) {
                                const int kc = k4 * 16 + fq * 4 + j; const bool ok = (kc >= c0 && kc < c0 + 16);
                                const float bv = bias_s[ok ? bbase + kc : 0];
                                s[k4][q][j] = ok ? s[k4][q][j] + bv : -1e30f;
                            }
                    }
                }
            }
            bf16x8 pf[2][2];
#pragma unroll
            for (int q = 0; q < 2; ++q) {
                float mx = -1e30f;
#pragma unroll
                for (int k4 = 0; k4 < 4; ++k4) mx = fmaxf(mx, fmaxf(fmaxf(s[k4][q][0], s[k4][q][1]), fmaxf(s[k4][q][2], s[k4][q][3])));
                mx = xmax32(xmax16(mx));
                const bool need = (it == 0) || (mx > 8.f);
                if (__builtin_amdgcn_ballot_w64(need) != 0ull) {
                    const float delta = need ? mx : 0.f;
                    mref[q] += delta; negm4[q] = negm4[q] - delta;
#pragma unroll
                    for (int k4 = 0; k4 < 4; ++k4) s[k4][q] = s[k4][q] - delta;
                    const float alpha = fexp2(-delta);
                    lo[q] = lo[q] * alpha;
#pragma unroll
                    for (int d = 0; d < 4; ++d) o[d][q] = o[d][q] * alpha;
                }
#pragma unroll
                for (int k4 = 0; k4 < 4; ++k4)
#pragma unroll
                    for (int j = 0; j < 4; ++j) s[k4][q][j] = fexp2(s[k4][q][j]);
#pragma unroll
                for (int kb2 = 0; kb2 < 2; ++kb2) {
                    u32x4 w; w.x = pk_bf16(s[2 * kb2][q][0], s[2 * kb2][q][1]); w.y = pk_bf16(s[2 * kb2][q][2], s[2 * kb2][q][3]);
                    w.z = pk_bf16(s[2 * kb2 + 1][q][0], s[2 * kb2 + 1][q][1]); w.w = pk_bf16(s[2 * kb2 + 1][q][2], s[2 * kb2 + 1][q][3]);
                    pf[q][kb2] = __builtin_bit_cast(bf16x8, w);
                }
            }
#pragma unroll
            for (int d = 0; d < 4; ++d)
#pragma unroll
                for (int kb2 = 0; kb2 < 2; ++kb2)
#pragma unroll
                    for (int q = 0; q < 2; ++q) o[d][q] = mfma16(vf[d][kb2], pf[q][kb2], o[d][q]);
#pragma unroll
            for (int kb2 = 0; kb2 < 2; ++kb2)
#pragma unroll
                for (int q = 0; q < 2; ++q) lo[q] = mfma16(ones8, pf[q][kb2], lo[q]);
        }
        __syncthreads();
    }
#pragma unroll
    for (int q = 0; q < 2; ++q) {
        float l = lo[q][0];
        if (MODE == 1) l += fexp2(p.sink_b[layer * 8 + head] * LOG2E - mref[q]);
        const float inv = 1.f / l;
        bf16_t* dst = p.O + (size_t)(qrow0 + q * 16 + fr) * 2048 + MODE * 512 + head * 64;
        store8x2(dst, o[0][q] * inv, o[1][q] * inv, fq); store8x2(dst + 32, o[2][q] * inv, o[3][q] * inv, fq);
    }
}


namespace pg8 {
#define PG8_LAS __attribute__((address_space(3)))
constexpr int BM = 256, BK = 64, HALF = 128, HTB = HALF * BK * 2  , STAGE_BYTES = 8 * HTB, NXCD = 8, WGM = 8;

__host__ __device__ __forceinline__ int lds_byte(int r, int c) { const int st = (r >> 4) * 2 + (c >> 5), rr = r & 15, cc = c & 31, ob = rr * 64 + cc * 2; return st * 1024 + (ob ^ (((ob >> 9) & 1) << 5)); }
__host__ __device__ __forceinline__ void stage_rc(int b, int& R, int& C) { const int st = b / 1024, sb = b % 1024, swz = sb ^ (((sb >> 9) & 1) << 5); R = (st >> 1) * 16 + swz / 64; C = (st & 1) * 32 + (swz % 64) / 2; }
__host__ __device__ __forceinline__ int perm32(int rho) { const int n = rho >> 4, i = rho & 15; return 8 * (i >> 2) + 4 * n + (i & 3); }

struct Unit { int pm, pn; };
struct Gemm { const bf16_t* A; const bf16_t* Bt; int M, N, K; };

template <class Epi, class Sched, bool ALIGN_EPI = false, bool SP2 = false, bool SWAPMMA = false>
__device__ __forceinline__ void gemm_phase(PG8_LAS unsigned char* lds, const Gemm g, const Sched& S, const Epi& E) {
    int tid = threadIdx.x; asm volatile("" : "+v"(tid));
    const int wid = __builtin_amdgcn_readfirstlane(tid >> 6), lane = tid & 63, wr = wid >> 2, wc = wid & 3, fr = lane & 15, fq = lane >> 4;
    const int K = g.K, nt = K / BK;
    unsigned voffA[2], voffB[2];
#pragma unroll
    for (int i = 0; i < 2; ++i) { int R, C; stage_rc(tid * 16 + i * 8192, R, C); const int Rb = Epi::PERM ? ((R & ~31) + perm32(R & 31)) : R;
        voffA[i] = (unsigned)(R * K + C) * 2u; voffB[i] = (unsigned)(Rb * K + C) * 2u; }
    const size_t kstep = (size_t)(BK * 2);
    const size_t hstep = (size_t)HALF * K * 2;
    const size_t tstep = 2 * hstep;
    const unsigned ldsw = (unsigned)wid * 1024u;
    const int aoff = lds_byte(wr * 64 + fr, fq * 8), boff = lds_byte(wc * 32 + fr, fq * 8);
#define PG8_SA(b, h) (((b) * 2 + (h)) * HTB)
#define PG8_SB(b, h) ((4 + (b) * 2 + (h)) * HTB)
#define PG8_STAGE(bufoff, gbase, voff) do { _Pragma("unroll") for (int _i = 0; _i < 2; ++_i) \
        __builtin_amdgcn_global_load_lds((const unsigned*)((const char*)(gbase) + (voff)[_i]), (PG8_LAS unsigned*)(lds + (bufoff) + ldsw + _i * 8192), 16, 0, 0); } while (0)
#define PG8_LDA(dst, b, h) do { _Pragma("unroll") for (int m = 0; m < 4; ++m) _Pragma("unroll") for (int k = 0; k < 2; ++k) dst[m][k] = *(const PG8_LAS bf16x8*)(lds + PG8_SA(b, h) + aoff + m * 2048 + k * 1024); } while (0)
#define PG8_LDB(dst, b, h) do { _Pragma("unroll") for (int n = 0; n < 2; ++n) _Pragma("unroll") for (int k = 0; k < 2; ++k) dst[n][k] = *(const PG8_LAS bf16x8*)(lds + PG8_SB(b, h) + boff + n * 2048 + k * 1024); } while (0)
#define PG8_MMA(ai, bj, At, Bt) do { __builtin_amdgcn_s_setprio(1); _Pragma("unroll") for (int m = 0; m < 4; ++m) _Pragma("unroll") for (int n = 0; n < 2; ++n) _Pragma("unroll") for (int k = 0; k < 2; ++k) \
        acc[ai][bj][m][n] = SWAPMMA ? __builtin_amdgcn_mfma_f32_16x16x32_bf16(At[m][k], Bt[n][k], acc[ai][bj][m][n], 0, 0, 0) : __builtin_amdgcn_mfma_f32_16x16x32_bf16(Bt[n][k], At[m][k], acc[ai][bj][m][n], 0, 0, 0); __builtin_amdgcn_s_setprio(0); } while (0)
#define PG8_WAIT_V(n) asm volatile("s_waitcnt vmcnt(" #n ")" ::: "memory")
#define PG8_WAIT_L(n) asm volatile("s_waitcnt lgkmcnt(" #n ")" ::: "memory")
#define PG8_BAR __builtin_amdgcn_s_barrier()
#define PG8_SCHED __builtin_amdgcn_sched_barrier(0)
    Unit cur, nxt; int ui = 0;
    if (!S.next(0, cur)) return;
    f32x4 acc[2][2][4][2];
#pragma unroll
    for (int a = 0; a < 2; ++a)
#pragma unroll
        for (int b = 0; b < 2; ++b)
#pragma unroll
            for (int m = 0; m < 4; ++m)
#pragma unroll
                for (int n = 0; n < 2; ++n) acc[a][b][m][n] = (f32x4){0.f, 0.f, 0.f, 0.f};
    bf16x8 At[4][2], B0[2][2], B1[2][2];
    const char* cA = (const char*)g.A + (size_t)cur.pm * tstep; const char* cB = (const char*)g.Bt + (size_t)cur.pn * tstep;
    S.a_ready(cur);
    if constexpr (SP2) {
        PG8_STAGE(PG8_SB(0, 0), cB, voffB); PG8_STAGE(PG8_SB(0, 1), cB + hstep, voffB); PG8_STAGE(PG8_SA(0, 0), cA, voffA); PG8_STAGE(PG8_SA(0, 1), cA + hstep, voffA);
        if (wr == 1) PG8_BAR;
        PG8_WAIT_V(2); PG8_BAR;
        PG8_STAGE(PG8_SB(1, 0), cB + kstep, voffB); PG8_STAGE(PG8_SA(1, 0), cA + kstep, voffA); PG8_STAGE(PG8_SB(1, 1), cB + hstep + kstep, voffB);
        PG8_WAIT_V(6); PG8_BAR;
    } else {
        PG8_STAGE(PG8_SB(0, 0), cB, voffB); PG8_STAGE(PG8_SA(0, 0), cA, voffA); PG8_STAGE(PG8_SB(0, 1), cB + hstep, voffB); PG8_STAGE(PG8_SA(0, 1), cA + hstep, voffA);
        if (wr == 1) PG8_BAR;
        PG8_WAIT_V(4); PG8_BAR;
        PG8_STAGE(PG8_SB(1, 0), cB + kstep, voffB); PG8_STAGE(PG8_SA(1, 0), cA + kstep, voffA); PG8_STAGE(PG8_SB(1, 1), cB + hstep + kstep, voffB);
        PG8_WAIT_V(6); PG8_BAR;
    }
    for (;;) {
        const bool has_next = S.next(ui + 1, nxt);
        const char* nA = has_next ? (const char*)g.A + (size_t)nxt.pm * tstep : cA; const char* nB = has_next ? (const char*)g.Bt + (size_t)nxt.pn * tstep : cB;
        for (int t = 0; t < nt; t += 2) {
            if constexpr (Epi::HAS_MID) { if (t != 0 && (t & 7) == 0) { E.mid(acc, cur, t >> 3, wid, lane); asm volatile("s_waitcnt vmcnt(0)" ::: "memory"); } }
            const bool last = (t == nt - 2);
            const char* a1 = cA + (size_t)(t + 1) * kstep;
            const char* a2 = last ? nA : cA + (size_t)(t + 2) * kstep; const char* b2 = last ? nB : cB + (size_t)(t + 2) * kstep;
            const char* a3 = a2 + kstep; const char* b3 = b2 + kstep;
            if (last && has_next) S.a_ready(nxt);
            if constexpr (SP2) {
            PG8_LDB(B0, 0, 0); PG8_LDB(B1, 0, 1); PG8_SCHED; PG8_LDA(At, 0, 0); PG8_STAGE(PG8_SA(1, 1), a1 + hstep, voffA);
            PG8_WAIT_V(8); PG8_WAIT_L(0); PG8_BAR; PG8_MMA(0, 0, At, B0); PG8_MMA(0, 1, At, B1); PG8_BAR; PG8_SCHED;
            PG8_LDA(At, 0, 1); PG8_STAGE(PG8_SB(0, 0), b2, voffB); PG8_STAGE(PG8_SB(0, 1), b2 + hstep, voffB); PG8_STAGE(PG8_SA(0, 0), a2, voffA);
            PG8_WAIT_V(8); PG8_WAIT_L(0); PG8_BAR; PG8_MMA(1, 0, At, B0); PG8_MMA(1, 1, At, B1); PG8_BAR; PG8_SCHED;
            PG8_LDB(B0, 1, 0); PG8_LDB(B1, 1, 1); PG8_SCHED; PG8_LDA(At, 1, 0); PG8_STAGE(PG8_SA(0, 1), a2 + hstep, voffA);
            PG8_WAIT_V(8); PG8_WAIT_L(0); PG8_BAR; PG8_MMA(0, 0, At, B0); PG8_MMA(0, 1, At, B1); PG8_BAR; PG8_SCHED;
            PG8_LDA(At, 1, 1); PG8_STAGE(PG8_SB(1, 0), b3, voffB); PG8_STAGE(PG8_SB(1, 1), b3 + hstep, voffB); PG8_STAGE(PG8_SA(1, 0), a3, voffA);
            PG8_WAIT_V(8); PG8_WAIT_L(0); PG8_BAR; PG8_MMA(1, 0, At, B0); PG8_MMA(1, 1, At, B1); PG8_BAR; PG8_SCHED;
            } else {
            PG8_LDB(B0, 0, 0); PG8_SCHED; PG8_LDA(At, 0, 0); PG8_STAGE(PG8_SA(1, 1), a1 + hstep, voffA);
            PG8_WAIT_L(8); PG8_BAR; PG8_WAIT_L(0); PG8_MMA(0, 0, At, B0); PG8_BAR; PG8_SCHED;
            PG8_LDB(B1, 0, 1); PG8_STAGE(PG8_SB(0, 0), b2, voffB);
            PG8_BAR; PG8_WAIT_L(0); PG8_MMA(0, 1, At, B1); PG8_BAR;
            PG8_LDA(At, 0, 1); PG8_STAGE(PG8_SA(0, 0), a2, voffA);
            PG8_BAR; PG8_WAIT_L(0); PG8_MMA(1, 0, At, B0); PG8_BAR; PG8_SCHED;
            PG8_STAGE(PG8_SB(0, 1), b2 + hstep, voffB);
            PG8_WAIT_V(6); PG8_BAR; PG8_MMA(1, 1, At, B1); PG8_BAR;
            PG8_LDB(B0, 1, 0); PG8_SCHED; PG8_LDA(At, 1, 0); PG8_STAGE(PG8_SA(0, 1), a2 + hstep, voffA);
            PG8_WAIT_L(8); PG8_BAR; PG8_WAIT_L(0); PG8_MMA(0, 0, At, B0); PG8_BAR; PG8_SCHED;
            PG8_LDB(B1, 1, 1); PG8_STAGE(PG8_SB(1, 0), b3, voffB);
            PG8_BAR; PG8_WAIT_L(0); PG8_MMA(0, 1, At, B1); PG8_BAR;
            PG8_LDA(At, 1, 1); PG8_STAGE(PG8_SA(1, 0), a3, voffA);
            PG8_BAR; PG8_WAIT_L(0); PG8_MMA(1, 0, At, B0); PG8_BAR; PG8_SCHED;
            PG8_STAGE(PG8_SB(1, 1), b3 + hstep, voffB);
            PG8_WAIT_V(6); PG8_BAR; PG8_MMA(1, 1, At, B1); PG8_BAR;
            }
        }
        if constexpr (ALIGN_EPI) { if (wr == 0) PG8_BAR; }
        if constexpr (!Epi::AFTER_DRAIN) { E(acc, cur, wr, wc, fr, fq); S.done(cur); }
        if (!has_next) break;
#pragma unroll
        for (int a = 0; a < 2; ++a)
#pragma unroll
            for (int b = 0; b < 2; ++b)
#pragma unroll
                for (int m = 0; m < 4; ++m)
#pragma unroll
                    for (int n = 0; n < 2; ++n) acc[a][b][m][n] = (f32x4){0.f, 0.f, 0.f, 0.f};
        cur = nxt; cA = nA; cB = nB; ++ui;
        if constexpr (ALIGN_EPI) { if (wr == 1) PG8_BAR; }
    }
    PG8_WAIT_V(0);
    if constexpr (!ALIGN_EPI) { if (wr == 0) PG8_BAR; }
    PG8_BAR;
    if constexpr (Epi::AFTER_DRAIN) { E.fused(acc, cur, wr, wc, fr, fq, lds, wid, lane); S.done(cur); }
#undef PG8_SA
#undef PG8_SB
#undef PG8_STAGE
#undef PG8_LDA
#undef PG8_LDB
#undef PG8_MMA
#undef PG8_WAIT_V
#undef PG8_WAIT_L
#undef PG8_BAR
#undef PG8_SCHED
}
}

struct XSched {
    int nN, nunits, G, c, skipctx;
    DEV bool next(int i, pg8::Unit& u) const {
        const int L = i * G + c; if (L >= nunits) return false;
        const int U = ((nunits & 7) == 0 && (G & 7) == 0) ? (L & 7) * (nunits >> 3) + (L >> 3) : L;
        { const int nM = nunits / nN, nig = 4 * nN, gid = U / nig, fm = gid * 4, gsz = min(nM - fm, 4), r = U - gid * nig; u.pm = fm + r % gsz; u.pn = r / gsz; }
        if (skipctx) u.pm = (u.pm >> 6) * 72 + (u.pm & 63);
        return true;
    }
    DEV void a_ready(const pg8::Unit&) const {}
    DEV void done(const pg8::Unit&) const {}
};
struct EpiStoreT {
    static constexpr bool PERM = false, AFTER_DRAIN = false, HAS_MID = false;
    bf16_t* out; int ld; int row_off;
    DEV void operator()(const f32x4 (&acc)[2][2][4][2], const pg8::Unit& u, int wr, int wc, int fr, int fq) const {
#pragma unroll
        for (int ai = 0; ai < 2; ++ai)
#pragma unroll
            for (int m = 0; m < 4; ++m) {
                bf16_t* d = out + (size_t)(row_off + u.pm * 256 + ai * 128 + wr * 64 + m * 16 + fr) * ld + u.pn * 256 + wc * 32;
#pragma unroll
                for (int bj = 0; bj < 2; ++bj) store8x2(d + bj * 128, acc[ai][bj][m][0], acc[ai][bj][m][1], fq);
            }
    }
};
struct EpiSwiglu {
    static constexpr bool PERM = false, AFTER_DRAIN = false, HAS_MID = false;
    bf16_t* act;
    DEV void operator()(const f32x4 (&acc)[2][2][4][2], const pg8::Unit& u, int wr, int wc, int fr, int fq) const {
#pragma unroll
        for (int ai = 0; ai < 2; ++ai)
#pragma unroll
            for (int m = 0; m < 4; ++m) {
                bf16_t* d = act + (size_t)(u.pm * 256 + ai * 128 + wr * 64 + m * 16 + fr) * DFF + u.pn * 128 + wc * 32;
                f32x4 r[2];
#pragma unroll
                for (int n = 0; n < 2; ++n) {
                    const f32x4 a = acc[ai][0][m][n], b = acc[ai][1][m][n];
#pragma unroll
                    for (int j = 0; j < 4; ++j) r[n][j] = a[j] * frcp(1.f + fexp2(-a[j] * LOG2E)) * b[j];
                }
                store8x2(d, r[0], r[1], fq);
            }
    }
};
struct EpiVT {
    static constexpr bool PERM = false, AFTER_DRAIN = false, HAS_MID = false;
    bf16_t* vt;
    DEV void operator()(const f32x4 (&acc)[2][2][4][2], const pg8::Unit& u, int wr, int wc, int fr, int fq) const {
#pragma unroll
        for (int bj = 0; bj < 2; ++bj)
#pragma unroll
            for (int n = 0; n < 2; ++n) {
                bf16_t* d = vt + (size_t)(u.pn * 256 + bj * 128 + wc * 32 + n * 16 + fr) * MC + u.pm * 256 + wr * 64 + fq * 8;
#pragma unroll
                for (int ai = 0; ai < 2; ++ai)
#pragma unroll
                    for (int m2 = 0; m2 < 2; ++m2) {
                        const f32x4 a = acc[ai][bj][2 * m2][n], b = acc[ai][bj][2 * m2 + 1][n];
                        u32x4 w; w.x = pk_bf16(a[0], a[1]); w.y = pk_bf16(a[2], a[3]); w.z = pk_bf16(b[0], b[1]); w.w = pk_bf16(b[2], b[3]);
                        *(u32x4*)(d + ai * 128 + m2 * 32) = w;
                    }
            }
    }
};
DEV size_t gate_index(int pm, int pn4, int wave, int r8, int lane) { return ((((size_t)pm * 16 + pn4) * 8 + wave) * 8 + r8) * 64 + lane; }
struct EpiGate {
    static constexpr bool PERM = false, AFTER_DRAIN = false, HAS_MID = false;
    u32x4* g8;
    DEV void operator()(const f32x4 (&acc)[2][2][4][2], const pg8::Unit& u, int wr, int wc, int fr, int fq) const {
        const int lane = fq * 16 + fr, wave = wr * 4 + wc;
#pragma unroll
        for (int ai = 0; ai < 2; ++ai)
#pragma unroll
            for (int m = 0; m < 4; ++m) {
                u32x4 w;
#pragma unroll
                for (int bj = 0; bj < 2; ++bj)
#pragma unroll
                    for (int n = 0; n < 2; ++n) {
                        const f32x4 a = acc[ai][bj][m][n]; unsigned x = 0;
#pragma unroll
                        for (int j = 0; j < 4; ++j) { const float s = frcp(1.f + fexp2(-a[j] * LOG2E)); x |= max(1u, (unsigned)(s * 255.f + 0.5f)) << (8 * j); }
                        w[bj * 2 + n] = x;
                    }
                g8[gate_index(u.pm, u.pn, wave, ai * 4 + m, lane)] = w;
            }
    }
};
struct EpiMerge {
    static constexpr bool PERM = false, AFTER_DRAIN = false, HAS_MID = true;
    bf16_t* out; const u32x4* g8;
    DEV void mid(f32x4 (&acc)[2][2][4][2], const pg8::Unit& u, int n, int wave, int lane) const {
#pragma unroll
        for (int ai = 0; ai < 2; ++ai)
#pragma unroll
            for (int m = 0; m < 4; ++m) {
                const u32x4 a = g8[gate_index(u.pm, (n - 1) * 4 + u.pn, wave, ai * 4 + m, lane)], b = g8[gate_index(u.pm, n * 4 + u.pn, wave, ai * 4 + m, lane)];
#pragma unroll
                for (int bj = 0; bj < 2; ++bj)
#pragma unroll
                    for (int nn = 0; nn < 2; ++nn) {
                        const unsigned x = a[bj * 2 + nn], y = b[bj * 2 + nn]; f32x4 r;
#pragma unroll
                        for (int j = 0; j < 4; ++j) r[j] = (float)((x >> (8 * j)) & 255u) * frcp((float)((y >> (8 * j)) & 255u));
                        acc[ai][bj][m][nn] = acc[ai][bj][m][nn] * r;
                    }
            }
    }
    DEV void operator()(const f32x4 (&acc)[2][2][4][2], const pg8::Unit& u, int wr, int wc, int fr, int fq) const {
        const int lane = fq * 16 + fr, wave = wr * 4 + wc;
#pragma unroll
        for (int ai = 0; ai < 2; ++ai)
#pragma unroll
            for (int m = 0; m < 4; ++m) {
                const u32x4 a = g8[gate_index(u.pm, 12 + u.pn, wave, ai * 4 + m, lane)];
                bf16_t* d = out + (size_t)(u.pm * 256 + ai * 128 + wr * 64 + m * 16 + fr) * 1024 + u.pn * 256 + wc * 32;
#pragma unroll
                for (int bj = 0; bj < 2; ++bj) {
                    f32x4 r[2];
#pragma unroll
                    for (int nn = 0; nn < 2; ++nn) {
                        const unsigned x = a[bj * 2 + nn];
#pragma unroll
                        for (int j = 0; j < 4; ++j) r[nn][j] = (float)((x >> (8 * j)) & 255u) * (1.f / 255.f);
                    }
                    store8x2(d + bj * 128, acc[ai][bj][m][0] * r[0], acc[ai][bj][m][1] * r[1], fq);
                }
            }
    }
};
struct EpiGemm1 {
    static constexpr bool PERM = false, AFTER_DRAIN = false, HAS_MID = false;
    const P* pp; int layer;
    DEV void operator()(const f32x4 (&acc)[2][2][4][2], const pg8::Unit& u, int wr, int wc, int fr, int fq) const {
        const int slab = u.pn * 256 + wc * 64; const bool lat = u.pm * 256 < LAT_C;
        if (slab >= 2752) return;
#pragma unroll
        for (int ai = 0; ai < 2; ++ai)
#pragma unroll
            for (int m = 0; m < 4; ++m) {
                f32x4 v[4] = {acc[ai][0][m][0], acc[ai][0][m][1], acc[ai][1][m][0], acc[ai][1][m][1]};
                gemm1_row(v, u.pm * 256 + ai * 128 + wr * 64 + m * 16 + fr, slab, lat, *pp, layer, fq);
            }
    }
};

#define LAS __attribute__((address_space(3)))
#define XB_TMO      128
#define XB_XCNT(j)  (256  + 64 * (j))
#define XB_XSUB(j)  (1280 + 64 * (j))
#define XB_XGEN(j)  (2304 + 64 * (j))
#define XB_TOP      3328
#define XB_TOPGEN   3392
#define XCD_BAR_WORDS 3456
#define XB_SPIN_CAP (1u << 18)

__device__ __forceinline__ unsigned xb_ld(unsigned* p)              { return __hip_atomic_load(p, __ATOMIC_RELAXED, __HIP_MEMORY_SCOPE_AGENT); }
__device__ __forceinline__ unsigned xb_add(unsigned* p, unsigned v) { return __hip_atomic_fetch_add(p, v, __ATOMIC_RELAXED, __HIP_MEMORY_SCOPE_AGENT); }
__device__ __forceinline__ unsigned xb_xcc_id() { return (unsigned)__builtin_amdgcn_s_getreg((3 << 11) | 20) & 0xFu; }
#define XB_SPIN(cond, bar) do { unsigned _sp = 0; while (cond) { __builtin_amdgcn_s_sleep(1); \
    if ((++_sp & 255u) == 0u) { if (xb_ld(&(bar)[XB_TMO])) break; if (_sp > XB_SPIN_CAP) { atomicAdd(&(bar)[XB_TMO], 1u); break; } } } } while (0)

struct XcdBarrier {
    unsigned* bar; unsigned x;
    volatile LAS unsigned* st;
};

__device__ __forceinline__ XcdBarrier xcd_barrier_post(unsigned* bar, volatile LAS unsigned* st) {
    XcdBarrier b; b.bar = bar; b.x = xb_xcc_id(); b.st = st;
    if (threadIdx.x == 0) (void)xb_add(&bar[XB_XCNT(b.x)], 1u);
    return b;
}
__device__ __forceinline__ void xcd_barrier_complete(unsigned* bar, unsigned x, unsigned& nloc, unsigned& nx) {
    const unsigned G = gridDim.x * gridDim.y * gridDim.z;
    unsigned sum, cnt, mine, sp = 0u;
    for (;;) {
        sum = 0u; cnt = 0u; mine = 0u;
#pragma unroll
        for (unsigned j = 0; j < 16; ++j) { const unsigned c = xb_ld(&bar[XB_XCNT(j)]); sum += c; cnt += (c > 0u) ? 1u : 0u; mine = (j == x) ? c : mine; }
        if (sum == G) break;
        __builtin_amdgcn_s_sleep(1);
        if ((++sp & 255u) == 0u) { if (xb_ld(&bar[XB_TMO])) break; if (sp > XB_SPIN_CAP) { atomicAdd(&bar[XB_TMO], 1u); break; } }
    }
    nloc = mine > 0u ? mine : 1u; nx = cnt > 0u ? cnt : 1u;
}

__device__ __forceinline__ void xcd_barrier(const XcdBarrier& b) {
    asm volatile("s_waitcnt vmcnt(0)" ::: "memory");
    __syncthreads();
    if (threadIdx.x == 0) {
        unsigned* bar = b.bar;
        __builtin_amdgcn_s_waitcnt(0);
        unsigned nloc = b.st[0], nx = b.st[1];
        if (nloc == 0u) { xcd_barrier_complete(bar, b.x, nloc, nx); b.st[0] = nloc; b.st[1] = nx; }
        const unsigned old = xb_add(&bar[XB_XSUB(b.x)], 1u);
        const unsigned gen = old / nloc;
        if (old + 1u == (gen + 1u) * nloc) {
            __builtin_amdgcn_fence(__ATOMIC_RELEASE, "agent");
            asm volatile("s_waitcnt vmcnt(0)" ::: "memory");
            const unsigned og = xb_add(&bar[XB_TOP], 1u);
            const unsigned tg = og / nx;
            if (og + 1u == (tg + 1u) * nx) xb_add(&bar[XB_TOPGEN], 1u);
            else XB_SPIN(xb_ld(&bar[XB_TOPGEN]) == tg, bar);
            __builtin_amdgcn_fence(__ATOMIC_ACQUIRE, "agent");
            xb_add(&bar[XB_XGEN(b.x)], 1u);
            asm volatile("s_waitcnt vmcnt(0)" ::: "memory");
        } else {
            XB_SPIN(xb_ld(&bar[XB_XGEN(b.x)]) == gen, bar);
            __builtin_amdgcn_fence(__ATOMIC_ACQUIRE, "agent");
            asm volatile("s_waitcnt vmcnt(0)" ::: "memory");
        }
    }
    __syncthreads();
}

typedef const __attribute__((address_space(4))) P* PP;
#define FRESH_P PP q_ = pp0; asm volatile("" : "+s"(q_)); const P& p = *(const P*)q_;
#define FRESH_BG int bidL = bid, GL = G; asm volatile("" : "+s"(bidL), "+s"(GL));
constexpr int DYN_LDS = 2 * SMEM_BYTES + 64;
__global__ void __launch_bounds__(512, 2) mega(P pv_) {
    cg::grid_group grid = cg::this_grid();
    PP pp0 = (PP)__builtin_amdgcn_kernarg_segment_ptr();
    extern __shared__ __attribute__((aligned(16))) unsigned char lds_dyn[];
    const int half = __builtin_amdgcn_readfirstlane((int)threadIdx.x >> 8);
    unsigned char* smraw = lds_dyn + half * SMEM_BYTES;
    bf16_t* sm = (bf16_t*)smraw;
    PG8_LAS unsigned char* ldsL = (PG8_LAS unsigned char*)lds_dyn;
    const int bid = blockIdx.x, G = gridDim.x, vb = bid * 2 + half, VG = G * 2, tid = threadIdx.x & 255;
    {
        FRESH_P
        volatile LAS unsigned* xst = (volatile LAS unsigned*)(ldsL + 2 * SMEM_BYTES);
        if (threadIdx.x == 0) { xst[0] = 0u; xst[1] = 0u; }
        __syncthreads();
        const XcdBarrier xb0 = xcd_barrier_post(p.barw, xst);
        if (threadIdx.x == 0) xst[2] = xb0.x;
        __syncthreads();
    }
#define GBAR() do { FRESH_P XcdBarrier b_; b_.bar = p.barw; b_.st = (volatile LAS unsigned*)(ldsL + 2 * SMEM_BYTES); b_.x = b_.st[2]; xcd_barrier(b_); } while (0)

    { FRESH_P
    for (int i = vb * 256 + tid; i < 64 * 16 + 64 * 8; i += VG * 256) {
        if (i < 1024) { const int pos = i >> 4, k = i & 15; const float inv = fexp2(-(float)k * (13.287712379549449f / 16.f)); const float a = (float)pos * inv; p.rt16[i] = (f32x2){__cosf(a), __sinf(a)}; }
        else { const int q = i - 1024; const int pos = q >> 3, k = q & 7; const float inv = fexp2(-(float)k * (13.287712379549449f / 8.f)); const float a = (float)pos * inv; p.rt8[q] = (f32x2){__cosf(a), __sinf(a)}; }
    }
    for (int t = vb; t < 384 + CONV_TILES; t += VG) { if (t < 384) mod_item(p, t, smraw); else conv_job(p, 0, t - 384, (float*)smraw); }
    }
    GBAR();
    { FRESH_P r_phase(p, 0, 0, vb, VG, 0, MTOT); }
    GBAR();

    for (int layer = 0; layer < DEPTH; ++layer) {
        const bool lastL = (layer == DEPTH - 1);
        for (int ch = 0; ch < NCH; ++ch) {
            { FRESH_P FRESH_BG
              const bf16_t* A = p.U + (size_t)ch * MC * 1024;
              { pg8::Gemm g{A, p.WinT, MC, 2816, 1024}; XSched S{11, 792, GL, bidL}; EpiGemm1 E{&p, layer};
                pg8::gemm_phase<EpiGemm1, XSched, true, true, false>(ldsL, g, S, E); }
              { pg8::Gemm g{A, p.WinT + (size_t)2816 * 1024, MC, 768, 1024}; XSched S{3, 216, GL, (bidL + GL - (792 % GL)) % GL}; EpiVT E{p.VT};
                pg8::gemm_phase<EpiVT, XSched, true, true, true>(ldsL, g, S, E); }
              { pg8::Gemm g{A, p.WinT + (size_t)NPROJ * 1024, MC, 4096, 1024}; XSched S{16, lastL ? 1024 : 1152, GL, (bidL + GL - (1008 % GL)) % GL}; EpiGate E{(u32x4*)p.G};
                pg8::gemm_phase<EpiGate, XSched, true, true, false>(ldsL, g, S, E); }
            }
            GBAR();
            { FRESH_P for (int t = vb; t < (lastL ? 4064 : 4448); t += VG) {
                if (t < 1024) attn_item<2>(p, layer, t, false, smraw);
                else if (t < 2048) attn_item<1>(p, layer, t - 1024, false, smraw);
                else if (t < 4064) { const int q = t - 2048; stage2_tile(p, q / 14, q % 14, smraw); }
                else if (t < 4192) attn_item<1>(p, layer, t - 4064, true, smraw);
                else if (t < 4320) attn_item<2>(p, layer, t - 4192, true, smraw);
                else attn_item<3>(p, layer, t - 4320, true, smraw);
            } }
            GBAR();
            { FRESH_P for (int t = vb; t < (lastL ? 2048 : 2176); t += VG) {
                if (t < 1024) attn_item<0>(p, layer, t, false, smraw);
                else if (t < 2048) attn_item<3>(p, layer, t - 1024, false, smraw);
                else attn_item<0>(p, layer, t - 2048, true, smraw);
            } }
            GBAR();
            { FRESH_P FRESH_BG pg8::Gemm g{p.O, p.WbrT, MC, 1024, 2048}; XSched S{4, lastL ? 256 : 288, GL, bidL}; EpiMerge E{p.MB, (const u32x4*)p.G};
              pg8::gemm_phase<EpiMerge, XSched, true, true, false>(ldsL, g, S, E); }
            GBAR();
            { FRESH_P FRESH_BG pg8::Gemm g{p.MB, p.WoutT, MC, 1024, 1024}; XSched S{4, lastL ? 256 : 288, GL, bidL}; EpiStoreT E{p.YC, 1024, 0};
              pg8::gemm_phase<EpiStoreT, XSched, true, true, false>(ldsL, g, S, E); }
            GBAR();
            { FRESH_P r_phase(p, 1, layer, vb, VG, ch * MC, ch * MC + (lastL ? LAT_C : MC)); }
            if (ch + 1 == NCH) GBAR();
        }
        { FRESH_P FRESH_BG pg8::Gemm g{p.U, p.Wf1T, MTOT, 2 * DFF, 1024}; XSched S{22, lastL ? 2816 : 3168, GL, bidL, lastL ? 1 : 0}; EpiSwiglu E{p.ACT};
          pg8::gemm_phase<EpiSwiglu, XSched, true, true, false>(ldsL, g, S, E); }
        GBAR();
        { FRESH_P FRESH_BG pg8::Gemm g{p.ACT, p.Wf2T, MTOT, 1024, DFF}; XSched S{4, lastL ? 512 : 576, GL, bidL, lastL ? 1 : 0}; EpiStoreT E{p.U, 1024, 0};
          pg8::gemm_phase<EpiStoreT, XSched, true, true, false>(ldsL, g, S, E); }
        GBAR();
        { FRESH_P r_phase(p, 2, layer, vb, VG, 0, MTOT, lastL);
          if (layer + 1 < DEPTH) { for (int t = vb; t < CONV_TILES; t += VG) conv_job(p, layer + 1, t, (float*)smraw); } }
        GBAR();
    }
}

extern "C" void kernel_launch(void* const* d_in, const int* in_sizes, int n_in, void* d_out, int out_size, void* d_ws, size_t ws_size, hipStream_t stream) {
    static int grid_blocks = 0;
    if (!grid_blocks) {
        int dev = 0, cus = 0, per_cu = 0;
        (void)hipGetDevice(&dev);
        (void)hipDeviceGetAttribute(&cus, hipDeviceAttributeMultiprocessorCount, dev);
        if (hipFuncSetAttribute((const void*)mega, hipFuncAttributeMaxDynamicSharedMemorySize, DYN_LDS) != hipSuccess) fprintf(stderr, "hipFuncSetAttribute failed\n");
        (void)hipOccupancyMaxActiveBlocksPerMultiprocessor(&per_cu, mega, 512, DYN_LDS);
        grid_blocks = cus;
    }
    P p{};
    const float** f = (const float**)&p;
    for (int i = 0; i < 23; ++i) f[i] = (const float*)d_in[i];
    p.out = (float*)d_out;
    unsigned char* w = (unsigned char*)d_ws; size_t off = 0;
    auto take = [&](size_t bytes) { void* r = w + off; off += (bytes + 255) & ~(size_t)255; return r; };
    p.WinT = (bf16_t*)take((size_t)NWIN * 1024 * 2);
    p.WuqT = (bf16_t*)take((size_t)768 * 256 * 2);
    p.WukvT = (bf16_t*)take((size_t)1024 * 128 * 2);
    p.WbrT = (bf16_t*)take((size_t)4 * 1024 * 512 * 2);
    p.WoutT = (bf16_t*)take((size_t)1024 * 1024 * 2);
    p.Wf1T = (bf16_t*)take((size_t)2 * DFF * 1024 * 2);
    p.Wf2T = (bf16_t*)take((size_t)1024 * DFF * 2);
    p.mod = (float*)take((size_t)DEPTH * 17 * 6144 * 4);
    p.rt16 = (f32x2*)take(64 * 16 * 8);
    p.rt8 = (f32x2*)take(64 * 8 * 8);
    p.hc = (float*)take((size_t)NBATCH * CTX * 1024 * 4);
    p.U = (bf16_t*)take((size_t)MTOT * 1024 * 2);
    p.G = (unsigned char*)take((size_t)MC * 4096);
    p.barw = (unsigned*)take((size_t)XCD_BAR_WORDS * 4);
    unsigned char* R = (unsigned char*)take(0);
    p.PJ = (bf16_t*)take((size_t)MC * PJLD * 2);
    p.QA = (bf16_t*)take((size_t)MC * 768 * 2);
    p.KN = (bf16_t*)take((size_t)MC * 512 * 2);
    p.VT = (bf16_t*)take((size_t)VTROWS * MC * 2);
    p.O = (bf16_t*)take((size_t)MC * 2048 * 2);
    p.YC = p.O;
    p.MB = p.PJ;
    p.ACT = (bf16_t*)R;
    if (off > ws_size) { fprintf(stderr, "workspace too small: need %zu have %zu\n", off, ws_size); return; }
    (void)hipMemsetAsync(p.barw, 0, (size_t)XCD_BAR_WORDS * 4, stream);
    void* args[] = {&p};
    hipError_t e = hipLaunchCooperativeKernel((void*)mega, dim3(grid_blocks), dim3(512), args, DYN_LDS, stream);
    if (e != hipSuccess) fprintf(stderr, "cooperative launch failed: %s (grid %d)\n", hipGetErrorString(e), grid_blocks);
}
```

```cpp
#include <hip/hip_runtime.h>
#include <hip/hip_cooperative_groups.h>
#include <cstdio>
#include <cstdint>
namespace cg = cooperative_groups;

typedef unsigned short bf16_t;
typedef short bf16x8 __attribute__((ext_vector_type(8)));
typedef short bf16x4 __attribute__((ext_vector_type(4)));
typedef float f32x4 __attribute__((ext_vector_type(4)));
typedef float f32x2 __attribute__((ext_vector_type(2)));
typedef unsigned u32x2 __attribute__((ext_vector_type(2)));
typedef unsigned u32x4 __attribute__((ext_vector_type(4)));
#define DEV __device__ __forceinline__

constexpr int DM = 1024, NBATCH = 16, SEQ = 2048, CTX = 256, DEPTH = 4;
constexpr int NCH = 2, BPC = NBATCH / NCH, LAT_C = BPC * SEQ, CTX_C = BPC * CTX, MC = LAT_C + CTX_C, MTOT = MC * NCH;
constexpr int INC = 7584, NPROJ = 3584, NWIN = 7680, PJLD = 2816, DFF = 2816, VTROWS = 1280;
constexpr float LOG2E = 1.4426950408889634f;
constexpr int LST = 72;
constexpr int TILE_E = 128 * LST;
constexpr int SMEM_BYTES = 4 * TILE_E * 2 + 1024;

struct P {
    const float *x, *c, *ctx, *c_ctx, *w_mod, *b_mod, *g_pre_mix, *g_post_mix, *g_pre_ffn, *g_post_ffn, *w_in, *g_a_q, *g_a_kv,
        *w_a_uq, *w_a_ukv, *sink_b, *rpb_c, *g_d_q, *g_d_k, *w_branch, *w_out, *w_ffn_in, *w_ffn_out;
    float* out;
    bf16_t *WinT, *WuqT, *WukvT, *WbrT, *WoutT, *Wf1T, *Wf2T;
    float* mod; f32x2 *rt16, *rt8; float* hc;
    bf16_t *U, *YC, *PJ, *QA, *KN, *VT, *O, *MB, *ACT;
    unsigned char* G;
    unsigned* barw;
};

typedef __bf16 bf16v2 __attribute__((ext_vector_type(2)));
DEV unsigned pk_bf16(float lo, float hi) { bf16v2 v = __builtin_convertvector((f32x2){lo, hi}, bf16v2); return __builtin_bit_cast(unsigned, v); }
DEV float bf2f(unsigned short v) { return __uint_as_float(((unsigned)v) << 16); }
DEV void store4(bf16_t* p, f32x4 v) { u32x2 w; w.x = pk_bf16(v[0], v[1]); w.y = pk_bf16(v[2], v[3]); *(u32x2*)p = w; }
DEV void store8x2(bf16_t* g0, f32x4 v0, f32x4 v1, int fq) {
    unsigned ax = pk_bf16(v0[0], v0[1]), ay = pk_bf16(v0[2], v0[3]), bx = pk_bf16(v1[0], v1[1]), by = pk_bf16(v1[2], v1[3]);
    auto rx = __builtin_amdgcn_permlane16_swap(ax, bx, false, false);
    auto ry = __builtin_amdgcn_permlane16_swap(ay, by, false, false);
    u32x4 w; w.x = rx[0]; w.y = ry[0]; w.z = rx[1]; w.w = ry[1];
    *(u32x4*)(g0 + (fq & 1) * 16 + (fq >> 1) * 8) = w;
}
DEV float fexp2(float x) { return __builtin_amdgcn_exp2f(x); }
DEV float frcp(float x) { return __builtin_amdgcn_rcpf(x); }
DEV float wave_sum(float v) {
    v += __shfl_xor(v, 1); v += __shfl_xor(v, 2); v += __shfl_xor(v, 4); v += __shfl_xor(v, 8); v += __shfl_xor(v, 16); v += __shfl_xor(v, 32); return v;
}
DEV int ltid() { int t = threadIdx.x & 255; asm volatile("" : "+v"(t)); return t; }
DEV int uni(int v) { return __builtin_amdgcn_readfirstlane(v); }
DEV float xmax16(float x) { auto r = __builtin_amdgcn_permlane16_swap(__float_as_uint(x), __float_as_uint(x), false, false); return fmaxf(__uint_as_float(r[0]), __uint_as_float(r[1])); }
DEV float xmax32(float x) { auto r = __builtin_amdgcn_permlane32_swap(__float_as_uint(x), __float_as_uint(x), false, false); return fmaxf(__uint_as_float(r[0]), __uint_as_float(r[1])); }
DEV float xadd16(float x) { auto r = __builtin_amdgcn_permlane16_swap(__float_as_uint(x), __float_as_uint(x), false, false); return __uint_as_float(r[0]) + __uint_as_float(r[1]); }
DEV float xadd32(float x) { auto r = __builtin_amdgcn_permlane32_swap(__float_as_uint(x), __float_as_uint(x), false, false); return __uint_as_float(r[0]) + __uint_as_float(r[1]); }
DEV f32x4 mfma16(bf16x8 a, bf16x8 b, f32x4 c) { return __builtin_amdgcn_mfma_f32_16x16x32_bf16(a, b, c, 0, 0, 0); }

template <int NFT, bool SWAP>
DEV void gemm_mainloop(const bf16_t* __restrict__ A, int lda, const bf16_t* __restrict__ Bt, int ldb, int K, f32x4 (&acc)[NFT][4], bf16_t* sm) {
    const int tid = ltid(), lane = tid & 63, wid = uni(tid >> 6), wm = wid & 1, wn = wid >> 1, fr = lane & 15, fq = lane >> 4;
    unsigned char* sA = (unsigned char*)sm; unsigned char* sB = sA + 2 * 16384;
    const int lrow = tid >> 3, lc8 = (tid & 7) * 8;
    const int wofs = lrow * 128 + (((tid & 7) ^ (lrow & 7)) << 4);
    const bf16_t* ga = A + (size_t)lrow * lda + lc8;
    const bf16_t* gb = Bt + (size_t)lrow * ldb + lc8;
    u32x4 ra[4], rb[NFT];
#pragma unroll
    for (int ft = 0; ft < NFT; ++ft)
#pragma unroll
        for (int tt = 0; tt < 4; ++tt) acc[ft][tt] = (f32x4){0.f, 0.f, 0.f, 0.f};
#pragma unroll
    for (int i = 0; i < 4; ++i) ra[i] = *(const u32x4*)(ga + (size_t)(i * 32) * lda);
#pragma unroll
    for (int i = 0; i < NFT; ++i) rb[i] = *(const u32x4*)(gb + (size_t)(i * 32) * ldb);
#pragma unroll
    for (int i = 0; i < 4; ++i) *(u32x4*)(sA + wofs + i * 4096) = ra[i];
#pragma unroll
    for (int i = 0; i < NFT; ++i) *(u32x4*)(sB + wofs + i * 4096) = rb[i];
    const int nk = K >> 6;
    if (nk > 1) {
#pragma unroll
        for (int i = 0; i < 4; ++i) ra[i] = *(const u32x4*)(ga + (size_t)(i * 32) * lda + 64);
#pragma unroll
        for (int i = 0; i < NFT; ++i) rb[i] = *(const u32x4*)(gb + (size_t)(i * 32) * ldb + 64);
    }
    __syncthreads();
    const int rofs0 = ((0 + fq) ^ (fr & 7)) << 4, rofs1 = ((4 + fq) ^ (fr & 7)) << 4;
    for (int kt = 0; kt < nk; ++kt) {
        const int cur = kt & 1;
        if (kt + 1 < nk) {
            const int nx = cur ^ 1;
#pragma unroll
            for (int i = 0; i < 4; ++i) *(u32x4*)(sA + nx * 16384 + wofs + i * 4096) = ra[i];
#pragma unroll
            for (int i = 0; i < NFT; ++i) *(u32x4*)(sB + nx * 16384 + wofs + i * 4096) = rb[i];
        }
        if (kt + 2 < nk) {
            const int ko = (kt + 2) * 64;
#pragma unroll
            for (int i = 0; i < 4; ++i) ra[i] = *(const u32x4*)(ga + (size_t)(i * 32) * lda + ko);
#pragma unroll
            for (int i = 0; i < NFT; ++i) rb[i] = *(const u32x4*)(gb + (size_t)(i * 32) * ldb + ko);
        }
        __builtin_amdgcn_sched_barrier(0);
        const unsigned char* cA = sA + cur * 16384 + (wm * 64 + fr) * 128;
        const unsigned char* cB = sB + cur * 16384 + (wn * NFT * 16 + fr) * 128;
#pragma unroll
        for (int ks = 0; ks < 2; ++ks) {
            const int ro = ks ? rofs1 : rofs0;
            bf16x8 af[4], wf[NFT];
#pragma unroll
            for (int tt = 0; tt < 4; ++tt) af[tt] = *(const bf16x8*)(cA + tt * 2048 + ro);
#pragma unroll
            for (int ft = 0; ft < NFT; ++ft) wf[ft] = *(const bf16x8*)(cB + ft * 2048 + ro);
#pragma unroll
            for (int ft = 0; ft < NFT; ++ft)
#pragma unroll
                for (int tt = 0; tt < 4; ++tt) acc[ft][tt] = SWAP ? mfma16(af[tt], wf[ft], acc[ft][tt]) : mfma16(wf[ft], af[tt], acc[ft][tt]);
        }
        __syncthreads();
    }
}

DEV bool tile_xcd(int q, int x, int nM, int nN, int& m, int& n) {
    const int j = q >> 5, w = q & 31;
    const int pp = (((j >> 1) * 8 + x) << 1) + (j & 1);
    const int npn = nN >> 2;
    if (pp >= (nM >> 3) * npn) return false;
    const int pm = pp / npn, pn = pp - pm * npn;
    m = pm * 8 + (w & 7); n = pn * 4 + (w >> 3);
    return true;
}
#define TILE_LOOP(nM, nN) const int x_ = bid & 7, spx_ = G >> 3; int mt, nt; for (int q_ = bid >> 3; tile_xcd(q_, x_, nM, nN, mt, nt); q_ += spx_)

DEV int srccol(int mapid, int n) {
    switch (mapid) {
    case 0:
        if (n < 2816) { const int rho = n & 255; n = (n & ~255) + ((rho >> 5) & 3) * 64 + (rho >> 7) * 32 + (rho & 31); }
        if (n < 384) return n;
        if (n < 896) return n - 384 + 416;
        if (n < 1024) return n - 896 + 928;
        if (n < 1536) return n - 1024 + 1184;
        if (n < 2048) return n - 1536 + 1696;
        if (n < 2560) return n - 2048 + 2720;
        if (n < 2688) return n - 2560 + 3232;
        if (n < 2720) return n - 2688 + 384;
        if (n < 2816) return -1;
        if (n < 2944) return n - 2816 + 1056;
        if (n < 3456) return n - 2944 + 2208;
        if (n < 3584) return n - 3456 + 3360;
        return n - 3584 + 3488;
    case 1: if (n < 512) return (n >> 6) * 96 + (n & 63); { const int q = n - 512; return (q >> 5) * 96 + 64 + (q & 31); }
    case 2: if (n < 512) return (n >> 6) * 128 + (n & 63); { const int q = n - 512; return (q >> 6) * 128 + 64 + (q & 63); }
    case 4: { const int pn = n >> 8, s = (n >> 7) & 1, wc = (n >> 5) & 3, nn = (n >> 4) & 1, f = n & 15; return s * DFF + pn * 128 + wc * 32 + nn * 16 + f; }
    default: return n;
    }
}
DEV void conv_tile(const float* __restrict__ src, int lds_, int K, bf16_t* __restrict__ dst, int n0, int k0, int mapid, const float* rowscale, float* st) {
    const int tid = ltid();
    {
        const int n = tid & 63, kk = tid >> 6; const int sc_ = srccol(mapid, n0 + n);
#pragma unroll
        for (int i = 0; i < 16; ++i) {
            const int k = kk * 16 + i;
            float v = sc_ >= 0 ? src[(size_t)(k0 + k) * lds_ + sc_] : 0.f;
            if (rowscale) v *= rowscale[k0 + k];
            st[k * 65 + n] = v;
        }
    }
    __syncthreads();
    {
        const int n = tid >> 2, kq = tid & 3; u32x4 w0, w1;
        const float* s = st + (kq * 16) * 65 + n;
        w0.x = pk_bf16(s[0 * 65], s[1 * 65]); w0.y = pk_bf16(s[2 * 65], s[3 * 65]); w0.z = pk_bf16(s[4 * 65], s[5 * 65]); w0.w = pk_bf16(s[6 * 65], s[7 * 65]);
        w1.x = pk_bf16(s[8 * 65], s[9 * 65]); w1.y = pk_bf16(s[10 * 65], s[11 * 65]); w1.z = pk_bf16(s[12 * 65], s[13 * 65]); w1.w = pk_bf16(s[14 * 65], s[15 * 65]);
        bf16_t* d = dst + (size_t)(n0 + n) * K + k0 + kq * 16;
        *(u32x4*)d = w0; *(u32x4*)(d + 8) = w1;
    }
    __syncthreads();
}
constexpr int CONV_TILES = 4880;
DEV void conv_job(const P& p, int layer, int t, float* st) {
    if (t < 1920) { conv_tile(p.w_in + (size_t)layer * DM * INC, INC, 1024, p.WinT, (t >> 4) * 64, (t & 15) * 64, 0, nullptr, st); return; }
    t -= 1920;
    if (t < 48) { conv_tile(p.w_a_uq + (size_t)layer * 256 * 768, 768, 256, p.WuqT, (t >> 2) * 64, (t & 3) * 64, 1, p.g_a_q + layer * 256, st); return; }
    t -= 48;
    if (t < 32) { conv_tile(p.w_a_ukv + (size_t)layer * 128 * 1024, 1024, 128, p.WukvT, (t >> 1) * 64, (t & 1) * 64, 2, p.g_a_kv + layer * 128, st); return; }
    t -= 32;
    if (t < 512) { conv_tile(p.w_branch + (size_t)layer * 4 * 512 * 1024, 1024, 2048, p.WbrT, (t >> 5) * 64, (t & 31) * 64, 3, nullptr, st); return; }
    t -= 512;
    if (t < 256) { conv_tile(p.w_out + (size_t)layer * 1024 * 1024, 1024, 1024, p.WoutT, (t >> 4) * 64, (t & 15) * 64, 3, nullptr, st); return; }
    t -= 256;
    if (t < 1408) { conv_tile(p.w_ffn_in + (size_t)layer * 1024 * 2 * DFF, 2 * DFF, 1024, p.Wf1T, (t >> 4) * 64, (t & 15) * 64, 4, nullptr, st); return; }
    t -= 1408;
    { const int nt = t / 44, kt = t - nt * 44; conv_tile(p.w_ffn_out + (size_t)layer * DFF * 1024, 1024, DFF, p.Wf2T, nt * 64, kt * 64, 3, nullptr, st); }
}

DEV void mod_item(const P& p, int item, unsigned char* smraw) {
    const int tid = ltid(), lane = tid & 63, wid = uni(tid >> 6);
    float* sc = (float*)smraw;
    const int l = item / 96, cgp = item - l * 96;
    for (int i = tid; i < 17 * 1024; i += 256) {
        const int r = i >> 10, k = i & 1023; const float v = r < 16 ? p.c[r * 1024 + k] : p.c_ctx[k];
        sc[i] = v * frcp(1.f + fexp2(-v * LOG2E));
    }
    __syncthreads();
    float acc[17];
#pragma unroll
    for (int r = 0; r < 17; ++r) acc[r] = 0.f;
    const float* w = p.w_mod + ((size_t)l * 1024 + wid * 256) * 6144 + cgp * 64 + lane;
    for (int k = 0; k < 256; k += 4) {
        const float w0 = w[(size_t)k * 6144], w1 = w[(size_t)(k + 1) * 6144], w2 = w[(size_t)(k + 2) * 6144], w3 = w[(size_t)(k + 3) * 6144];
#pragma unroll
        for (int r = 0; r < 17; ++r) { const f32x4 s = *(const f32x4*)(sc + r * 1024 + wid * 256 + k); acc[r] += s[0] * w0 + s[1] * w1 + s[2] * w2 + s[3] * w3; }
    }
    __syncthreads();
    float* red = (float*)smraw;
#pragma unroll
    for (int r = 0; r < 17; ++r) red[(wid * 17 + r) * 64 + lane] = acc[r];
    __syncthreads();
    for (int i = tid; i < 17 * 64; i += 256) {
        const int r = i >> 6, ci = i & 63;
        const float v = red[(0 * 17 + r) * 64 + ci] + red[(1 * 17 + r) * 64 + ci] + red[(2 * 17 + r) * 64 + ci] + red[(3 * 17 + r) * 64 + ci] + p.b_mod[l * 6144 + cgp * 64 + ci];
        p.mod[((size_t)l * 17 + r) * 6144 + cgp * 64 + ci] = v;
    }
    __syncthreads();
}

DEV void r_phase(const P& p, int mode, int layer, int vb, int VG, int g_lo, int g_hi, bool skipctx = false) {
    const int tid_ = ltid(), lane = tid_ & 63, wid = uni(tid_ >> 6);
    const int nw = VG * 4;
    for (int g = g_lo + vb * 4 + wid; g < g_hi; g += nw) {
        const int ch = g / MC, local = g - ch * MC;
        if (skipctx && local >= LAT_C) continue;
        const float* hin; float* hout; const float* mod;
        if (local < LAT_C) {
            const int idx = ch * LAT_C + local; const int b = idx >> 11;
            hin = (mode == 0 ? p.x : p.out) + (size_t)idx * 1024; hout = p.out + (size_t)idx * 1024; mod = p.mod + ((size_t)layer * 17 + b) * 6144;
        } else {
            const int idx = ch * CTX_C + local - LAT_C;
            hin = (mode == 0 ? p.ctx : p.hc) + (size_t)idx * 1024; hout = p.hc + (size_t)idx * 1024; mod = p.mod + ((size_t)layer * 17 + 16) * 6144;
        }
        f32x4 h[4];
#pragma unroll
        for (int i = 0; i < 2; ++i)
#pragma unroll
            for (int k = 0; k < 2; ++k) h[2 * i + k] = *(const f32x4*)(hin + i * 512 + lane * 8 + 4 * k);
        if (mode != 0) {
            f32x4 y[4]; float ss = 0.f;
            const bf16_t* yp = (mode == 1 ? p.YC + (size_t)local * 1024 : p.U + (size_t)g * 1024);
#pragma unroll
            for (int i = 0; i < 2; ++i) {
                const u32x4 w = *(const u32x4*)(yp + i * 512 + lane * 8);
                y[2 * i] = (f32x4){__uint_as_float(w.x << 16), __uint_as_float(w.x & 0xffff0000u), __uint_as_float(w.y << 16), __uint_as_float(w.y & 0xffff0000u)};
                y[2 * i + 1] = (f32x4){__uint_as_float(w.z << 16), __uint_as_float(w.z & 0xffff0000u), __uint_as_float(w.w << 16), __uint_as_float(w.w & 0xffff0000u)};
            }
#pragma unroll
            for (int i = 0; i < 4; ++i) ss += y[i][0] * y[i][0] + y[i][1] * y[i][1] + y[i][2] * y[i][2] + y[i][3] * y[i][3];
            ss = wave_sum(ss);
            const float rs = rsqrtf(ss * (1.f / 1024.f) + 1e-6f);
            const float* gp = (mode == 1 ? p.g_post_mix : p.g_post_ffn) + layer * 1024;
            const float* ga = mod + (mode == 1 ? 2048 : 5120);
#pragma unroll
            for (int i = 0; i < 2; ++i)
#pragma unroll
                for (int k = 0; k < 2; ++k) {
                    const int e = i * 512 + lane * 8 + 4 * k;
                    const f32x4 gg = *(const f32x4*)(gp + e), aa = *(const f32x4*)(ga + e);
                    h[2 * i + k] = h[2 * i + k] + aa * (y[2 * i + k] * rs * gg);
                }
        }
#pragma unroll
        for (int i = 0; i < 2; ++i)
#pragma unroll
            for (int k = 0; k < 2; ++k) *(f32x4*)(hout + i * 512 + lane * 8 + 4 * k) = h[2 * i + k];
        const int nl = (mode == 2) ? layer + 1 : layer;
        if (nl < DEPTH) {
            float ss = 0.f;
#pragma unroll
            for (int i = 0; i < 4; ++i) ss += h[i][0] * h[i][0] + h[i][1] * h[i][1] + h[i][2] * h[i][2] + h[i][3] * h[i][3];
            ss = wave_sum(ss);
            const float rs = rsqrtf(ss * (1.f / 1024.f) + 1e-6f);
            const float* gpre = (mode == 1 ? p.g_pre_ffn : p.g_pre_mix) + nl * 1024;
            const float* modn = (mode == 2) ? mod + 17 * 6144 : mod;
            const float* sh = modn + (mode == 1 ? 3072 : 0);
            const float* sc = modn + (mode == 1 ? 4096 : 1024);
#pragma unroll
            for (int i = 0; i < 2; ++i) {
                f32x4 u[2];
#pragma unroll
                for (int k = 0; k < 2; ++k) {
                    const int e = i * 512 + lane * 8 + 4 * k;
                    const f32x4 gg = *(const f32x4*)(gpre + e), s1 = *(const f32x4*)(sc + e), s0 = *(const f32x4*)(sh + e);
                    u[k] = h[2 * i + k] * rs * gg * (s1 + 1.f) + s0;
                }
                u32x4 w; w.x = pk_bf16(u[0][0], u[0][1]); w.y = pk_bf16(u[0][2], u[0][3]); w.z = pk_bf16(u[1][0], u[1][1]); w.w = pk_bf16(u[1][2], u[1][3]);
                *(u32x4*)(p.U + (size_t)g * 1024 + i * 512 + lane * 8) = w;
            }
        }
    }
}

DEV void gemm1_row(f32x4 (&v)[4], int row, int slab, bool lat, const P& p, int layer, int fq) {
    const bool hnorm = (slab >= 2048 && slab < 2688);
    const bool rope64 = lat && ((slab >= 384 && slab < 1024) || hnorm);
    const bool isq = (slab >= 384 && slab < 896) || (slab >= 1024 && slab < 1536) || (slab >= 2048 && slab < 2560);
    const float sc = isq ? 0.125f * LOG2E : 1.f;
    const bool kr = (slab == 2688);
    const int tok = row & 2047; const int pr = tok >> 6, pc = tok & 63;
    if (hnorm) {
        float ss = 0.f;
#pragma unroll
        for (int ft = 0; ft < 4; ++ft) ss += v[ft][0] * v[ft][0] + v[ft][1] * v[ft][1] + v[ft][2] * v[ft][2] + v[ft][3] * v[ft][3];
        ss += __shfl_xor(ss, 16); ss += __shfl_xor(ss, 32);
        const float rs = rsqrtf(ss * (1.f / 64.f) + 1e-6f);
        const float* g = (slab < 2560 ? p.g_d_q : p.g_d_k) + layer * 64;
#pragma unroll
        for (int ft = 0; ft < 4; ++ft) { const f32x4 gg = *(const f32x4*)(g + ft * 16 + fq * 4); v[ft] = v[ft] * rs * gg; }
    }
    if (rope64) {
#pragma unroll
        for (int j = 0; j < 4; ++j) {
            const int i = fq * 4 + j;
            f32x2 cs = p.rt16[pr * 16 + i]; float a = v[0][j], b = v[1][j];
            v[0][j] = a * cs[0] - b * cs[1]; v[1][j] = b * cs[0] + a * cs[1];
            cs = p.rt16[pc * 16 + i]; a = v[2][j]; b = v[3][j];
            v[2][j] = a * cs[0] - b * cs[1]; v[3][j] = b * cs[0] + a * cs[1];
        }
    }
    if (kr && lat) {
#pragma unroll
        for (int ft = 0; ft < 2; ++ft) {
            const int pos = ft == 0 ? pr : pc;
#pragma unroll
            for (int j = 0; j < 4; ++j) {
                const int i = (fq & 1) * 4 + j; const f32x2 cs = p.rt8[pos * 8 + i];
                const float xv = v[ft][j]; const float o = __shfl_xor(xv, 32);
                v[ft][j] = fq < 2 ? xv * cs[0] - o * cs[1] : xv * cs[0] + o * cs[1];
            }
        }
    }
    bf16_t* dst = p.PJ + (size_t)row * PJLD + slab;
    store8x2(dst, v[0] * sc, v[1] * sc, fq);
    if (!kr) store8x2(dst + 32, v[2] * sc, v[3] * sc, fq);
}
DEV void stage2_tile(const P& p, int mt, int j, unsigned char* smraw) {
    bf16_t* sm = (bf16_t*)smraw; float* s_rs = (float*)(smraw + 73728);
    const int tid = ltid(), lane = tid & 63, wid = uni(tid >> 6), wm = wid & 1, wn = wid >> 1, fr = lane & 15, fq = lane >> 4;
    const int m0 = mt * 128; const bool isq = j < 6; const bool lat = m0 < LAT_C;
    const int K = isq ? 256 : 128; const int acol = isq ? 0 : 256;
    {
        const int r = tid >> 1, hf = tid & 1; const int n = K >> 1;
        const bf16_t* src = p.PJ + (size_t)(m0 + r) * PJLD + acol + hf * n; float ss = 0.f;
        for (int i = 0; i < n; i += 8) {
            const u32x4 w = *(const u32x4*)(src + i);
#pragma unroll
            for (int q = 0; q < 4; ++q) { const float a = __uint_as_float(w[q] << 16), b = __uint_as_float(w[q] & 0xffff0000u); ss += a * a + b * b; }
        }
        ss += __shfl_xor(ss, 1);
        if (hf == 0) s_rs[r] = rsqrtf(ss / (float)K + 1e-6f);
    }
    __syncthreads();
    f32x4 acc[4][4];
    const bf16_t* A = p.PJ + (size_t)m0 * PJLD + acol;
    if (isq) {
        const int n0 = j * 128;
        gemm_mainloop<4, false>(A, PJLD, p.WuqT + (size_t)n0 * 256, 256, 256, acc, sm);
        const int slab = n0 + wn * 64; const float qs = 0.10206207261596577f * LOG2E;
#pragma unroll
        for (int tt = 0; tt < 4; ++tt) {
            const int lr = wm * 64 + tt * 16 + fr; const int row = m0 + lr; const float rs = s_rs[lr] * qs;
            const int tok = row & 2047; const int pr = tok >> 6, pc = tok & 63;
            f32x4 v[4] = {acc[0][tt], acc[1][tt], acc[2][tt], acc[3][tt]};
            if (slab >= 512 && lat) {
#pragma unroll
                for (int ft = 0; ft < 4; ++ft) {
                    const int pos = (ft & 1) == 0 ? pr : pc;
#pragma unroll
                    for (int jj = 0; jj < 4; ++jj) {
                        const int i = (fq & 1) * 4 + jj; const f32x2 cs = p.rt8[pos * 8 + i];
                        const float xv = v[ft][jj]; const float o = __shfl_xor(xv, 32);
                        v[ft][jj] = fq < 2 ? xv * cs[0] - o * cs[1] : xv * cs[0] + o * cs[1];
                    }
                }
            }
            bf16_t* dst = p.QA + (size_t)row * 768 + slab;
            store8x2(dst, v[0] * rs, v[1] * rs, fq); store8x2(dst + 32, v[2] * rs, v[3] * rs, fq);
        }
    } else {
        const int n0 = (j - 6) * 128;
        if (n0 < 512) {
            gemm_mainloop<4, false>(A, PJLD, p.WukvT + (size_t)n0 * 128, 128, 128, acc, sm);
#pragma unroll
            for (int tt = 0; tt < 4; ++tt) {
                const int lr = wm * 64 + tt * 16 + fr; const float rs = s_rs[lr];
                bf16_t* dst = p.KN + (size_t)(m0 + lr) * 512 + n0 + wn * 64;
                store8x2(dst, acc[0][tt] * rs, acc[1][tt] * rs, fq); store8x2(dst + 32, acc[2][tt] * rs, acc[3][tt] * rs, fq);
            }
        } else {
            gemm_mainloop<4, true>(A, PJLD, p.WukvT + (size_t)n0 * 128, 128, 128, acc, sm);
            const int vrow0 = 768 + (n0 - 512) + wn * 64;
#pragma unroll
            for (int t2 = 0; t2 < 2; ++t2) {
                const int lr = wm * 64 + t2 * 32 + fq * 4;
                const f32x4 rs0 = *(const f32x4*)(s_rs + lr), rs1 = *(const f32x4*)(s_rs + lr + 16);
                const int lp = wm * 64 + t2 * 32 + fq * 8;
#pragma unroll
                for (int ft = 0; ft < 4; ++ft) {
                    const f32x4 a = acc[ft][2 * t2] * rs0, b = acc[ft][2 * t2 + 1] * rs1;
                    u32x4 w; w.x = pk_bf16(a[0], a[1]); w.y = pk_bf16(a[2], a[3]); w.z = pk_bf16(b[0], b[1]); w.w = pk_bf16(b[2], b[3]);
                    *(u32x4*)(p.VT + (size_t)(vrow0 + ft * 16 + fr) * MC + m0 + lp) = w;
                }
            }
        }
    }
    __syncthreads();
}

template <int MODE>
DEV void attn_item(const P& p, int layer, int item, bool ctxq, unsigned char* smraw) {
    constexpr bool GQA = (MODE == 1 || MODE == 3);
    constexpr int DQK = (MODE == 0) ? 96 : 64, NKS = DQK / 32;
    constexpr int KRB = (MODE == 0) ? 256 : 128, KM = (MODE == 0) ? 15 : 7;
    constexpr int KT_B = 64 * KRB, VT_B = 64 * 128;
    unsigned char* Ks = smraw; unsigned char* Vs = smraw + 32768; float* bias_s = (float*)(smraw + 49152);
    const int tid = ltid(), lane = tid & 63, wid = uni(tid >> 6), fr = lane & 15, fq = lane >> 4;
    const int nqt = ctxq ? (GQA ? 8 : 2) : (GQA ? 64 : 16);
    const int nh = GQA ? 2 : 8;
    const int qt = item % nqt, hh = (item / nqt) % nh, lb = item / (nqt * nh);
    const int head = GQA ? hh * 4 + wid : hh;
    const int tok0 = GQA ? qt * 32 : qt * 128 + wid * 32;
    const int qrow0 = (ctxq ? LAT_C + lb * CTX : lb * SEQ) + tok0;
    bf16x8 qf[2][NKS];
#pragma unroll
    for (int q = 0; q < 2; ++q) {
        const int row = qrow0 + q * 16 + fr;
        if (MODE == 0) {
            qf[q][0] = *(const bf16x8*)(p.QA + (size_t)row * 768 + head * 64 + fq * 8);
            qf[q][1] = *(const bf16x8*)(p.QA + (size_t)row * 768 + head * 64 + 32 + fq * 8);
            qf[q][NKS - 1] = *(const bf16x8*)(p.QA + (size_t)row * 768 + 512 + head * 32 + fq * 8);
        } else {
            const int qoff = MODE == 1 ? 384 : (MODE == 2 ? 1024 : 2048);
#pragma unroll
            for (int ks = 0; ks < NKS; ++ks) qf[q][ks] = *(const bf16x8*)(p.PJ + (size_t)row * PJLD + qoff + head * 64 + ks * 32 + fq * 8);
        }
    }
    const int koff = MODE == 1 ? 896 + hh * 64 : (MODE == 2 ? 1536 + hh * 64 : 2560 + hh * 64);
    const int vrow0 = MODE == 0 ? 768 + hh * 64 : (MODE == 1 ? hh * 64 : (MODE == 2 ? 128 + hh * 64 : 640 + hh * 64));
    int ktlo = 0, nlat = 0;
    if (!ctxq) {
        if (MODE == 0 || MODE == 3) { ktlo = 0; nlat = 32; }
        else if (MODE == 1) { const int q0 = qt * 32; const int lo = max(0, q0 - 128), hi = min(SEQ - 1, q0 + 159); ktlo = lo >> 6; nlat = (hi >> 6) - ktlo + 1; }
        else { const int r0a = min(max(2 * qt - 4, 0), 24), r0b = min(max(2 * qt + 1 - 4, 0), 24); ktlo = r0a; nlat = r0b + 8 - r0a; }
    }
    const int nt = 4 + nlat;
    const int ntf = ctxq ? 4 : ((MODE == 0 || MODE == 3) ? 36 : (MODE == 1 ? 9 : 13));
    if (MODE == 2 && !ctxq) { for (int i = tid; i < 465; i += 256) bias_s[i] = p.rpb_c[(layer * 8 + hh) * 465 + i] * LOG2E; }

    u32x4 rk[NKS], rv[2];
    auto tile_krow = [&](int it) { it = min(it, nt - 1); return it < 4 ? LAT_C + lb * CTX + it * 64 : lb * SEQ + (ktlo + it - 4) * 64; };
    auto gload = [&](int it) {
        const int krow = tile_krow(it);
#pragma unroll
        for (int i = 0; i < NKS; ++i) {
            const int id = tid + i * 256;
            if (MODE == 0) {
                const int key = id / 12, c = id - key * 12;
                const bf16_t* src = c < 8 ? p.KN + (size_t)(krow + key) * 512 + hh * 64 + c * 8 : p.PJ + (size_t)(krow + key) * PJLD + 2688 + (c - 8) * 8;
                rk[i] = *(const u32x4*)src;
            } else {
                const int key = id >> 3, c = id & 7;
                rk[i] = *(const u32x4*)(p.PJ + (size_t)(krow + key) * PJLD + koff + c * 8);
            }
        }
#pragma unroll
        for (int i = 0; i < 2; ++i) { const int id = tid + i * 256; const int dv = id >> 3, c = id & 7; rv[i] = *(const u32x4*)(p.VT + (size_t)(vrow0 + dv) * MC + krow + c * 8); }
    };
    auto lstore = [&](int buf) {
#pragma unroll
        for (int i = 0; i < NKS; ++i) {
            const int id = tid + i * 256; int key, c;
            if (MODE == 0) { key = id / 12; c = id - key * 12; } else { key = id >> 3; c = id & 7; }
            *(u32x4*)(Ks + buf * KT_B + key * KRB + ((c ^ (key & KM)) << 4)) = rk[i];
        }
#pragma unroll
        for (int i = 0; i < 2; ++i) { const int id = tid + i * 256; const int dv = id >> 3, c = id & 7; *(u32x4*)(Vs + buf * VT_B + dv * 128 + ((c ^ (dv & 7)) << 4)) = rv[i]; }
    };

    f32x4 o[4][2], lo[2], negm4[2]; float mref[2];
    const bf16x8 ones8 = __builtin_bit_cast(bf16x8, (u32x4){0x3F803F80u, 0x3F803F80u, 0x3F803F80u, 0x3F803F80u});
#pragma unroll
    for (int q = 0; q < 2; ++q) { mref[q] = 0.f; lo[q] = (f32x4){0.f, 0.f, 0.f, 0.f}; negm4[q] = (f32x4){0.f, 0.f, 0.f, 0.f};
#pragma unroll
        for (int d = 0; d < 4; ++d) o[d][q] = (f32x4){0.f, 0.f, 0.f, 0.f}; }

    gload(0); lstore(0); gload(1); __syncthreads();
    for (int it = 0; it < ntf; ++it) {
        const int cur = it & 1;
        if (it + 1 < ntf) lstore(cur ^ 1);
        if (it + 2 < ntf) gload(it + 2);
        __builtin_amdgcn_sched_barrier(0);
        const int kt = ktlo + it - 4;
        bool active = it < nt;
        int r = 0, r0 = 0;
        if (MODE == 2 && !ctxq && it >= 4) { r = 2 * qt + (wid >> 1); r0 = min(max(r - 4, 0), 24); active = active && (kt >= r0 && kt < r0 + 8); }
        if (active) {
            f32x4 s[4][2];
            const unsigned char* kb = Ks + cur * KT_B + fr * KRB;
            bf16x8 kf[4][NKS];
#pragma unroll
            for (int k4 = 0; k4 < 4; ++k4)
#pragma unroll
                for (int ks = 0; ks < NKS; ++ks) kf[k4][ks] = *(const bf16x8*)(kb + k4 * 16 * KRB + (((ks * 4 + fq) ^ (fr & KM)) << 4));
            __builtin_amdgcn_sched_barrier(0);
#pragma unroll
            for (int k4 = 0; k4 < 4; ++k4) {
#pragma unroll
                for (int q = 0; q < 2; ++q) s[k4][q] = mfma16(kf[k4][0], qf[q][0], negm4[q]);
#pragma unroll
                for (int ks = 1; ks < NKS; ++ks)
#pragma unroll
                    for (int q = 0; q < 2; ++q) s[k4][q] = mfma16(kf[k4][ks], qf[q][ks], s[k4][q]);
            }
            const unsigned char* vb = Vs + cur * VT_B + fr * 128;
            bf16x8 vf[4][2];
#pragma unroll
            for (int d = 0; d < 4; ++d)
#pragma unroll
                for (int kb2 = 0; kb2 < 2; ++kb2) vf[d][kb2] = *(const bf16x8*)(vb + d * 16 * 128 + (((kb2 * 4 + fq) ^ (fr & 7)) << 4));
            __builtin_amdgcn_sched_barrier(0);
            if (!ctxq && it >= 4) {
                if (MODE == 1) {
#pragma unroll
                    for (int q = 0; q < 2; ++q) {
                        const int qpos = tok0 + q * 16 + fr;
#pragma unroll
                        for (int k4 = 0; k4 < 4; ++k4)
#pragma unroll
                            for (int j = 0; j < 4; ++j) { const int d = qpos - (kt * 64 + k4 * 16 + fq * 4 + j); if (d > 128 || d < -128) s[k4][q][j] = -1e30f; }
                    }
                }
                if (MODE == 2) {
#pragma unroll
                    for (int q = 0; q < 2; ++q) {
                        const int qc = (wid & 1) * 32 + q * 16 + fr; const int c0 = min(max(qc - 8, 0), 48);
                        const int bbase = (kt - r + 7) * 31 + 15 - qc;
#pragma unroll
                        for (int k4 = 0; k4 < 4; ++k4)
#pragma unroll
                            for (int j = 0; j < 4; ++j) {
                                const int kc = k4 * 16 + fq * 4 + j; const bool ok = (kc >= c0 && kc < c0 + 16);
                                const float bv = bias_s[ok ? bbase + kc : 0];
                                s[k4][q][j] = ok ? s[k4][q][j] + bv : -1e30f;
                            }
                    }
                }
            }
            bf16x8 pf[2][2];
#pragma unroll
            for (int q = 0; q < 2; ++q) {
                float mx = -1e30f;
#pragma unroll
                for (int k4 = 0; k4 < 4; ++k4) mx = fmaxf(mx, fmaxf(fmaxf(s[k4][q][0], s[k4][q][1]), fmaxf(s[k4][q][2], s[k4][q][3])));
                mx = xmax32(xmax16(mx));
                const bool need = (it == 0) || (mx > 8.f);
                if (__builtin_amdgcn_ballot_w64(need) != 0ull) {
                    const float delta = need ? mx : 0.f;
                    mref[q] += delta; negm4[q] = negm4[q] - delta;
#pragma unroll
                    for (int k4 = 0; k4 < 4; ++k4) s[k4][q] = s[k4][q] - delta;
                    const float alpha = fexp2(-delta);
                    lo[q] = lo[q] * alpha;
#pragma unroll
                    for (int d = 0; d < 4; ++d) o[d][q] = o[d][q] * alpha;
                }
#pragma unroll
                for (int k4 = 0; k4 < 4; ++k4)
#pragma unroll
                    for (int j = 0; j < 4; ++j) s[k4][q][j] = fexp2(s[k4][q][j]);
#pragma unroll
                for (int kb2 = 0; kb2 < 2; ++kb2) {
                    u32x4 w; w.x = pk_bf16(s[2 * kb2][q][0], s[2 * kb2][q][1]); w.y = pk_bf16(s[2 * kb2][q][2], s[2 * kb2][q][3]);
                    w.z = pk_bf16(s[2 * kb2 + 1][q][0], s[2 * kb2 + 1][q][1]); w.w = pk_bf16(s[2 * kb2 + 1][q][2], s[2 * kb2 + 1][q][3]);
                    pf[q][kb2] = __builtin_bit_cast(bf16x8, w);
                }
            }
#pragma unroll
            for (int d = 0; d < 4; ++d)
#pragma unroll
                for (int kb2 = 0; kb2 < 2; ++kb2)
#pragma unroll
                    for (int q = 0; q < 2; ++q) o[d][q] = mfma16(vf[d][kb2], pf[q][kb2], o[d][q]);
#pragma unroll
            for (int kb2 = 0; kb2 < 2; ++kb2)
#pragma unroll
                for (int q = 0; q < 2; ++q) lo[q] = mfma16(ones8, pf[q][kb2], lo[q]);
        }
        __syncthreads();
    }
#pragma unroll
    for (int q = 0; q < 2; ++q) {
        float l = lo[q][0];
        if (MODE == 1) l += fexp2(p.sink_b[layer * 8 + head] * LOG2E - mref[q]);
        const float inv = 1.f / l;
        bf16_t* dst = p.O + (size_t)(qrow0 + q * 16 + fr) * 2048 + MODE * 512 + head * 64;
        store8x2(dst, o[0][q] * inv, o[1][q] * inv, fq); store8x2(dst + 32, o[2][q] * inv, o[3][q] * inv, fq);
    }
}


namespace pg8 {
#define PG8_LAS __attribute__((address_space(3)))
constexpr int BM = 256, BK = 64, HALF = 128, HTB = HALF * BK * 2  , STAGE_BYTES = 8 * HTB, NXCD = 8, WGM = 8;

__host__ __device__ __forceinline__ int lds_byte(int r, int c) { const int st = (r >> 4) * 2 + (c >> 5), rr = r & 15, cc = c & 31, ob = rr * 64 + cc * 2; return st * 1024 + (ob ^ (((ob >> 9) & 1) << 5)); }
__host__ __device__ __forceinline__ void stage_rc(int b, int& R, int& C) { const int st = b / 1024, sb = b % 1024, swz = sb ^ (((sb >> 9) & 1) << 5); R = (st >> 1) * 16 + swz / 64; C = (st & 1) * 32 + (swz % 64) / 2; }
__host__ __device__ __forceinline__ int perm32(int rho) { const int n = rho >> 4, i = rho & 15; return 8 * (i >> 2) + 4 * n + (i & 3); }

struct Unit { int pm, pn; };
struct Gemm { const bf16_t* A; const bf16_t* Bt; int M, N, K; };

template <class Epi, class Sched, bool ALIGN_EPI = false, bool SP2 = false, bool SWAPMMA = false>
__device__ __forceinline__ void gemm_phase(PG8_LAS unsigned char* lds, const Gemm g, const Sched& S, const Epi& E) {
    int tid = threadIdx.x; asm volatile("" : "+v"(tid));
    const int wid = __builtin_amdgcn_readfirstlane(tid >> 6), lane = tid & 63, wr = wid >> 2, wc = wid & 3, fr = lane & 15, fq = lane >> 4;
    const int K = g.K, nt = K / BK;
    unsigned voffA[2], voffB[2];
#pragma unroll
    for (int i = 0; i < 2; ++i) { int R, C; stage_rc(tid * 16 + i * 8192, R, C); const int Rb = Epi::PERM ? ((R & ~31) + perm32(R & 31)) : R;
        voffA[i] = (unsigned)(R * K + C) * 2u; voffB[i] = (unsigned)(Rb * K + C) * 2u; }
    const size_t kstep = (size_t)(BK * 2);
    const size_t hstep = (size_t)HALF * K * 2;
    const size_t tstep = 2 * hstep;
    const unsigned ldsw = (unsigned)wid * 1024u;
    const int aoff = lds_byte(wr * 64 + fr, fq * 8), boff = lds_byte(wc * 32 + fr, fq * 8);
#define PG8_SA(b, h) (((b) * 2 + (h)) * HTB)
#define PG8_SB(b, h) ((4 + (b) * 2 + (h)) * HTB)
#define PG8_STAGE(bufoff, gbase, voff) do { _Pragma("unroll") for (int _i = 0; _i < 2; ++_i) \
        __builtin_amdgcn_global_load_lds((const unsigned*)((const char*)(gbase) + (voff)[_i]), (PG8_LAS unsigned*)(lds + (bufoff) + ldsw + _i * 8192), 16, 0, 0); } while (0)
#define PG8_LDA(dst, b, h) do { _Pragma("unroll") for (int m = 0; m < 4; ++m) _Pragma("unroll") for (int k = 0; k < 2; ++k) dst[m][k] = *(const PG8_LAS bf16x8*)(lds + PG8_SA(b, h) + aoff + m * 2048 + k * 1024); } while (0)
#define PG8_LDB(dst, b, h) do { _Pragma("unroll") for (int n = 0; n < 2; ++n) _Pragma("unroll") for (int k = 0; k < 2; ++k) dst[n][k] = *(const PG8_LAS bf16x8*)(lds + PG8_SB(b, h) + boff + n * 2048 + k * 1024); } while (0)
#define PG8_MMA(ai, bj, At, Bt) do { __builtin_amdgcn_s_setprio(1); _Pragma("unroll") for (int m = 0; m < 4; ++m) _Pragma("unroll") for (int n = 0; n < 2; ++n) _Pragma("unroll") for (int k = 0; k < 2; ++k) \
        acc[ai][bj][m][n] = SWAPMMA ? __builtin_amdgcn_mfma_f32_16x16x32_bf16(At[m][k], Bt[n][k], acc[ai][bj][m][n], 0, 0, 0) : __builtin_amdgcn_mfma_f32_16x16x32_bf16(Bt[n][k], At[m][k], acc[ai][bj][m][n], 0, 0, 0); __builtin_amdgcn_s_setprio(0); } while (0)
#define PG8_WAIT_V(n) asm volatile("s_waitcnt vmcnt(" #n ")" ::: "memory")
#define PG8_WAIT_L(n) asm volatile("s_waitcnt lgkmcnt(" #n ")" ::: "memory")
#define PG8_BAR __builtin_amdgcn_s_barrier()
#define PG8_SCHED __builtin_amdgcn_sched_barrier(0)
    Unit cur, nxt; int ui = 0;
    if (!S.next(0, cur)) return;
    f32x4 acc[2][2][4][2];
#pragma unroll
    for (int a = 0; a < 2; ++a)
#pragma unroll
        for (int b = 0; b < 2; ++b)
#pragma unroll
            for (int m = 0; m < 4; ++m)
#pragma unroll
                for (int n = 0; n < 2; ++n) acc[a][b][m][n] = (f32x4){0.f, 0.f, 0.f, 0.f};
    bf16x8 At[4][2], B0[2][2], B1[2][2];
    const char* cA = (const char*)g.A + (size_t)cur.pm * tstep; const char* cB = (const char*)g.Bt + (size_t)cur.pn * tstep;
    S.a_ready(cur);
    if constexpr (SP2) {
        PG8_STAGE(PG8_SB(0, 0), cB, voffB); PG8_STAGE(PG8_SB(0, 1), cB + hstep, voffB); PG8_STAGE(PG8_SA(0, 0), cA, voffA); PG8_STAGE(PG8_SA(0, 1), cA + hstep, voffA);
        if (wr == 1) PG8_BAR;
        PG8_WAIT_V(2); PG8_BAR;
        PG8_STAGE(PG8_SB(1, 0), cB + kstep, voffB); PG8_STAGE(PG8_SA(1, 0), cA + kstep, voffA); PG8_STAGE(PG8_SB(1, 1), cB + hstep + kstep, voffB);
        PG8_WAIT_V(6); PG8_BAR;
    } else {
        PG8_STAGE(PG8_SB(0, 0), cB, voffB); PG8_STAGE(PG8_SA(0, 0), cA, voffA); PG8_STAGE(PG8_SB(0, 1), cB + hstep, voffB); PG8_STAGE(PG8_SA(0, 1), cA + hstep, voffA);
        if (wr == 1) PG8_BAR;
        PG8_WAIT_V(4); PG8_BAR;
        PG8_STAGE(PG8_SB(1, 0), cB + kstep, voffB); PG8_STAGE(PG8_SA(1, 0), cA + kstep, voffA); PG8_STAGE(PG8_SB(1, 1), cB + hstep + kstep, voffB);
        PG8_WAIT_V(6); PG8_BAR;
    }
    for (;;) {
        const bool has_next = S.next(ui + 1, nxt);
        const char* nA = has_next ? (const char*)g.A + (size_t)nxt.pm * tstep : cA; const char* nB = has_next ? (const char*)g.Bt + (size_t)nxt.pn * tstep : cB;
        for (int t = 0; t < nt; t += 2) {
            if constexpr (Epi::HAS_MID) { if (t != 0 && (t & 7) == 0) { E.mid(acc, cur, t >> 3, wid, lane); asm volatile("s_waitcnt vmcnt(0)" ::: "memory"); } }
            const bool last = (t == nt - 2);
            const char* a1 = cA + (size_t)(t + 1) * kstep;
            const char* a2 = last ? nA : cA + (size_t)(t + 2) * kstep; const char* b2 = last ? nB : cB + (size_t)(t + 2) * kstep;
            const char* a3 = a2 + kstep; const char* b3 = b2 + kstep;
            if (last && has_next) S.a_ready(nxt);
            if constexpr (SP2) {
            PG8_LDB(B0, 0, 0); PG8_LDB(B1, 0, 1); PG8_SCHED; PG8_LDA(At, 0, 0); PG8_STAGE(PG8_SA(1, 1), a1 + hstep, voffA);
            PG8_WAIT_V(8); PG8_WAIT_L(0); PG8_BAR; PG8_MMA(0, 0, At, B0); PG8_MMA(0, 1, At, B1); PG8_BAR; PG8_SCHED;
            PG8_LDA(At, 0, 1); PG8_STAGE(PG8_SB(0, 0), b2, voffB); PG8_STAGE(PG8_SB(0, 1), b2 + hstep, voffB); PG8_STAGE(PG8_SA(0, 0), a2, voffA);
            PG8_WAIT_V(8); PG8_WAIT_L(0); PG8_BAR; PG8_MMA(1, 0, At, B0); PG8_MMA(1, 1, At, B1); PG8_BAR; PG8_SCHED;
            PG8_LDB(B0, 1, 0); PG8_LDB(B1, 1, 1); PG8_SCHED; PG8_LDA(At, 1, 0); PG8_STAGE(PG8_SA(0, 1), a2 + hstep, voffA);
            PG8_WAIT_V(8); PG8_WAIT_L(0); PG8_BAR; PG8_MMA(0, 0, At, B0); PG8_MMA(0, 1, At, B1); PG8_BAR; PG8_SCHED;
            PG8_LDA(At, 1, 1); PG8_STAGE(PG8_SB(1, 0), b3, voffB); PG8_STAGE(PG8_SB(1, 1), b3 + hstep, voffB); PG8_STAGE(PG8_SA(1, 0), a3, voffA);
            PG8_WAIT_V(8); PG8_WAIT_L(0); PG8_BAR; PG8_MMA(1, 0, At, B0); PG8_MMA(1, 1, At, B1); PG8_BAR; PG8_SCHED;
            } else {
            PG8_LDB(B0, 0, 0); PG8_SCHED; PG8_LDA(At, 0, 0); PG8_STAGE(PG8_SA(1, 1), a1 + hstep, voffA);
            PG8_WAIT_L(8); PG8_BAR; PG8_WAIT_L(0); PG8_MMA(0, 0, At, B0); PG8_BAR; PG8_SCHED;
            PG8_LDB(B1, 0, 1); PG8_STAGE(PG8_SB(0, 0), b2, voffB);
            PG8_BAR; PG8_WAIT_L(0); PG8_MMA(0, 1, At, B1); PG8_BAR;
            PG8_LDA(At, 0, 1); PG8_STAGE(PG8_SA(0, 0), a2, voffA);
            PG8_BAR; PG8_WAIT_L(0); PG8_MMA(1, 0, At, B0); PG8_BAR; PG8_SCHED;
            PG8_STAGE(PG8_SB(0, 1), b2 + hstep, voffB);
            PG8_WAIT_V(6); PG8_BAR; PG8_MMA(1, 1, At, B1); PG8_BAR;
            PG8_LDB(B0, 1, 0); PG8_SCHED; PG8_LDA(At, 1, 0); PG8_STAGE(PG8_SA(0, 1), a2 + hstep, voffA);
            PG8_WAIT_L(8); PG8_BAR; PG8_WAIT_L(0); PG8_MMA(0, 0, At, B0); PG8_BAR; PG8_SCHED;
            PG8_LDB(B1, 1, 1); PG8_STAGE(PG8_SB(1, 0), b3, voffB);
            PG8_BAR; PG8_WAIT_L(0); PG8_MMA(0, 1, At, B1); PG8_BAR;
            PG8_LDA(At, 1, 1); PG8_STAGE(PG8_SA(1, 0), a3, voffA);
            PG8_BAR; PG8_WAIT_L(0); PG8_MMA(1, 0, At, B0); PG8_BAR; PG8_SCHED;
            PG8_STAGE(PG8_SB(1, 1), b3 + hstep, voffB);
            PG8_WAIT_V(6); PG8_BAR; PG8_MMA(1, 1, At, B1); PG8_BAR;
            }
        }
        if constexpr (ALIGN_EPI) { if (wr == 0) PG8_BAR; }
        if constexpr (!Epi::AFTER_DRAIN) { E(acc, cur, wr, wc, fr, fq); S.done(cur); }
        if (!has_next) break;
#pragma unroll
        for (int a = 0; a < 2; ++a)
#pragma unroll
            for (int b = 0; b < 2; ++b)
#pragma unroll
                for (int m = 0; m < 4; ++m)
#pragma unroll
                    for (int n = 0; n < 2; ++n) acc[a][b][m][n] = (f32x4){0.f, 0.f, 0.f, 0.f};
        cur = nxt; cA = nA; cB = nB; ++ui;
        if constexpr (ALIGN_EPI) { if (wr == 1) PG8_BAR; }
    }
    PG8_WAIT_V(0);
    if constexpr (!ALIGN_EPI) { if (wr == 0) PG8_BAR; }
    PG8_BAR;
    if constexpr (Epi::AFTER_DRAIN) { E.fused(acc, cur, wr, wc, fr, fq, lds, wid, lane); S.done(cur); }
#undef PG8_SA
#undef PG8_SB
#undef PG8_STAGE
#undef PG8_LDA
#undef PG8_LDB
#undef PG8_MMA
#undef PG8_WAIT_V
#undef PG8_WAIT_L
#undef PG8_BAR
#undef PG8_SCHED
}
}

struct XSched {
    int nN, nunits, G, c, skipctx;
    DEV bool next(int i, pg8::Unit& u) const {
        const int L = i * G + c; if (L >= nunits) return false;
        const int U = ((nunits & 7) == 0 && (G & 7) == 0) ? (L & 7) * (nunits >> 3) + (L >> 3) : L;
        { const int nM = nunits / nN, nig = 4 * nN, gid = U / nig, fm = gid * 4, gsz = min(nM - fm, 4), r = U - gid * nig; u.pm = fm + r % gsz; u.pn = r / gsz; }
        if (skipctx) u.pm = (u.pm >> 6) * 72 + (u.pm & 63);
        return true;
    }
    DEV void a_ready(const pg8::Unit&) const {}
    DEV void done(const pg8::Unit&) const {}
};
struct EpiStoreT {
    static constexpr bool PERM = false, AFTER_DRAIN = false, HAS_MID = false;
    bf16_t* out; int ld; int row_off;
    DEV void operator()(const f32x4 (&acc)[2][2][4][2], const pg8::Unit& u, int wr, int wc, int fr, int fq) const {
#pragma unroll
        for (int ai = 0; ai < 2; ++ai)
#pragma unroll
            for (int m = 0; m < 4; ++m) {
                bf16_t* d = out + (size_t)(row_off + u.pm * 256 + ai * 128 + wr * 64 + m * 16 + fr) * ld + u.pn * 256 + wc * 32;
#pragma unroll
                for (int bj = 0; bj < 2; ++bj) store8x2(d + bj * 128, acc[ai][bj][m][0], acc[ai][bj][m][1], fq);
            }
    }
};
struct EpiSwiglu {
    static constexpr bool PERM = false, AFTER_DRAIN = false, HAS_MID = false;
    bf16_t* act;
    DEV void operator()(const f32x4 (&acc)[2][2][4][2], const pg8::Unit& u, int wr, int wc, int fr, int fq) const {
#pragma unroll
        for (int ai = 0; ai < 2; ++ai)
#pragma unroll
            for (int m = 0; m < 4; ++m) {
                bf16_t* d = act + (size_t)(u.pm * 256 + ai * 128 + wr * 64 + m * 16 + fr) * DFF + u.pn * 128 + wc * 32;
                f32x4 r[2];
#pragma unroll
                for (int n = 0; n < 2; ++n) {
                    const f32x4 a = acc[ai][0][m][n], b = acc[ai][1][m][n];
#pragma unroll
                    for (int j = 0; j < 4; ++j) r[n][j] = a[j] * frcp(1.f + fexp2(-a[j] * LOG2E)) * b[j];
                }
                store8x2(d, r[0], r[1], fq);
            }
    }
};
struct EpiVT {
    static constexpr bool PERM = false, AFTER_DRAIN = false, HAS_MID = false;
    bf16_t* vt;
    DEV void operator()(const f32x4 (&acc)[2][2][4][2], const pg8::Unit& u, int wr, int wc, int fr, int fq) const {
#pragma unroll
        for (int bj = 0; bj < 2; ++bj)
#pragma unroll
            for (int n = 0; n < 2; ++n) {
                bf16_t* d = vt + (size_t)(u.pn * 256 + bj * 128 + wc * 32 + n * 16 + fr) * MC + u.pm * 256 + wr * 64 + fq * 8;
#pragma unroll
                for (int ai = 0; ai < 2; ++ai)
#pragma unroll
                    for (int m2 = 0; m2 < 2; ++m2) {
                        const f32x4 a = acc[ai][bj][2 * m2][n], b = acc[ai][bj][2 * m2 + 1][n];
                        u32x4 w; w.x = pk_bf16(a[0], a[1]); w.y = pk_bf16(a[2], a[3]); w.z = pk_bf16(b[0], b[1]); w.w = pk_bf16(b[2], b[3]);
                        *(u32x4*)(d + ai * 128 + m2 * 32) = w;
                    }
            }
    }
};
DEV size_t gate_index(int pm, int pn4, int wave, int r8, int lane) { return ((((size_t)pm * 16 + pn4) * 8 + wave) * 8 + r8) * 64 + lane; }
struct EpiGate {
    static constexpr bool PERM = false, AFTER_DRAIN = false, HAS_MID = false;
    u32x4* g8;
    DEV void operator()(const f32x4 (&acc)[2][2][4][2], const pg8::Unit& u, int wr, int wc, int fr, int fq) const {
        const int lane = fq * 16 + fr, wave = wr * 4 + wc;
#pragma unroll
        for (int ai = 0; ai < 2; ++ai)
#pragma unroll
            for (int m = 0; m < 4; ++m) {
                u32x4 w;
#pragma unroll
                for (int bj = 0; bj < 2; ++bj)
#pragma unroll
                    for (int n = 0; n < 2; ++n) {
                        const f32x4 a = acc[ai][bj][m][n]; unsigned x = 0;
#pragma unroll
                        for (int j = 0; j < 4; ++j) { const float s = frcp(1.f + fexp2(-a[j] * LOG2E)); x |= max(1u, (unsigned)(s * 255.f + 0.5f)) << (8 * j); }
                        w[bj * 2 + n] = x;
                    }
                g8[gate_index(u.pm, u.pn, wave, ai * 4 + m, lane)] = w;
            }
    }
};
struct EpiMerge {
    static constexpr bool PERM = false, AFTER_DRAIN = false, HAS_MID = true;
    bf16_t* out; const u32x4* g8;
    DEV void mid(f32x4 (&acc)[2][2][4][2], const pg8::Unit& u, int n, int wave, int lane) const {
#pragma unroll
        for (int ai = 0; ai < 2; ++ai)
#pragma unroll
            for (int m = 0; m < 4; ++m) {
                const u32x4 a = g8[gate_index(u.pm, (n - 1) * 4 + u.pn, wave, ai * 4 + m, lane)], b = g8[gate_index(u.pm, n * 4 + u.pn, wave, ai * 4 + m, lane)];
#pragma unroll
                for (int bj = 0; bj < 2; ++bj)
#pragma unroll
                    for (int nn = 0; nn < 2; ++nn) {
                        const unsigned x = a[bj * 2 + nn], y = b[bj * 2 + nn]; f32x4 r;
#pragma unroll
                        for (int j = 0; j < 4; ++j) r[j] = (float)((x >> (8 * j)) & 255u) * frcp((float)((y >> (8 * j)) & 255u));
                        acc[ai][bj][m][nn] = acc[ai][bj][m][nn] * r;
                    }
            }
    }
    DEV void operator()(const f32x4 (&acc)[2][2][4][2], const pg8::Unit& u, int wr, int wc, int fr, int fq) const {
        const int lane = fq * 16 + fr, wave = wr * 4 + wc;
#pragma unroll
        for (int ai = 0; ai < 2; ++ai)
#pragma unroll
            for (int m = 0; m < 4; ++m) {
                const u32x4 a = g8[gate_index(u.pm, 12 + u.pn, wave, ai * 4 + m, lane)];
                bf16_t* d = out + (size_t)(u.pm * 256 + ai * 128 + wr * 64 + m * 16 + fr) * 1024 + u.pn * 256 + wc * 32;
#pragma unroll
                for (int bj = 0; bj < 2; ++bj) {
                    f32x4 r[2];
#pragma unroll
                    for (int nn = 0; nn < 2; ++nn) {
                        const unsigned x = a[bj * 2 + nn];
#pragma unroll
                        for (int j = 0; j < 4; ++j) r[nn][j] = (float)((x >> (8 * j)) & 255u) * (1.f / 255.f);
                    }
                    store8x2(d + bj * 128, acc[ai][bj][m][0] * r[0], acc[ai][bj][m][1] * r[1], fq);
                }
            }
    }
};
struct EpiGemm1 {
    static constexpr bool PERM = false, AFTER_DRAIN = false, HAS_MID = false;
    const P* pp; int layer;
    DEV void operator()(const f32x4 (&acc)[2][2][4][2], const pg8::Unit& u, int wr, int wc, int fr, int fq) const {
        const int slab = u.pn * 256 + wc * 64; const bool lat = u.pm * 256 < LAT_C;
        if (slab >= 2752) return;
#pragma unroll
        for (int ai = 0; ai < 2; ++ai)
#pragma unroll
            for (int m = 0; m < 4; ++m) {
                f32x4 v[4] = {acc[ai][0][m][0], acc[ai][0][m][1], acc[ai][1][m][0], acc[ai][1][m][1]};
                gemm1_row(v, u.pm * 256 + ai * 128 + wr * 64 + m * 16 + fr, slab, lat, *pp, layer, fq);
            }
    }
};

#define LAS __attribute__((address_space(3)))
#define XB_TMO      128
#define XB_XCNT(j)  (256  + 64 * (j))
#define XB_XSUB(j)  (1280 + 64 * (j))
#define XB_XGEN(j)  (2304 + 64 * (j))
#define XB_TOP      3328
#define XB_TOPGEN   3392
#define XCD_BAR_WORDS 3456
#define XB_SPIN_CAP (1u << 18)

__device__ __forceinline__ unsigned xb_ld(unsigned* p)              { return __hip_atomic_load(p, __ATOMIC_RELAXED, __HIP_MEMORY_SCOPE_AGENT); }
__device__ __forceinline__ unsigned xb_add(unsigned* p, unsigned v) { return __hip_atomic_fetch_add(p, v, __ATOMIC_RELAXED, __HIP_MEMORY_SCOPE_AGENT); }
__device__ __forceinline__ unsigned xb_xcc_id() { return (unsigned)__builtin_amdgcn_s_getreg((3 << 11) | 20) & 0xFu; }
#define XB_SPIN(cond, bar) do { unsigned _sp = 0; while (cond) { __builtin_amdgcn_s_sleep(1); \
    if ((++_sp & 255u) == 0u) { if (xb_ld(&(bar)[XB_TMO])) break; if (_sp > XB_SPIN_CAP) { atomicAdd(&(bar)[XB_TMO], 1u); break; } } } } while (0)

struct XcdBarrier {
    unsigned* bar; unsigned x;
    volatile LAS unsigned* st;
};

__device__ __forceinline__ XcdBarrier xcd_barrier_post(unsigned* bar, volatile LAS unsigned* st) {
    XcdBarrier b; b.bar = bar; b.x = xb_xcc_id(); b.st = st;
    if (threadIdx.x == 0) (void)xb_add(&bar[XB_XCNT(b.x)], 1u);
    return b;
}
__device__ __forceinline__ void xcd_barrier_complete(unsigned* bar, unsigned x, unsigned& nloc, unsigned& nx) {
    const unsigned G = gridDim.x * gridDim.y * gridDim.z;
    unsigned sum, cnt, mine, sp = 0u;
    for (;;) {
        sum = 0u; cnt = 0u; mine = 0u;
#pragma unroll
        for (unsigned j = 0; j < 16; ++j) { const unsigned c = xb_ld(&bar[XB_XCNT(j)]); sum += c; cnt += (c > 0u) ? 1u : 0u; mine = (j == x) ? c : mine; }
        if (sum == G) break;
        __builtin_amdgcn_s_sleep(1);
        if ((++sp & 255u) == 0u) { if (xb_ld(&bar[XB_TMO])) break; if (sp > XB_SPIN_CAP) { atomicAdd(&bar[XB_TMO], 1u); break; } }
    }
    nloc = mine > 0u ? mine : 1u; nx = cnt > 0u ? cnt : 1u;
}

__device__ __forceinline__ void xcd_barrier(const XcdBarrier& b) {
    asm volatile("s_waitcnt vmcnt(0)" ::: "memory");
    __syncthreads();
    if (threadIdx.x == 0) {
        unsigned* bar = b.bar;
        __builtin_amdgcn_s_waitcnt(0);
        unsigned nloc = b.st[0], nx = b.st[1];
        if (nloc == 0u) { xcd_barrier_complete(bar, b.x, nloc, nx); b.st[0] = nloc; b.st[1] = nx; }
        const unsigned old = xb_add(&bar[XB_XSUB(b.x)], 1u);
        const unsigned gen = old / nloc;
        if (old + 1u == (gen + 1u) * nloc) {
            __builtin_amdgcn_fence(__ATOMIC_RELEASE, "agent");
            asm volatile("s_waitcnt vmcnt(0)" ::: "memory");
            const unsigned og = xb_add(&bar[XB_TOP], 1u);
            const unsigned tg = og / nx;
            if (og + 1u == (tg + 1u) * nx) xb_add(&bar[XB_TOPGEN], 1u);
            else XB_SPIN(xb_ld(&bar[XB_TOPGEN]) == tg, bar);
            __builtin_amdgcn_fence(__ATOMIC_ACQUIRE, "agent");
            xb_add(&bar[XB_XGEN(b.x)], 1u);
            asm volatile("s_waitcnt vmcnt(0)" ::: "memory");
        } else {
            XB_SPIN(xb_ld(&bar[XB_XGEN(b.x)]) == gen, bar);
            __builtin_amdgcn_fence(__ATOMIC_ACQUIRE, "agent");
            asm volatile("s_waitcnt vmcnt(0)" ::: "memory");
        }
    }
    __syncthreads();
}

typedef const __attribute__((address_space(4))) P* PP;
#define FRESH_P PP q_ = pp0; asm volatile("" : "+s"(q_)); const P& p = *(const P*)q_;
#define FRESH_BG int bidL = bid, GL = G; asm volatile("" : "+s"(bidL), "+s"(GL));
constexpr int DYN_LDS = 2 * SMEM_BYTES + 64;
__global__ void __launch_bounds__(512, 2) mega(P pv_) {
    cg::grid_group grid = cg::this_grid();
    PP pp0 = (PP)__builtin_amdgcn_kernarg_segment_ptr();
    extern __shared__ __attribute__((aligned(16))) unsigned char lds_dyn[];
    const int half = __builtin_amdgcn_readfirstlane((int)threadIdx.x >> 8);
    unsigned char* smraw = lds_dyn + half * SMEM_BYTES;
    bf16_t* sm = (bf16_t*)smraw;
    PG8_LAS unsigned char* ldsL = (PG8_LAS unsigned char*)lds_dyn;
    const int bid = blockIdx.x, G = gridDim.x, vb = bid * 2 + half, VG = G * 2, tid = threadIdx.x & 255;
    {
        FRESH_P
        volatile LAS unsigned* xst = (volatile LAS unsigned*)(ldsL + 2 * SMEM_BYTES);
        if (threadIdx.x == 0) { xst[0] = 0u; xst[1] = 0u; }
        __syncthreads();
        const XcdBarrier xb0 = xcd_barrier_post(p.barw, xst);
        if (threadIdx.x == 0) xst[2] = xb0.x;
        __syncthreads();
    }
#define GBAR() do { FRESH_P XcdBarrier b_; b_.bar = p.barw; b_.st = (volatile LAS unsigned*)(ldsL + 2 * SMEM_BYTES); b_.x = b_.st[2]; xcd_barrier(b_); } while (0)

    { FRESH_P
    for (int i = vb * 256 + tid; i < 64 * 16 + 64 * 8; i += VG * 256) {
        if (i < 1024) { const int pos = i >> 4, k = i & 15; const float inv = fexp2(-(float)k * (13.287712379549449f / 16.f)); const float a = (float)pos * inv; p.rt16[i] = (f32x2){__cosf(a), __sinf(a)}; }
        else { const int q = i - 1024; const int pos = q >> 3, k = q & 7; const float inv = fexp2(-(float)k * (13.287712379549449f / 8.f)); const float a = (float)pos * inv; p.rt8[q] = (f32x2){__cosf(a), __sinf(a)}; }
    }
    for (int t = vb; t < 384 + CONV_TILES; t += VG) { if (t < 384) mod_item(p, t, smraw); else conv_job(p, 0, t - 384, (float*)smraw); }
    }
    GBAR();
    { FRESH_P r_phase(p, 0, 0, vb, VG, 0, MTOT); }
    GBAR();

    for (int layer = 0; layer < DEPTH; ++layer) {
        const bool lastL = (layer == DEPTH - 1);
        for (int ch = 0; ch < NCH; ++ch) {
            { FRESH_P FRESH_BG
              const bf16_t* A = p.U + (size_t)ch * MC * 1024;
              { pg8::Gemm g{A, p.WinT, MC, 2816, 1024}; XSched S{11, 792, GL, bidL}; EpiGemm1 E{&p, layer};
                pg8::gemm_phase<EpiGemm1, XSched, true, true, false>(ldsL, g, S, E); }
              { pg8::Gemm g{A, p.WinT + (size_t)2816 * 1024, MC, 768, 1024}; XSched S{3, 216, GL, (bidL + GL - (792 % GL)) % GL}; EpiVT E{p.VT};
                pg8::gemm_phase<EpiVT, XSched, true, true, true>(ldsL, g, S, E); }
              { pg8::Gemm g{A, p.WinT + (size_t)NPROJ * 1024, MC, 4096, 1024}; XSched S{16, lastL ? 1024 : 1152, GL, (bidL + GL - (1008 % GL)) % GL}; EpiGate E{(u32x4*)p.G};
                pg8::gemm_phase<EpiGate, XSched, true, true, false>(ldsL, g, S, E); }
            }
            GBAR();
            { FRESH_P for (int t = vb; t < (lastL ? 4064 : 4448); t += VG) {
                if (t < 1024) attn_item<2>(p, layer, t, false, smraw);
                else if (t < 2048) attn_item<1>(p, layer, t - 1024, false, smraw);
                else if (t < 4064) { const int q = t - 2048; stage2_tile(p, q / 14, q % 14, smraw); }
                else if (t < 4192) attn_item<1>(p, layer, t - 4064, true, smraw);
                else if (t < 4320) attn_item<2>(p, layer, t - 4192, true, smraw);
                else attn_item<3>(p, layer, t - 4320, true, smraw);
            } }
            GBAR();
            { FRESH_P for (int t = vb; t < (lastL ? 2048 : 2176); t += VG) {
                if (t < 1024) attn_item<0>(p, layer, t, false, smraw);
                else if (t < 2048) attn_item<3>(p, layer, t - 1024, false, smraw);
                else attn_item<0>(p, layer, t - 2048, true, smraw);
            } }
            GBAR();
            { FRESH_P FRESH_BG pg8::Gemm g{p.O, p.WbrT, MC, 1024, 2048}; XSched S{4, lastL ? 256 : 288, GL, bidL}; EpiMerge E{p.MB, (const u32x4*)p.G};
              pg8::gemm_phase<EpiMerge, XSched, true, true, false>(ldsL, g, S, E); }
            GBAR();
            { FRESH_P FRESH_BG pg8::Gemm g{p.MB, p.WoutT, MC, 1024, 1024}; XSched S{4, lastL ? 256 : 288, GL, bidL}; EpiStoreT E{p.YC, 1024, 0};
              pg8::gemm_phase<EpiStoreT, XSched, true, true, false>(ldsL, g, S, E); }
            GBAR();
            { FRESH_P r_phase(p, 1, layer, vb, VG, ch * MC, ch * MC + (lastL ? LAT_C : MC)); }
            if (ch + 1 == NCH) GBAR();
        }
        { FRESH_P FRESH_BG pg8::Gemm g{p.U, p.Wf1T, MTOT, 2 * DFF, 1024}; XSched S{22, lastL ? 2816 : 3168, GL, bidL, lastL ? 1 : 0}; EpiSwiglu E{p.ACT};
          pg8::gemm_phase<EpiSwiglu, XSched, true, true, false>(ldsL, g, S, E); }
        GBAR();
        { FRESH_P FRESH_BG pg8::Gemm g{p.ACT, p.Wf2T, MTOT, 1024, DFF}; XSched S{4, lastL ? 512 : 576, GL, bidL, lastL ? 1 : 0}; EpiStoreT E{p.U, 1024, 0};
          pg8::gemm_phase<EpiStoreT, XSched, true, true, false>(ldsL, g, S, E); }
        GBAR();
        { FRESH_P r_phase(p, 2, layer, vb, VG, 0, MTOT, lastL);
          if (layer + 1 < DEPTH) { for (int t = vb; t < CONV_TILES; t += VG) conv_job(p, layer + 1, t, (float*)smraw); } }
        GBAR();
    }
}

extern "C" void kernel_launch(void* const* d_in, const int* in_sizes, int n_in, void* d_out, int out_size, void* d_ws, size_t ws_size, hipStream_t stream) {
    static int grid_blocks = 0;
    if (!grid_blocks) {
        int dev = 0, cus = 0, per_cu = 0;
        (void)hipGetDevice(&dev);
        (void)hipDeviceGetAttribute(&cus, hipDeviceAttributeMultiprocessorCount, dev);
        if (hipFuncSetAttribute((const void*)mega, hipFuncAttributeMaxDynamicSharedMemorySize, DYN_LDS) != hipSuccess) fprintf(stderr, "hipFuncSetAttribute failed\n");
        (void)hipOccupancyMaxActiveBlocksPerMultiprocessor(&per_cu, mega, 512, DYN_LDS);
        grid_blocks = cus;
    }
    P p{};
    const float** f = (const float**)&p;
    for (int i = 0; i < 23; ++i) f[i] = (const float*)d_in[i];
    p.out = (float*)d_out;
    unsigned char* w = (unsigned char*)d_ws; size_t off = 0;
    auto take = [&](size_t bytes) { void* r = w + off; off += (bytes + 255) & ~(size_t)255; return r; };
    p.WinT = (bf16_t*)take((size_t)NWIN * 1024 * 2);
    p.WuqT = (bf16_t*)take((size_t)768 * 256 * 2);
    p.WukvT = (bf16_t*)take((size_t)1024 * 128 * 2);
    p.WbrT = (bf16_t*)take((size_t)4 * 1024 * 512 * 2);
    p.WoutT = (bf16_t*)take((size_t)1024 * 1024 * 2);
    p.Wf1T = (bf16_t*)take((size_t)2 * DFF * 1024 * 2);
    p.Wf2T = (bf16_t*)take((size_t)1024 * DFF * 2);
    p.mod = (float*)take((size_t)DEPTH * 17 * 6144 * 4);
    p.rt16 = (f32x2*)take(64 * 16 * 8);
    p.rt8 = (f32x2*)take(64 * 8 * 8);
    p.hc = (float*)take((size_t)NBATCH * CTX * 1024 * 4);
    p.U = (bf16_t*)take((size_t)MTOT * 1024 * 2);
    p.G = (unsigned char*)take((size_t)MC * 4096);
    p.barw = (unsigned*)take((size_t)XCD_BAR_WORDS * 4);
    unsigned char* R = (unsigned char*)take(0);
    p.PJ = (bf16_t*)take((size_t)MC * PJLD * 2);
    p.QA = (bf16_t*)take((size_t)MC * 768 * 2);
    p.KN = (bf16_t*)take((size_t)MC * 512 * 2);
    p.VT = (bf16_t*)take((size_t)VTROWS * MC * 2);
    p.O = (bf16_t*)take((size_t)MC * 2048 * 2);
    p.YC = p.O;
    p.MB = p.PJ;
    p.ACT = (bf16_t*)R;
    if (off > ws_size) { fprintf(stderr, "workspace too small: need %zu have %zu\n", off, ws_size); return; }
    (void)hipMemsetAsync(p.barw, 0, (size_t)XCD_BAR_WORDS * 4, stream);
    void* args[] = {&p};
    hipError_t e = hipLaunchCooperativeKernel((void*)mega, dim3(grid_blocks), dim3(512), args, DYN_LDS, stream);
    if (e != hipSuccess) fprintf(stderr, "cooperative launch failed: %s (grid %d)\n", hipGetErrorString(e), grid_blocks);
}
```

```cpp
#include <hip/hip_runtime.h>
#include <hip/hip_cooperative_groups.h>
#include <cstdio>
#include <cstdint>
namespace cg = cooperative_groups;

typedef unsigned short bf16_t;
typedef short bf16x8 __attribute__((ext_vector_type(8)));
typedef short bf16x4 __attribute__((ext_vector_type(4)));
typedef float f32x4 __attribute__((ext_vector_type(4)));
typedef float f32x2 __attribute__((ext_vector_type(2)));
typedef unsigned u32x2 __attribute__((ext_vector_type(2)));
typedef unsigned u32x4 __attribute__((ext_vector_type(4)));
#define DEV __device__ __forceinline__

constexpr int DM = 1024, NBATCH = 16, SEQ = 2048, CTX = 256, DEPTH = 4;
constexpr int NCH = 2, BPC = NBATCH / NCH, LAT_C = BPC * SEQ, CTX_C = BPC * CTX, MC = LAT_C + CTX_C, MTOT = MC * NCH;
constexpr int INC = 7584, NPROJ = 3584, NWIN = 7680, PJLD = 2816, DFF = 2816, VTROWS = 1280;
constexpr float LOG2E = 1.4426950408889634f;
constexpr int LST = 72;
constexpr int TILE_E = 128 * LST;
constexpr int SMEM_BYTES = 4 * TILE_E * 2 + 1024;

struct P {
    const float *x, *c, *ctx, *c_ctx, *w_mod, *b_mod, *g_pre_mix, *g_post_mix, *g_pre_ffn, *g_post_ffn, *w_in, *g_a_q, *g_a_kv,
        *w_a_uq, *w_a_ukv, *sink_b, *rpb_c, *g_d_q, *g_d_k, *w_branch, *w_out, *w_ffn_in, *w_ffn_out;
    float* out;
    bf16_t *WinT, *WuqT, *WukvT, *WbrT, *WoutT, *Wf1T, *Wf2T;
    float* mod; f32x2 *rt16, *rt8; float* hc;
    bf16_t *U, *YC, *PJ, *QA, *KN, *VT, *O, *MB, *ACT;
    unsigned char* G;
    unsigned* barw;
};

typedef __bf16 bf16v2 __attribute__((ext_vector_type(2)));
DEV unsigned pk_bf16(float lo, float hi) { bf16v2 v = __builtin_convertvector((f32x2){lo, hi}, bf16v2); return __builtin_bit_cast(unsigned, v); }
DEV float bf2f(unsigned short v) { return __uint_as_float(((unsigned)v) << 16); }
DEV void store4(bf16_t* p, f32x4 v) { u32x2 w; w.x = pk_bf16(v[0], v[1]); w.y = pk_bf16(v[2], v[3]); *(u32x2*)p = w; }
DEV void store8x2(bf16_t* g0, f32x4 v0, f32x4 v1, int fq) {
    unsigned ax = pk_bf16(v0[0], v0[1]), ay = pk_bf16(v0[2], v0[3]), bx = pk_bf16(v1[0], v1[1]), by = pk_bf16(v1[2], v1[3]);
    auto rx = __builtin_amdgcn_permlane16_swap(ax, bx, false, false);
    auto ry = __builtin_amdgcn_permlane16_swap(ay, by, false, false);
    u32x4 w; w.x = rx[0]; w.y = ry[0]; w.z = rx[1]; w.w = ry[1];
    *(u32x4*)(g0 + (fq & 1) * 16 + (fq >> 1) * 8) = w;
}
DEV float fexp2(float x) { return __builtin_amdgcn_exp2f(x); }
DEV float frcp(float x) { return __builtin_amdgcn_rcpf(x); }
DEV float wave_sum(float v) {
    v += __shfl_xor(v, 1); v += __shfl_xor(v, 2); v += __shfl_xor(v, 4); v += __shfl_xor(v, 8); v += __shfl_xor(v, 16); v += __shfl_xor(v, 32); return v;
}
DEV int ltid() { int t = threadIdx.x & 255; asm volatile("" : "+v"(t)); return t; }
DEV int uni(int v) { return __builtin_amdgcn_readfirstlane(v); }
DEV float xmax16(float x) { auto r = __builtin_amdgcn_permlane16_swap(__float_as_uint(x), __float_as_uint(x), false, false); return fmaxf(__uint_as_float(r[0]), __uint_as_float(r[1])); }
DEV float xmax32(float x) { auto r = __builtin_amdgcn_permlane32_swap(__float_as_uint(x), __float_as_uint(x), false, false); return fmaxf(__uint_as_float(r[0]), __uint_as_float(r[1])); }
DEV float xadd16(float x) { auto r = __builtin_amdgcn_permlane16_swap(__float_as_uint(x), __float_as_uint(x), false, false); return __uint_as_float(r[0]) + __uint_as_float(r[1]); }
DEV float xadd32(float x) { auto r = __builtin_amdgcn_permlane32_swap(__float_as_uint(x), __float_as_uint(x), false, false); return __uint_as_float(r[0]) + __uint_as_float(r[1]); }
DEV f32x4 mfma16(bf16x8 a, bf16x8 b, f32x4 c) { return __builtin_amdgcn_mfma_f32_16x16x32_bf16(a, b, c, 0, 0, 0); }

template <int NFT, bool SWAP>
DEV void gemm_mainloop(const bf16_t* __restrict__ A, int lda, const bf16_t* __restrict__ Bt, int ldb, int K, f32x4 (&acc)[NFT][4], bf16_t* sm) {
    const int tid = ltid(), lane = tid & 63, wid = uni(tid >> 6), wm = wid & 1, wn = wid >> 1, fr = lane & 15, fq = lane >> 4;
    unsigned char* sA = (unsigned char*)sm; unsigned char* sB = sA + 2 * 16384;
    const int lrow = tid >> 3, lc8 = (tid & 7) * 8;
    const int wofs = lrow * 128 + (((tid & 7) ^ (lrow & 7)) << 4);
    const bf16_t* ga = A + (size_t)lrow * lda + lc8;
    const bf16_t* gb = Bt + (size_t)lrow * ldb + lc8;
    u32x4 ra[4], rb[NFT];
#pragma unroll
    for (int ft = 0; ft < NFT; ++ft)
#pragma unroll
        for (int tt = 0; tt < 4; ++tt) acc[ft][tt] = (f32x4){0.f, 0.f, 0.f, 0.f};
#pragma unroll
    for (int i = 0; i < 4; ++i) ra[i] = *(const u32x4*)(ga + (size_t)(i * 32) * lda);
#pragma unroll
    for (int i = 0; i < NFT; ++i) rb[i] = *(const u32x4*)(gb + (size_t)(i * 32) * ldb);
#pragma unroll
    for (int i = 0; i < 4; ++i) *(u32x4*)(sA + wofs + i * 4096) = ra[i];
#pragma unroll
    for (int i = 0; i < NFT; ++i) *(u32x4*)(sB + wofs + i * 4096) = rb[i];
    const int nk = K >> 6;
    if (nk > 1) {
#pragma unroll
        for (int i = 0; i < 4; ++i) ra[i] = *(const u32x4*)(ga + (size_t)(i * 32) * lda + 64);
#pragma unroll
        for (int i = 0; i < NFT; ++i) rb[i] = *(const u32x4*)(gb + (size_t)(i * 32) * ldb + 64);
    }
    __syncthreads();
    const int rofs0 = ((0 + fq) ^ (fr & 7)) << 4, rofs1 = ((4 + fq) ^ (fr & 7)) << 4;
    for (int kt = 0; kt < nk; ++kt) {
        const int cur = kt & 1;
        if (kt + 1 < nk) {
            const int nx = cur ^ 1;
#pragma unroll
            for (int i = 0; i < 4; ++i) *(u32x4*)(sA + nx * 16384 + wofs + i * 4096) = ra[i];
#pragma unroll
            for (int i = 0; i < NFT; ++i) *(u32x4*)(sB + nx * 16384 + wofs + i * 4096) = rb[i];
        }
        if (kt + 2 < nk) {
            const int ko = (kt + 2) * 64;
#pragma unroll
            for (int i = 0; i < 4; ++i) ra[i] = *(const u32x4*)(ga + (size_t)(i * 32) * lda + ko);
#pragma unroll
            for (int i = 0; i < NFT; ++i) rb[i] = *(const u32x4*)(gb + (size_t)(i * 32) * ldb + ko);
        }
        __builtin_amdgcn_sched_barrier(0);
        const unsigned char* cA = sA + cur * 16384 + (wm * 64 + fr) * 128;
        const unsigned char* cB = sB + cur * 16384 + (wn * NFT * 16 + fr) * 128;
#pragma unroll
        for (int ks = 0; ks < 2; ++ks) {
            const int ro = ks ? rofs1 : rofs0;
            bf16x8 af[4], wf[NFT];
#pragma unroll
            for (int tt = 0; tt < 4; ++tt) af[tt] = *(const bf16x8*)(cA + tt * 2048 + ro);
#pragma unroll
            for (int ft = 0; ft < NFT; ++ft) wf[ft] = *(const bf16x8*)(cB + ft * 2048 + ro);
#pragma unroll
            for (int ft = 0; ft < NFT; ++ft)
#pragma unroll
                for (int tt = 0; tt < 4; ++tt) acc[ft][tt] = SWAP ? mfma16(af[tt], wf[ft], acc[ft][tt]) : mfma16(wf[ft], af[tt], acc[ft][tt]);
        }
        __syncthreads();
    }
}

DEV bool tile_xcd(int q, int x, int nM, int nN, int& m, int& n) {
    const int j = q >> 5, w = q & 31;
    const int pp = (((j >> 1) * 8 + x) << 1) + (j & 1);
    const int npn = nN >> 2;
    if (pp >= (nM >> 3) * npn) return false;
    const int pm = pp / npn, pn = pp - pm * npn;
    m = pm * 8 + (w & 7); n = pn * 4 + (w >> 3);
    return true;
}
#define TILE_LOOP(nM, nN) const int x_ = bid & 7, spx_ = G >> 3; int mt, nt; for (int q_ = bid >> 3; tile_xcd(q_, x_, nM, nN, mt, nt); q_ += spx_)

DEV int srccol(int mapid, int n) {
    switch (mapid) {
    case 0:
        if (n < 2816 || n >= 3584) { const int rho = n & 255; n = (n & ~255) + ((rho >> 5) & 3) * 64 + (rho >> 7) * 32 + (rho & 31); }
        if (n < 384) return n;
        if (n < 896) return n - 384 + 416;
        if (n < 1024) return n - 896 + 928;
        if (n < 1536) return n - 1024 + 1184;
        if (n < 2048) return n - 1536 + 1696;
        if (n < 2560) return n - 2048 + 2720;
        if (n < 2688) return n - 2560 + 3232;
        if (n < 2720) return n - 2688 + 384;
        if (n < 2816) return -1;
        if (n < 2944) return n - 2816 + 1056;
        if (n < 3456) return n - 2944 + 2208;
        if (n < 3584) return n - 3456 + 3360;
        return n - 3584 + 3488;
    case 1: if (n < 512) return (n >> 6) * 96 + (n & 63); { const int q = n - 512; return (q >> 5) * 96 + 64 + (q & 31); }
    case 2: if (n < 512) return (n >> 6) * 128 + (n & 63); { const int q = n - 512; return (q >> 6) * 128 + 64 + (q & 63); }
    case 4: { const int pn = n >> 8, s = (n >> 7) & 1, wc = (n >> 5) & 3, nn = (n >> 4) & 1, f = n & 15; return s * DFF + pn * 128 + wc * 32 + nn * 16 + f; }
    case 5: { const int rho = n & 255; return (n & ~255) + ((rho >> 5) & 3) * 64 + (rho >> 7) * 32 + (rho & 31); }
    default: return n;
    }
}
DEV void conv_tile(const float* __restrict__ src, int lds_, int K, bf16_t* __restrict__ dst, int n0, int k0, int mapid, const float* rowscale, float* st) {
    const int tid = ltid();
    {
        const int n = tid & 63, kk = tid >> 6; const int sc_ = srccol(mapid, n0 + n);
#pragma unroll
        for (int i = 0; i < 16; ++i) {
            const int k = kk * 16 + i;
            float v = sc_ >= 0 ? src[(size_t)(k0 + k) * lds_ + sc_] : 0.f;
            if (rowscale) v *= rowscale[k0 + k];
            st[k * 65 + n] = v;
        }
    }
    __syncthreads();
    {
        const int n = tid >> 2, kq = tid & 3; u32x4 w0, w1;
        const float* s = st + (kq * 16) * 65 + n;
        w0.x = pk_bf16(s[0 * 65], s[1 * 65]); w0.y = pk_bf16(s[2 * 65], s[3 * 65]); w0.z = pk_bf16(s[4 * 65], s[5 * 65]); w0.w = pk_bf16(s[6 * 65], s[7 * 65]);
        w1.x = pk_bf16(s[8 * 65], s[9 * 65]); w1.y = pk_bf16(s[10 * 65], s[11 * 65]); w1.z = pk_bf16(s[12 * 65], s[13 * 65]); w1.w = pk_bf16(s[14 * 65], s[15 * 65]);
        bf16_t* d = dst + (size_t)(n0 + n) * K + k0 + kq * 16;
        *(u32x4*)d = w0; *(u32x4*)(d + 8) = w1;
    }
    __syncthreads();
}
constexpr int CONV_TILES = 4880;
DEV void conv_job(const P& p, int layer, int t, float* st) {
    if (t < 1920) { conv_tile(p.w_in + (size_t)layer * DM * INC, INC, 1024, p.WinT, (t >> 4) * 64, (t & 15) * 64, 0, nullptr, st); return; }
    t -= 1920;
    if (t < 48) { conv_tile(p.w_a_uq + (size_t)layer * 256 * 768, 768, 256, p.WuqT, (t >> 2) * 64, (t & 3) * 64, 1, p.g_a_q + layer * 256, st); return; }
    t -= 48;
    if (t < 32) { conv_tile(p.w_a_ukv + (size_t)layer * 128 * 1024, 1024, 128, p.WukvT, (t >> 1) * 64, (t & 1) * 64, 2, p.g_a_kv + layer * 128, st); return; }
    t -= 32;
    if (t < 512) { conv_tile(p.w_branch + (size_t)layer * 4 * 512 * 1024, 1024, 2048, p.WbrT, (t >> 5) * 64, (t & 31) * 64, 5, nullptr, st); return; }
    t -= 512;
    if (t < 256) { conv_tile(p.w_out + (size_t)layer * 1024 * 1024, 1024, 1024, p.WoutT, (t >> 4) * 64, (t & 15) * 64, 5, nullptr, st); return; }
    t -= 256;
    if (t < 1408) { conv_tile(p.w_ffn_in + (size_t)layer * 1024 * 2 * DFF, 2 * DFF, 1024, p.Wf1T, (t >> 4) * 64, (t & 15) * 64, 4, nullptr, st); return; }
    t -= 1408;
    { const int nt = t / 44, kt = t - nt * 44; conv_tile(p.w_ffn_out + (size_t)layer * DFF * 1024, 1024, DFF, p.Wf2T, nt * 64, kt * 64, 5, nullptr, st); }
}

DEV void mod_item(const P& p, int item, unsigned char* smraw) {
    const int tid = ltid(), lane = tid & 63, wid = uni(tid >> 6);
    float* sc = (float*)smraw;
    const int l = item / 96, cgp = item - l * 96;
    for (int i = tid; i < 17 * 1024; i += 256) {
        const int r = i >> 10, k = i & 1023; const float v = r < 16 ? p.c[r * 1024 + k] : p.c_ctx[k];
        sc[i] = v * frcp(1.f + fexp2(-v * LOG2E));
    }
    __syncthreads();
    float acc[17];
#pragma unroll
    for (int r = 0; r < 17; ++r) acc[r] = 0.f;
    const float* w = p.w_mod + ((size_t)l * 1024 + wid * 256) * 6144 + cgp * 64 + lane;
    for (int k = 0; k < 256; k += 4) {
        const float w0 = w[(size_t)k * 6144], w1 = w[(size_t)(k + 1) * 6144], w2 = w[(size_t)(k + 2) * 6144], w3 = w[(size_t)(k + 3) * 6144];
#pragma unroll
        for (int r = 0; r < 17; ++r) { const f32x4 s = *(const f32x4*)(sc + r * 1024 + wid * 256 + k); acc[r] += s[0] * w0 + s[1] * w1 + s[2] * w2 + s[3] * w3; }
    }
    __syncthreads();
    float* red = (float*)smraw;
#pragma unroll
    for (int r = 0; r < 17; ++r) red[(wid * 17 + r) * 64 + lane] = acc[r];
    __syncthreads();
    for (int i = tid; i < 17 * 64; i += 256) {
        const int r = i >> 6, ci = i & 63;
        const float v = red[(0 * 17 + r) * 64 + ci] + red[(1 * 17 + r) * 64 + ci] + red[(2 * 17 + r) * 64 + ci] + red[(3 * 17 + r) * 64 + ci] + p.b_mod[l * 6144 + cgp * 64 + ci];
        p.mod[((size_t)l * 17 + r) * 6144 + cgp * 64 + ci] = v;
    }
    __syncthreads();
}

DEV void r_phase(const P& p, int mode, int layer, int vb, int VG, int g_lo, int g_hi, bool skipctx = false) {
    const int tid_ = ltid(), lane = tid_ & 63, wid = uni(tid_ >> 6);
    const int nw = VG * 4;
    for (int g = g_lo + vb * 4 + wid; g < g_hi; g += nw) {
        const int ch = g / MC, local = g - ch * MC;
        if (skipctx && local >= LAT_C) continue;
        const float* hin; float* hout; const float* mod;
        if (local < LAT_C) {
            const int idx = ch * LAT_C + local; const int b = idx >> 11;
            hin = (mode == 0 ? p.x : p.out) + (size_t)idx * 1024; hout = p.out + (size_t)idx * 1024; mod = p.mod + ((size_t)layer * 17 + b) * 6144;
        } else {
            const int idx = ch * CTX_C + local - LAT_C;
            hin = (mode == 0 ? p.ctx : p.hc) + (size_t)idx * 1024; hout = p.hc + (size_t)idx * 1024; mod = p.mod + ((size_t)layer * 17 + 16) * 6144;
        }
        f32x4 h[4];
#pragma unroll
        for (int i = 0; i < 2; ++i)
#pragma unroll
            for (int k = 0; k < 2; ++k) h[2 * i + k] = *(const f32x4*)(hin + i * 512 + lane * 8 + 4 * k);
        if (mode != 0) {
            f32x4 y[4]; float ss = 0.f;
            const bf16_t* yp = (mode == 1 ? p.YC + (size_t)local * 1024 : p.U + (size_t)g * 1024);
#pragma unroll
            for (int i = 0; i < 2; ++i) {
                const u32x4 w = *(const u32x4*)(yp + i * 512 + lane * 8);
                y[2 * i] = (f32x4){__uint_as_float(w.x << 16), __uint_as_float(w.x & 0xffff0000u), __uint_as_float(w.y << 16), __uint_as_float(w.y & 0xffff0000u)};
                y[2 * i + 1] = (f32x4){__uint_as_float(w.z << 16), __uint_as_float(w.z & 0xffff0000u), __uint_as_float(w.w << 16), __uint_as_float(w.w & 0xffff0000u)};
            }
#pragma unroll
            for (int i = 0; i < 4; ++i) ss += y[i][0] * y[i][0] + y[i][1] * y[i][1] + y[i][2] * y[i][2] + y[i][3] * y[i][3];
            ss = wave_sum(ss);
            const float rs = rsqrtf(ss * (1.f / 1024.f) + 1e-6f);
            const float* gp = (mode == 1 ? p.g_post_mix : p.g_post_ffn) + layer * 1024;
            const float* ga = mod + (mode == 1 ? 2048 : 5120);
#pragma unroll
            for (int i = 0; i < 2; ++i)
#pragma unroll
                for (int k = 0; k < 2; ++k) {
                    const int e = i * 512 + lane * 8 + 4 * k;
                    const f32x4 gg = *(const f32x4*)(gp + e), aa = *(const f32x4*)(ga + e);
                    h[2 * i + k] = h[2 * i + k] + aa * (y[2 * i + k] * rs * gg);
                }
        }
#pragma unroll
        for (int i = 0; i < 2; ++i)
#pragma unroll
            for (int k = 0; k < 2; ++k) *(f32x4*)(hout + i * 512 + lane * 8 + 4 * k) = h[2 * i + k];
        const int nl = (mode == 2) ? layer + 1 : layer;
        if (nl < DEPTH) {
            float ss = 0.f;
#pragma unroll
            for (int i = 0; i < 4; ++i) ss += h[i][0] * h[i][0] + h[i][1] * h[i][1] + h[i][2] * h[i][2] + h[i][3] * h[i][3];
            ss = wave_sum(ss);
            const float rs = rsqrtf(ss * (1.f / 1024.f) + 1e-6f);
            const float* gpre = (mode == 1 ? p.g_pre_ffn : p.g_pre_mix) + nl * 1024;
            const float* modn = (mode == 2) ? mod + 17 * 6144 : mod;
            const float* sh = modn + (mode == 1 ? 3072 : 0);
            const float* sc = modn + (mode == 1 ? 4096 : 1024);
#pragma unroll
            for (int i = 0; i < 2; ++i) {
                f32x4 u[2];
#pragma unroll
                for (int k = 0; k < 2; ++k) {
                    const int e = i * 512 + lane * 8 + 4 * k;
                    const f32x4 gg = *(const f32x4*)(gpre + e), s1 = *(const f32x4*)(sc + e), s0 = *(const f32x4*)(sh + e);
                    u[k] = h[2 * i + k] * rs * gg * (s1 + 1.f) + s0;
                }
                u32x4 w; w.x = pk_bf16(u[0][0], u[0][1]); w.y = pk_bf16(u[0][2], u[0][3]); w.z = pk_bf16(u[1][0], u[1][1]); w.w = pk_bf16(u[1][2], u[1][3]);
                *(u32x4*)(p.U + (size_t)g * 1024 + i * 512 + lane * 8) = w;
            }
        }
    }
}

DEV void gemm1_row(f32x4 (&v)[4], int row, int slab, bool lat, const P& p, int layer, int fq) {
    const bool hnorm = (slab >= 2048 && slab < 2688);
    const bool rope64 = lat && ((slab >= 384 && slab < 1024) || hnorm);
    const bool isq = (slab >= 384 && slab < 896) || (slab >= 1024 && slab < 1536) || (slab >= 2048 && slab < 2560);
    const float sc = isq ? 0.125f * LOG2E : 1.f;
    const bool kr = (slab == 2688);
    const int tok = row & 2047; const int pr = tok >> 6, pc = tok & 63;
    if (hnorm) {
        float ss = 0.f;
#pragma unroll
        for (int ft = 0; ft < 4; ++ft) ss += v[ft][0] * v[ft][0] + v[ft][1] * v[ft][1] + v[ft][2] * v[ft][2] + v[ft][3] * v[ft][3];
        ss += __shfl_xor(ss, 16); ss += __shfl_xor(ss, 32);
        const float rs = rsqrtf(ss * (1.f / 64.f) + 1e-6f);
        const float* g = (slab < 2560 ? p.g_d_q : p.g_d_k) + layer * 64;
#pragma unroll
        for (int ft = 0; ft < 4; ++ft) { const f32x4 gg = *(const f32x4*)(g + ft * 16 + fq * 4); v[ft] = v[ft] * rs * gg; }
    }
    if (rope64) {
#pragma unroll
        for (int j = 0; j < 4; ++j) {
            const int i = fq * 4 + j;
            f32x2 cs = p.rt16[pr * 16 + i]; float a = v[0][j], b = v[1][j];
            v[0][j] = a * cs[0] - b * cs[1]; v[1][j] = b * cs[0] + a * cs[1];
            cs = p.rt16[pc * 16 + i]; a = v[2][j]; b = v[3][j];
            v[2][j] = a * cs[0] - b * cs[1]; v[3][j] = b * cs[0] + a * cs[1];
        }
    }
    if (kr && lat) {
#pragma unroll
        for (int ft = 0; ft < 2; ++ft) {
            const int pos = ft == 0 ? pr : pc;
#pragma unroll
            for (int j = 0; j < 4; ++j) {
                const int i = (fq & 1) * 4 + j; const f32x2 cs = p.rt8[pos * 8 + i];
                const float xv = v[ft][j]; const float o = __shfl_xor(xv, 32);
                v[ft][j] = fq < 2 ? xv * cs[0] - o * cs[1] : xv * cs[0] + o * cs[1];
            }
        }
    }
    bf16_t* dst = p.PJ + (size_t)row * PJLD + slab;
    store8x2(dst, v[0] * sc, v[1] * sc, fq);
    if (!kr) store8x2(dst + 32, v[2] * sc, v[3] * sc, fq);
}
DEV void stage2_tile(const P& p, int mt, int j, unsigned char* smraw) {
    bf16_t* sm = (bf16_t*)smraw; float* s_rs = (float*)(smraw + 73728);
    const int tid = ltid(), lane = tid & 63, wid = uni(tid >> 6), wm = wid & 1, wn = wid >> 1, fr = lane & 15, fq = lane >> 4;
    const int m0 = mt * 128; const bool isq = j < 6; const bool lat = m0 < LAT_C;
    const int K = isq ? 256 : 128; const int acol = isq ? 0 : 256;
    {
        const int r = tid >> 1, hf = tid & 1; const int n = K >> 1;
        const bf16_t* src = p.PJ + (size_t)(m0 + r) * PJLD + acol + hf * n; float ss = 0.f;
        for (int i = 0; i < n; i += 8) {
            const u32x4 w = *(const u32x4*)(src + i);
#pragma unroll
            for (int q = 0; q < 4; ++q) { const float a = __uint_as_float(w[q] << 16), b = __uint_as_float(w[q] & 0xffff0000u); ss += a * a + b * b; }
        }
        ss += __shfl_xor(ss, 1);
        if (hf == 0) s_rs[r] = rsqrtf(ss / (float)K + 1e-6f);
    }
    __syncthreads();
    f32x4 acc[4][4];
    const bf16_t* A = p.PJ + (size_t)m0 * PJLD + acol;
    if (isq) {
        const int n0 = j * 128;
        gemm_mainloop<4, false>(A, PJLD, p.WuqT + (size_t)n0 * 256, 256, 256, acc, sm);
        const int slab = n0 + wn * 64; const float qs = 0.10206207261596577f * LOG2E;
#pragma unroll
        for (int tt = 0; tt < 4; ++tt) {
            const int lr = wm * 64 + tt * 16 + fr; const int row = m0 + lr; const float rs = s_rs[lr] * qs;
            const int tok = row & 2047; const int pr = tok >> 6, pc = tok & 63;
            f32x4 v[4] = {acc[0][tt], acc[1][tt], acc[2][tt], acc[3][tt]};
            if (slab >= 512 && lat) {
#pragma unroll
                for (int ft = 0; ft < 4; ++ft) {
                    const int pos = (ft & 1) == 0 ? pr : pc;
#pragma unroll
                    for (int jj = 0; jj < 4; ++jj) {
                        const int i = (fq & 1) * 4 + jj; const f32x2 cs = p.rt8[pos * 8 + i];
                        const float xv = v[ft][jj]; const float o = __shfl_xor(xv, 32);
                        v[ft][jj] = fq < 2 ? xv * cs[0] - o * cs[1] : xv * cs[0] + o * cs[1];
                    }
                }
            }
            bf16_t* dst = p.QA + (size_t)row * 768 + slab;
            store8x2(dst, v[0] * rs, v[1] * rs, fq); store8x2(dst + 32, v[2] * rs, v[3] * rs, fq);
        }
    } else {
        const int n0 = (j - 6) * 128;
        if (n0 < 512) {
            gemm_mainloop<4, false>(A, PJLD, p.WukvT + (size_t)n0 * 128, 128, 128, acc, sm);
#pragma unroll
            for (int tt = 0; tt < 4; ++tt) {
                const int lr = wm * 64 + tt * 16 + fr; const float rs = s_rs[lr];
                bf16_t* dst = p.KN + (size_t)(m0 + lr) * 512 + n0 + wn * 64;
                store8x2(dst, acc[0][tt] * rs, acc[1][tt] * rs, fq); store8x2(dst + 32, acc[2][tt] * rs, acc[3][tt] * rs, fq);
            }
        } else {
            gemm_mainloop<4, true>(A, PJLD, p.WukvT + (size_t)n0 * 128, 128, 128, acc, sm);
            const int vrow0 = 768 + (n0 - 512) + wn * 64;
#pragma unroll
            for (int t2 = 0; t2 < 2; ++t2) {
                const int lr = wm * 64 + t2 * 32 + fq * 4;
                const f32x4 rs0 = *(const f32x4*)(s_rs + lr), rs1 = *(const f32x4*)(s_rs + lr + 16);
                const int lp = wm * 64 + t2 * 32 + fq * 8;
#pragma unroll
                for (int ft = 0; ft < 4; ++ft) {
                    const f32x4 a = acc[ft][2 * t2] * rs0, b = acc[ft][2 * t2 + 1] * rs1;
                    u32x4 w; w.x = pk_bf16(a[0], a[1]); w.y = pk_bf16(a[2], a[3]); w.z = pk_bf16(b[0], b[1]); w.w = pk_bf16(b[2], b[3]);
                    *(u32x4*)(p.VT + (size_t)(vrow0 + ft * 16 + fr) * MC + m0 + lp) = w;
                }
            }
        }
    }
    __syncthreads();
}

template <int MODE>
DEV void attn_item(const P& p, int layer, int item, bool ctxq, unsigned char* smraw) {
    constexpr bool GQA = (MODE == 1 || MODE == 3);
    constexpr int DQK = (MODE == 0) ? 96 : 64, NKS = DQK / 32;
    constexpr int KRB = (MODE == 0) ? 256 : 128, KM = (MODE == 0) ? 15 : 7;
    constexpr int KT_B = 64 * KRB, VT_B = 64 * 128;
    unsigned char* Ks = smraw; unsigned char* Vs = smraw + 32768; float* bias_s = (float*)(smraw + 49152);
    const int tid = ltid(), lane = tid & 63, wid = uni(tid >> 6), fr = lane & 15, fq = lane >> 4;
    const int nqt = ctxq ? (GQA ? 8 : 2) : (GQA ? 64 : 16);
    const int nh = GQA ? 2 : 8;
    const int qt = item % nqt, hh = (item / nqt) % nh, lb = item / (nqt * nh);
    const int head = GQA ? hh * 4 + wid : hh;
    const int tok0 = GQA ? qt * 32 : qt * 128 + wid * 32;
    const int qrow0 = (ctxq ? LAT_C + lb * CTX : lb * SEQ) + tok0;
    bf16x8 qf[2][NKS];
#pragma unroll
    for (int q = 0; q < 2; ++q) {
        const int row = qrow0 + q * 16 + fr;
        if (MODE == 0) {
            qf[q][0] = *(const bf16x8*)(p.QA + (size_t)row * 768 + head * 64 + fq * 8);
            qf[q][1] = *(const bf16x8*)(p.QA + (size_t)row * 768 + head * 64 + 32 + fq * 8);
            qf[q][NKS - 1] = *(const bf16x8*)(p.QA + (size_t)row * 768 + 512 + head * 32 + fq * 8);
        } else {
            const int qoff = MODE == 1 ? 384 : (MODE == 2 ? 1024 : 2048);
#pragma unroll
            for (int ks = 0; ks < NKS; ++ks) qf[q][ks] = *(const bf16x8*)(p.PJ + (size_t)row * PJLD + qoff + head * 64 + ks * 32 + fq * 8);
        }
    }
    const int koff = MODE == 1 ? 896 + hh * 64 : (MODE == 2 ? 1536 + hh * 64 : 2560 + hh * 64);
    const int vrow0 = MODE == 0 ? 768 + hh * 64 : (MODE == 1 ? hh * 64 : (MODE == 2 ? 128 + hh * 64 : 640 + hh * 64));
    int ktlo = 0, nlat = 0;
    if (!ctxq) {
        if (MODE == 0 || MODE == 3) { ktlo = 0; nlat = 32; }
        else if (MODE == 1) { const int q0 = qt * 32; const int lo = max(0, q0 - 128), hi = min(SEQ - 1, q0 + 159); ktlo = lo >> 6; nlat = (hi >> 6) - ktlo + 1; }
        else { const int r0a = min(max(2 * qt - 4, 0), 24), r0b = min(max(2 * qt + 1 - 4, 0), 24); ktlo = r0a; nlat = r0b + 8 - r0a; }
    }
    const int nt = 4 + nlat;
    const int ntf = ctxq ? 4 : ((MODE == 0 || MODE == 3) ? 36 : (MODE == 1 ? 9 : 13));
    if (MODE == 2 && !ctxq) { for (int i = tid; i < 465; i += 256) bias_s[i] = p.rpb_c[(layer * 8 + hh) * 465 + i] * LOG2E; }

    u32x4 rk[NKS], rv[2];
    auto tile_krow = [&](int it) { it = min(it, nt - 1); return it < 4 ? LAT_C + lb * CTX + it * 64 : lb * SEQ + (ktlo + it - 4) * 64; };
    auto gload = [&](int it) {
        const int krow = tile_krow(it);
#pragma unroll
        for (int i = 0; i < NKS; ++i) {
            const int id = tid + i * 256;
            if (MODE == 0) {
                const int key = id / 12, c = id - key * 12;
                const bf16_t* src = c < 8 ? p.KN + (size_t)(krow + key) * 512 + hh * 64 + c * 8 : p.PJ + (size_t)(krow + key) * PJLD + 2688 + (c - 8) * 8;
                rk[i] = *(const u32x4*)src;
            } else {
                const int key = id >> 3, c = id & 7;
                rk[i] = *(const u32x4*)(p.PJ + (size_t)(krow + key) * PJLD + koff + c * 8);
            }
        }
#pragma unroll
        for (int i = 0; i < 2; ++i) { const int id = tid + i * 256; const int dv = id >> 3, c = id & 7; rv[i] = *(const u32x4*)(p.VT + (size_t)(vrow0 + dv) * MC + krow + c * 8); }
    };
    auto lstore = [&](int buf) {
#pragma unroll
        for (int i = 0; i < NKS; ++i) {
            const int id = tid + i * 256; int key, c;
            if (MODE == 0) { key = id / 12; c = id - key * 12; } else { key = id >> 3; c = id & 7; }
            *(u32x4*)(Ks + buf * KT_B + key * KRB + ((c ^ (key & KM)) << 4)) = rk[i];
        }
#pragma unroll
        for (int i = 0; i < 2; ++i) { const int id = tid + i * 256; const int dv = id >> 3, c = id & 7; *(u32x4*)(Vs + buf * VT_B + dv * 128 + ((c ^ (dv & 7)) << 4)) = rv[i]; }
    };

    f32x4 o[4][2], lo[2], negm4[2]; float mref[2];
    const bf16x8 ones8 = __builtin_bit_cast(bf16x8, (u32x4){0x3F803F80u, 0x3F803F80u, 0x3F803F80u, 0x3F803F80u});
#pragma unroll
    for (int q = 0; q < 2; ++q) { mref[q] = 0.f; lo[q] = (f32x4){0.f, 0.f, 0.f, 0.f}; negm4[q] = (f32x4){0.f, 0.f, 0.f, 0.f};
#pragma unroll
        for (int d = 0; d < 4; ++d) o[d][q] = (f32x4){0.f, 0.f, 0.f, 0.f}; }

    gload(0); lstore(0); gload(1); __syncthreads();
    for (int it = 0; it < ntf; ++it) {
        const int cur = it & 1;
        if (it + 1 < ntf) lstore(cur ^ 1);
        if (it + 2 < ntf) gload(it + 2);
        __builtin_amdgcn_sched_barrier(0);
        const int kt = ktlo + it - 4;
        bool active = it < nt;
        int r = 0, r0 = 0;
        if (MODE == 2 && !ctxq && it >= 4) { r = 2 * qt + (wid >> 1); r0 = min(max(r - 4, 0), 24); active = active && (kt >= r0 && kt < r0 + 8); }
        if (active) {
            f32x4 s[4][2];
            const unsigned char* kb = Ks + cur * KT_B + fr * KRB;
            bf16x8 kf[4][NKS];
#pragma unroll
            for (int k4 = 0; k4 < 4; ++k4)
#pragma unroll
                for (int ks = 0; ks < NKS; ++ks) kf[k4][ks] = *(const bf16x8*)(kb + k4 * 16 * KRB + (((ks * 4 + fq) ^ (fr & KM)) << 4));
            __builtin_amdgcn_sched_barrier(0);
#pragma unroll
            for (int k4 = 0; k4 < 4; ++k4) {
#pragma unroll
                for (int q = 0; q < 2; ++q) s[k4][q] = mfma16(kf[k4][0], qf[q][0], negm4[q]);
#pragma unroll
                for (int ks = 1; ks < NKS; ++ks)
#pragma unroll
                    for (int q = 0; q < 2; ++q) s[k4][q] = mfma16(kf[k4][ks], qf[q][ks], s[k4][q]);
            }
            const unsigned char* vb = Vs + cur * VT_B + fr * 128;
            bf16x8 vf[4][2];
#pragma unroll
            for (int d = 0; d < 4; ++d)
#pragma unroll
                for (int kb2 = 0; kb2 < 2; ++kb2) vf[d][kb2] = *(const bf16x8*)(vb + d * 16 * 128 + (((kb2 * 4 + fq) ^ (fr & 7)) << 4));
            __builtin_amdgcn_sched_barrier(0);
            if (!ctxq && it >= 4) {
                if (MODE == 1) {
#pragma unroll
                    for (int q = 0; q < 2; ++q) {
                        const int qpos = tok0 + q * 16 + fr;
#pragma unroll
                        for (int k4 = 0; k4 < 4; ++k4)
#pragma unroll
                            for (int j = 0; j < 4; ++j) { const int d = qpos - (kt * 64 + k4 * 16 + fq * 4 + j); if (d > 128 || d < -128) s[k4][q][j] = -1e30f; }
                    }
                }
                if (MODE == 2) {
#pragma unroll
                    for (int q = 0; q < 2; ++q) {
                        const int qc = (wid & 1) * 32 + q * 16 + fr; const int c0 = min(max(qc - 8, 0), 48);
                        const int bbase = (kt - r + 7) * 31 + 15 - qc;
#pragma unroll
                        for (int k4 = 0; k4 < 4; ++k4)
#pragma unroll
                            for (int j = 0; j < 4; ++j) {
                                const int kc = k4 * 16 + fq * 4 + j; const bool ok = (kc >= c0 && kc < c0 + 16);
                                const float bv = bias_s[ok ? bbase + kc : 0];
                                s[k4][q][j] = ok ? s[k4][q][j] + bv : -1e30f;
                            }
                    }
                }
            }
            bf16x8 pf[2][2];
#pragma unroll
            for (int q = 0; q < 2; ++q) {
                float mx = -1e30f;
#pragma unroll
                for (int k4 = 0; k4 < 4; ++k4) mx = fmaxf(mx, fmaxf(fmaxf(s[k4][q][0], s[k4][q][1]), fmaxf(s[k4][q][2], s[k4][q][3])));
                mx = xmax32(xmax16(mx));
                const bool need = (it == 0) || (mx > 8.f);
                if (__builtin_amdgcn_ballot_w64(need) != 0ull) {
                    const float delta = need ? mx : 0.f;
                    mref[q] += delta; negm4[q] = negm4[q] - delta;
#pragma unroll
                    for (int k4 = 0; k4 < 4; ++k4) s[k4][q] = s[k4][q] - delta;
                    const float alpha = fexp2(-delta);
                    lo[q] = lo[q] * alpha;
#pragma unroll
                    for (int d = 0; d < 4; ++d) o[d][q] = o[d][q] * alpha;
                }
#pragma unroll
                for (int k4 = 0; k4 < 4; ++k4)
#pragma unroll
                    for (int j = 0; j < 4; ++j) s[k4][q][j] = fexp2(s[k4][q][j]);
#pragma unroll
                for (int kb2 = 0; kb2 < 2; ++kb2) {
                    u32x4 w; w.x = pk_bf16(s[2 * kb2][q][0], s[2 * kb2][q][1]); w.y = pk_bf16(s[2 * kb2][q][2], s[2 * kb2][q][3]);
                    w.z = pk_bf16(s[2 * kb2 + 1][q][0], s[2 * kb2 + 1][q][1]); w.w = pk_bf16(s[2 * kb2 + 1][q][2], s[2 * kb2 + 1][q][3]);
                    pf[q][kb2] = __builtin_bit_cast(bf16x8, w);
                }
            }
#pragma unroll
            for (int d = 0; d < 4; ++d)
#pragma unroll
                for (int kb2 = 0; kb2 < 2; ++kb2)
#pragma unroll
                    for (int q = 0; q < 2; ++q) o[d][q] = mfma16(vf[d][kb2], pf[q][kb2], o[d][q]);
#pragma unroll
            for (int kb2 = 0; kb2 < 2; ++kb2)
#pragma unroll
                for (int q = 0; q < 2; ++q) lo[q] = mfma16(ones8, pf[q][kb2], lo[q]);
        }
        __syncthreads();
    }
#pragma unroll
    for (int q = 0; q < 2; ++q) {
        float l = lo[q][0];
        if (MODE == 1) l += fexp2(p.sink_b[layer * 8 + head] * LOG2E - mref[q]);
        const float inv = 1.f / l;
        bf16_t* dst = p.O + (size_t)(qrow0 + q * 16 + fr) * 2048 + MODE * 512 + head * 64;
        store8x2(dst, o[0][q] * inv, o[1][q] * inv, fq); store8x2(dst + 32, o[2][q] * inv, o[3][q] * inv, fq);
    }
}


namespace pg8 {
#define PG8_LAS __attribute__((address_space(3)))
constexpr int BM = 256, BK = 64, HALF = 128, HTB = HALF * BK * 2  , STAGE_BYTES = 8 * HTB, NXCD = 8, WGM = 8;

__host__ __device__ __forceinline__ int lds_byte(int r, int c) { const int st = (r >> 4) * 2 + (c >> 5), rr = r & 15, cc = c & 31, ob = rr * 64 + cc * 2; return st * 1024 + (ob ^ (((ob >> 9) & 1) << 5)); }
__host__ __device__ __forceinline__ void stage_rc(int b, int& R, int& C) { const int st = b / 1024, sb = b % 1024, swz = sb ^ (((sb >> 9) & 1) << 5); R = (st >> 1) * 16 + swz / 64; C = (st & 1) * 32 + (swz % 64) / 2; }
__host__ __device__ __forceinline__ int perm32(int rho) { const int n = rho >> 4, i = rho & 15; return 8 * (i >> 2) + 4 * n + (i & 3); }

struct Unit { int pm, pn; };
struct Gemm { const bf16_t* A; const bf16_t* Bt; int M, N, K; };

template <class Epi, class Sched, bool ALIGN_EPI = false, bool SP2 = false, bool SWAPMMA = false>
__device__ __forceinline__ void gemm_phase(PG8_LAS unsigned char* lds, const Gemm g, const Sched& S, const Epi& E) {
    int tid = threadIdx.x; asm volatile("" : "+v"(tid));
    const int wid = __builtin_amdgcn_readfirstlane(tid >> 6), lane = tid & 63, wr = wid >> 2, wc = wid & 3, fr = lane & 15, fq = lane >> 4;
    const int K = g.K, nt = K / BK;
    unsigned voffA[2], voffB[2];
#pragma unroll
    for (int i = 0; i < 2; ++i) { int R, C; stage_rc(tid * 16 + i * 8192, R, C); const int Rb = Epi::PERM ? ((R & ~31) + perm32(R & 31)) : R;
        voffA[i] = (unsigned)(R * K + C) * 2u; voffB[i] = (unsigned)(Rb * K + C) * 2u; }
    const size_t kstep = (size_t)(BK * 2);
    const size_t hstep = (size_t)HALF * K * 2;
    const size_t tstep = 2 * hstep;
    const unsigned ldsw = (unsigned)wid * 1024u;
    const int aoff = lds_byte(wr * 64 + fr, fq * 8), boff = lds_byte(wc * 32 + fr, fq * 8);
#define PG8_SA(b, h) (((b) * 2 + (h)) * HTB)
#define PG8_SB(b, h) ((4 + (b) * 2 + (h)) * HTB)
#define PG8_STAGE(bufoff, gbase, voff) do { _Pragma("unroll") for (int _i = 0; _i < 2; ++_i) \
        __builtin_amdgcn_global_load_lds((const unsigned*)((const char*)(gbase) + (voff)[_i]), (PG8_LAS unsigned*)(lds + (bufoff) + ldsw + _i * 8192), 16, 0, 0); } while (0)
#define PG8_LDA(dst, b, h) do { _Pragma("unroll") for (int m = 0; m < 4; ++m) _Pragma("unroll") for (int k = 0; k < 2; ++k) dst[m][k] = *(const PG8_LAS bf16x8*)(lds + PG8_SA(b, h) + aoff + m * 2048 + k * 1024); } while (0)
#define PG8_LDB(dst, b, h) do { _Pragma("unroll") for (int n = 0; n < 2; ++n) _Pragma("unroll") for (int k = 0; k < 2; ++k) dst[n][k] = *(const PG8_LAS bf16x8*)(lds + PG8_SB(b, h) + boff + n * 2048 + k * 1024); } while (0)
#define PG8_MMA(ai, bj, At, Bt) do { __builtin_amdgcn_s_setprio(1); _Pragma("unroll") for (int m = 0; m < 4; ++m) _Pragma("unroll") for (int n = 0; n < 2; ++n) _Pragma("unroll") for (int k = 0; k < 2; ++k) \
        acc[ai][bj][m][n] = SWAPMMA ? __builtin_amdgcn_mfma_f32_16x16x32_bf16(At[m][k], Bt[n][k], acc[ai][bj][m][n], 0, 0, 0) : __builtin_amdgcn_mfma_f32_16x16x32_bf16(Bt[n][k], At[m][k], acc[ai][bj][m][n], 0, 0, 0); __builtin_amdgcn_s_setprio(0); } while (0)
#define PG8_WAIT_V(n) asm volatile("s_waitcnt vmcnt(" #n ")" ::: "memory")
#define PG8_WAIT_L(n) asm volatile("s_waitcnt lgkmcnt(" #n ")" ::: "memory")
#define PG8_BAR __builtin_amdgcn_s_barrier()
#define PG8_SCHED __builtin_amdgcn_sched_barrier(0)
    Unit cur, nxt; int ui = 0;
    if (!S.next(0, cur)) return;
    f32x4 acc[2][2][4][2];
#pragma unroll
    for (int a = 0; a < 2; ++a)
#pragma unroll
        for (int b = 0; b < 2; ++b)
#pragma unroll
            for (int m = 0; m < 4; ++m)
#pragma unroll
                for (int n = 0; n < 2; ++n) acc[a][b][m][n] = (f32x4){0.f, 0.f, 0.f, 0.f};
    bf16x8 At[4][2], B0[2][2], B1[2][2];
    const char* cA = (const char*)g.A + (size_t)cur.pm * tstep; const char* cB = (const char*)g.Bt + (size_t)cur.pn * tstep;
    S.a_ready(cur);
    if constexpr (SP2) {
        PG8_STAGE(PG8_SB(0, 0), cB, voffB); PG8_STAGE(PG8_SB(0, 1), cB + hstep, voffB); PG8_STAGE(PG8_SA(0, 0), cA, voffA); PG8_STAGE(PG8_SA(0, 1), cA + hstep, voffA);
        if (wr == 1) PG8_BAR;
        PG8_WAIT_V(2); PG8_BAR;
        PG8_STAGE(PG8_SB(1, 0), cB + kstep, voffB); PG8_STAGE(PG8_SA(1, 0), cA + kstep, voffA); PG8_STAGE(PG8_SB(1, 1), cB + hstep + kstep, voffB);
        PG8_WAIT_V(6); PG8_BAR;
    } else {
        PG8_STAGE(PG8_SB(0, 0), cB, voffB); PG8_STAGE(PG8_SA(0, 0), cA, voffA); PG8_STAGE(PG8_SB(0, 1), cB + hstep, voffB); PG8_STAGE(PG8_SA(0, 1), cA + hstep, voffA);
        if (wr == 1) PG8_BAR;
        PG8_WAIT_V(4); PG8_BAR;
        PG8_STAGE(PG8_SB(1, 0), cB + kstep, voffB); PG8_STAGE(PG8_SA(1, 0), cA + kstep, voffA); PG8_STAGE(PG8_SB(1, 1), cB + hstep + kstep, voffB);
        PG8_WAIT_V(6); PG8_BAR;
    }
    for (;;) {
        const bool has_next = S.next(ui + 1, nxt);
        const char* nA = has_next ? (const char*)g.A + (size_t)nxt.pm * tstep : cA; const char* nB = has_next ? (const char*)g.Bt + (size_t)nxt.pn * tstep : cB;
        for (int t = 0; t < nt; t += 2) {
            if constexpr (Epi::HAS_MID) { if (t != 0 && (t & 7) == 0) { E.mid(acc, cur, t >> 3, wid, lane); asm volatile("s_waitcnt vmcnt(0)" ::: "memory"); } }
            const bool last = (t == nt - 2);
            const char* a1 = cA + (size_t)(t + 1) * kstep;
            const char* a2 = last ? nA : cA + (size_t)(t + 2) * kstep; const char* b2 = last ? nB : cB + (size_t)(t + 2) * kstep;
            const char* a3 = a2 + kstep; const char* b3 = b2 + kstep;
            if (last && has_next) S.a_ready(nxt);
            if constexpr (SP2) {
            PG8_LDB(B0, 0, 0); PG8_LDB(B1, 0, 1); PG8_SCHED; PG8_LDA(At, 0, 0); PG8_STAGE(PG8_SA(1, 1), a1 + hstep, voffA);
            PG8_WAIT_V(8); PG8_WAIT_L(0); PG8_BAR; PG8_MMA(0, 0, At, B0); PG8_MMA(0, 1, At, B1); PG8_BAR; PG8_SCHED;
            PG8_LDA(At, 0, 1); PG8_STAGE(PG8_SB(0, 0), b2, voffB); PG8_STAGE(PG8_SB(0, 1), b2 + hstep, voffB); PG8_STAGE(PG8_SA(0, 0), a2, voffA);
            PG8_WAIT_V(8); PG8_WAIT_L(0); PG8_BAR; PG8_MMA(1, 0, At, B0); PG8_MMA(1, 1, At, B1); PG8_BAR; PG8_SCHED;
            PG8_LDB(B0, 1, 0); PG8_LDB(B1, 1, 1); PG8_SCHED; PG8_LDA(At, 1, 0); PG8_STAGE(PG8_SA(0, 1), a2 + hstep, voffA);
            PG8_WAIT_V(8); PG8_WAIT_L(0); PG8_BAR; PG8_MMA(0, 0, At, B0); PG8_MMA(0, 1, At, B1); PG8_BAR; PG8_SCHED;
            PG8_LDA(At, 1, 1); PG8_STAGE(PG8_SB(1, 0), b3, voffB); PG8_STAGE(PG8_SB(1, 1), b3 + hstep, voffB); PG8_STAGE(PG8_SA(1, 0), a3, voffA);
            PG8_WAIT_V(8); PG8_WAIT_L(0); PG8_BAR; PG8_MMA(1, 0, At, B0); PG8_MMA(1, 1, At, B1); PG8_BAR; PG8_SCHED;
            } else {
            PG8_LDB(B0, 0, 0); PG8_SCHED; PG8_LDA(At, 0, 0); PG8_STAGE(PG8_SA(1, 1), a1 + hstep, voffA);
            PG8_WAIT_L(8); PG8_BAR; PG8_WAIT_L(0); PG8_MMA(0, 0, At, B0); PG8_BAR; PG8_SCHED;
            PG8_LDB(B1, 0, 1); PG8_STAGE(PG8_SB(0, 0), b2, voffB);
            PG8_BAR; PG8_WAIT_L(0); PG8_MMA(0, 1, At, B1); PG8_BAR;
            PG8_LDA(At, 0, 1); PG8_STAGE(PG8_SA(0, 0), a2, voffA);
            PG8_BAR; PG8_WAIT_L(0); PG8_MMA(1, 0, At, B0); PG8_BAR; PG8_SCHED;
            PG8_STAGE(PG8_SB(0, 1), b2 + hstep, voffB);
            PG8_WAIT_V(6); PG8_BAR; PG8_MMA(1, 1, At, B1); PG8_BAR;
            PG8_LDB(B0, 1, 0); PG8_SCHED; PG8_LDA(At, 1, 0); PG8_STAGE(PG8_SA(0, 1), a2 + hstep, voffA);
            PG8_WAIT_L(8); PG8_BAR; PG8_WAIT_L(0); PG8_MMA(0, 0, At, B0); PG8_BAR; PG8_SCHED;
            PG8_LDB(B1, 1, 1); PG8_STAGE(PG8_SB(1, 0), b3, voffB);
            PG8_BAR; PG8_WAIT_L(0); PG8_MMA(0, 1, At, B1); PG8_BAR;
            PG8_LDA(At, 1, 1); PG8_STAGE(PG8_SA(1, 0), a3, voffA);
            PG8_BAR; PG8_WAIT_L(0); PG8_MMA(1, 0, At, B0); PG8_BAR; PG8_SCHED;
            PG8_STAGE(PG8_SB(1, 1), b3 + hstep, voffB);
            PG8_WAIT_V(6); PG8_BAR; PG8_MMA(1, 1, At, B1); PG8_BAR;
            }
        }
        if constexpr (ALIGN_EPI) { if (wr == 0) PG8_BAR; }
        if constexpr (!Epi::AFTER_DRAIN) { E(acc, cur, wr, wc, fr, fq); S.done(cur); }
        if (!has_next) break;
#pragma unroll
        for (int a = 0; a < 2; ++a)
#pragma unroll
            for (int b = 0; b < 2; ++b)
#pragma unroll
                for (int m = 0; m < 4; ++m)
#pragma unroll
                    for (int n = 0; n < 2; ++n) acc[a][b][m][n] = (f32x4){0.f, 0.f, 0.f, 0.f};
        cur = nxt; cA = nA; cB = nB; ++ui;
        if constexpr (ALIGN_EPI) { if (wr == 1) PG8_BAR; }
    }
    PG8_WAIT_V(0);
    if constexpr (!ALIGN_EPI) { if (wr == 0) PG8_BAR; }
    PG8_BAR;
    if constexpr (Epi::AFTER_DRAIN) { E.fused(acc, cur, wr, wc, fr, fq, lds, wid, lane); S.done(cur); }
#undef PG8_SA
#undef PG8_SB
#undef PG8_STAGE
#undef PG8_LDA
#undef PG8_LDB
#undef PG8_MMA
#undef PG8_WAIT_V
#undef PG8_WAIT_L
#undef PG8_BAR
#undef PG8_SCHED
}
}

struct XSched {
    int nN, nunits, G, c, skipctx;
    DEV bool next(int i, pg8::Unit& u) const {
        const int L = i * G + c; if (L >= nunits) return false;
        const int U = ((nunits & 7) == 0 && (G & 7) == 0) ? (L & 7) * (nunits >> 3) + (L >> 3) : L;
        { const int nM = nunits / nN, nig = 4 * nN, gid = U / nig, fm = gid * 4, gsz = min(nM - fm, 4), r = U - gid * nig; u.pm = fm + r % gsz; u.pn = r / gsz; }
        if (skipctx) u.pm = (u.pm >> 6) * 72 + (u.pm & 63);
        return true;
    }
    DEV void a_ready(const pg8::Unit&) const {}
    DEV void done(const pg8::Unit&) const {}
};
struct EpiStoreT {
    static constexpr bool PERM = false, AFTER_DRAIN = false, HAS_MID = false;
    bf16_t* out; int ld; int row_off;
    DEV void operator()(const f32x4 (&acc)[2][2][4][2], const pg8::Unit& u, int wr, int wc, int fr, int fq) const {
#pragma unroll
        for (int ai = 0; ai < 2; ++ai)
#pragma unroll
            for (int m = 0; m < 4; ++m) {
                bf16_t* d = out + (size_t)(row_off + u.pm * 256 + ai * 128 + wr * 64 + m * 16 + fr) * ld + u.pn * 256 + wc * 64;
#pragma unroll
                for (int bj = 0; bj < 2; ++bj) store8x2(d + bj * 32, acc[ai][bj][m][0], acc[ai][bj][m][1], fq);
            }
    }
};
struct EpiSwiglu {
    static constexpr bool PERM = false, AFTER_DRAIN = false, HAS_MID = false;
    bf16_t* act;
    DEV void operator()(const f32x4 (&acc)[2][2][4][2], const pg8::Unit& u, int wr, int wc, int fr, int fq) const {
#pragma unroll
        for (int ai = 0; ai < 2; ++ai)
#pragma unroll
            for (int m = 0; m < 4; ++m) {
                bf16_t* d = act + (size_t)(u.pm * 256 + ai * 128 + wr * 64 + m * 16 + fr) * DFF + u.pn * 128 + wc * 32;
                f32x4 r[2];
#pragma unroll
                for (int n = 0; n < 2; ++n) {
                    const f32x4 a = acc[ai][0][m][n], b = acc[ai][1][m][n];
#pragma unroll
                    for (int j = 0; j < 4; ++j) r[n][j] = a[j] * frcp(1.f + fexp2(-a[j] * LOG2E)) * b[j];
                }
                store8x2(d, r[0], r[1], fq);
            }
    }
};
struct EpiVT {
    static constexpr bool PERM = false, AFTER_DRAIN = false, HAS_MID = false;
    bf16_t* vt;
    DEV void operator()(const f32x4 (&acc)[2][2][4][2], const pg8::Unit& u, int wr, int wc, int fr, int fq) const {
#pragma unroll
        for (int bj = 0; bj < 2; ++bj)
#pragma unroll
            for (int n = 0; n < 2; ++n) {
                bf16_t* d = vt + (size_t)(u.pn * 256 + bj * 128 + wc * 32 + n * 16 + fr) * MC + u.pm * 256 + wr * 64 + fq * 8;
#pragma unroll
                for (int ai = 0; ai < 2; ++ai)
#pragma unroll
                    for (int m2 = 0; m2 < 2; ++m2) {
                        const f32x4 a = acc[ai][bj][2 * m2][n], b = acc[ai][bj][2 * m2 + 1][n];
                        u32x4 w; w.x = pk_bf16(a[0], a[1]); w.y = pk_bf16(a[2], a[3]); w.z = pk_bf16(b[0], b[1]); w.w = pk_bf16(b[2], b[3]);
                        *(u32x4*)(d + ai * 128 + m2 * 32) = w;
                    }
            }
    }
};
DEV size_t gate_index(int pm, int pn4, int wave, int r8, int lane) { return ((((size_t)pm * 16 + pn4) * 8 + wave) * 8 + r8) * 64 + lane; }
struct EpiGate {
    static constexpr bool PERM = false, AFTER_DRAIN = false, HAS_MID = false;
    u32x4* g8;
    DEV void operator()(const f32x4 (&acc)[2][2][4][2], const pg8::Unit& u, int wr, int wc, int fr, int fq) const {
        const int lane = fq * 16 + fr, wave = wr * 4 + wc;
#pragma unroll
        for (int ai = 0; ai < 2; ++ai)
#pragma unroll
            for (int m = 0; m < 4; ++m) {
                u32x4 w;
#pragma unroll
                for (int bj = 0; bj < 2; ++bj)
#pragma unroll
                    for (int n = 0; n < 2; ++n) {
                        const f32x4 a = acc[ai][bj][m][n]; unsigned x = 0;
#pragma unroll
                        for (int j = 0; j < 4; ++j) { const float s = frcp(1.f + fexp2(-a[j] * LOG2E)); x |= max(1u, (unsigned)(s * 255.f + 0.5f)) << (8 * j); }
                        w[bj * 2 + n] = x;
                    }
                g8[gate_index(u.pm, u.pn, wave, ai * 4 + m, lane)] = w;
            }
    }
};
struct EpiMerge {
    static constexpr bool PERM = false, AFTER_DRAIN = false, HAS_MID = true;
    bf16_t* out; const u32x4* g8;
    DEV void mid(f32x4 (&acc)[2][2][4][2], const pg8::Unit& u, int n, int wave, int lane) const {
#pragma unroll
        for (int ai = 0; ai < 2; ++ai)
#pragma unroll
            for (int m = 0; m < 4; ++m) {
                const u32x4 a = g8[gate_index(u.pm, (n - 1) * 4 + u.pn, wave, ai * 4 + m, lane)], b = g8[gate_index(u.pm, n * 4 + u.pn, wave, ai * 4 + m, lane)];
#pragma unroll
                for (int bj = 0; bj < 2; ++bj)
#pragma unroll
                    for (int nn = 0; nn < 2; ++nn) {
                        const unsigned x = a[bj * 2 + nn], y = b[bj * 2 + nn]; f32x4 r;
#pragma unroll
                        for (int j = 0; j < 4; ++j) r[j] = (float)((x >> (8 * j)) & 255u) * frcp((float)((y >> (8 * j)) & 255u));
                        acc[ai][bj][m][nn] = acc[ai][bj][m][nn] * r;
                    }
            }
    }
    DEV void operator()(const f32x4 (&acc)[2][2][4][2], const pg8::Unit& u, int wr, int wc, int fr, int fq) const {
        const int lane = fq * 16 + fr, wave = wr * 4 + wc;
#pragma unroll
        for (int ai = 0; ai < 2; ++ai)
#pragma unroll
            for (int m = 0; m < 4; ++m) {
                const u32x4 a = g8[gate_index(u.pm, 12 + u.pn, wave, ai * 4 + m, lane)];
                bf16_t* d = out + (size_t)(u.pm * 256 + ai * 128 + wr * 64 + m * 16 + fr) * 1024 + u.pn * 256 + wc * 64;
#pragma unroll
                for (int bj = 0; bj < 2; ++bj) {
                    f32x4 r[2];
#pragma unroll
                    for (int nn = 0; nn < 2; ++nn) {
                        const unsigned x = a[bj * 2 + nn];
#pragma unroll
                        for (int j = 0; j < 4; ++j) r[nn][j] = (float)((x >> (8 * j)) & 255u) * (1.f / 255.f);
                    }
                    store8x2(d + bj * 32, acc[ai][bj][m][0] * r[0], acc[ai][bj][m][1] * r[1], fq);
                }
            }
    }
};
struct EpiGemm1 {
    static constexpr bool PERM = false, AFTER_DRAIN = false, HAS_MID = false;
    const P* pp; int layer;
    DEV void operator()(const f32x4 (&acc)[2][2][4][2], const pg8::Unit& u, int wr, int wc, int fr, int fq) const {
        const int slab = u.pn * 256 + wc * 64; const bool lat = u.pm * 256 < LAT_C;
        if (slab >= 2752) return;
#pragma unroll
        for (int ai = 0; ai < 2; ++ai)
#pragma unroll
            for (int m = 0; m < 4; ++m) {
                f32x4 v[4] = {acc[ai][0][m][0], acc[ai][0][m][1], acc[ai][1][m][0], acc[ai][1][m][1]};
                gemm1_row(v, u.pm * 256 + ai * 128 + wr * 64 + m * 16 + fr, slab, lat, *pp, layer, fq);
            }
    }
};

#define LAS __attribute__((address_space(3)))
#define XB_TMO      128
#define XB_XCNT(j)  (256  + 64 * (j))
#define XB_XSUB(j)  (1280 + 64 * (j))
#define XB_XGEN(j)  (2304 + 64 * (j))
#define XB_TOP      3328
#define XB_TOPGEN   3392
#define XCD_BAR_WORDS 3456
#define XB_SPIN_CAP (1u << 18)

__device__ __forceinline__ unsigned xb_ld(unsigned* p)              { return __hip_atomic_load(p, __ATOMIC_RELAXED, __HIP_MEMORY_SCOPE_AGENT); }
__device__ __forceinline__ unsigned xb_add(unsigned* p, unsigned v) { return __hip_atomic_fetch_add(p, v, __ATOMIC_RELAXED, __HIP_MEMORY_SCOPE_AGENT); }
__device__ __forceinline__ unsigned xb_xcc_id() { return (unsigned)__builtin_amdgcn_s_getreg((3 << 11) | 20) & 0xFu; }
#define XB_SPIN(cond, bar) do { unsigned _sp = 0; while (cond) { __builtin_amdgcn_s_sleep(1); \
    if ((++_sp & 255u) == 0u) { if (xb_ld(&(bar)[XB_TMO])) break; if (_sp > XB_SPIN_CAP) { atomicAdd(&(bar)[XB_TMO], 1u); break; } } } } while (0)

struct XcdBarrier {
    unsigned* bar; unsigned x;
    volatile LAS unsigned* st;
};

__device__ __forceinline__ XcdBarrier xcd_barrier_post(unsigned* bar, volatile LAS unsigned* st) {
    XcdBarrier b; b.bar = bar; b.x = xb_xcc_id(); b.st = st;
    if (threadIdx.x == 0) (void)xb_add(&bar[XB_XCNT(b.x)], 1u);
    return b;
}
__device__ __forceinline__ void xcd_barrier_complete(unsigned* bar, unsigned x, unsigned& nloc, unsigned& nx) {
    const unsigned G = gridDim.x * gridDim.y * gridDim.z;
    unsigned sum, cnt, mine, sp = 0u;
    for (;;) {
        sum = 0u; cnt = 0u; mine = 0u;
#pragma unroll
        for (unsigned j = 0; j < 16; ++j) { const unsigned c = xb_ld(&bar[XB_XCNT(j)]); sum += c; cnt += (c > 0u) ? 1u : 0u; mine = (j == x) ? c : mine; }
        if (sum == G) break;
        __builtin_amdgcn_s_sleep(1);
        if ((++sp & 255u) == 0u) { if (xb_ld(&bar[XB_TMO])) break; if (sp > XB_SPIN_CAP) { atomicAdd(&bar[XB_TMO], 1u); break; } }
    }
    nloc = mine > 0u ? mine : 1u; nx = cnt > 0u ? cnt : 1u;
}

__device__ __forceinline__ void xcd_barrier(const XcdBarrier& b) {
    asm volatile("s_waitcnt vmcnt(0)" ::: "memory");
    __syncthreads();
    if (threadIdx.x == 0) {
        unsigned* bar = b.bar;
        __builtin_amdgcn_s_waitcnt(0);
        unsigned nloc = b.st[0], nx = b.st[1];
        if (nloc == 0u) { xcd_barrier_complete(bar, b.x, nloc, nx); b.st[0] = nloc; b.st[1] = nx; }
        const unsigned old = xb_add(&bar[XB_XSUB(b.x)], 1u);
        const unsigned gen = old / nloc;
        if (old + 1u == (gen + 1u) * nloc) {
            __builtin_amdgcn_fence(__ATOMIC_RELEASE, "agent");
            asm volatile("s_waitcnt vmcnt(0)" ::: "memory");
            const unsigned og = xb_add(&bar[XB_TOP], 1u);
            const unsigned tg = og / nx;
            if (og + 1u == (tg + 1u) * nx) xb_add(&bar[XB_TOPGEN], 1u);
            else XB_SPIN(xb_ld(&bar[XB_TOPGEN]) == tg, bar);
            __builtin_amdgcn_fence(__ATOMIC_ACQUIRE, "agent");
            xb_add(&bar[XB_XGEN(b.x)], 1u);
            asm volatile("s_waitcnt vmcnt(0)" ::: "memory");
        } else {
            XB_SPIN(xb_ld(&bar[XB_XGEN(b.x)]) == gen, bar);
            __builtin_amdgcn_fence(__ATOMIC_ACQUIRE, "agent");
            asm volatile("s_waitcnt vmcnt(0)" ::: "memory");
        }
    }
    __syncthreads();
}

typedef const __attribute__((address_space(4))) P* PP;
#define FRESH_P PP q_ = pp0; asm volatile("" : "+s"(q_)); const P& p = *(const P*)q_;
#define FRESH_BG int bidL = bid, GL = G; asm volatile("" : "+s"(bidL), "+s"(GL));
constexpr int DYN_LDS = 2 * SMEM_BYTES + 64;
__global__ void __launch_bounds__(512, 2) mega(P pv_) {
    cg::grid_group grid = cg::this_grid();
    PP pp0 = (PP)__builtin_amdgcn_kernarg_segment_ptr();
    extern __shared__ __attribute__((aligned(16))) unsigned char lds_dyn[];
    const int half = __builtin_amdgcn_readfirstlane((int)threadIdx.x >> 8);
    unsigned char* smraw = lds_dyn + half * SMEM_BYTES;
    bf16_t* sm = (bf16_t*)smraw;
    PG8_LAS unsigned char* ldsL = (PG8_LAS unsigned char*)lds_dyn;
    const int bid = blockIdx.x, G = gridDim.x, vb = bid * 2 + half, VG = G * 2, tid = threadIdx.x & 255;
    {
        FRESH_P
        volatile LAS unsigned* xst = (volatile LAS unsigned*)(ldsL + 2 * SMEM_BYTES);
        if (threadIdx.x == 0) { xst[0] = 0u; xst[1] = 0u; }
        __syncthreads();
        const XcdBarrier xb0 = xcd_barrier_post(p.barw, xst);
        if (threadIdx.x == 0) xst[2] = xb0.x;
        __syncthreads();
    }
#define GBAR() do { FRESH_P XcdBarrier b_; b_.bar = p.barw; b_.st = (volatile LAS unsigned*)(ldsL + 2 * SMEM_BYTES); b_.x = b_.st[2]; xcd_barrier(b_); } while (0)

    { FRESH_P
    for (int i = vb * 256 + tid; i < 64 * 16 + 64 * 8; i += VG * 256) {
        if (i < 1024) { const int pos = i >> 4, k = i & 15; const float inv = fexp2(-(float)k * (13.287712379549449f / 16.f)); const float a = (float)pos * inv; p.rt16[i] = (f32x2){__cosf(a), __sinf(a)}; }
        else { const int q = i - 1024; const int pos = q >> 3, k = q & 7; const float inv = fexp2(-(float)k * (13.287712379549449f / 8.f)); const float a = (float)pos * inv; p.rt8[q] = (f32x2){__cosf(a), __sinf(a)}; }
    }
    for (int t = vb; t < 384 + CONV_TILES; t += VG) { if (t < 384) mod_item(p, t, smraw); else conv_job(p, 0, t - 384, (float*)smraw); }
    }
    GBAR();
    { FRESH_P r_phase(p, 0, 0, vb, VG, 0, MTOT); }
    GBAR();

    for (int layer = 0; layer < DEPTH; ++layer) {
        const bool lastL = (layer == DEPTH - 1);
        for (int ch = 0; ch < NCH; ++ch) {
            { FRESH_P FRESH_BG
              const bf16_t* A = p.U + (size_t)ch * MC * 1024;
              { pg8::Gemm g{A, p.WinT, MC, 2816, 1024}; XSched S{11, 792, GL, bidL}; EpiGemm1 E{&p, layer};
                pg8::gemm_phase<EpiGemm1, XSched, true, true, false>(ldsL, g, S, E); }
              { pg8::Gemm g{A, p.WinT + (size_t)2816 * 1024, MC, 768, 1024}; XSched S{3, 216, GL, (bidL + GL - (792 % GL)) % GL}; EpiVT E{p.VT};
                pg8::gemm_phase<EpiVT, XSched, true, true, true>(ldsL, g, S, E); }
              { pg8::Gemm g{A, p.WinT + (size_t)NPROJ * 1024, MC, 4096, 1024}; XSched S{16, lastL ? 1024 : 1152, GL, (bidL + GL - (1008 % GL)) % GL}; EpiGate E{(u32x4*)p.G};
                pg8::gemm_phase<EpiGate, XSched, true, true, false>(ldsL, g, S, E); }
            }
            GBAR();
            { FRESH_P for (int t = vb; t < (lastL ? 4064 : 4448); t += VG) {
                if (t < 1024) attn_item<2>(p, layer, t, false, smraw);
                else if (t < 2048) attn_item<1>(p, layer, t - 1024, false, smraw);
                else if (t < 4064) { const int q = t - 2048; stage2_tile(p, q / 14, q % 14, smraw); }
                else if (t < 4192) attn_item<1>(p, layer, t - 4064, true, smraw);
                else if (t < 4320) attn_item<2>(p, layer, t - 4192, true, smraw);
                else attn_item<3>(p, layer, t - 4320, true, smraw);
            } }
            GBAR();
            { FRESH_P for (int t = vb; t < (lastL ? 2048 : 2176); t += VG) {
                if (t < 1024) attn_item<0>(p, layer, t, false, smraw);
                else if (t < 2048) attn_item<3>(p, layer, t - 1024, false, smraw);
                else attn_item<0>(p, layer, t - 2048, true, smraw);
            } }
            GBAR();
            { FRESH_P FRESH_BG pg8::Gemm g{p.O, p.WbrT, MC, 1024, 2048}; XSched S{4, lastL ? 256 : 288, GL, bidL}; EpiMerge E{p.MB, (const u32x4*)p.G};
              pg8::gemm_phase<EpiMerge, XSched, true, true, false>(ldsL, g, S, E); }
            GBAR();
            { FRESH_P FRESH_BG pg8::Gemm g{p.MB, p.WoutT, MC, 1024, 1024}; XSched S{4, lastL ? 256 : 288, GL, bidL}; EpiStoreT E{p.YC, 1024, 0};
              pg8::gemm_phase<EpiStoreT, XSched, true, true, false>(ldsL, g, S, E); }
            GBAR();
            { FRESH_P r_phase(p, 1, layer, vb, VG, ch * MC, ch * MC + (lastL ? LAT_C : MC)); }
            if (ch + 1 == NCH) GBAR();
        }
        { FRESH_P FRESH_BG pg8::Gemm g{p.U, p.Wf1T, MTOT, 2 * DFF, 1024}; XSched S{22, lastL ? 2816 : 3168, GL, bidL, lastL ? 1 : 0}; EpiSwiglu E{p.ACT};
          pg8::gemm_phase<EpiSwiglu, XSched, true, true, false>(ldsL, g, S, E); }
        GBAR();
        { FRESH_P FRESH_BG pg8::Gemm g{p.ACT, p.Wf2T, MTOT, 1024, DFF}; XSched S{4, lastL ? 512 : 576, GL, bidL, lastL ? 1 : 0}; EpiStoreT E{p.U, 1024, 0};
          pg8::gemm_phase<EpiStoreT, XSched, true, true, false>(ldsL, g, S, E); }
        GBAR();
        { FRESH_P r_phase(p, 2, layer, vb, VG, 0, MTOT, lastL);
          if (layer + 1 < DEPTH) { for (int t = vb; t < CONV_TILES; t += VG) conv_job(p, layer + 1, t, (float*)smraw); } }
        GBAR();
    }
}

extern "C" void kernel_launch(void* const* d_in, const int* in_sizes, int n_in, void* d_out, int out_size, void* d_ws, size_t ws_size, hipStream_t stream) {
    static int grid_blocks = 0;
    if (!grid_blocks) {
        int dev = 0, cus = 0, per_cu = 0;
        (void)hipGetDevice(&dev);
        (void)hipDeviceGetAttribute(&cus, hipDeviceAttributeMultiprocessorCount, dev);
        if (hipFuncSetAttribute((const void*)mega, hipFuncAttributeMaxDynamicSharedMemorySize, DYN_LDS) != hipSuccess) fprintf(stderr, "hipFuncSetAttribute failed\n");
        (void)hipOccupancyMaxActiveBlocksPerMultiprocessor(&per_cu, mega, 512, DYN_LDS);
        grid_blocks = cus;
    }
    P p{};
    const float** f = (const float**)&p;
    for (int i = 0; i < 23; ++i) f[i] = (const float*)d_in[i];
    p.out = (float*)d_out;
    unsigned char* w = (unsigned char*)d_ws; size_t off = 0;
    auto take = [&](size_t bytes) { void* r = w + off; off += (bytes + 255) & ~(size_t)255; return r; };
    p.WinT = (bf16_t*)take((size_t)NWIN * 1024 * 2);
    p.WuqT = (bf16_t*)take((size_t)768 * 256 * 2);
    p.WukvT = (bf16_t*)take((size_t)1024 * 128 * 2);
    p.WbrT = (bf16_t*)take((size_t)4 * 1024 * 512 * 2);
    p.WoutT = (bf16_t*)take((size_t)1024 * 1024 * 2);
    p.Wf1T = (bf16_t*)take((size_t)2 * DFF * 1024 * 2);
    p.Wf2T = (bf16_t*)take((size_t)1024 * DFF * 2);
    p.mod = (float*)take((size_t)DEPTH * 17 * 6144 * 4);
    p.rt16 = (f32x2*)take(64 * 16 * 8);
    p.rt8 = (f32x2*)take(64 * 8 * 8);
    p.hc = (float*)take((size_t)NBATCH * CTX * 1024 * 4);
    p.U = (bf16_t*)take((size_t)MTOT * 1024 * 2);
    p.G = (unsigned char*)take((size_t)MC * 4096);
    p.barw = (unsigned*)take((size_t)XCD_BAR_WORDS * 4);
    unsigned char* R = (unsigned char*)take(0);
    p.PJ = (bf16_t*)take((size_t)MC * PJLD * 2);
    p.QA = (bf16_t*)take((size_t)MC * 768 * 2);
    p.KN = (bf16_t*)take((size_t)MC * 512 * 2);
    p.VT = (bf16_t*)take((size_t)VTROWS * MC * 2);
    p.O = (bf16_t*)take((size_t)MC * 2048 * 2);
    p.YC = p.O;
    p.MB = p.PJ;
    p.ACT = (bf16_t*)R;
    if (off > ws_size) { fprintf(stderr, "workspace too small: need %zu have %zu\n", off, ws_size); return; }
    (void)hipMemsetAsync(p.barw, 0, (size_t)XCD_BAR_WORDS * 4, stream);
    void* args[] = {&p};
    hipError_t e = hipLaunchCooperativeKernel((void*)mega, dim3(grid_blocks), dim3(512), args, DYN_LDS, stream);
    if (e != hipSuccess) fprintf(stderr, "cooperative launch failed: %s (grid %d)\n", hipGetErrorString(e), grid_blocks);
}
```

```cpp
#include <hip/hip_runtime.h>
#include <hip/hip_cooperative_groups.h>
#include <cstdio>
#include <cstdint>
namespace cg = cooperative_groups;

typedef unsigned short bf16_t;
typedef short bf16x8 __attribute__((ext_vector_type(8)));
typedef short bf16x4 __attribute__((ext_vector_type(4)));
typedef float f32x4 __attribute__((ext_vector_type(4)));
typedef float f32x2 __attribute__((ext_vector_type(2)));
typedef unsigned u32x2 __attribute__((ext_vector_type(2)));
typedef unsigned u32x4 __attribute__((ext_vector_type(4)));
#define DEV __device__ __forceinline__

constexpr int DM = 1024, NBATCH = 16, SEQ = 2048, CTX = 256, DEPTH = 4;
constexpr int NCH = 2, BPC = NBATCH / NCH, LAT_C = BPC * SEQ, CTX_C = BPC * CTX, MC = LAT_C + CTX_C, MTOT = MC * NCH;
constexpr int INC = 7584, NPROJ = 3584, NWIN = 7680, PJLD = 2816, DFF = 2816, VTROWS = 1280;
constexpr float LOG2E = 1.4426950408889634f;
constexpr int LST = 72;
constexpr int TILE_E = 128 * LST;
constexpr int SMEM_BYTES = 4 * TILE_E * 2 + 1024;

struct P {
    const float *x, *c, *ctx, *c_ctx, *w_mod, *b_mod, *g_pre_mix, *g_post_mix, *g_pre_ffn, *g_post_ffn, *w_in, *g_a_q, *g_a_kv,
        *w_a_uq, *w_a_ukv, *sink_b, *rpb_c, *g_d_q, *g_d_k, *w_branch, *w_out, *w_ffn_in, *w_ffn_out;
    float* out;
    bf16_t *WinT, *WuqT, *WukvT, *WbrT, *WoutT, *Wf1T, *Wf2T;
    float* mod; f32x2 *rt16, *rt8; float* hc;
    bf16_t *U, *YC, *PJ, *QA, *KN, *VT, *O, *MB, *ACT;
    unsigned char* G;
    unsigned* barw;
    size_t wset;
};

typedef __bf16 bf16v2 __attribute__((ext_vector_type(2)));
#define WL(ptr, layer) ((ptr) + (size_t)((layer) & 1) * p.wset)
DEV unsigned pk_bf16(float lo, float hi) { bf16v2 v = __builtin_convertvector((f32x2){lo, hi}, bf16v2); return __builtin_bit_cast(unsigned, v); }
DEV float bf2f(unsigned short v) { return __uint_as_float(((unsigned)v) << 16); }
DEV void store4(bf16_t* p, f32x4 v) { u32x2 w; w.x = pk_bf16(v[0], v[1]); w.y = pk_bf16(v[2], v[3]); *(u32x2*)p = w; }
DEV void store8x2(bf16_t* g0, f32x4 v0, f32x4 v1, int fq) {
    unsigned ax = pk_bf16(v0[0], v0[1]), ay = pk_bf16(v0[2], v0[3]), bx = pk_bf16(v1[0], v1[1]), by = pk_bf16(v1[2], v1[3]);
    auto rx = __builtin_amdgcn_permlane16_swap(ax, bx, false, false);
    auto ry = __builtin_amdgcn_permlane16_swap(ay, by, false, false);
    u32x4 w; w.x = rx[0]; w.y = ry[0]; w.z = rx[1]; w.w = ry[1];
    *(u32x4*)(g0 + (fq & 1) * 16 + (fq >> 1) * 8) = w;
}
DEV float fexp2(float x) { return __builtin_amdgcn_exp2f(x); }
DEV float frcp(float x) { return __builtin_amdgcn_rcpf(x); }
DEV float wave_sum(float v) {
    v += __shfl_xor(v, 1); v += __shfl_xor(v, 2); v += __shfl_xor(v, 4); v += __shfl_xor(v, 8); v += __shfl_xor(v, 16); v += __shfl_xor(v, 32); return v;
}
DEV int ltid() { int t = threadIdx.x & 255; asm volatile("" : "+v"(t)); return t; }
DEV int uni(int v) { return __builtin_amdgcn_readfirstlane(v); }
DEV float xmax16(float x) { auto r = __builtin_amdgcn_permlane16_swap(__float_as_uint(x), __float_as_uint(x), false, false); return fmaxf(__uint_as_float(r[0]), __uint_as_float(r[1])); }
DEV float xmax32(float x) { auto r = __builtin_amdgcn_permlane32_swap(__float_as_uint(x), __float_as_uint(x), false, false); return fmaxf(__uint_as_float(r[0]), __uint_as_float(r[1])); }
DEV float xadd16(float x) { auto r = __builtin_amdgcn_permlane16_swap(__float_as_uint(x), __float_as_uint(x), false, false); return __uint_as_float(r[0]) + __uint_as_float(r[1]); }
DEV float xadd32(float x) { auto r = __builtin_amdgcn_permlane32_swap(__float_as_uint(x), __float_as_uint(x), false, false); return __uint_as_float(r[0]) + __uint_as_float(r[1]); }
DEV f32x4 mfma16(bf16x8 a, bf16x8 b, f32x4 c) { return __builtin_amdgcn_mfma_f32_16x16x32_bf16(a, b, c, 0, 0, 0); }

template <int NFT, bool SWAP>
DEV void gemm_mainloop(const bf16_t* __restrict__ A, int lda, const bf16_t* __restrict__ Bt, int ldb, int K, f32x4 (&acc)[NFT][4], bf16_t* sm) {
    const int tid = ltid(), lane = tid & 63, wid = uni(tid >> 6), wm = wid & 1, wn = wid >> 1, fr = lane & 15, fq = lane >> 4;
    unsigned char* sA = (unsigned char*)sm; unsigned char* sB = sA + 2 * 16384;
    const int lrow = tid >> 3, lc8 = (tid & 7) * 8;
    const int wofs = lrow * 128 + (((tid & 7) ^ (lrow & 7)) << 4);
    const bf16_t* ga = A + (size_t)lrow * lda + lc8;
    const bf16_t* gb = Bt + (size_t)lrow * ldb + lc8;
    u32x4 ra[4], rb[NFT];
#pragma unroll
    for (int ft = 0; ft < NFT; ++ft)
#pragma unroll
        for (int tt = 0; tt < 4; ++tt) acc[ft][tt] = (f32x4){0.f, 0.f, 0.f, 0.f};
#pragma unroll
    for (int i = 0; i < 4; ++i) ra[i] = *(const u32x4*)(ga + (size_t)(i * 32) * lda);
#pragma unroll
    for (int i = 0; i < NFT; ++i) rb[i] = *(const u32x4*)(gb + (size_t)(i * 32) * ldb);
#pragma unroll
    for (int i = 0; i < 4; ++i) *(u32x4*)(sA + wofs + i * 4096) = ra[i];
#pragma unroll
    for (int i = 0; i < NFT; ++i) *(u32x4*)(sB + wofs + i * 4096) = rb[i];
    const int nk = K >> 6;
    if (nk > 1) {
#pragma unroll
        for (int i = 0; i < 4; ++i) ra[i] = *(const u32x4*)(ga + (size_t)(i * 32) * lda + 64);
#pragma unroll
        for (int i = 0; i < NFT; ++i) rb[i] = *(const u32x4*)(gb + (size_t)(i * 32) * ldb + 64);
    }
    __syncthreads();
    const int rofs0 = ((0 + fq) ^ (fr & 7)) << 4, rofs1 = ((4 + fq) ^ (fr & 7)) << 4;
    for (int kt = 0; kt < nk; ++kt) {
        const int cur = kt & 1;
        if (kt + 1 < nk) {
            const int nx = cur ^ 1;
#pragma unroll
            for (int i = 0; i < 4; ++i) *(u32x4*)(sA + nx * 16384 + wofs + i * 4096) = ra[i];
#pragma unroll
            for (int i = 0; i < NFT; ++i) *(u32x4*)(sB + nx * 16384 + wofs + i * 4096) = rb[i];
        }
        if (kt + 2 < nk) {
            const int ko = (kt + 2) * 64;
#pragma unroll
            for (int i = 0; i < 4; ++i) ra[i] = *(const u32x4*)(ga + (size_t)(i * 32) * lda + ko);
#pragma unroll
            for (int i = 0; i < NFT; ++i) rb[i] = *(const u32x4*)(gb + (size_t)(i * 32) * ldb + ko);
        }
        __builtin_amdgcn_sched_barrier(0);
        const unsigned char* cA = sA + cur * 16384 + (wm * 64 + fr) * 128;
        const unsigned char* cB = sB + cur * 16384 + (wn * NFT * 16 + fr) * 128;
#pragma unroll
        for (int ks = 0; ks < 2; ++ks) {
            const int ro = ks ? rofs1 : rofs0;
            bf16x8 af[4], wf[NFT];
#pragma unroll
            for (int tt = 0; tt < 4; ++tt) af[tt] = *(const bf16x8*)(cA + tt * 2048 + ro);
#pragma unroll
            for (int ft = 0; ft < NFT; ++ft) wf[ft] = *(const bf16x8*)(cB + ft * 2048 + ro);
#pragma unroll
            for (int ft = 0; ft < NFT; ++ft)
#pragma unroll
                for (int tt = 0; tt < 4; ++tt) acc[ft][tt] = SWAP ? mfma16(af[tt], wf[ft], acc[ft][tt]) : mfma16(wf[ft], af[tt], acc[ft][tt]);
        }
        __syncthreads();
    }
}

DEV bool tile_xcd(int q, int x, int nM, int nN, int& m, int& n) {
    const int j = q >> 5, w = q & 31;
    const int pp = (((j >> 1) * 8 + x) << 1) + (j & 1);
    const int npn = nN >> 2;
    if (pp >= (nM >> 3) * npn) return false;
    const int pm = pp / npn, pn = pp - pm * npn;
    m = pm * 8 + (w & 7); n = pn * 4 + (w >> 3);
    return true;
}
#define TILE_LOOP(nM, nN) const int x_ = bid & 7, spx_ = G >> 3; int mt, nt; for (int q_ = bid >> 3; tile_xcd(q_, x_, nM, nN, mt, nt); q_ += spx_)

DEV int srccol(int mapid, int n) {
    switch (mapid) {
    case 0:
        if (n < 2816 || n >= 3584) { const int rho = n & 255; n = (n & ~255) + ((rho >> 5) & 3) * 64 + (rho >> 7) * 32 + (rho & 31); }
        if (n < 384) return n;
        if (n < 896) return n - 384 + 416;
        if (n < 1024) return n - 896 + 928;
        if (n < 1536) return n - 1024 + 1184;
        if (n < 2048) return n - 1536 + 1696;
        if (n < 2560) return n - 2048 + 2720;
        if (n < 2688) return n - 2560 + 3232;
        if (n < 2720) return n - 2688 + 384;
        if (n < 2816) return -1;
        if (n < 2944) return n - 2816 + 1056;
        if (n < 3456) return n - 2944 + 2208;
        if (n < 3584) return n - 3456 + 3360;
        return n - 3584 + 3488;
    case 1: if (n < 512) return (n >> 6) * 96 + (n & 63); { const int q = n - 512; return (q >> 5) * 96 + 64 + (q & 31); }
    case 2: if (n < 512) return (n >> 6) * 128 + (n & 63); { const int q = n - 512; return (q >> 6) * 128 + 64 + (q & 63); }
    case 4: { const int pn = n >> 8, s = (n >> 7) & 1, wc = (n >> 5) & 3, nn = (n >> 4) & 1, f = n & 15; return s * DFF + pn * 128 + wc * 32 + nn * 16 + f; }
    case 5: { const int rho = n & 255; return (n & ~255) + ((rho >> 5) & 3) * 64 + (rho >> 7) * 32 + (rho & 31); }
    default: return n;
    }
}
DEV void conv_tile(const float* __restrict__ src, int lds_, int K, bf16_t* __restrict__ dst, int n0, int k0, int mapid, const float* rowscale, float* st) {
    const int tid = ltid();
    {
        const int n = tid & 63, kk = tid >> 6; const int sc_ = srccol(mapid, n0 + n);
#pragma unroll
        for (int i = 0; i < 16; ++i) {
            const int k = kk * 16 + i;
            float v = sc_ >= 0 ? src[(size_t)(k0 + k) * lds_ + sc_] : 0.f;
            if (rowscale) v *= rowscale[k0 + k];
            st[k * 65 + n] = v;
        }
    }
    __syncthreads();
    {
        const int n = tid >> 2, kq = tid & 3; u32x4 w0, w1;
        const float* s = st + (kq * 16) * 65 + n;
        w0.x = pk_bf16(s[0 * 65], s[1 * 65]); w0.y = pk_bf16(s[2 * 65], s[3 * 65]); w0.z = pk_bf16(s[4 * 65], s[5 * 65]); w0.w = pk_bf16(s[6 * 65], s[7 * 65]);
        w1.x = pk_bf16(s[8 * 65], s[9 * 65]); w1.y = pk_bf16(s[10 * 65], s[11 * 65]); w1.z = pk_bf16(s[12 * 65], s[13 * 65]); w1.w = pk_bf16(s[14 * 65], s[15 * 65]);
        bf16_t* d = dst + (size_t)(n0 + n) * K + k0 + kq * 16;
        *(u32x4*)d = w0; *(u32x4*)(d + 8) = w1;
    }
    __syncthreads();
}
constexpr int CONV_TILES = 4880;
DEV void conv_job(const P& p, int layer, int t, float* st) {
    if (t < 1920) { conv_tile(p.w_in + (size_t)layer * DM * INC, INC, 1024, WL(p.WinT, layer), (t >> 4) * 64, (t & 15) * 64, 0, nullptr, st); return; }
    t -= 1920;
    if (t < 48) { conv_tile(p.w_a_uq + (size_t)layer * 256 * 768, 768, 256, WL(p.WuqT, layer), (t >> 2) * 64, (t & 3) * 64, 1, p.g_a_q + layer * 256, st); return; }
    t -= 48;
    if (t < 32) { conv_tile(p.w_a_ukv + (size_t)layer * 128 * 1024, 1024, 128, WL(p.WukvT, layer), (t >> 1) * 64, (t & 1) * 64, 2, p.g_a_kv + layer * 128, st); return; }
    t -= 32;
    if (t < 512) { conv_tile(p.w_branch + (size_t)layer * 4 * 512 * 1024, 1024, 2048, WL(p.WbrT, layer), (t >> 5) * 64, (t & 31) * 64, 5, nullptr, st); return; }
    t -= 512;
    if (t < 256) { conv_tile(p.w_out + (size_t)layer * 1024 * 1024, 1024, 1024, WL(p.WoutT, layer), (t >> 4) * 64, (t & 15) * 64, 5, nullptr, st); return; }
    t -= 256;
    if (t < 1408) { conv_tile(p.w_ffn_in + (size_t)layer * 1024 * 2 * DFF, 2 * DFF, 1024, WL(p.Wf1T, layer), (t >> 4) * 64, (t & 15) * 64, 4, nullptr, st); return; }
    t -= 1408;
    { const int nt = t / 44, kt = t - nt * 44; conv_tile(p.w_ffn_out + (size_t)layer * DFF * 1024, 1024, DFF, WL(p.Wf2T, layer), nt * 64, kt * 64, 5, nullptr, st); }
}

DEV void mod_item(const P& p, int item, unsigned char* smraw) {
    const int tid = ltid(), lane = tid & 63, wid = uni(tid >> 6);
    float* sc = (float*)smraw;
    const int l = item / 96, cgp = item - l * 96;
    for (int i = tid; i < 17 * 1024; i += 256) {
        const int r = i >> 10, k = i & 1023; const float v = r < 16 ? p.c[r * 1024 + k] : p.c_ctx[k];
        sc[i] = v * frcp(1.f + fexp2(-v * LOG2E));
    }
    __syncthreads();
    float acc[17];
#pragma unroll
    for (int r = 0; r < 17; ++r) acc[r] = 0.f;
    const float* w = p.w_mod + ((size_t)l * 1024 + wid * 256) * 6144 + cgp * 64 + lane;
    for (int k = 0; k < 256; k += 4) {
        const float w0 = w[(size_t)k * 6144], w1 = w[(size_t)(k + 1) * 6144], w2 = w[(size_t)(k + 2) * 6144], w3 = w[(size_t)(k + 3) * 6144];
#pragma unroll
        for (int r = 0; r < 17; ++r) { const f32x4 s = *(const f32x4*)(sc + r * 1024 + wid * 256 + k); acc[r] += s[0] * w0 + s[1] * w1 + s[2] * w2 + s[3] * w3; }
    }
    __syncthreads();
    float* red = (float*)smraw;
#pragma unroll
    for (int r = 0; r < 17; ++r) red[(wid * 17 + r) * 64 + lane] = acc[r];
    __syncthreads();
    for (int i = tid; i < 17 * 64; i += 256) {
        const int r = i >> 6, ci = i & 63;
        const float v = red[(0 * 17 + r) * 64 + ci] + red[(1 * 17 + r) * 64 + ci] + red[(2 * 17 + r) * 64 + ci] + red[(3 * 17 + r) * 64 + ci] + p.b_mod[l * 6144 + cgp * 64 + ci];
        p.mod[((size_t)l * 17 + r) * 6144 + cgp * 64 + ci] = v;
    }
    __syncthreads();
}

DEV void r_phase(const P& p, int mode, int layer, int vb, int VG, int g_lo, int g_hi, bool skipctx = false) {
    const int tid_ = ltid(), lane = tid_ & 63, wid = uni(tid_ >> 6);
    const int nw = VG * 4;
    for (int g = g_lo + vb * 4 + wid; g < g_hi; g += nw) {
        const int ch = g / MC, local = g - ch * MC;
        if (skipctx && local >= LAT_C) continue;
        const float* hin; float* hout; const float* mod;
        if (local < LAT_C) {
            const int idx = ch * LAT_C + local; const int b = idx >> 11;
            hin = (mode == 0 ? p.x : p.out) + (size_t)idx * 1024; hout = p.out + (size_t)idx * 1024; mod = p.mod + ((size_t)layer * 17 + b) * 6144;
        } else {
            const int idx = ch * CTX_C + local - LAT_C;
            hin = (mode == 0 ? p.ctx : p.hc) + (size_t)idx * 1024; hout = p.hc + (size_t)idx * 1024; mod = p.mod + ((size_t)layer * 17 + 16) * 6144;
        }
        f32x4 h[4];
#pragma unroll
        for (int i = 0; i < 2; ++i)
#pragma unroll
            for (int k = 0; k < 2; ++k) h[2 * i + k] = *(const f32x4*)(hin + i * 512 + lane * 8 + 4 * k);
        if (mode != 0) {
            f32x4 y[4]; float ss = 0.f;
            const bf16_t* yp = (mode == 1 ? p.YC + (size_t)local * 1024 : p.U + (size_t)g * 1024);
#pragma unroll
            for (int i = 0; i < 2; ++i) {
                const u32x4 w = *(const u32x4*)(yp + i * 512 + lane * 8);
                y[2 * i] = (f32x4){__uint_as_float(w.x << 16), __uint_as_float(w.x & 0xffff0000u), __uint_as_float(w.y << 16), __uint_as_float(w.y & 0xffff0000u)};
                y[2 * i + 1] = (f32x4){__uint_as_float(w.z << 16), __uint_as_float(w.z & 0xffff0000u), __uint_as_float(w.w << 16), __uint_as_float(w.w & 0xffff0000u)};
            }
#pragma unroll
            for (int i = 0; i < 4; ++i) ss += y[i][0] * y[i][0] + y[i][1] * y[i][1] + y[i][2] * y[i][2] + y[i][3] * y[i][3];
            ss = wave_sum(ss);
            const float rs = rsqrtf(ss * (1.f / 1024.f) + 1e-6f);
            const float* gp = (mode == 1 ? p.g_post_mix : p.g_post_ffn) + layer * 1024;
            const float* ga = mod + (mode == 1 ? 2048 : 5120);
#pragma unroll
            for (int i = 0; i < 2; ++i)
#pragma unroll
                for (int k = 0; k < 2; ++k) {
                    const int e = i * 512 + lane * 8 + 4 * k;
                    const f32x4 gg = *(const f32x4*)(gp + e), aa = *(const f32x4*)(ga + e);
                    h[2 * i + k] = h[2 * i + k] + aa * (y[2 * i + k] * rs * gg);
                }
        }
#pragma unroll
        for (int i = 0; i < 2; ++i)
#pragma unroll
            for (int k = 0; k < 2; ++k) *(f32x4*)(hout + i * 512 + lane * 8 + 4 * k) = h[2 * i + k];
        const int nl = (mode == 2) ? layer + 1 : layer;
        if (nl < DEPTH) {
            float ss = 0.f;
#pragma unroll
            for (int i = 0; i < 4; ++i) ss += h[i][0] * h[i][0] + h[i][1] * h[i][1] + h[i][2] * h[i][2] + h[i][3] * h[i][3];
            ss = wave_sum(ss);
            const float rs = rsqrtf(ss * (1.f / 1024.f) + 1e-6f);
            const float* gpre = (mode == 1 ? p.g_pre_ffn : p.g_pre_mix) + nl * 1024;
            const float* modn = (mode == 2) ? mod + 17 * 6144 : mod;
            const float* sh = modn + (mode == 1 ? 3072 : 0);
            const float* sc = modn + (mode == 1 ? 4096 : 1024);
#pragma unroll
            for (int i = 0; i < 2; ++i) {
                f32x4 u[2];
#pragma unroll
                for (int k = 0; k < 2; ++k) {
                    const int e = i * 512 + lane * 8 + 4 * k;
                    const f32x4 gg = *(const f32x4*)(gpre + e), s1 = *(const f32x4*)(sc + e), s0 = *(const f32x4*)(sh + e);
                    u[k] = h[2 * i + k] * rs * gg * (s1 + 1.f) + s0;
                }
                u32x4 w; w.x = pk_bf16(u[0][0], u[0][1]); w.y = pk_bf16(u[0][2], u[0][3]); w.z = pk_bf16(u[1][0], u[1][1]); w.w = pk_bf16(u[1][2], u[1][3]);
                *(u32x4*)(p.U + (size_t)g * 1024 + i * 512 + lane * 8) = w;
            }
        }
    }
}

DEV void gemm1_row(f32x4 (&v)[4], int row, int slab, bool lat, const P& p, int layer, int fq) {
    const bool hnorm = (slab >= 2048 && slab < 2688);
    const bool rope64 = lat && ((slab >= 384 && slab < 1024) || hnorm);
    const bool isq = (slab >= 384 && slab < 896) || (slab >= 1024 && slab < 1536) || (slab >= 2048 && slab < 2560);
    const float sc = isq ? 0.125f * LOG2E : 1.f;
    const bool kr = (slab == 2688);
    const int tok = row & 2047; const int pr = tok >> 6, pc = tok & 63;
    if (hnorm) {
        float ss = 0.f;
#pragma unroll
        for (int ft = 0; ft < 4; ++ft) ss += v[ft][0] * v[ft][0] + v[ft][1] * v[ft][1] + v[ft][2] * v[ft][2] + v[ft][3] * v[ft][3];
        ss += __shfl_xor(ss, 16); ss += __shfl_xor(ss, 32);
        const float rs = rsqrtf(ss * (1.f / 64.f) + 1e-6f);
        const float* g = (slab < 2560 ? p.g_d_q : p.g_d_k) + layer * 64;
#pragma unroll
        for (int ft = 0; ft < 4; ++ft) { const f32x4 gg = *(const f32x4*)(g + ft * 16 + fq * 4); v[ft] = v[ft] * rs * gg; }
    }
    if (rope64) {
#pragma unroll
        for (int j = 0; j < 4; ++j) {
            const int i = fq * 4 + j;
            f32x2 cs = p.rt16[pr * 16 + i]; float a = v[0][j], b = v[1][j];
            v[0][j] = a * cs[0] - b * cs[1]; v[1][j] = b * cs[0] + a * cs[1];
            cs = p.rt16[pc * 16 + i]; a = v[2][j]; b = v[3][j];
            v[2][j] = a * cs[0] - b * cs[1]; v[3][j] = b * cs[0] + a * cs[1];
        }
    }
    if (kr && lat) {
#pragma unroll
        for (int ft = 0; ft < 2; ++ft) {
            const int pos = ft == 0 ? pr : pc;
#pragma unroll
            for (int j = 0; j < 4; ++j) {
                const int i = (fq & 1) * 4 + j; const f32x2 cs = p.rt8[pos * 8 + i];
                const float xv = v[ft][j]; const float o = __shfl_xor(xv, 32);
                v[ft][j] = fq < 2 ? xv * cs[0] - o * cs[1] : xv * cs[0] + o * cs[1];
            }
        }
    }
    bf16_t* dst = p.PJ + (size_t)row * PJLD + slab;
    store8x2(dst, v[0] * sc, v[1] * sc, fq);
    if (!kr) store8x2(dst + 32, v[2] * sc, v[3] * sc, fq);
}
DEV void stage2_tile(const P& p, int layer, int mt, int j, unsigned char* smraw) {
    bf16_t* sm = (bf16_t*)smraw; float* s_rs = (float*)(smraw + 73728);
    const int tid = ltid(), lane = tid & 63, wid = uni(tid >> 6), wm = wid & 1, wn = wid >> 1, fr = lane & 15, fq = lane >> 4;
    const int m0 = mt * 128; const bool isq = j < 6; const bool lat = m0 < LAT_C;
    const int K = isq ? 256 : 128; const int acol = isq ? 0 : 256;
    {
        const int r = tid >> 1, hf = tid & 1; const int n = K >> 1;
        const bf16_t* src = p.PJ + (size_t)(m0 + r) * PJLD + acol + hf * n; float ss = 0.f;
        for (int i = 0; i < n; i += 8) {
            const u32x4 w = *(const u32x4*)(src + i);
#pragma unroll
            for (int q = 0; q < 4; ++q) { const float a = __uint_as_float(w[q] << 16), b = __uint_as_float(w[q] & 0xffff0000u); ss += a * a + b * b; }
        }
        ss += __shfl_xor(ss, 1);
        if (hf == 0) s_rs[r] = rsqrtf(ss / (float)K + 1e-6f);
    }
    __syncthreads();
    f32x4 acc[4][4];
    const bf16_t* A = p.PJ + (size_t)m0 * PJLD + acol;
    if (isq) {
        const int n0 = j * 128;
        gemm_mainloop<4, false>(A, PJLD, WL(p.WuqT, layer) + (size_t)n0 * 256, 256, 256, acc, sm);
        const int slab = n0 + wn * 64; const float qs = 0.10206207261596577f * LOG2E;
#pragma unroll
        for (int tt = 0; tt < 4; ++tt) {
            const int lr = wm * 64 + tt * 16 + fr; const int row = m0 + lr; const float rs = s_rs[lr] * qs;
            const int tok = row & 2047; const int pr = tok >> 6, pc = tok & 63;
            f32x4 v[4] = {acc[0][tt], acc[1][tt], acc[2][tt], acc[3][tt]};
            if (slab >= 512 && lat) {
#pragma unroll
                for (int ft = 0; ft < 4; ++ft) {
                    const int pos = (ft & 1) == 0 ? pr : pc;
#pragma unroll
                    for (int jj = 0; jj < 4; ++jj) {
                        const int i = (fq & 1) * 4 + jj; const f32x2 cs = p.rt8[pos * 8 + i];
                        const float xv = v[ft][jj]; const float o = __shfl_xor(xv, 32);
                        v[ft][jj] = fq < 2 ? xv * cs[0] - o * cs[1] : xv * cs[0] + o * cs[1];
                    }
                }
            }
            bf16_t* dst = p.QA + (size_t)row * 768 + slab;
            store8x2(dst, v[0] * rs, v[1] * rs, fq); store8x2(dst + 32, v[2] * rs, v[3] * rs, fq);
        }
    } else {
        const int n0 = (j - 6) * 128;
        if (n0 < 512) {
            gemm_mainloop<4, false>(A, PJLD, WL(p.WukvT, layer) + (size_t)n0 * 128, 128, 128, acc, sm);
#pragma unroll
            for (int tt = 0; tt < 4; ++tt) {
                const int lr = wm * 64 + tt * 16 + fr; const float rs = s_rs[lr];
                bf16_t* dst = p.KN + (size_t)(m0 + lr) * 512 + n0 + wn * 64;
                store8x2(dst, acc[0][tt] * rs, acc[1][tt] * rs, fq); store8x2(dst + 32, acc[2][tt] * rs, acc[3][tt] * rs, fq);
            }
        } else {
            gemm_mainloop<4, true>(A, PJLD, WL(p.WukvT, layer) + (size_t)n0 * 128, 128, 128, acc, sm);
            const int vrow0 = 768 + (n0 - 512) + wn * 64;
#pragma unroll
            for (int t2 = 0; t2 < 2; ++t2) {
                const int lr = wm * 64 + t2 * 32 + fq * 4;
                const f32x4 rs0 = *(const f32x4*)(s_rs + lr), rs1 = *(const f32x4*)(s_rs + lr + 16);
                const int lp = wm * 64 + t2 * 32 + fq * 8;
#pragma unroll
                for (int ft = 0; ft < 4; ++ft) {
                    const f32x4 a = acc[ft][2 * t2] * rs0, b = acc[ft][2 * t2 + 1] * rs1;
                    u32x4 w; w.x = pk_bf16(a[0], a[1]); w.y = pk_bf16(a[2], a[3]); w.z = pk_bf16(b[0], b[1]); w.w = pk_bf16(b[2], b[3]);
                    *(u32x4*)(p.VT + (size_t)(vrow0 + ft * 16 + fr) * MC + m0 + lp) = w;
                }
            }
        }
    }
    __syncthreads();
}

template <int MODE>
DEV void attn_item(const P& p, int layer, int item, bool ctxq, unsigned char* smraw) {
    constexpr bool GQA = (MODE == 1 || MODE == 3);
    constexpr int DQK = (MODE == 0) ? 96 : 64, NKS = DQK / 32;
    constexpr int KRB = (MODE == 0) ? 256 : 128, KM = (MODE == 0) ? 15 : 7;
    constexpr int KT_B = 64 * KRB, VT_B = 64 * 128;
    unsigned char* Ks = smraw; unsigned char* Vs = smraw + 32768; float* bias_s = (float*)(smraw + 49152);
    const int tid = ltid(), lane = tid & 63, wid = uni(tid >> 6), fr = lane & 15, fq = lane >> 4;
    const int nqt = ctxq ? (GQA ? 8 : 2) : (GQA ? 64 : 16);
    const int nh = GQA ? 2 : 8;
    const int qt = item % nqt, hh = (item / nqt) % nh, lb = item / (nqt * nh);
    const int head = GQA ? hh * 4 + wid : hh;
    const int tok0 = GQA ? qt * 32 : qt * 128 + wid * 32;
    const int qrow0 = (ctxq ? LAT_C + lb * CTX : lb * SEQ) + tok0;
    bf16x8 qf[2][NKS];
#pragma unroll
    for (int q = 0; q < 2; ++q) {
        const int row = qrow0 + q * 16 + fr;
        if (MODE == 0) {
            qf[q][0] = *(const bf16x8*)(p.QA + (size_t)row * 768 + head * 64 + fq * 8);
            qf[q][1] = *(const bf16x8*)(p.QA + (size_t)row * 768 + head * 64 + 32 + fq * 8);
            qf[q][NKS - 1] = *(const bf16x8*)(p.QA + (size_t)row * 768 + 512 + head * 32 + fq * 8);
        } else {
            const int qoff = MODE == 1 ? 384 : (MODE == 2 ? 1024 : 2048);
#pragma unroll
            for (int ks = 0; ks < NKS; ++ks) qf[q][ks] = *(const bf16x8*)(p.PJ + (size_t)row * PJLD + qoff + head * 64 + ks * 32 + fq * 8);
        }
    }
    const int koff = MODE == 1 ? 896 + hh * 64 : (MODE == 2 ? 1536 + hh * 64 : 2560 + hh * 64);
    const int vrow0 = MODE == 0 ? 768 + hh * 64 : (MODE == 1 ? hh * 64 : (MODE == 2 ? 128 + hh * 64 : 640 + hh * 64));
    int ktlo = 0, nlat = 0;
    if (!ctxq) {
        if (MODE == 0 || MODE == 3) { ktlo = 0; nlat = 32; }
        else if (MODE == 1) { const int q0 = qt * 32; const int lo = max(0, q0 - 128), hi = min(SEQ - 1, q0 + 159); ktlo = lo >> 6; nlat = (hi >> 6) - ktlo + 1; }
        else { const int r0a = min(max(2 * qt - 4, 0), 24), r0b = min(max(2 * qt + 1 - 4, 0), 24); ktlo = r0a; nlat = r0b + 8 - r0a; }
    }
    const int nt = 4 + nlat;
    const int ntf = ctxq ? 4 : ((MODE == 0 || MODE == 3) ? 36 : (MODE == 1 ? 9 : 13));
    if (MODE == 2 && !ctxq) { for (int i = tid; i < 465; i += 256) bias_s[i] = p.rpb_c[(layer * 8 + hh) * 465 + i] * LOG2E; }

    u32x4 rk[NKS], rv[2];
    auto tile_krow = [&](int it) { it = min(it, nt - 1); return it < 4 ? LAT_C + lb * CTX + it * 64 : lb * SEQ + (ktlo + it - 4) * 64; };
    auto gload = [&](int it) {
        const int krow = tile_krow(it);
#pragma unroll
        for (int i = 0; i < NKS; ++i) {
            const int id = tid + i * 256;
            if (MODE == 0) {
                const int key = id / 12, c = id - key * 12;
                const bf16_t* src = c < 8 ? p.KN + (size_t)(krow + key) * 512 + hh * 64 + c * 8 : p.PJ + (size_t)(krow + key) * PJLD + 2688 + (c - 8) * 8;
                rk[i] = *(const u32x4*)src;
            } else {
                const int key = id >> 3, c = id & 7;
                rk[i] = *(const u32x4*)(p.PJ + (size_t)(krow + key) * PJLD + koff + c * 8);
            }
        }
#pragma unroll
        for (int i = 0; i < 2; ++i) { const int id = tid + i * 256; const int dv = id >> 3, c = id & 7; rv[i] = *(const u32x4*)(p.VT + (size_t)(vrow0 + dv) * MC + krow + c * 8); }
    };
    auto lstore = [&](int buf) {
#pragma unroll
        for (int i = 0; i < NKS; ++i) {
            const int id = tid + i * 256; int key, c;
            if (MODE == 0) { key = id / 12; c = id - key * 12; } else { key = id >> 3; c = id & 7; }
            *(u32x4*)(Ks + buf * KT_B + key * KRB + ((c ^ (key & KM)) << 4)) = rk[i];
        }
#pragma unroll
        for (int i = 0; i < 2; ++i) { const int id = tid + i * 256; const int dv = id >> 3, c = id & 7; *(u32x4*)(Vs + buf * VT_B + dv * 128 + ((c ^ (dv & 7)) << 4)) = rv[i]; }
    };

    f32x4 o[4][2], lo[2], negm4[2]; float mref[2];
    const bf16x8 ones8 = __builtin_bit_cast(bf16x8, (u32x4){0x3F803F80u, 0x3F803F80u, 0x3F803F80u, 0x3F803F80u});
#pragma unroll
    for (int q = 0; q < 2; ++q) { mref[q] = 0.f; lo[q] = (f32x4){0.f, 0.f, 0.f, 0.f}; negm4[q] = (f32x4){0.f, 0.f, 0.f, 0.f};
#pragma unroll
        for (int d = 0; d < 4; ++d) o[d][q] = (f32x4){0.f, 0.f, 0.f, 0.f}; }

    gload(0); lstore(0); gload(1); __syncthreads();
    for (int it = 0; it < ntf; ++it) {
        const int cur = it & 1;
        if (it + 1 < ntf) lstore(cur ^ 1);
        if (it + 2 < ntf) gload(it + 2);
        __builtin_amdgcn_sched_barrier(0);
        const int kt = ktlo + it - 4;
        bool active = it < nt;
        int r = 0, r0 = 0;
        if (MODE == 2 && !ctxq && it >= 4) { r = 2 * qt + (wid >> 1); r0 = min(max(r - 4, 0), 24); active = active && (kt >= r0 && kt < r0 + 8); }
        if (active) {
            f32x4 s[4][2];
            const unsigned char* kb = Ks + cur * KT_B + fr * KRB;
            bf16x8 kf[4][NKS];
#pragma unroll
            for (int k4 = 0; k4 < 4; ++k4)
#pragma unroll
                for (int ks = 0; ks < NKS; ++ks) kf[k4][ks] = *(const bf16x8*)(kb + k4 * 16 * KRB + (((ks * 4 + fq) ^ (fr & KM)) << 4));
            __builtin_amdgcn_sched_barrier(0);
#pragma unroll
            for (int k4 = 0; k4 < 4; ++k4) {
#pragma unroll
                for (int q = 0; q < 2; ++q) s[k4][q] = mfma16(kf[k4][0], qf[q][0], negm4[q]);
#pragma unroll
                for (int ks = 1; ks < NKS; ++ks)
#pragma unroll
                    for (int q = 0; q < 2; ++q) s[k4][q] = mfma16(kf[k4][ks], qf[q][ks], s[k4][q]);
            }
            const unsigned char* vb = Vs + cur * VT_B + fr * 128;
            bf16x8 vf[4][2];
#pragma unroll
            for (int d = 0; d < 4; ++d)
#pragma unroll
                for (int kb2 = 0; kb2 < 2; ++kb2) vf[d][kb2] = *(const bf16x8*)(vb + d * 16 * 128 + (((kb2 * 4 + fq) ^ (fr & 7)) << 4));
            __builtin_amdgcn_sched_barrier(0);
            if (!ctxq && it >= 4) {
                if (MODE == 1) {
#pragma unroll
                    for (int q = 0; q < 2; ++q) {
                        const int qpos = tok0 + q * 16 + fr;
#pragma unroll
                        for (int k4 = 0; k4 < 4; ++k4)
#pragma unroll
                            for (int j = 0; j < 4; ++j) { const int d = qpos - (kt * 64 + k4 * 16 + fq * 4 + j); if (d > 128 || d < -128) s[k4][q][j] = -1e30f; }
                    }
                }
                if (MODE == 2) {
#pragma unroll
                    for (int q = 0; q < 2; ++q) {
                        const int qc = (wid & 1) * 32 + q * 16 + fr; const int c0 = min(max(qc - 8, 0), 48);
                        const int bbase = (kt - r + 7) * 31 + 15 - qc;
#pragma unroll
                        for (int k4 = 0; k4 < 4; ++k4)
#pragma unroll
                            for (int j = 0; j < 4; ++j) {
                                const int kc = k4 * 16 + fq * 4 + j; const bool ok = (kc >= c0 && kc < c0 + 16);
                                const float bv = bias_s[ok ? bbase + kc : 0];
                                s[k4][q][j] = ok ? s[k4][q][j] + bv : -1e30f;
                            }
                    }
                }
            }
            bf16x8 pf[2][2];
#pragma unroll
            for (int q = 0; q < 2; ++q) {
                float mx = -1e30f;
#pragma unroll
                for (int k4 = 0; k4 < 4; ++k4) mx = fmaxf(mx, fmaxf(fmaxf(s[k4][q][0], s[k4][q][1]), fmaxf(s[k4][q][2], s[k4][q][3])));
                mx = xmax32(xmax16(mx));
                const bool need = (it == 0) || (mx > 8.f);
                if (__builtin_amdgcn_ballot_w64(need) != 0ull) {
                    const float delta = need ? mx : 0.f;
                    mref[q] += delta; negm4[q] = negm4[q] - delta;
#pragma unroll
                    for (int k4 = 0; k4 < 4; ++k4) s[k4][q] = s[k4][q] - delta;
                    const float alpha = fexp2(-delta);
                    lo[q] = lo[q] * alpha;
#pragma unroll
                    for (int d = 0; d < 4; ++d) o[d][q] = o[d][q] * alpha;
                }
#pragma unroll
                for (int k4 = 0; k4 < 4; ++k4)
#pragma unroll
                    for (int j = 0; j < 4; ++j) s[k4][q][j] = fexp2(s[k4][q][j]);
#pragma unroll
                for (int kb2 = 0; kb2 < 2; ++kb2) {
                    u32x4 w; w.x = pk_bf16(s[2 * kb2][q][0], s[2 * kb2][q][1]); w.y = pk_bf16(s[2 * kb2][q][2], s[2 * kb2][q][3]);
                    w.z = pk_bf16(s[2 * kb2 + 1][q][0], s[2 * kb2 + 1][q][1]); w.w = pk_bf16(s[2 * kb2 + 1][q][2], s[2 * kb2 + 1][q][3]);
                    pf[q][kb2] = __builtin_bit_cast(bf16x8, w);
                }
            }
#pragma unroll
            for (int d = 0; d < 4; ++d)
#pragma unroll
                for (int kb2 = 0; kb2 < 2; ++kb2)
#pragma unroll
                    for (int q = 0; q < 2; ++q) o[d][q] = mfma16(vf[d][kb2], pf[q][kb2], o[d][q]);
#pragma unroll
            for (int kb2 = 0; kb2 < 2; ++kb2)
#pragma unroll
                for (int q = 0; q < 2; ++q) lo[q] = mfma16(ones8, pf[q][kb2], lo[q]);
        }
        __syncthreads();
    }
#pragma unroll
    for (int q = 0; q < 2; ++q) {
        float l = lo[q][0];
        if (MODE == 1) l += fexp2(p.sink_b[layer * 8 + head] * LOG2E - mref[q]);
        const float inv = 1.f / l;
        bf16_t* dst = p.O + (size_t)(qrow0 + q * 16 + fr) * 2048 + MODE * 512 + head * 64;
        store8x2(dst, o[0][q] * inv, o[1][q] * inv, fq); store8x2(dst + 32, o[2][q] * inv, o[3][q] * inv, fq);
    }
}


namespace pg8 {
#define PG8_LAS __attribute__((address_space(3)))
constexpr int BM = 256, BK = 64, HALF = 128, HTB = HALF * BK * 2  , STAGE_BYTES = 8 * HTB, NXCD = 8, WGM = 8;

__host__ __device__ __forceinline__ int lds_byte(int r, int c) { const int st = (r >> 4) * 2 + (c >> 5), rr = r & 15, cc = c & 31, ob = rr * 64 + cc * 2; return st * 1024 + (ob ^ (((ob >> 9) & 1) << 5)); }
__host__ __device__ __forceinline__ void stage_rc(int b, int& R, int& C) { const int st = b / 1024, sb = b % 1024, swz = sb ^ (((sb >> 9) & 1) << 5); R = (st >> 1) * 16 + swz / 64; C = (st & 1) * 32 + (swz % 64) / 2; }
__host__ __device__ __forceinline__ int perm32(int rho) { const int n = rho >> 4, i = rho & 15; return 8 * (i >> 2) + 4 * n + (i & 3); }

struct Unit { int pm, pn; };
struct Gemm { const bf16_t* A; const bf16_t* Bt; int M, N, K; };

template <class Epi, class Sched, bool ALIGN_EPI = false, bool SP2 = false, bool SWAPMMA = false>
__device__ __forceinline__ void gemm_phase(PG8_LAS unsigned char* lds, const Gemm g, const Sched& S, const Epi& E) {
    int tid = threadIdx.x; asm volatile("" : "+v"(tid));
    const int wid = __builtin_amdgcn_readfirstlane(tid >> 6), lane = tid & 63, wr = wid >> 2, wc = wid & 3, fr = lane & 15, fq = lane >> 4;
    const int K = g.K, nt = K / BK;
    unsigned voffA[2], voffB[2];
#pragma unroll
    for (int i = 0; i < 2; ++i) { int R, C; stage_rc(tid * 16 + i * 8192, R, C); const int Rb = Epi::PERM ? ((R & ~31) + perm32(R & 31)) : R;
        voffA[i] = (unsigned)(R * K + C) * 2u; voffB[i] = (unsigned)(Rb * K + C) * 2u; }
    const size_t kstep = (size_t)(BK * 2);
    const size_t hstep = (size_t)HALF * K * 2;
    const size_t tstep = 2 * hstep;
    const unsigned ldsw = (unsigned)wid * 1024u;
    const int aoff = lds_byte(wr * 64 + fr, fq * 8), boff = lds_byte(wc * 32 + fr, fq * 8);
#define PG8_SA(b, h) (((b) * 2 + (h)) * HTB)
#define PG8_SB(b, h) ((4 + (b) * 2 + (h)) * HTB)
#define PG8_STAGE(bufoff, gbase, voff) do { _Pragma("unroll") for (int _i = 0; _i < 2; ++_i) \
        __builtin_amdgcn_global_load_lds((const unsigned*)((const char*)(gbase) + (voff)[_i]), (PG8_LAS unsigned*)(lds + (bufoff) + ldsw + _i * 8192), 16, 0, 0); } while (0)
#define PG8_LDA(dst, b, h) do { _Pragma("unroll") for (int m = 0; m < 4; ++m) _Pragma("unroll") for (int k = 0; k < 2; ++k) dst[m][k] = *(const PG8_LAS bf16x8*)(lds + PG8_SA(b, h) + aoff + m * 2048 + k * 1024); } while (0)
#define PG8_LDB(dst, b, h) do { _Pragma("unroll") for (int n = 0; n < 2; ++n) _Pragma("unroll") for (int k = 0; k < 2; ++k) dst[n][k] = *(const PG8_LAS bf16x8*)(lds + PG8_SB(b, h) + boff + n * 2048 + k * 1024); } while (0)
#define PG8_MMA(ai, bj, At, Bt) do { __builtin_amdgcn_s_setprio(1); _Pragma("unroll") for (int m = 0; m < 4; ++m) _Pragma("unroll") for (int n = 0; n < 2; ++n) _Pragma("unroll") for (int k = 0; k < 2; ++k) \
        acc[ai][bj][m][n] = SWAPMMA ? __builtin_amdgcn_mfma_f32_16x16x32_bf16(At[m][k], Bt[n][k], acc[ai][bj][m][n], 0, 0, 0) : __builtin_amdgcn_mfma_f32_16x16x32_bf16(Bt[n][k], At[m][k], acc[ai][bj][m][n], 0, 0, 0); __builtin_amdgcn_s_setprio(0); } while (0)
#define PG8_WAIT_V(n) asm volatile("s_waitcnt vmcnt(" #n ")" ::: "memory")
#define PG8_WAIT_L(n) asm volatile("s_waitcnt lgkmcnt(" #n ")" ::: "memory")
#define PG8_BAR __builtin_amdgcn_s_barrier()
#define PG8_SCHED __builtin_amdgcn_sched_barrier(0)
    Unit cur, nxt; int ui = 0;
    if (!S.next(0, cur)) return;
    f32x4 acc[2][2][4][2];
#pragma unroll
    for (int a = 0; a < 2; ++a)
#pragma unroll
        for (int b = 0; b < 2; ++b)
#pragma unroll
            for (int m = 0; m < 4; ++m)
#pragma unroll
                for (int n = 0; n < 2; ++n) acc[a][b][m][n] = (f32x4){0.f, 0.f, 0.f, 0.f};
    bf16x8 At[4][2], B0[2][2], B1[2][2];
    const char* cA = (const char*)g.A + (size_t)cur.pm * tstep; const char* cB = (const char*)g.Bt + (size_t)cur.pn * tstep;
    S.a_ready(cur);
    if constexpr (SP2) {
        PG8_STAGE(PG8_SB(0, 0), cB, voffB); PG8_STAGE(PG8_SB(0, 1), cB + hstep, voffB); PG8_STAGE(PG8_SA(0, 0), cA, voffA); PG8_STAGE(PG8_SA(0, 1), cA + hstep, voffA);
        if (wr == 1) PG8_BAR;
        PG8_WAIT_V(2); PG8_BAR;
        PG8_STAGE(PG8_SB(1, 0), cB + kstep, voffB); PG8_STAGE(PG8_SA(1, 0), cA + kstep, voffA); PG8_STAGE(PG8_SB(1, 1), cB + hstep + kstep, voffB);
        PG8_WAIT_V(6); PG8_BAR;
    } else {
        PG8_STAGE(PG8_SB(0, 0), cB, voffB); PG8_STAGE(PG8_SA(0, 0), cA, voffA); PG8_STAGE(PG8_SB(0, 1), cB + hstep, voffB); PG8_STAGE(PG8_SA(0, 1), cA + hstep, voffA);
        if (wr == 1) PG8_BAR;
        PG8_WAIT_V(4); PG8_BAR;
        PG8_STAGE(PG8_SB(1, 0), cB + kstep, voffB); PG8_STAGE(PG8_SA(1, 0), cA + kstep, voffA); PG8_STAGE(PG8_SB(1, 1), cB + hstep + kstep, voffB);
        PG8_WAIT_V(6); PG8_BAR;
    }
    for (;;) {
        const bool has_next = S.next(ui + 1, nxt);
        const char* nA = has_next ? (const char*)g.A + (size_t)nxt.pm * tstep : cA; const char* nB = has_next ? (const char*)g.Bt + (size_t)nxt.pn * tstep : cB;
        for (int t = 0; t < nt; t += 2) {
            if constexpr (Epi::HAS_MID) { if (t != 0 && (t & 7) == 0) { E.mid(acc, cur, t >> 3, wid, lane); asm volatile("s_waitcnt vmcnt(0)" ::: "memory"); } }
            const bool last = (t == nt - 2);
            const char* a1 = cA + (size_t)(t + 1) * kstep;
            const char* a2 = last ? nA : cA + (size_t)(t + 2) * kstep; const char* b2 = last ? nB : cB + (size_t)(t + 2) * kstep;
            const char* a3 = a2 + kstep; const char* b3 = b2 + kstep;
            if (last && has_next) S.a_ready(nxt);
            if constexpr (SP2) {
            PG8_LDB(B0, 0, 0); PG8_LDB(B1, 0, 1); PG8_SCHED; PG8_LDA(At, 0, 0); PG8_STAGE(PG8_SA(1, 1), a1 + hstep, voffA);
            PG8_WAIT_V(8); PG8_WAIT_L(0); PG8_BAR; PG8_MMA(0, 0, At, B0); PG8_MMA(0, 1, At, B1); PG8_BAR; PG8_SCHED;
            PG8_LDA(At, 0, 1); PG8_STAGE(PG8_SB(0, 0), b2, voffB); PG8_STAGE(PG8_SB(0, 1), b2 + hstep, voffB); PG8_STAGE(PG8_SA(0, 0), a2, voffA);
            PG8_WAIT_V(8); PG8_WAIT_L(0); PG8_BAR; PG8_MMA(1, 0, At, B0); PG8_MMA(1, 1, At, B1); PG8_BAR; PG8_SCHED;
            PG8_LDB(B0, 1, 0); PG8_LDB(B1, 1, 1); PG8_SCHED; PG8_LDA(At, 1, 0); PG8_STAGE(PG8_SA(0, 1), a2 + hstep, voffA);
            PG8_WAIT_V(8); PG8_WAIT_L(0); PG8_BAR; PG8_MMA(0, 0, At, B0); PG8_MMA(0, 1, At, B1); PG8_BAR; PG8_SCHED;
            PG8_LDA(At, 1, 1); PG8_STAGE(PG8_SB(1, 0), b3, voffB); PG8_STAGE(PG8_SB(1, 1), b3 + hstep, voffB); PG8_STAGE(PG8_SA(1, 0), a3, voffA);
            PG8_WAIT_V(8); PG8_WAIT_L(0); PG8_BAR; PG8_MMA(1, 0, At, B0); PG8_MMA(1, 1, At, B1); PG8_BAR; PG8_SCHED;
            } else {
            PG8_LDB(B0, 0, 0); PG8_SCHED; PG8_LDA(At, 0, 0); PG8_STAGE(PG8_SA(1, 1), a1 + hstep, voffA);
            PG8_WAIT_L(8); PG8_BAR; PG8_WAIT_L(0); PG8_MMA(0, 0, At, B0); PG8_BAR; PG8_SCHED;
            PG8_LDB(B1, 0, 1); PG8_STAGE(PG8_SB(0, 0), b2, voffB);
            PG8_BAR; PG8_WAIT_L(0); PG8_MMA(0, 1, At, B1); PG8_BAR;
            PG8_LDA(At, 0, 1); PG8_STAGE(PG8_SA(0, 0), a2, voffA);
            PG8_BAR; PG8_WAIT_L(0); PG8_MMA(1, 0, At, B0); PG8_BAR; PG8_SCHED;
            PG8_STAGE(PG8_SB(0, 1), b2 + hstep, voffB);
            PG8_WAIT_V(6); PG8_BAR; PG8_MMA(1, 1, At, B1); PG8_BAR;
            PG8_LDB(B0, 1, 0); PG8_SCHED; PG8_LDA(At, 1, 0); PG8_STAGE(PG8_SA(0, 1), a2 + hstep, voffA);
            PG8_WAIT_L(8); PG8_BAR; PG8_WAIT_L(0); PG8_MMA(0, 0, At, B0); PG8_BAR; PG8_SCHED;
            PG8_LDB(B1, 1, 1); PG8_STAGE(PG8_SB(1, 0), b3, voffB);
            PG8_BAR; PG8_WAIT_L(0); PG8_MMA(0, 1, At, B1); PG8_BAR;
            PG8_LDA(At, 1, 1); PG8_STAGE(PG8_SA(1, 0), a3, voffA);
            PG8_BAR; PG8_WAIT_L(0); PG8_MMA(1, 0, At, B0); PG8_BAR; PG8_SCHED;
            PG8_STAGE(PG8_SB(1, 1), b3 + hstep, voffB);
            PG8_WAIT_V(6); PG8_BAR; PG8_MMA(1, 1, At, B1); PG8_BAR;
            }
        }
        if constexpr (ALIGN_EPI) { if (wr == 0) PG8_BAR; }
        if constexpr (!Epi::AFTER_DRAIN) { E(acc, cur, wr, wc, fr, fq); S.done(cur); }
        if (!has_next) break;
#pragma unroll
        for (int a = 0; a < 2; ++a)
#pragma unroll
            for (int b = 0; b < 2; ++b)
#pragma unroll
                for (int m = 0; m < 4; ++m)
#pragma unroll
                    for (int n = 0; n < 2; ++n) acc[a][b][m][n] = (f32x4){0.f, 0.f, 0.f, 0.f};
        cur = nxt; cA = nA; cB = nB; ++ui;
        if constexpr (ALIGN_EPI) { if (wr == 1) PG8_BAR; }
    }
    PG8_WAIT_V(0);
    if constexpr (!ALIGN_EPI) { if (wr == 0) PG8_BAR; }
    PG8_BAR;
    if constexpr (Epi::AFTER_DRAIN) { E.fused(acc, cur, wr, wc, fr, fq, lds, wid, lane); S.done(cur); }
#undef PG8_SA
#undef PG8_SB
#undef PG8_STAGE
#undef PG8_LDA
#undef PG8_LDB
#undef PG8_MMA
#undef PG8_WAIT_V
#undef PG8_WAIT_L
#undef PG8_BAR
#undef PG8_SCHED
}
}

struct XSched {
    int nN, nunits, G, c, skipctx;
    DEV bool next(int i, pg8::Unit& u) const {
        const int L = i * G + c; if (L >= nunits) return false;
        const int U = ((nunits & 7) == 0 && (G & 7) == 0) ? (L & 7) * (nunits >> 3) + (L >> 3) : L;
        { const int nM = nunits / nN, nig = 4 * nN, gid = U / nig, fm = gid * 4, gsz = min(nM - fm, 4), r = U - gid * nig; u.pm = fm + r % gsz; u.pn = r / gsz; }
        if (skipctx) u.pm = (u.pm >> 6) * 72 + (u.pm & 63);
        return true;
    }
    DEV void a_ready(const pg8::Unit&) const {}
    DEV void done(const pg8::Unit&) const {}
};
struct EpiStoreT {
    static constexpr bool PERM = false, AFTER_DRAIN = false, HAS_MID = false;
    bf16_t* out; int ld; int row_off;
    DEV void operator()(const f32x4 (&acc)[2][2][4][2], const pg8::Unit& u, int wr, int wc, int fr, int fq) const {
#pragma unroll
        for (int ai = 0; ai < 2; ++ai)
#pragma unroll
            for (int m = 0; m < 4; ++m) {
                bf16_t* d = out + (size_t)(row_off + u.pm * 256 + ai * 128 + wr * 64 + m * 16 + fr) * ld + u.pn * 256 + wc * 64;
#pragma unroll
                for (int bj = 0; bj < 2; ++bj) store8x2(d + bj * 32, acc[ai][bj][m][0], acc[ai][bj][m][1], fq);
            }
    }
};
struct EpiSwiglu {
    static constexpr bool PERM = false, AFTER_DRAIN = false, HAS_MID = false;
    bf16_t* act;
    DEV void operator()(const f32x4 (&acc)[2][2][4][2], const pg8::Unit& u, int wr, int wc, int fr, int fq) const {
#pragma unroll
        for (int ai = 0; ai < 2; ++ai)
#pragma unroll
            for (int m = 0; m < 4; ++m) {
                bf16_t* d = act + (size_t)(u.pm * 256 + ai * 128 + wr * 64 + m * 16 + fr) * DFF + u.pn * 128 + wc * 32;
                f32x4 r[2];
#pragma unroll
                for (int n = 0; n < 2; ++n) {
                    const f32x4 a = acc[ai][0][m][n], b = acc[ai][1][m][n];
#pragma unroll
                    for (int j = 0; j < 4; ++j) r[n][j] = a[j] * frcp(1.f + fexp2(-a[j] * LOG2E)) * b[j];
                }
                store8x2(d, r[0], r[1], fq);
            }
    }
};
struct EpiVT {
    static constexpr bool PERM = false, AFTER_DRAIN = false, HAS_MID = false;
    bf16_t* vt;
    DEV void operator()(const f32x4 (&acc)[2][2][4][2], const pg8::Unit& u, int wr, int wc, int fr, int fq) const {
#pragma unroll
        for (int bj = 0; bj < 2; ++bj)
#pragma unroll
            for (int n = 0; n < 2; ++n) {
                bf16_t* d = vt + (size_t)(u.pn * 256 + bj * 128 + wc * 32 + n * 16 + fr) * MC + u.pm * 256 + wr * 64 + fq * 8;
#pragma unroll
                for (int ai = 0; ai < 2; ++ai)
#pragma unroll
                    for (int m2 = 0; m2 < 2; ++m2) {
                        const f32x4 a = acc[ai][bj][2 * m2][n], b = acc[ai][bj][2 * m2 + 1][n];
                        u32x4 w; w.x = pk_bf16(a[0], a[1]); w.y = pk_bf16(a[2], a[3]); w.z = pk_bf16(b[0], b[1]); w.w = pk_bf16(b[2], b[3]);
                        *(u32x4*)(d + ai * 128 + m2 * 32) = w;
                    }
            }
    }
};
DEV size_t gate_index(int pm, int pn4, int wave, int r8, int lane) { return ((((size_t)pm * 16 + pn4) * 8 + wave) * 8 + r8) * 64 + lane; }
struct EpiGate {
    static constexpr bool PERM = false, AFTER_DRAIN = false, HAS_MID = false;
    u32x4* g8;
    DEV void operator()(const f32x4 (&acc)[2][2][4][2], const pg8::Unit& u, int wr, int wc, int fr, int fq) const {
        const int lane = fq * 16 + fr, wave = wr * 4 + wc;
#pragma unroll
        for (int ai = 0; ai < 2; ++ai)
#pragma unroll
            for (int m = 0; m < 4; ++m) {
                u32x4 w;
#pragma unroll
                for (int bj = 0; bj < 2; ++bj)
#pragma unroll
                    for (int n = 0; n < 2; ++n) {
                        const f32x4 a = acc[ai][bj][m][n]; unsigned x = 0;
#pragma unroll
                        for (int j = 0; j < 4; ++j) { const float s = frcp(1.f + fexp2(-a[j] * LOG2E)); x |= max(1u, (unsigned)(s * 255.f + 0.5f)) << (8 * j); }
                        w[bj * 2 + n] = x;
                    }
                g8[gate_index(u.pm, u.pn, wave, ai * 4 + m, lane)] = w;
            }
    }
};
struct EpiMerge {
    static constexpr bool PERM = false, AFTER_DRAIN = false, HAS_MID = true;
    bf16_t* out; const u32x4* g8;
    DEV void mid(f32x4 (&acc)[2][2][4][2], const pg8::Unit& u, int n, int wave, int lane) const {
#pragma unroll
        for (int ai = 0; ai < 2; ++ai)
#pragma unroll
            for (int m = 0; m < 4; ++m) {
                const u32x4 a = g8[gate_index(u.pm, (n - 1) * 4 + u.pn, wave, ai * 4 + m, lane)], b = g8[gate_index(u.pm, n * 4 + u.pn, wave, ai * 4 + m, lane)];
#pragma unroll
                for (int bj = 0; bj < 2; ++bj)
#pragma unroll
                    for (int nn = 0; nn < 2; ++nn) {
                        const unsigned x = a[bj * 2 + nn], y = b[bj * 2 + nn]; f32x4 r;
#pragma unroll
                        for (int j = 0; j < 4; ++j) r[j] = (float)((x >> (8 * j)) & 255u) * frcp((float)((y >> (8 * j)) & 255u));
                        acc[ai][bj][m][nn] = acc[ai][bj][m][nn] * r;
                    }
            }
    }
    DEV void operator()(const f32x4 (&acc)[2][2][4][2], const pg8::Unit& u, int wr, int wc, int fr, int fq) const {
        const int lane = fq * 16 + fr, wave = wr * 4 + wc;
#pragma unroll
        for (int ai = 0; ai < 2; ++ai)
#pragma unroll
            for (int m = 0; m < 4; ++m) {
                const u32x4 a = g8[gate_index(u.pm, 12 + u.pn, wave, ai * 4 + m, lane)];
                bf16_t* d = out + (size_t)(u.pm * 256 + ai * 128 + wr * 64 + m * 16 + fr) * 1024 + u.pn * 256 + wc * 64;
#pragma unroll
                for (int bj = 0; bj < 2; ++bj) {
                    f32x4 r[2];
#pragma unroll
                    for (int nn = 0; nn < 2; ++nn) {
                        const unsigned x = a[bj * 2 + nn];
#pragma unroll
                        for (int j = 0; j < 4; ++j) r[nn][j] = (float)((x >> (8 * j)) & 255u) * (1.f / 255.f);
                    }
                    store8x2(d + bj * 32, acc[ai][bj][m][0] * r[0], acc[ai][bj][m][1] * r[1], fq);
                }
            }
    }
};
struct EpiGemm1 {
    static constexpr bool PERM = false, AFTER_DRAIN = false, HAS_MID = false;
    const P* pp; int layer;
    DEV void operator()(const f32x4 (&acc)[2][2][4][2], const pg8::Unit& u, int wr, int wc, int fr, int fq) const {
        const int slab = u.pn * 256 + wc * 64; const bool lat = u.pm * 256 < LAT_C;
        if (slab >= 2752) return;
#pragma unroll
        for (int ai = 0; ai < 2; ++ai)
#pragma unroll
            for (int m = 0; m < 4; ++m) {
                f32x4 v[4] = {acc[ai][0][m][0], acc[ai][0][m][1], acc[ai][1][m][0], acc[ai][1][m][1]};
                gemm1_row(v, u.pm * 256 + ai * 128 + wr * 64 + m * 16 + fr, slab, lat, *pp, layer, fq);
            }
    }
};

#define LAS __attribute__((address_space(3)))
#define XB_TMO      128
#define XB_XCNT(j)  (256  + 64 * (j))
#define XB_XSUB(j)  (1280 + 64 * (j))
#define XB_XGEN(j)  (2304 + 64 * (j))
#define XB_TOP      3328
#define XB_TOPGEN   3392
#define XCD_BAR_WORDS 3456
#define XB_SPIN_CAP (1u << 18)

__device__ __forceinline__ unsigned xb_ld(unsigned* p)              { return __hip_atomic_load(p, __ATOMIC_RELAXED, __HIP_MEMORY_SCOPE_AGENT); }
__device__ __forceinline__ unsigned xb_add(unsigned* p, unsigned v) { return __hip_atomic_fetch_add(p, v, __ATOMIC_RELAXED, __HIP_MEMORY_SCOPE_AGENT); }
__device__ __forceinline__ unsigned xb_xcc_id() { return (unsigned)__builtin_amdgcn_s_getreg((3 << 11) | 20) & 0xFu; }
#define XB_SPIN(cond, bar) do { unsigned _sp = 0; while (cond) { __builtin_amdgcn_s_sleep(1); \
    if ((++_sp & 255u) == 0u) { if (xb_ld(&(bar)[XB_TMO])) break; if (_sp > XB_SPIN_CAP) { atomicAdd(&(bar)[XB_TMO], 1u); break; } } } } while (0)

struct XcdBarrier {
    unsigned* bar; unsigned x;
    volatile LAS unsigned* st;
};

__device__ __forceinline__ XcdBarrier xcd_barrier_post(unsigned* bar, volatile LAS unsigned* st) {
    XcdBarrier b; b.bar = bar; b.x = xb_xcc_id(); b.st = st;
    if (threadIdx.x == 0) (void)xb_add(&bar[XB_XCNT(b.x)], 1u);
    return b;
}
__device__ __forceinline__ void xcd_barrier_complete(unsigned* bar, unsigned x, unsigned& nloc, unsigned& nx) {
    const unsigned G = gridDim.x * gridDim.y * gridDim.z;
    unsigned sum, cnt, mine, sp = 0u;
    for (;;) {
        sum = 0u; cnt = 0u; mine = 0u;
#pragma unroll
        for (unsigned j = 0; j < 16; ++j) { const unsigned c = xb_ld(&bar[XB_XCNT(j)]); sum += c; cnt += (c > 0u) ? 1u : 0u; mine = (j == x) ? c : mine; }
        if (sum == G) break;
        __builtin_amdgcn_s_sleep(1);
        if ((++sp & 255u) == 0u) { if (xb_ld(&bar[XB_TMO])) break; if (sp > XB_SPIN_CAP) { atomicAdd(&bar[XB_TMO], 1u); break; } }
    }
    nloc = mine > 0u ? mine : 1u; nx = cnt > 0u ? cnt : 1u;
}

__device__ __forceinline__ void xcd_barrier(const XcdBarrier& b) {
    asm volatile("s_waitcnt vmcnt(0)" ::: "memory");
    __syncthreads();
    if (threadIdx.x == 0) {
        unsigned* bar = b.bar;
        __builtin_amdgcn_s_waitcnt(0);
        unsigned nloc = b.st[0], nx = b.st[1];
        if (nloc == 0u) { xcd_barrier_complete(bar, b.x, nloc, nx); b.st[0] = nloc; b.st[1] = nx; }
        const unsigned old = xb_add(&bar[XB_XSUB(b.x)], 1u);
        const unsigned gen = old / nloc;
        if (old + 1u == (gen + 1u) * nloc) {
            __builtin_amdgcn_fence(__ATOMIC_RELEASE, "agent");
            asm volatile("s_waitcnt vmcnt(0)" ::: "memory");
            const unsigned og = xb_add(&bar[XB_TOP], 1u);
            const unsigned tg = og / nx;
            if (og + 1u == (tg + 1u) * nx) xb_add(&bar[XB_TOPGEN], 1u);
            else XB_SPIN(xb_ld(&bar[XB_TOPGEN]) == tg, bar);
            __builtin_amdgcn_fence(__ATOMIC_ACQUIRE, "agent");
            xb_add(&bar[XB_XGEN(b.x)], 1u);
            asm volatile("s_waitcnt vmcnt(0)" ::: "memory");
        } else {
            XB_SPIN(xb_ld(&bar[XB_XGEN(b.x)]) == gen, bar);
            __builtin_amdgcn_fence(__ATOMIC_ACQUIRE, "agent");
            asm volatile("s_waitcnt vmcnt(0)" ::: "memory");
        }
    }
    __syncthreads();
}

typedef const __attribute__((address_space(4))) P* PP;
#define FRESH_P PP q_ = pp0; asm volatile("" : "+s"(q_)); const P& p = *(const P*)q_;
#define FRESH_BG int bidL = bid, GL = G; asm volatile("" : "+s"(bidL), "+s"(GL));
constexpr int DYN_LDS = 2 * SMEM_BYTES + 64;
__global__ void __launch_bounds__(512, 2) mega(P pv_) {
    cg::grid_group grid = cg::this_grid();
    PP pp0 = (PP)__builtin_amdgcn_kernarg_segment_ptr();
    extern __shared__ __attribute__((aligned(16))) unsigned char lds_dyn[];
    const int half = __builtin_amdgcn_readfirstlane((int)threadIdx.x >> 8);
    unsigned char* smraw = lds_dyn + half * SMEM_BYTES;
    bf16_t* sm = (bf16_t*)smraw;
    PG8_LAS unsigned char* ldsL = (PG8_LAS unsigned char*)lds_dyn;
    const int bid = blockIdx.x, G = gridDim.x, vb = bid * 2 + half, VG = G * 2, tid = threadIdx.x & 255;
    {
        FRESH_P
        volatile LAS unsigned* xst = (volatile LAS unsigned*)(ldsL + 2 * SMEM_BYTES);
        if (threadIdx.x == 0) { xst[0] = 0u; xst[1] = 0u; }
        __syncthreads();
        const XcdBarrier xb0 = xcd_barrier_post(p.barw, xst);
        if (threadIdx.x == 0) xst[2] = xb0.x;
        __syncthreads();
    }
#define GBAR() do { FRESH_P XcdBarrier b_; b_.bar = p.barw; b_.st = (volatile LAS unsigned*)(ldsL + 2 * SMEM_BYTES); b_.x = b_.st[2]; xcd_barrier(b_); } while (0)

    { FRESH_P
    for (int i = vb * 256 + tid; i < 64 * 16 + 64 * 8; i += VG * 256) {
        if (i < 1024) { const int pos = i >> 4, k = i & 15; const float inv = fexp2(-(float)k * (13.287712379549449f / 16.f)); const float a = (float)pos * inv; p.rt16[i] = (f32x2){__cosf(a), __sinf(a)}; }
        else { const int q = i - 1024; const int pos = q >> 3, k = q & 7; const float inv = fexp2(-(float)k * (13.287712379549449f / 8.f)); const float a = (float)pos * inv; p.rt8[q] = (f32x2){__cosf(a), __sinf(a)}; }
    }
    for (int t = vb; t < 384 + CONV_TILES; t += VG) { if (t < 384) mod_item(p, t, smraw); else conv_job(p, 0, t - 384, (float*)smraw); }
    }
    GBAR();
    { FRESH_P r_phase(p, 0, 0, vb, VG, 0, MTOT); }
    GBAR();

    for (int layer = 0; layer < DEPTH; ++layer) {
        const bool lastL = (layer == DEPTH - 1);
        for (int ch = 0; ch < NCH; ++ch) {
            { FRESH_P FRESH_BG
              const bf16_t* A = p.U + (size_t)ch * MC * 1024;
              { pg8::Gemm g{A, WL(p.WinT, layer), MC, 2816, 1024}; XSched S{11, 792, GL, bidL}; EpiGemm1 E{&p, layer};
                pg8::gemm_phase<EpiGemm1, XSched, true, true, false>(ldsL, g, S, E); }
              { pg8::Gemm g{A, WL(p.WinT, layer) + (size_t)2816 * 1024, MC, 768, 1024}; XSched S{3, 216, GL, (bidL + GL - (792 % GL)) % GL}; EpiVT E{p.VT};
                pg8::gemm_phase<EpiVT, XSched, true, true, true>(ldsL, g, S, E); }
              { pg8::Gemm g{A, WL(p.WinT, layer) + (size_t)NPROJ * 1024, MC, 4096, 1024}; XSched S{16, lastL ? 1024 : 1152, GL, (bidL + GL - (1008 % GL)) % GL}; EpiGate E{(u32x4*)p.G};
                pg8::gemm_phase<EpiGate, XSched, true, true, false>(ldsL, g, S, E); }
            }
            GBAR();
            { FRESH_P for (int t = vb; t < (lastL ? 4064 : 4448); t += VG) {
                if (t < 1024) attn_item<2>(p, layer, t, false, smraw);
                else if (t < 2048) attn_item<1>(p, layer, t - 1024, false, smraw);
                else if (t < 4064) { const int q = t - 2048; stage2_tile(p, layer, q / 14, q % 14, smraw); }
                else if (t < 4192) attn_item<1>(p, layer, t - 4064, true, smraw);
                else if (t < 4320) attn_item<2>(p, layer, t - 4192, true, smraw);
                else attn_item<3>(p, layer, t - 4320, true, smraw);
            } }
            GBAR();
            { FRESH_P for (int t = vb; t < (lastL ? 2048 : 2176); t += VG) {
                if (t < 1024) attn_item<0>(p, layer, t, false, smraw);
                else if (t < 2048) attn_item<3>(p, layer, t - 1024, false, smraw);
                else attn_item<0>(p, layer, t - 2048, true, smraw);
            } }
            GBAR();
            { FRESH_P FRESH_BG pg8::Gemm g{p.O, WL(p.WbrT, layer), MC, 1024, 2048}; XSched S{4, lastL ? 256 : 288, GL, bidL}; EpiMerge E{p.MB, (const u32x4*)p.G};
              pg8::gemm_phase<EpiMerge, XSched, true, true, false>(ldsL, g, S, E);
              if (!lastL && ch + 1 == NCH) { const int cb = G > 64 ? 32 : 0; if (bid >= cb) for (int q = bid - cb; 2 * q + 1 < CONV_TILES; q += G - cb) conv_job(p, layer + 1, 2 * q + half, (float*)smraw); } }
            GBAR();
            { FRESH_P FRESH_BG pg8::Gemm g{p.MB, WL(p.WoutT, layer), MC, 1024, 1024}; XSched S{4, lastL ? 256 : 288, GL, bidL}; EpiStoreT E{p.YC, 1024, 0};
              pg8::gemm_phase<EpiStoreT, XSched, true, true, false>(ldsL, g, S, E); }
            GBAR();
            { FRESH_P r_phase(p, 1, layer, vb, VG, ch * MC, ch * MC + (lastL ? LAT_C : MC)); }
            if (ch + 1 == NCH) GBAR();
        }
        { FRESH_P FRESH_BG pg8::Gemm g{p.U, WL(p.Wf1T, layer), MTOT, 2 * DFF, 1024}; XSched S{22, lastL ? 2816 : 3168, GL, bidL, lastL ? 1 : 0}; EpiSwiglu E{p.ACT};
          pg8::gemm_phase<EpiSwiglu, XSched, true, true, false>(ldsL, g, S, E); }
        GBAR();
        { FRESH_P FRESH_BG pg8::Gemm g{p.ACT, WL(p.Wf2T, layer), MTOT, 1024, DFF}; XSched S{4, lastL ? 512 : 576, GL, bidL, lastL ? 1 : 0}; EpiStoreT E{p.U, 1024, 0};
          pg8::gemm_phase<EpiStoreT, XSched, true, true, false>(ldsL, g, S, E); }
        GBAR();
        { FRESH_P r_phase(p, 2, layer, vb, VG, 0, MTOT, lastL); }
        GBAR();
    }
}

extern "C" void kernel_launch(void* const* d_in, const int* in_sizes, int n_in, void* d_out, int out_size, void* d_ws, size_t ws_size, hipStream_t stream) {
    static int grid_blocks = 0;
    if (!grid_blocks) {
        int dev = 0, cus = 0, per_cu = 0;
        (void)hipGetDevice(&dev);
        (void)hipDeviceGetAttribute(&cus, hipDeviceAttributeMultiprocessorCount, dev);
        if (hipFuncSetAttribute((const void*)mega, hipFuncAttributeMaxDynamicSharedMemorySize, DYN_LDS) != hipSuccess) fprintf(stderr, "hipFuncSetAttribute failed\n");
        (void)hipOccupancyMaxActiveBlocksPerMultiprocessor(&per_cu, mega, 512, DYN_LDS);
        grid_blocks = cus;
    }
    P p{};
    const float** f = (const float**)&p;
    for (int i = 0; i < 23; ++i) f[i] = (const float*)d_in[i];
    p.out = (float*)d_out;
    unsigned char* w = (unsigned char*)d_ws; size_t off = 0;
    auto take = [&](size_t bytes) { void* r = w + off; off += (bytes + 255) & ~(size_t)255; return r; };
    p.WinT = (bf16_t*)take((size_t)NWIN * 1024 * 2);
    p.WuqT = (bf16_t*)take((size_t)768 * 256 * 2);
    p.WukvT = (bf16_t*)take((size_t)1024 * 128 * 2);
    p.WbrT = (bf16_t*)take((size_t)4 * 1024 * 512 * 2);
    p.WoutT = (bf16_t*)take((size_t)1024 * 1024 * 2);
    p.Wf1T = (bf16_t*)take((size_t)2 * DFF * 1024 * 2);
    p.Wf2T = (bf16_t*)take((size_t)1024 * DFF * 2);
    p.wset = (size_t)((unsigned char*)take(0) - (unsigned char*)p.WinT) / 2;
    (void)take((size_t)p.wset * 2);
    p.mod = (float*)take((size_t)DEPTH * 17 * 6144 * 4);
    p.rt16 = (f32x2*)take(64 * 16 * 8);
    p.rt8 = (f32x2*)take(64 * 8 * 8);
    p.hc = (float*)take((size_t)NBATCH * CTX * 1024 * 4);
    p.U = (bf16_t*)take((size_t)MTOT * 1024 * 2);
    p.G = (unsigned char*)take((size_t)MC * 4096);
    p.barw = (unsigned*)take((size_t)XCD_BAR_WORDS * 4);
    unsigned char* R = (unsigned char*)take(0);
    p.PJ = (bf16_t*)take((size_t)MC * PJLD * 2);
    p.QA = (bf16_t*)take((size_t)MC * 768 * 2);
    p.KN = (bf16_t*)take((size_t)MC * 512 * 2);
    p.VT = (bf16_t*)take((size_t)VTROWS * MC * 2);
    p.O = (bf16_t*)take((size_t)MC * 2048 * 2);
    p.YC = p.O;
    p.MB = p.PJ;
    p.ACT = (bf16_t*)R;
    if (off > ws_size) { fprintf(stderr, "workspace too small: need %zu have %zu\n", off, ws_size); return; }
    (void)hipMemsetAsync(p.barw, 0, (size_t)XCD_BAR_WORDS * 4, stream);
    void* args[] = {&p};
    hipError_t e = hipLaunchCooperativeKernel((void*)mega, dim3(grid_blocks), dim3(512), args, DYN_LDS, stream);
    if (e != hipSuccess) fprintf(stderr, "cooperative launch failed: %s (grid %d)\n", hipGetErrorString(e), grid_blocks);
}
```

```cpp
#include <hip/hip_runtime.h>
#include <hip/hip_cooperative_groups.h>
#include <cstdio>
#include <cstdint>
namespace cg = cooperative_groups;

typedef unsigned short bf16_t;
typedef short bf16x8 __attribute__((ext_vector_type(8)));
typedef short bf16x4 __attribute__((ext_vector_type(4)));
typedef float f32x4 __attribute__((ext_vector_type(4)));
typedef float f32x2 __attribute__((ext_vector_type(2)));
typedef unsigned u32x2 __attribute__((ext_vector_type(2)));
typedef unsigned u32x4 __attribute__((ext_vector_type(4)));
#define DEV __device__ __forceinline__

constexpr int DM = 1024, NBATCH = 16, SEQ = 2048, CTX = 256, DEPTH = 4;
constexpr int NCH = 2, BPC = NBATCH / NCH, LAT_C = BPC * SEQ, CTX_C = BPC * CTX, MC = LAT_C + CTX_C, MTOT = MC * NCH;
constexpr int INC = 7584, NPROJ = 3584, NWIN = 7680, PJLD = 2816, DFF = 2816, VTROWS = 1280;
constexpr float LOG2E = 1.4426950408889634f;
constexpr int LST = 72;
constexpr int TILE_E = 128 * LST;
constexpr int SMEM_BYTES = 4 * TILE_E * 2 + 1024;

struct P {
    const float *x, *c, *ctx, *c_ctx, *w_mod, *b_mod, *g_pre_mix, *g_post_mix, *g_pre_ffn, *g_post_ffn, *w_in, *g_a_q, *g_a_kv,
        *w_a_uq, *w_a_ukv, *sink_b, *rpb_c, *g_d_q, *g_d_k, *w_branch, *w_out, *w_ffn_in, *w_ffn_out;
    float* out;
    bf16_t *WinT, *WuqT, *WukvT, *WbrT, *WoutT, *Wf1T, *Wf2T;
    float* mod; f32x2 *rt16, *rt8; float* hc;
    bf16_t *U, *YC, *PJ, *QA, *KN, *VT, *O, *MB, *ACT;
    unsigned char* G;
    unsigned* barw;
    size_t wset;
};

typedef __bf16 bf16v2 __attribute__((ext_vector_type(2)));
#define WL(ptr, layer) ((ptr) + (size_t)((layer) & 1) * p.wset)
DEV unsigned pk_bf16(float lo, float hi) { bf16v2 v = __builtin_convertvector((f32x2){lo, hi}, bf16v2); return __builtin_bit_cast(unsigned, v); }
DEV float bf2f(unsigned short v) { return __uint_as_float(((unsigned)v) << 16); }
DEV void store4(bf16_t* p, f32x4 v) { u32x2 w; w.x = pk_bf16(v[0], v[1]); w.y = pk_bf16(v[2], v[3]); *(u32x2*)p = w; }
DEV void store8x2(bf16_t* g0, f32x4 v0, f32x4 v1, int fq) {
    unsigned ax = pk_bf16(v0[0], v0[1]), ay = pk_bf16(v0[2], v0[3]), bx = pk_bf16(v1[0], v1[1]), by = pk_bf16(v1[2], v1[3]);
    auto rx = __builtin_amdgcn_permlane16_swap(ax, bx, false, false);
    auto ry = __builtin_amdgcn_permlane16_swap(ay, by, false, false);
    u32x4 w; w.x = rx[0]; w.y = ry[0]; w.z = rx[1]; w.w = ry[1];
    *(u32x4*)(g0 + (fq & 1) * 16 + (fq >> 1) * 8) = w;
}
DEV float fexp2(float x) { return __builtin_amdgcn_exp2f(x); }
DEV float frcp(float x) { return __builtin_amdgcn_rcpf(x); }
DEV float wave_sum(float v) {
    v += __shfl_xor(v, 1); v += __shfl_xor(v, 2); v += __shfl_xor(v, 4); v += __shfl_xor(v, 8); v += __shfl_xor(v, 16); v += __shfl_xor(v, 32); return v;
}
DEV int ltid() { int t = threadIdx.x & 255; asm volatile("" : "+v"(t)); return t; }
DEV int uni(int v) { return __builtin_amdgcn_readfirstlane(v); }
DEV float xmax16(float x) { auto r = __builtin_amdgcn_permlane16_swap(__float_as_uint(x), __float_as_uint(x), false, false); return fmaxf(__uint_as_float(r[0]), __uint_as_float(r[1])); }
DEV float xmax32(float x) { auto r = __builtin_amdgcn_permlane32_swap(__float_as_uint(x), __float_as_uint(x), false, false); return fmaxf(__uint_as_float(r[0]), __uint_as_float(r[1])); }
DEV float xadd16(float x) { auto r = __builtin_amdgcn_permlane16_swap(__float_as_uint(x), __float_as_uint(x), false, false); return __uint_as_float(r[0]) + __uint_as_float(r[1]); }
DEV float xadd32(float x) { auto r = __builtin_amdgcn_permlane32_swap(__float_as_uint(x), __float_as_uint(x), false, false); return __uint_as_float(r[0]) + __uint_as_float(r[1]); }
DEV f32x4 mfma16(bf16x8 a, bf16x8 b, f32x4 c) { return __builtin_amdgcn_mfma_f32_16x16x32_bf16(a, b, c, 0, 0, 0); }

template <int NFT, bool SWAP>
DEV void gemm_mainloop(const bf16_t* __restrict__ A, int lda, const bf16_t* __restrict__ Bt, int ldb, int K, f32x4 (&acc)[NFT][4], bf16_t* sm) {
    const int tid = ltid(), lane = tid & 63, wid = uni(tid >> 6), wm = wid & 1, wn = wid >> 1, fr = lane & 15, fq = lane >> 4;
    unsigned char* sA = (unsigned char*)sm; unsigned char* sB = sA + 2 * 16384;
    const int lrow = tid >> 3, lc8 = (tid & 7) * 8;
    const int wofs = lrow * 128 + (((tid & 7) ^ (lrow & 7)) << 4);
    const bf16_t* ga = A + (size_t)lrow * lda + lc8;
    const bf16_t* gb = Bt + (size_t)lrow * ldb + lc8;
    u32x4 ra[4], rb[NFT];
#pragma unroll
    for (int ft = 0; ft < NFT; ++ft)
#pragma unroll
        for (int tt = 0; tt < 4; ++tt) acc[ft][tt] = (f32x4){0.f, 0.f, 0.f, 0.f};
#pragma unroll
    for (int i = 0; i < 4; ++i) ra[i] = *(const u32x4*)(ga + (size_t)(i * 32) * lda);
#pragma unroll
    for (int i = 0; i < NFT; ++i) rb[i] = *(const u32x4*)(gb + (size_t)(i * 32) * ldb);
#pragma unroll
    for (int i = 0; i < 4; ++i) *(u32x4*)(sA + wofs + i * 4096) = ra[i];
#pragma unroll
    for (int i = 0; i < NFT; ++i) *(u32x4*)(sB + wofs + i * 4096) = rb[i];
    const int nk = K >> 6;
    if (nk > 1) {
#pragma unroll
        for (int i = 0; i < 4; ++i) ra[i] = *(const u32x4*)(ga + (size_t)(i * 32) * lda + 64);
#pragma unroll
        for (int i = 0; i < NFT; ++i) rb[i] = *(const u32x4*)(gb + (size_t)(i * 32) * ldb + 64);
    }
    __syncthreads();
    const int rofs0 = ((0 + fq) ^ (fr & 7)) << 4, rofs1 = ((4 + fq) ^ (fr & 7)) << 4;
    for (int kt = 0; kt < nk; ++kt) {
        const int cur = kt & 1;
        if (kt + 1 < nk) {
            const int nx = cur ^ 1;
#pragma unroll
            for (int i = 0; i < 4; ++i) *(u32x4*)(sA + nx * 16384 + wofs + i * 4096) = ra[i];
#pragma unroll
            for (int i = 0; i < NFT; ++i) *(u32x4*)(sB + nx * 16384 + wofs + i * 4096) = rb[i];
        }
        if (kt + 2 < nk) {
            const int ko = (kt + 2) * 64;
#pragma unroll
            for (int i = 0; i < 4; ++i) ra[i] = *(const u32x4*)(ga + (size_t)(i * 32) * lda + ko);
#pragma unroll
            for (int i = 0; i < NFT; ++i) rb[i] = *(const u32x4*)(gb + (size_t)(i * 32) * ldb + ko);
        }
        __builtin_amdgcn_sched_barrier(0);
        const unsigned char* cA = sA + cur * 16384 + (wm * 64 + fr) * 128;
        const unsigned char* cB = sB + cur * 16384 + (wn * NFT * 16 + fr) * 128;
#pragma unroll
        for (int ks = 0; ks < 2; ++ks) {
            const int ro = ks ? rofs1 : rofs0;
            bf16x8 af[4], wf[NFT];
#pragma unroll
            for (int tt = 0; tt < 4; ++tt) af[tt] = *(const bf16x8*)(cA + tt * 2048 + ro);
#pragma unroll
            for (int ft = 0; ft < NFT; ++ft) wf[ft] = *(const bf16x8*)(cB + ft * 2048 + ro);
#pragma unroll
            for (int ft = 0; ft < NFT; ++ft)
#pragma unroll
                for (int tt = 0; tt < 4; ++tt) acc[ft][tt] = SWAP ? mfma16(af[tt], wf[ft], acc[ft][tt]) : mfma16(wf[ft], af[tt], acc[ft][tt]);
        }
        __syncthreads();
    }
}

DEV bool tile_xcd(int q, int x, int nM, int nN, int& m, int& n) {
    const int j = q >> 5, w = q & 31;
    const int pp = (((j >> 1) * 8 + x) << 1) + (j & 1);
    const int npn = nN >> 2;
    if (pp >= (nM >> 3) * npn) return false;
    const int pm = pp / npn, pn = pp - pm * npn;
    m = pm * 8 + (w & 7); n = pn * 4 + (w >> 3);
    return true;
}
#define TILE_LOOP(nM, nN) const int x_ = bid & 7, spx_ = G >> 3; int mt, nt; for (int q_ = bid >> 3; tile_xcd(q_, x_, nM, nN, mt, nt); q_ += spx_)

DEV int srccol(int mapid, int n) {
    switch (mapid) {
    case 0:
        if (n < 2816 || n >= 3584) { const int rho = n & 255; n = (n & ~255) + ((rho >> 5) & 3) * 64 + (rho >> 7) * 32 + (rho & 31); }
        if (n < 384) return n;
        if (n < 896) return n - 384 + 416;
        if (n < 1024) return n - 896 + 928;
        if (n < 1536) return n - 1024 + 1184;
        if (n < 2048) return n - 1536 + 1696;
        if (n < 2560) return n - 2048 + 2720;
        if (n < 2688) return n - 2560 + 3232;
        if (n < 2720) return n - 2688 + 384;
        if (n < 2816) return -1;
        if (n < 2944) return n - 2816 + 1056;
        if (n < 3456) return n - 2944 + 2208;
        if (n < 3584) return n - 3456 + 3360;
        return n - 3584 + 3488;
    case 1: if (n < 512) return (n >> 6) * 96 + (n & 63); { const int q = n - 512; return (q >> 5) * 96 + 64 + (q & 31); }
    case 2: if (n < 512) return (n >> 6) * 128 + (n & 63); { const int q = n - 512; return (q >> 6) * 128 + 64 + (q & 63); }
    case 4: { const int pn = n >> 8, s = (n >> 7) & 1, wc = (n >> 5) & 3, nn = (n >> 4) & 1, f = n & 15; return s * DFF + pn * 128 + wc * 32 + nn * 16 + f; }
    case 5: { const int rho = n & 255; return (n & ~255) + ((rho >> 5) & 3) * 64 + (rho >> 7) * 32 + (rho & 31); }
    default: return n;
    }
}
DEV void conv_tile(const float* __restrict__ src, int lds_, int K, bf16_t* __restrict__ dst, int n0, int k0, int mapid, const float* rowscale, float* st) {
    const int tid = ltid();
    {
        const int n = tid & 63, kk = tid >> 6; const int sc_ = srccol(mapid, n0 + n);
#pragma unroll
        for (int i = 0; i < 16; ++i) {
            const int k = kk * 16 + i;
            float v = sc_ >= 0 ? src[(size_t)(k0 + k) * lds_ + sc_] : 0.f;
            if (rowscale) v *= rowscale[k0 + k];
            st[k * 65 + n] = v;
        }
    }
    __syncthreads();
    {
        const int n = tid >> 2, kq = tid & 3; u32x4 w0, w1;
        const float* s = st + (kq * 16) * 65 + n;
        w0.x = pk_bf16(s[0 * 65], s[1 * 65]); w0.y = pk_bf16(s[2 * 65], s[3 * 65]); w0.z = pk_bf16(s[4 * 65], s[5 * 65]); w0.w = pk_bf16(s[6 * 65], s[7 * 65]);
        w1.x = pk_bf16(s[8 * 65], s[9 * 65]); w1.y = pk_bf16(s[10 * 65], s[11 * 65]); w1.z = pk_bf16(s[12 * 65], s[13 * 65]); w1.w = pk_bf16(s[14 * 65], s[15 * 65]);
        bf16_t* d = dst + (size_t)(n0 + n) * K + k0 + kq * 16;
        *(u32x4*)d = w0; *(u32x4*)(d + 8) = w1;
    }
    __syncthreads();
}
constexpr int CONV_TILES = 4880;
DEV void conv_job(const P& p, int layer, int t, float* st) {
    if (t < 1920) { conv_tile(p.w_in + (size_t)layer * DM * INC, INC, 1024, WL(p.WinT, layer), (t >> 4) * 64, (t & 15) * 64, 0, nullptr, st); return; }
    t -= 1920;
    if (t < 48) { conv_tile(p.w_a_uq + (size_t)layer * 256 * 768, 768, 256, WL(p.WuqT, layer), (t >> 2) * 64, (t & 3) * 64, 1, p.g_a_q + layer * 256, st); return; }
    t -= 48;
    if (t < 32) { conv_tile(p.w_a_ukv + (size_t)layer * 128 * 1024, 1024, 128, WL(p.WukvT, layer), (t >> 1) * 64, (t & 1) * 64, 2, p.g_a_kv + layer * 128, st); return; }
    t -= 32;
    if (t < 512) { conv_tile(p.w_branch + (size_t)layer * 4 * 512 * 1024, 1024, 2048, WL(p.WbrT, layer), (t >> 5) * 64, (t & 31) * 64, 5, nullptr, st); return; }
    t -= 512;
    if (t < 256) { conv_tile(p.w_out + (size_t)layer * 1024 * 1024, 1024, 1024, WL(p.WoutT, layer), (t >> 4) * 64, (t & 15) * 64, 5, nullptr, st); return; }
    t -= 256;
    if (t < 1408) { conv_tile(p.w_ffn_in + (size_t)layer * 1024 * 2 * DFF, 2 * DFF, 1024, WL(p.Wf1T, layer), (t >> 4) * 64, (t & 15) * 64, 4, nullptr, st); return; }
    t -= 1408;
    { const int nt = t / 44, kt = t - nt * 44; conv_tile(p.w_ffn_out + (size_t)layer * DFF * 1024, 1024, DFF, WL(p.Wf2T, layer), nt * 64, kt * 64, 5, nullptr, st); }
}

DEV void mod_item(const P& p, int item, unsigned char* smraw) {
    const int tid = ltid(), lane = tid & 63, wid = uni(tid >> 6);
    float* sc = (float*)smraw;
    const int l = item / 96, cgp = item - l * 96;
    for (int i = tid; i < 17 * 1024; i += 256) {
        const int r = i >> 10, k = i & 1023; const float v = r < 16 ? p.c[r * 1024 + k] : p.c_ctx[k];
        sc[i] = v * frcp(1.f + fexp2(-v * LOG2E));
    }
    __syncthreads();
    float acc[17];
#pragma unroll
    for (int r = 0; r < 17; ++r) acc[r] = 0.f;
    const float* w = p.w_mod + ((size_t)l * 1024 + wid * 256) * 6144 + cgp * 64 + lane;
    for (int k = 0; k < 256; k += 4) {
        const float w0 = w[(size_t)k * 6144], w1 = w[(size_t)(k + 1) * 6144], w2 = w[(size_t)(k + 2) * 6144], w3 = w[(size_t)(k + 3) * 6144];
#pragma unroll
        for (int r = 0; r < 17; ++r) { const f32x4 s = *(const f32x4*)(sc + r * 1024 + wid * 256 + k); acc[r] += s[0] * w0 + s[1] * w1 + s[2] * w2 + s[3] * w3; }
    }
    __syncthreads();
    float* red = (float*)smraw;
#pragma unroll
    for (int r = 0; r < 17; ++r) red[(wid * 17 + r) * 64 + lane] = acc[r];
    __syncthreads();
    for (int i = tid; i < 17 * 64; i += 256) {
        const int r = i >> 6, ci = i & 63;
        const float v = red[(0 * 17 + r) * 64 + ci] + red[(1 * 17 + r) * 64 + ci] + red[(2 * 17 + r) * 64 + ci] + red[(3 * 17 + r) * 64 + ci] + p.b_mod[l * 6144 + cgp * 64 + ci];
        p.mod[((size_t)l * 17 + r) * 6144 + cgp * 64 + ci] = v;
    }
    __syncthreads();
}

DEV void r_phase(const P& p, int mode, int layer, int vb, int VG, int g_lo, int g_hi, bool skipctx = false) {
    const int tid_ = ltid(), lane = tid_ & 63, wid = uni(tid_ >> 6);
    const int nw = VG * 4;
    for (int g = g_lo + vb * 4 + wid; g < g_hi; g += nw) {
        const int ch = g / MC, local = g - ch * MC;
        if (skipctx && local >= LAT_C) continue;
        const float* hin; float* hout; const float* mod;
        if (local < LAT_C) {
            const int idx = ch * LAT_C + local; const int b = idx >> 11;
            hin = (mode == 0 ? p.x : p.out) + (size_t)idx * 1024; hout = p.out + (size_t)idx * 1024; mod = p.mod + ((size_t)layer * 17 + b) * 6144;
        } else {
            const int idx = ch * CTX_C + local - LAT_C;
            hin = (mode == 0 ? p.ctx : p.hc) + (size_t)idx * 1024; hout = p.hc + (size_t)idx * 1024; mod = p.mod + ((size_t)layer * 17 + 16) * 6144;
        }
        f32x4 h[4];
#pragma unroll
        for (int i = 0; i < 2; ++i)
#pragma unroll
            for (int k = 0; k < 2; ++k) h[2 * i + k] = *(const f32x4*)(hin + i * 512 + lane * 8 + 4 * k);
        if (mode != 0) {
            f32x4 y[4]; float ss = 0.f;
            const bf16_t* yp = (mode == 1 ? p.YC + (size_t)local * 1024 : p.U + (size_t)g * 1024);
#pragma unroll
            for (int i = 0; i < 2; ++i) {
                const u32x4 w = *(const u32x4*)(yp + i * 512 + lane * 8);
                y[2 * i] = (f32x4){__uint_as_float(w.x << 16), __uint_as_float(w.x & 0xffff0000u), __uint_as_float(w.y << 16), __uint_as_float(w.y & 0xffff0000u)};
                y[2 * i + 1] = (f32x4){__uint_as_float(w.z << 16), __uint_as_float(w.z & 0xffff0000u), __uint_as_float(w.w << 16), __uint_as_float(w.w & 0xffff0000u)};
            }
#pragma unroll
            for (int i = 0; i < 4; ++i) ss += y[i][0] * y[i][0] + y[i][1] * y[i][1] + y[i][2] * y[i][2] + y[i][3] * y[i][3];
            ss = wave_sum(ss);
            const float rs = rsqrtf(ss * (1.f / 1024.f) + 1e-6f);
            const float* gp = (mode == 1 ? p.g_post_mix : p.g_post_ffn) + layer * 1024;
            const float* ga = mod + (mode == 1 ? 2048 : 5120);
#pragma unroll
            for (int i = 0; i < 2; ++i)
#pragma unroll
                for (int k = 0; k < 2; ++k) {
                    const int e = i * 512 + lane * 8 + 4 * k;
                    const f32x4 gg = *(const f32x4*)(gp + e), aa = *(const f32x4*)(ga + e);
                    h[2 * i + k] = h[2 * i + k] + aa * (y[2 * i + k] * rs * gg);
                }
        }
#pragma unroll
        for (int i = 0; i < 2; ++i)
#pragma unroll
            for (int k = 0; k < 2; ++k) *(f32x4*)(hout + i * 512 + lane * 8 + 4 * k) = h[2 * i + k];
        const int nl = (mode == 2) ? layer + 1 : layer;
        if (nl < DEPTH) {
            float ss = 0.f;
#pragma unroll
            for (int i = 0; i < 4; ++i) ss += h[i][0] * h[i][0] + h[i][1] * h[i][1] + h[i][2] * h[i][2] + h[i][3] * h[i][3];
            ss = wave_sum(ss);
            const float rs = rsqrtf(ss * (1.f / 1024.f) + 1e-6f);
            const float* gpre = (mode == 1 ? p.g_pre_ffn : p.g_pre_mix) + nl * 1024;
            const float* modn = (mode == 2) ? mod + 17 * 6144 : mod;
            const float* sh = modn + (mode == 1 ? 3072 : 0);
            const float* sc = modn + (mode == 1 ? 4096 : 1024);
#pragma unroll
            for (int i = 0; i < 2; ++i) {
                f32x4 u[2];
#pragma unroll
                for (int k = 0; k < 2; ++k) {
                    const int e = i * 512 + lane * 8 + 4 * k;
                    const f32x4 gg = *(const f32x4*)(gpre + e), s1 = *(const f32x4*)(sc + e), s0 = *(const f32x4*)(sh + e);
                    u[k] = h[2 * i + k] * rs * gg * (s1 + 1.f) + s0;
                }
                u32x4 w; w.x = pk_bf16(u[0][0], u[0][1]); w.y = pk_bf16(u[0][2], u[0][3]); w.z = pk_bf16(u[1][0], u[1][1]); w.w = pk_bf16(u[1][2], u[1][3]);
                *(u32x4*)(p.U + (size_t)g * 1024 + i * 512 + lane * 8) = w;
            }
        }
    }
}

DEV void gemm1_row(f32x4 (&v)[4], int row, int slab, bool lat, const P& p, int layer, int fq) {
    const bool hnorm = (slab >= 2048 && slab < 2688);
    const bool rope64 = lat && ((slab >= 384 && slab < 1024) || hnorm);
    const bool isq = (slab >= 384 && slab < 896) || (slab >= 1024 && slab < 1536) || (slab >= 2048 && slab < 2560);
    const float sc = isq ? 0.125f * LOG2E : 1.f;
    const bool kr = (slab == 2688);
    const int tok = row & 2047; const int pr = tok >> 6, pc = tok & 63;
    if (hnorm) {
        float ss = 0.f;
#pragma unroll
        for (int ft = 0; ft < 4; ++ft) ss += v[ft][0] * v[ft][0] + v[ft][1] * v[ft][1] + v[ft][2] * v[ft][2] + v[ft][3] * v[ft][3];
        ss += __shfl_xor(ss, 16); ss += __shfl_xor(ss, 32);
        const float rs = rsqrtf(ss * (1.f / 64.f) + 1e-6f);
        const float* g = (slab < 2560 ? p.g_d_q : p.g_d_k) + layer * 64;
#pragma unroll
        for (int ft = 0; ft < 4; ++ft) { const f32x4 gg = *(const f32x4*)(g + ft * 16 + fq * 4); v[ft] = v[ft] * rs * gg; }
    }
    if (rope64) {
#pragma unroll
        for (int j = 0; j < 4; ++j) {
            const int i = fq * 4 + j;
            f32x2 cs = p.rt16[pr * 16 + i]; float a = v[0][j], b = v[1][j];
            v[0][j] = a * cs[0] - b * cs[1]; v[1][j] = b * cs[0] + a * cs[1];
            cs = p.rt16[pc * 16 + i]; a = v[2][j]; b = v[3][j];
            v[2][j] = a * cs[0] - b * cs[1]; v[3][j] = b * cs[0] + a * cs[1];
        }
    }
    if (kr && lat) {
#pragma unroll
        for (int ft = 0; ft < 2; ++ft) {
            const int pos = ft == 0 ? pr : pc;
#pragma unroll
            for (int j = 0; j < 4; ++j) {
                const int i = (fq & 1) * 4 + j; const f32x2 cs = p.rt8[pos * 8 + i];
                const float xv = v[ft][j]; const float o = __shfl_xor(xv, 32);
                v[ft][j] = fq < 2 ? xv * cs[0] - o * cs[1] : xv * cs[0] + o * cs[1];
            }
        }
    }
    bf16_t* dst = p.PJ + (size_t)row * PJLD + slab;
    store8x2(dst, v[0] * sc, v[1] * sc, fq);
    if (!kr) store8x2(dst + 32, v[2] * sc, v[3] * sc, fq);
}
DEV void stage2_tile(const P& p, int layer, int mt, int j, unsigned char* smraw) {
    bf16_t* sm = (bf16_t*)smraw; float* s_rs = (float*)(smraw + 73728);
    const int tid = ltid(), lane = tid & 63, wid = uni(tid >> 6), wm = wid & 1, wn = wid >> 1, fr = lane & 15, fq = lane >> 4;
    const int m0 = mt * 128; const bool isq = j < 6; const bool lat = m0 < LAT_C;
    const int K = isq ? 256 : 128; const int acol = isq ? 0 : 256;
    {
        const int r = tid >> 1, hf = tid & 1; const int n = K >> 1;
        const bf16_t* src = p.PJ + (size_t)(m0 + r) * PJLD + acol + hf * n; float ss = 0.f;
        for (int i = 0; i < n; i += 8) {
            const u32x4 w = *(const u32x4*)(src + i);
#pragma unroll
            for (int q = 0; q < 4; ++q) { const float a = __uint_as_float(w[q] << 16), b = __uint_as_float(w[q] & 0xffff0000u); ss += a * a + b * b; }
        }
        ss += __shfl_xor(ss, 1);
        if (hf == 0) s_rs[r] = rsqrtf(ss / (float)K + 1e-6f);
    }
    __syncthreads();
    f32x4 acc[4][4];
    const bf16_t* A = p.PJ + (size_t)m0 * PJLD + acol;
    if (isq) {
        const int n0 = j * 128;
        gemm_mainloop<4, false>(A, PJLD, WL(p.WuqT, layer) + (size_t)n0 * 256, 256, 256, acc, sm);
        const int slab = n0 + wn * 64; const float qs = 0.10206207261596577f * LOG2E;
#pragma unroll
        for (int tt = 0; tt < 4; ++tt) {
            const int lr = wm * 64 + tt * 16 + fr; const int row = m0 + lr; const float rs = s_rs[lr] * qs;
            const int tok = row & 2047; const int pr = tok >> 6, pc = tok & 63;
            f32x4 v[4] = {acc[0][tt], acc[1][tt], acc[2][tt], acc[3][tt]};
            if (slab >= 512 && lat) {
#pragma unroll
                for (int ft = 0; ft < 4; ++ft) {
                    const int pos = (ft & 1) == 0 ? pr : pc;
#pragma unroll
                    for (int jj = 0; jj < 4; ++jj) {
                        const int i = (fq & 1) * 4 + jj; const f32x2 cs = p.rt8[pos * 8 + i];
                        const float xv = v[ft][jj]; const float o = __shfl_xor(xv, 32);
                        v[ft][jj] = fq < 2 ? xv * cs[0] - o * cs[1] : xv * cs[0] + o * cs[1];
                    }
                }
            }
            bf16_t* dst = p.QA + (size_t)row * 768 + slab;
            store8x2(dst, v[0] * rs, v[1] * rs, fq); store8x2(dst + 32, v[2] * rs, v[3] * rs, fq);
        }
    } else {
        const int n0 = (j - 6) * 128;
        if (n0 < 512) {
            gemm_mainloop<4, false>(A, PJLD, WL(p.WukvT, layer) + (size_t)n0 * 128, 128, 128, acc, sm);
#pragma unroll
            for (int tt = 0; tt < 4; ++tt) {
                const int lr = wm * 64 + tt * 16 + fr; const float rs = s_rs[lr];
                bf16_t* dst = p.KN + (size_t)(m0 + lr) * 512 + n0 + wn * 64;
                store8x2(dst, acc[0][tt] * rs, acc[1][tt] * rs, fq); store8x2(dst + 32, acc[2][tt] * rs, acc[3][tt] * rs, fq);
            }
        } else {
            gemm_mainloop<4, true>(A, PJLD, WL(p.WukvT, layer) + (size_t)n0 * 128, 128, 128, acc, sm);
            const int vrow0 = 768 + (n0 - 512) + wn * 64;
#pragma unroll
            for (int t2 = 0; t2 < 2; ++t2) {
                const int lr = wm * 64 + t2 * 32 + fq * 4;
                const f32x4 rs0 = *(const f32x4*)(s_rs + lr), rs1 = *(const f32x4*)(s_rs + lr + 16);
                const int lp = wm * 64 + t2 * 32 + fq * 8;
#pragma unroll
                for (int ft = 0; ft < 4; ++ft) {
                    const f32x4 a = acc[ft][2 * t2] * rs0, b = acc[ft][2 * t2 + 1] * rs1;
                    u32x4 w; w.x = pk_bf16(a[0], a[1]); w.y = pk_bf16(a[2], a[3]); w.z = pk_bf16(b[0], b[1]); w.w = pk_bf16(b[2], b[3]);
                    *(u32x4*)(p.VT + (size_t)(vrow0 + ft * 16 + fr) * MC + m0 + lp) = w;
                }
            }
        }
    }
    __syncthreads();
}

template <int MODE>
DEV void attn_item(const P& p, int layer, int item, bool ctxq, unsigned char* smraw) {
    constexpr bool GQA = (MODE == 1 || MODE == 3);
    constexpr int DQK = (MODE == 0) ? 96 : 64, NKS = DQK / 32;
    constexpr int KRB = (MODE == 0) ? 256 : 128, KM = (MODE == 0) ? 15 : 7;
    constexpr int KT_B = 64 * KRB, VT_B = 64 * 128;
    unsigned char* Ks = smraw; unsigned char* Vs = smraw + 32768; float* bias_s = (float*)(smraw + 49152);
    const int tid = ltid(), lane = tid & 63, wid = uni(tid >> 6), fr = lane & 15, fq = lane >> 4;
    const int nqt = ctxq ? (GQA ? 8 : 2) : (GQA ? 64 : 16);
    const int nh = GQA ? 2 : 8;
    const int qt = item % nqt, hh = (item / nqt) % nh, lb = item / (nqt * nh);
    const int head = GQA ? hh * 4 + wid : hh;
    const int tok0 = GQA ? qt * 32 : qt * 128 + wid * 32;
    const int qrow0 = (ctxq ? LAT_C + lb * CTX : lb * SEQ) + tok0;
    bf16x8 qf[2][NKS];
#pragma unroll
    for (int q = 0; q < 2; ++q) {
        const int row = qrow0 + q * 16 + fr;
        if (MODE == 0) {
            qf[q][0] = *(const bf16x8*)(p.QA + (size_t)row * 768 + head * 64 + fq * 8);
            qf[q][1] = *(const bf16x8*)(p.QA + (size_t)row * 768 + head * 64 + 32 + fq * 8);
            qf[q][NKS - 1] = *(const bf16x8*)(p.QA + (size_t)row * 768 + 512 + head * 32 + fq * 8);
        } else {
            const int qoff = MODE == 1 ? 384 : (MODE == 2 ? 1024 : 2048);
#pragma unroll
            for (int ks = 0; ks < NKS; ++ks) qf[q][ks] = *(const bf16x8*)(p.PJ + (size_t)row * PJLD + qoff + head * 64 + ks * 32 + fq * 8);
        }
    }
    const int koff = MODE == 1 ? 896 + hh * 64 : (MODE == 2 ? 1536 + hh * 64 : 2560 + hh * 64);
    const int vrow0 = MODE == 0 ? 768 + hh * 64 : (MODE == 1 ? hh * 64 : (MODE == 2 ? 128 + hh * 64 : 640 + hh * 64));
    int ktlo = 0, nlat = 0;
    if (!ctxq) {
        if (MODE == 0 || MODE == 3) { ktlo = 0; nlat = 32; }
        else if (MODE == 1) { const int q0 = qt * 32; const int lo = max(0, q0 - 128), hi = min(SEQ - 1, q0 + 159); ktlo = lo >> 6; nlat = (hi >> 6) - ktlo + 1; }
        else { const int r0a = min(max(2 * qt - 4, 0), 24), r0b = min(max(2 * qt + 1 - 4, 0), 24); ktlo = r0a; nlat = r0b + 8 - r0a; }
    }
    const int nt = 4 + nlat;
    const int ntf = ctxq ? 4 : ((MODE == 0 || MODE == 3) ? 36 : (MODE == 1 ? 9 : 13));
    if (MODE == 2 && !ctxq) { for (int i = tid; i < 465; i += 256) bias_s[i] = p.rpb_c[(layer * 8 + hh) * 465 + i] * LOG2E; }

    u32x4 rk[NKS], rv[2];
    auto tile_krow = [&](int it) { it = min(it, nt - 1); return it < 4 ? LAT_C + lb * CTX + it * 64 : lb * SEQ + (ktlo + it - 4) * 64; };
    auto gload = [&](int it) {
        const int krow = tile_krow(it);
#pragma unroll
        for (int i = 0; i < NKS; ++i) {
            const int id = tid + i * 256;
            if (MODE == 0) {
                const int key = id / 12, c = id - key * 12;
                const bf16_t* src = c < 8 ? p.KN + (size_t)(krow + key) * 512 + hh * 64 + c * 8 : p.PJ + (size_t)(krow + key) * PJLD + 2688 + (c - 8) * 8;
                rk[i] = *(const u32x4*)src;
            } else {
                const int key = id >> 3, c = id & 7;
                rk[i] = *(const u32x4*)(p.PJ + (size_t)(krow + key) * PJLD + koff + c * 8);
            }
        }
#pragma unroll
        for (int i = 0; i < 2; ++i) { const int id = tid + i * 256; const int dv = id >> 3, c = id & 7; rv[i] = *(const u32x4*)(p.VT + (size_t)(vrow0 + dv) * MC + krow + c * 8); }
    };
    auto lstore = [&](int buf) {
#pragma unroll
        for (int i = 0; i < NKS; ++i) {
            const int id = tid + i * 256; int key, c;
            if (MODE == 0) { key = id / 12; c = id - key * 12; } else { key = id >> 3; c = id & 7; }
            *(u32x4*)(Ks + buf * KT_B + key * KRB + ((c ^ (key & KM)) << 4)) = rk[i];
        }
#pragma unroll
        for (int i = 0; i < 2; ++i) { const int id = tid + i * 256; const int dv = id >> 3, c = id & 7; *(u32x4*)(Vs + buf * VT_B + dv * 128 + ((c ^ (dv & 7)) << 4)) = rv[i]; }
    };

    f32x4 o[4][2], lo[2], negm4[2]; float mref[2];
    const bf16x8 ones8 = __builtin_bit_cast(bf16x8, (u32x4){0x3F803F80u, 0x3F803F80u, 0x3F803F80u, 0x3F803F80u});
#pragma unroll
    for (int q = 0; q < 2; ++q) { mref[q] = 0.f; lo[q] = (f32x4){0.f, 0.f, 0.f, 0.f}; negm4[q] = (f32x4){0.f, 0.f, 0.f, 0.f};
#pragma unroll
        for (int d = 0; d < 4; ++d) o[d][q] = (f32x4){0.f, 0.f, 0.f, 0.f}; }

    gload(0); lstore(0); gload(1); __syncthreads();
    for (int it = 0; it < ntf; ++it) {
        const int cur = it & 1;
        if (it + 1 < ntf) lstore(cur ^ 1);
        if (it + 2 < ntf) gload(it + 2);
        __builtin_amdgcn_sched_barrier(0);
        const int kt = ktlo + it - 4;
        bool active = it < nt;
        int r = 0, r0 = 0;
        if (MODE == 2 && !ctxq && it >= 4) { r = 2 * qt + (wid >> 1); r0 = min(max(r - 4, 0), 24); active = active && (kt >= r0 && kt < r0 + 8); }
        if (active) {
            f32x4 s[4][2];
            const unsigned char* kb = Ks + cur * KT_B + fr * KRB;
            bf16x8 kf[4][NKS];
#pragma unroll
            for (int k4 = 0; k4 < 4; ++k4)
#pragma unroll
                for (int ks = 0; ks < NKS; ++ks) kf[k4][ks] = *(const bf16x8*)(kb + k4 * 16 * KRB + (((ks * 4 + fq) ^ (fr & KM)) << 4));
            __builtin_amdgcn_sched_barrier(0);
            __builtin_amdgcn_s_setprio(1);
#pragma unroll
            for (int k4 = 0; k4 < 4; ++k4) {
#pragma unroll
                for (int q = 0; q < 2; ++q) s[k4][q] = mfma16(kf[k4][0], qf[q][0], negm4[q]);
#pragma unroll
                for (int ks = 1; ks < NKS; ++ks)
#pragma unroll
                    for (int q = 0; q < 2; ++q) s[k4][q] = mfma16(kf[k4][ks], qf[q][ks], s[k4][q]);
            }
            __builtin_amdgcn_s_setprio(0);
            const unsigned char* vb = Vs + cur * VT_B + fr * 128;
            bf16x8 vf[4][2];
#pragma unroll
            for (int d = 0; d < 4; ++d)
#pragma unroll
                for (int kb2 = 0; kb2 < 2; ++kb2) vf[d][kb2] = *(const bf16x8*)(vb + d * 16 * 128 + (((kb2 * 4 + fq) ^ (fr & 7)) << 4));
            __builtin_amdgcn_sched_barrier(0);
            if (!ctxq && it >= 4) {
                if (MODE == 1) {
#pragma unroll
                    for (int q = 0; q < 2; ++q) {
                        const int qpos = tok0 + q * 16 + fr;
#pragma unroll
                        for (int k4 = 0; k4 < 4; ++k4)
#pragma unroll
                            for (int j = 0; j < 4; ++j) { const int d = qpos - (kt * 64 + k4 * 16 + fq * 4 + j); if (d > 128 || d < -128) s[k4][q][j] = -1e30f; }
                    }
                }
                if (MODE == 2) {
#pragma unroll
                    for (int q = 0; q < 2; ++q) {
                        const int qc = (wid & 1) * 32 + q * 16 + fr; const int c0 = min(max(qc - 8, 0), 48);
                        const int bbase = (kt - r + 7) * 31 + 15 - qc;
#pragma unroll
                        for (int k4 = 0; k4 < 4; ++k4)
#pragma unroll
                            for (int j = 0; j < 4; ++j) {
                                const int kc = k4 * 16 + fq * 4 + j; const bool ok = (kc >= c0 && kc < c0 + 16);
                                const float bv = bias_s[ok ? bbase + kc : 0];
                                s[k4][q][j] = ok ? s[k4][q][j] + bv : -1e30f;
                            }
                    }
                }
            }
            bf16x8 pf[2][2];
#pragma unroll
            for (int q = 0; q < 2; ++q) {
                float mx = -1e30f;
#pragma unroll
                for (int k4 = 0; k4 < 4; ++k4) mx = fmaxf(mx, fmaxf(fmaxf(s[k4][q][0], s[k4][q][1]), fmaxf(s[k4][q][2], s[k4][q][3])));
                mx = xmax32(xmax16(mx));
                const bool need = (it == 0) || (mx > 8.f);
                if (__builtin_amdgcn_ballot_w64(need) != 0ull) {
                    const float delta = need ? mx : 0.f;
                    mref[q] += delta; negm4[q] = negm4[q] - delta;
#pragma unroll
                    for (int k4 = 0; k4 < 4; ++k4) s[k4][q] = s[k4][q] - delta;
                    const float alpha = fexp2(-delta);
                    lo[q] = lo[q] * alpha;
#pragma unroll
                    for (int d = 0; d < 4; ++d) o[d][q] = o[d][q] * alpha;
                }
#pragma unroll
                for (int k4 = 0; k4 < 4; ++k4)
#pragma unroll
                    for (int j = 0; j < 4; ++j) s[k4][q][j] = fexp2(s[k4][q][j]);
#pragma unroll
                for (int kb2 = 0; kb2 < 2; ++kb2) {
                    u32x4 w; w.x = pk_bf16(s[2 * kb2][q][0], s[2 * kb2][q][1]); w.y = pk_bf16(s[2 * kb2][q][2], s[2 * kb2][q][3]);
                    w.z = pk_bf16(s[2 * kb2 + 1][q][0], s[2 * kb2 + 1][q][1]); w.w = pk_bf16(s[2 * kb2 + 1][q][2], s[2 * kb2 + 1][q][3]);
                    pf[q][kb2] = __builtin_bit_cast(bf16x8, w);
                }
            }
            __builtin_amdgcn_s_setprio(1);
#pragma unroll
            for (int d = 0; d < 4; ++d)
#pragma unroll
                for (int kb2 = 0; kb2 < 2; ++kb2)
#pragma unroll
                    for (int q = 0; q < 2; ++q) o[d][q] = mfma16(vf[d][kb2], pf[q][kb2], o[d][q]);
#pragma unroll
            for (int kb2 = 0; kb2 < 2; ++kb2)
#pragma unroll
                for (int q = 0; q < 2; ++q) lo[q] = mfma16(ones8, pf[q][kb2], lo[q]);
            __builtin_amdgcn_s_setprio(0);
        }
        __syncthreads();
    }
#pragma unroll
    for (int q = 0; q < 2; ++q) {
        float l = lo[q][0];
        if (MODE == 1) l += fexp2(p.sink_b[layer * 8 + head] * LOG2E - mref[q]);
        const float inv = 1.f / l;
        bf16_t* dst = p.O + (size_t)(qrow0 + q * 16 + fr) * 2048 + MODE * 512 + head * 64;
        store8x2(dst, o[0][q] * inv, o[1][q] * inv, fq); store8x2(dst + 32, o[2][q] * inv, o[3][q] * inv, fq);
    }
}


namespace pg8 {
#define PG8_LAS __attribute__((address_space(3)))
constexpr int BM = 256, BK = 64, HALF = 128, HTB = HALF * BK * 2  , STAGE_BYTES = 8 * HTB, NXCD = 8, WGM = 8;

__host__ __device__ __forceinline__ int lds_byte(int r, int c) { const int st = (r >> 4) * 2 + (c >> 5), rr = r & 15, cc = c & 31, ob = rr * 64 + cc * 2; return st * 1024 + (ob ^ (((ob >> 9) & 1) << 5)); }
__host__ __device__ __forceinline__ void stage_rc(int b, int& R, int& C) { const int st = b / 1024, sb = b % 1024, swz = sb ^ (((sb >> 9) & 1) << 5); R = (st >> 1) * 16 + swz / 64; C = (st & 1) * 32 + (swz % 64) / 2; }
__host__ __device__ __forceinline__ int perm32(int rho) { const int n = rho >> 4, i = rho & 15; return 8 * (i >> 2) + 4 * n + (i & 3); }

struct Unit { int pm, pn; };
struct Gemm { const bf16_t* A; const bf16_t* Bt; int M, N, K; };

template <class Epi, class Sched, bool ALIGN_EPI = false, bool SP2 = false, bool SWAPMMA = false>
__device__ __forceinline__ void gemm_phase(PG8_LAS unsigned char* lds, const Gemm g, const Sched& S, const Epi& E) {
    int tid = threadIdx.x; asm volatile("" : "+v"(tid));
    const int wid = __builtin_amdgcn_readfirstlane(tid >> 6), lane = tid & 63, wr = wid >> 2, wc = wid & 3, fr = lane & 15, fq = lane >> 4;
    const int K = g.K, nt = K / BK;
    unsigned voffA[2], voffB[2];
#pragma unroll
    for (int i = 0; i < 2; ++i) { int R, C; stage_rc(tid * 16 + i * 8192, R, C); const int Rb = Epi::PERM ? ((R & ~31) + perm32(R & 31)) : R;
        voffA[i] = (unsigned)(R * K + C) * 2u; voffB[i] = (unsigned)(Rb * K + C) * 2u; }
    const size_t kstep = (size_t)(BK * 2);
    const size_t hstep = (size_t)HALF * K * 2;
    const size_t tstep = 2 * hstep;
    const unsigned ldsw = (unsigned)wid * 1024u;
    const int aoff = lds_byte(wr * 64 + fr, fq * 8), boff = lds_byte(wc * 32 + fr, fq * 8);
#define PG8_SA(b, h) (((b) * 2 + (h)) * HTB)
#define PG8_SB(b, h) ((4 + (b) * 2 + (h)) * HTB)
#define PG8_STAGE(bufoff, gbase, voff) do { _Pragma("unroll") for (int _i = 0; _i < 2; ++_i) \
        __builtin_amdgcn_global_load_lds((const unsigned*)((const char*)(gbase) + (voff)[_i]), (PG8_LAS unsigned*)(lds + (bufoff) + ldsw + _i * 8192), 16, 0, 0); } while (0)
#define PG8_LDA(dst, b, h) do { _Pragma("unroll") for (int m = 0; m < 4; ++m) _Pragma("unroll") for (int k = 0; k < 2; ++k) dst[m][k] = *(const PG8_LAS bf16x8*)(lds + PG8_SA(b, h) + aoff + m * 2048 + k * 1024); } while (0)
#define PG8_LDB(dst, b, h) do { _Pragma("unroll") for (int n = 0; n < 2; ++n) _Pragma("unroll") for (int k = 0; k < 2; ++k) dst[n][k] = *(const PG8_LAS bf16x8*)(lds + PG8_SB(b, h) + boff + n * 2048 + k * 1024); } while (0)
#define PG8_MMA(ai, bj, At, Bt) do { __builtin_amdgcn_s_setprio(1); _Pragma("unroll") for (int m = 0; m < 4; ++m) _Pragma("unroll") for (int n = 0; n < 2; ++n) _Pragma("unroll") for (int k = 0; k < 2; ++k) \
        acc[ai][bj][m][n] = SWAPMMA ? __builtin_amdgcn_mfma_f32_16x16x32_bf16(At[m][k], Bt[n][k], acc[ai][bj][m][n], 0, 0, 0) : __builtin_amdgcn_mfma_f32_16x16x32_bf16(Bt[n][k], At[m][k], acc[ai][bj][m][n], 0, 0, 0); __builtin_amdgcn_s_setprio(0); } while (0)
#define PG8_WAIT_V(n) asm volatile("s_waitcnt vmcnt(" #n ")" ::: "memory")
#define PG8_WAIT_L(n) asm volatile("s_waitcnt lgkmcnt(" #n ")" ::: "memory")
#define PG8_BAR __builtin_amdgcn_s_barrier()
#define PG8_SCHED __builtin_amdgcn_sched_barrier(0)
    Unit cur, nxt; int ui = 0;
    if (!S.next(0, cur)) return;
    f32x4 acc[2][2][4][2];
#pragma unroll
    for (int a = 0; a < 2; ++a)
#pragma unroll
        for (int b = 0; b < 2; ++b)
#pragma unroll
            for (int m = 0; m < 4; ++m)
#pragma unroll
                for (int n = 0; n < 2; ++n) acc[a][b][m][n] = (f32x4){0.f, 0.f, 0.f, 0.f};
    bf16x8 At[4][2], B0[2][2], B1[2][2];
    const char* cA = (const char*)g.A + (size_t)cur.pm * tstep; const char* cB = (const char*)g.Bt + (size_t)cur.pn * tstep;
    S.a_ready(cur);
    if constexpr (SP2) {
        PG8_STAGE(PG8_SB(0, 0), cB, voffB); PG8_STAGE(PG8_SB(0, 1), cB + hstep, voffB); PG8_STAGE(PG8_SA(0, 0), cA, voffA); PG8_STAGE(PG8_SA(0, 1), cA + hstep, voffA);
        if (wr == 1) PG8_BAR;
        PG8_WAIT_V(2); PG8_BAR;
        PG8_STAGE(PG8_SB(1, 0), cB + kstep, voffB); PG8_STAGE(PG8_SA(1, 0), cA + kstep, voffA); PG8_STAGE(PG8_SB(1, 1), cB + hstep + kstep, voffB);
        PG8_WAIT_V(6); PG8_BAR;
    } else {
        PG8_STAGE(PG8_SB(0, 0), cB, voffB); PG8_STAGE(PG8_SA(0, 0), cA, voffA); PG8_STAGE(PG8_SB(0, 1), cB + hstep, voffB); PG8_STAGE(PG8_SA(0, 1), cA + hstep, voffA);
        if (wr == 1) PG8_BAR;
        PG8_WAIT_V(4); PG8_BAR;
        PG8_STAGE(PG8_SB(1, 0), cB + kstep, voffB); PG8_STAGE(PG8_SA(1, 0), cA + kstep, voffA); PG8_STAGE(PG8_SB(1, 1), cB + hstep + kstep, voffB);
        PG8_WAIT_V(6); PG8_BAR;
    }
    for (;;) {
        const bool has_next = S.next(ui + 1, nxt);
        const char* nA = has_next ? (const char*)g.A + (size_t)nxt.pm * tstep : cA; const char* nB = has_next ? (const char*)g.Bt + (size_t)nxt.pn * tstep : cB;
        for (int t = 0; t < nt; t += 2) {
            if constexpr (Epi::HAS_MID) { if (t != 0 && (t & 7) == 0) { E.mid(acc, cur, t >> 3, wid, lane); asm volatile("s_waitcnt vmcnt(0)" ::: "memory"); } }
            const bool last = (t == nt - 2);
            const char* a1 = cA + (size_t)(t + 1) * kstep;
            const char* a2 = last ? nA : cA + (size_t)(t + 2) * kstep; const char* b2 = last ? nB : cB + (size_t)(t + 2) * kstep;
            const char* a3 = a2 + kstep; const char* b3 = b2 + kstep;
            if (last && has_next) S.a_ready(nxt);
            if constexpr (SP2) {
            PG8_LDB(B0, 0, 0); PG8_LDB(B1, 0, 1); PG8_SCHED; PG8_LDA(At, 0, 0); PG8_STAGE(PG8_SA(1, 1), a1 + hstep, voffA);
            PG8_WAIT_V(8); PG8_WAIT_L(0); PG8_BAR; PG8_MMA(0, 0, At, B0); PG8_MMA(0, 1, At, B1); PG8_BAR; PG8_SCHED;
            PG8_LDA(At, 0, 1); PG8_STAGE(PG8_SB(0, 0), b2, voffB); PG8_STAGE(PG8_SB(0, 1), b2 + hstep, voffB); PG8_STAGE(PG8_SA(0, 0), a2, voffA);
            PG8_WAIT_V(8); PG8_WAIT_L(0); PG8_BAR; PG8_MMA(1, 0, At, B0); PG8_MMA(1, 1, At, B1); PG8_BAR; PG8_SCHED;
            PG8_LDB(B0, 1, 0); PG8_LDB(B1, 1, 1); PG8_SCHED; PG8_LDA(At, 1, 0); PG8_STAGE(PG8_SA(0, 1), a2 + hstep, voffA);
            PG8_WAIT_V(8); PG8_WAIT_L(0); PG8_BAR; PG8_MMA(0, 0, At, B0); PG8_MMA(0, 1, At, B1); PG8_BAR; PG8_SCHED;
            PG8_LDA(At, 1, 1); PG8_STAGE(PG8_SB(1, 0), b3, voffB); PG8_STAGE(PG8_SB(1, 1), b3 + hstep, voffB); PG8_STAGE(PG8_SA(1, 0), a3, voffA);
            PG8_WAIT_V(8); PG8_WAIT_L(0); PG8_BAR; PG8_MMA(1, 0, At, B0); PG8_MMA(1, 1, At, B1); PG8_BAR; PG8_SCHED;
            } else {
            PG8_LDB(B0, 0, 0); PG8_SCHED; PG8_LDA(At, 0, 0); PG8_STAGE(PG8_SA(1, 1), a1 + hstep, voffA);
            PG8_WAIT_L(8); PG8_BAR; PG8_WAIT_L(0); PG8_MMA(0, 0, At, B0); PG8_BAR; PG8_SCHED;
            PG8_LDB(B1, 0, 1); PG8_STAGE(PG8_SB(0, 0), b2, voffB);
            PG8_BAR; PG8_WAIT_L(0); PG8_MMA(0, 1, At, B1); PG8_BAR;
            PG8_LDA(At, 0, 1); PG8_STAGE(PG8_SA(0, 0), a2, voffA);
            PG8_BAR; PG8_WAIT_L(0); PG8_MMA(1, 0, At, B0); PG8_BAR; PG8_SCHED;
            PG8_STAGE(PG8_SB(0, 1), b2 + hstep, voffB);
            PG8_WAIT_V(6); PG8_BAR; PG8_MMA(1, 1, At, B1); PG8_BAR;
            PG8_LDB(B0, 1, 0); PG8_SCHED; PG8_LDA(At, 1, 0); PG8_STAGE(PG8_SA(0, 1), a2 + hstep, voffA);
            PG8_WAIT_L(8); PG8_BAR; PG8_WAIT_L(0); PG8_MMA(0, 0, At, B0); PG8_BAR; PG8_SCHED;
            PG8_LDB(B1, 1, 1); PG8_STAGE(PG8_SB(1, 0), b3, voffB);
            PG8_BAR; PG8_WAIT_L(0); PG8_MMA(0, 1, At, B1); PG8_BAR;
            PG8_LDA(At, 1, 1); PG8_STAGE(PG8_SA(1, 0), a3, voffA);
            PG8_BAR; PG8_WAIT_L(0); PG8_MMA(1, 0, At, B0); PG8_BAR; PG8_SCHED;
            PG8_STAGE(PG8_SB(1, 1), b3 + hstep, voffB);
            PG8_WAIT_V(6); PG8_BAR; PG8_MMA(1, 1, At, B1); PG8_BAR;
            }
        }
        if constexpr (ALIGN_EPI) { if (wr == 0) PG8_BAR; }
        if constexpr (!Epi::AFTER_DRAIN) { E(acc, cur, wr, wc, fr, fq); S.done(cur); }
        if (!has_next) break;
#pragma unroll
        for (int a = 0; a < 2; ++a)
#pragma unroll
            for (int b = 0; b < 2; ++b)
#pragma unroll
                for (int m = 0; m < 4; ++m)
#pragma unroll
                    for (int n = 0; n < 2; ++n) acc[a][b][m][n] = (f32x4){0.f, 0.f, 0.f, 0.f};
        cur = nxt; cA = nA; cB = nB; ++ui;
        if constexpr (ALIGN_EPI) { if (wr == 1) PG8_BAR; }
    }
    PG8_WAIT_V(0);
    if constexpr (!ALIGN_EPI) { if (wr == 0) PG8_BAR; }
    PG8_BAR;
    if constexpr (Epi::AFTER_DRAIN) { E.fused(acc, cur, wr, wc, fr, fq, lds, wid, lane); S.done(cur); }
#undef PG8_SA
#undef PG8_SB
#undef PG8_STAGE
#undef PG8_LDA
#undef PG8_LDB
#undef PG8_MMA
#undef PG8_WAIT_V
#undef PG8_WAIT_L
#undef PG8_BAR
#undef PG8_SCHED
}
}

struct XSched {
    int nN, nunits, G, c, skipctx;
    DEV bool next(int i, pg8::Unit& u) const {
        const int L = i * G + c; if (L >= nunits) return false;
        const int U = ((nunits & 7) == 0 && (G & 7) == 0) ? (L & 7) * (nunits >> 3) + (L >> 3) : L;
        { const int nM = nunits / nN, nig = 4 * nN, gid = U / nig, fm = gid * 4, gsz = min(nM - fm, 4), r = U - gid * nig; u.pm = fm + r % gsz; u.pn = r / gsz; }
        if (skipctx) u.pm = (u.pm >> 6) * 72 + (u.pm & 63);
        return true;
    }
    DEV void a_ready(const pg8::Unit&) const {}
    DEV void done(const pg8::Unit&) const {}
};
struct EpiStoreT {
    static constexpr bool PERM = false, AFTER_DRAIN = false, HAS_MID = false;
    bf16_t* out; int ld; int row_off;
    DEV void operator()(const f32x4 (&acc)[2][2][4][2], const pg8::Unit& u, int wr, int wc, int fr, int fq) const {
#pragma unroll
        for (int ai = 0; ai < 2; ++ai)
#pragma unroll
            for (int m = 0; m < 4; ++m) {
                bf16_t* d = out + (size_t)(row_off + u.pm * 256 + ai * 128 + wr * 64 + m * 16 + fr) * ld + u.pn * 256 + wc * 64;
#pragma unroll
                for (int bj = 0; bj < 2; ++bj) store8x2(d + bj * 32, acc[ai][bj][m][0], acc[ai][bj][m][1], fq);
            }
    }
};
struct EpiSwiglu {
    static constexpr bool PERM = false, AFTER_DRAIN = false, HAS_MID = false;
    bf16_t* act;
    DEV void operator()(const f32x4 (&acc)[2][2][4][2], const pg8::Unit& u, int wr, int wc, int fr, int fq) const {
#pragma unroll
        for (int ai = 0; ai < 2; ++ai)
#pragma unroll
            for (int m = 0; m < 4; ++m) {
                bf16_t* d = act + (size_t)(u.pm * 256 + ai * 128 + wr * 64 + m * 16 + fr) * DFF + u.pn * 128 + wc * 32;
                f32x4 r[2];
#pragma unroll
                for (int n = 0; n < 2; ++n) {
                    const f32x4 a = acc[ai][0][m][n], b = acc[ai][1][m][n];
#pragma unroll
                    for (int j = 0; j < 4; ++j) r[n][j] = a[j] * frcp(1.f + fexp2(-a[j] * LOG2E)) * b[j];
                }
                store8x2(d, r[0], r[1], fq);
            }
    }
};
struct EpiVT {
    static constexpr bool PERM = false, AFTER_DRAIN = false, HAS_MID = false;
    bf16_t* vt;
    DEV void operator()(const f32x4 (&acc)[2][2][4][2], const pg8::Unit& u, int wr, int wc, int fr, int fq) const {
#pragma unroll
        for (int bj = 0; bj < 2; ++bj)
#pragma unroll
            for (int n = 0; n < 2; ++n) {
                bf16_t* d = vt + (size_t)(u.pn * 256 + bj * 128 + wc * 32 + n * 16 + fr) * MC + u.pm * 256 + wr * 64 + fq * 8;
#pragma unroll
                for (int ai = 0; ai < 2; ++ai)
#pragma unroll
                    for (int m2 = 0; m2 < 2; ++m2) {
                        const f32x4 a = acc[ai][bj][2 * m2][n], b = acc[ai][bj][2 * m2 + 1][n];
                        u32x4 w; w.x = pk_bf16(a[0], a[1]); w.y = pk_bf16(a[2], a[3]); w.z = pk_bf16(b[0], b[1]); w.w = pk_bf16(b[2], b[3]);
                        *(u32x4*)(d + ai * 128 + m2 * 32) = w;
                    }
            }
    }
};
DEV size_t gate_index(int pm, int pn4, int wave, int r8, int lane) { return ((((size_t)pm * 16 + pn4) * 8 + wave) * 8 + r8) * 64 + lane; }
struct EpiGate {
    static constexpr bool PERM = false, AFTER_DRAIN = false, HAS_MID = false;
    u32x4* g8;
    DEV void operator()(const f32x4 (&acc)[2][2][4][2], const pg8::Unit& u, int wr, int wc, int fr, int fq) const {
        const int lane = fq * 16 + fr, wave = wr * 4 + wc;
#pragma unroll
        for (int ai = 0; ai < 2; ++ai)
#pragma unroll
            for (int m = 0; m < 4; ++m) {
                u32x4 w;
#pragma unroll
                for (int bj = 0; bj < 2; ++bj)
#pragma unroll
                    for (int n = 0; n < 2; ++n) {
                        const f32x4 a = acc[ai][bj][m][n]; unsigned x = 0;
#pragma unroll
                        for (int j = 0; j < 4; ++j) { const float s = frcp(1.f + fexp2(-a[j] * LOG2E)); x |= max(1u, (unsigned)(s * 255.f + 0.5f)) << (8 * j); }
                        w[bj * 2 + n] = x;
                    }
                g8[gate_index(u.pm, u.pn, wave, ai * 4 + m, lane)] = w;
            }
    }
};
struct EpiMerge {
    static constexpr bool PERM = false, AFTER_DRAIN = false, HAS_MID = true;
    bf16_t* out; const u32x4* g8;
    DEV void mid(f32x4 (&acc)[2][2][4][2], const pg8::Unit& u, int n, int wave, int lane) const {
#pragma unroll
        for (int ai = 0; ai < 2; ++ai)
#pragma unroll
            for (int m = 0; m < 4; ++m) {
                const u32x4 a = g8[gate_index(u.pm, (n - 1) * 4 + u.pn, wave, ai * 4 + m, lane)], b = g8[gate_index(u.pm, n * 4 + u.pn, wave, ai * 4 + m, lane)];
#pragma unroll
                for (int bj = 0; bj < 2; ++bj)
#pragma unroll
                    for (int nn = 0; nn < 2; ++nn) {
                        const unsigned x = a[bj * 2 + nn], y = b[bj * 2 + nn]; f32x4 r;
#pragma unroll
                        for (int j = 0; j < 4; ++j) r[j] = (float)((x >> (8 * j)) & 255u) * frcp((float)((y >> (8 * j)) & 255u));
                        acc[ai][bj][m][nn] = acc[ai][bj][m][nn] * r;
                    }
            }
    }
    DEV void operator()(const f32x4 (&acc)[2][2][4][2], const pg8::Unit& u, int wr, int wc, int fr, int fq) const {
        const int lane = fq * 16 + fr, wave = wr * 4 + wc;
#pragma unroll
        for (int ai = 0; ai < 2; ++ai)
#pragma unroll
            for (int m = 0; m < 4; ++m) {
                const u32x4 a = g8[gate_index(u.pm, 12 + u.pn, wave, ai * 4 + m, lane)];
                bf16_t* d = out + (size_t)(u.pm * 256 + ai * 128 + wr * 64 + m * 16 + fr) * 1024 + u.pn * 256 + wc * 64;
#pragma unroll
                for (int bj = 0; bj < 2; ++bj) {
                    f32x4 r[2];
#pragma unroll
                    for (int nn = 0; nn < 2; ++nn) {
                        const unsigned x = a[bj * 2 + nn];
#pragma unroll
                        for (int j = 0; j < 4; ++j) r[nn][j] = (float)((x >> (8 * j)) & 255u) * (1.f / 255.f);
                    }
                    store8x2(d + bj * 32, acc[ai][bj][m][0] * r[0], acc[ai][bj][m][1] * r[1], fq);
                }
            }
    }
};
struct EpiGemm1 {
    static constexpr bool PERM = false, AFTER_DRAIN = false, HAS_MID = false;
    const P* pp; int layer;
    DEV void operator()(const f32x4 (&acc)[2][2][4][2], const pg8::Unit& u, int wr, int wc, int fr, int fq) const {
        const int slab = u.pn * 256 + wc * 64; const bool lat = u.pm * 256 < LAT_C;
        if (slab >= 2752) return;
#pragma unroll
        for (int ai = 0; ai < 2; ++ai)
#pragma unroll
            for (int m = 0; m < 4; ++m) {
                f32x4 v[4] = {acc[ai][0][m][0], acc[ai][0][m][1], acc[ai][1][m][0], acc[ai][1][m][1]};
                gemm1_row(v, u.pm * 256 + ai * 128 + wr * 64 + m * 16 + fr, slab, lat, *pp, layer, fq);
            }
    }
};

#define LAS __attribute__((address_space(3)))
#define XB_TMO      128
#define XB_XCNT(j)  (256  + 64 * (j))
#define XB_XSUB(j)  (1280 + 64 * (j))
#define XB_XGEN(j)  (2304 + 64 * (j))
#define XB_TOP      3328
#define XB_TOPGEN   3392
#define XCD_BAR_WORDS 3456
#define XB_SPIN_CAP (1u << 18)

__device__ __forceinline__ unsigned xb_ld(unsigned* p)              { return __hip_atomic_load(p, __ATOMIC_RELAXED, __HIP_MEMORY_SCOPE_AGENT); }
__device__ __forceinline__ unsigned xb_add(unsigned* p, unsigned v) { return __hip_atomic_fetch_add(p, v, __ATOMIC_RELAXED, __HIP_MEMORY_SCOPE_AGENT); }
__device__ __forceinline__ unsigned xb_xcc_id() { return (unsigned)__builtin_amdgcn_s_getreg((3 << 11) | 20) & 0xFu; }
#define XB_SPIN(cond, bar) do { unsigned _sp = 0; while (cond) { __builtin_amdgcn_s_sleep(1); \
    if ((++_sp & 255u) == 0u) { if (xb_ld(&(bar)[XB_TMO])) break; if (_sp > XB_SPIN_CAP) { atomicAdd(&(bar)[XB_TMO], 1u); break; } } } } while (0)

struct XcdBarrier {
    unsigned* bar; unsigned x;
    volatile LAS unsigned* st;
};

__device__ __forceinline__ XcdBarrier xcd_barrier_post(unsigned* bar, volatile LAS unsigned* st) {
    XcdBarrier b; b.bar = bar; b.x = xb_xcc_id(); b.st = st;
    if (threadIdx.x == 0) (void)xb_add(&bar[XB_XCNT(b.x)], 1u);
    return b;
}
__device__ __forceinline__ void xcd_barrier_complete(unsigned* bar, unsigned x, unsigned& nloc, unsigned& nx) {
    const unsigned G = gridDim.x * gridDim.y * gridDim.z;
    unsigned sum, cnt, mine, sp = 0u;
    for (;;) {
        sum = 0u; cnt = 0u; mine = 0u;
#pragma unroll
        for (unsigned j = 0; j < 16; ++j) { const unsigned c = xb_ld(&bar[XB_XCNT(j)]); sum += c; cnt += (c > 0u) ? 1u : 0u; mine = (j == x) ? c : mine; }
        if (sum == G) break;
        __builtin_amdgcn_s_sleep(1);
        if ((++sp & 255u) == 0u) { if (xb_ld(&bar[XB_TMO])) break; if (sp > XB_SPIN_CAP) { atomicAdd(&bar[XB_TMO], 1u); break; } }
    }
    nloc = mine > 0u ? mine : 1u; nx = cnt > 0u ? cnt : 1u;
}

__device__ __forceinline__ void xcd_barrier(const XcdBarrier& b) {
    asm volatile("s_waitcnt vmcnt(0)" ::: "memory");
    __syncthreads();
    if (threadIdx.x == 0) {
        unsigned* bar = b.bar;
        __builtin_amdgcn_s_waitcnt(0);
        unsigned nloc = b.st[0], nx = b.st[1];
        if (nloc == 0u) { xcd_barrier_complete(bar, b.x, nloc, nx); b.st[0] = nloc; b.st[1] = nx; }
        const unsigned old = xb_add(&bar[XB_XSUB(b.x)], 1u);
        const unsigned gen = old / nloc;
        if (old + 1u == (gen + 1u) * nloc) {
            __builtin_amdgcn_fence(__ATOMIC_RELEASE, "agent");
            asm volatile("s_waitcnt vmcnt(0)" ::: "memory");
            const unsigned og = xb_add(&bar[XB_TOP], 1u);
            const unsigned tg = og / nx;
            if (og + 1u == (tg + 1u) * nx) xb_add(&bar[XB_TOPGEN], 1u);
            else XB_SPIN(xb_ld(&bar[XB_TOPGEN]) == tg, bar);
            __builtin_amdgcn_fence(__ATOMIC_ACQUIRE, "agent");
            xb_add(&bar[XB_XGEN(b.x)], 1u);
            asm volatile("s_waitcnt vmcnt(0)" ::: "memory");
        } else {
            XB_SPIN(xb_ld(&bar[XB_XGEN(b.x)]) == gen, bar);
            __builtin_amdgcn_fence(__ATOMIC_ACQUIRE, "agent");
            asm volatile("s_waitcnt vmcnt(0)" ::: "memory");
        }
    }
    __syncthreads();
}

typedef const __attribute__((address_space(4))) P* PP;
#define FRESH_P PP q_ = pp0; asm volatile("" : "+s"(q_)); const P& p = *(const P*)q_;
#define FRESH_BG int bidL = bid, GL = G; asm volatile("" : "+s"(bidL), "+s"(GL));
constexpr int DYN_LDS = 2 * SMEM_BYTES + 64;
__global__ void __launch_bounds__(512, 2) mega(P pv_) {
    cg::grid_group grid = cg::this_grid();
    PP pp0 = (PP)__builtin_amdgcn_kernarg_segment_ptr();
    extern __shared__ __attribute__((aligned(16))) unsigned char lds_dyn[];
    const int half = __builtin_amdgcn_readfirstlane((int)threadIdx.x >> 8);
    unsigned char* smraw = lds_dyn + half * SMEM_BYTES;
    bf16_t* sm = (bf16_t*)smraw;
    PG8_LAS unsigned char* ldsL = (PG8_LAS unsigned char*)lds_dyn;
    const int bid = blockIdx.x, G = gridDim.x, vb = bid * 2 + half, VG = G * 2, tid = threadIdx.x & 255;
    {
        FRESH_P
        volatile LAS unsigned* xst = (volatile LAS unsigned*)(ldsL + 2 * SMEM_BYTES);
        if (threadIdx.x == 0) { xst[0] = 0u; xst[1] = 0u; }
        __syncthreads();
        const XcdBarrier xb0 = xcd_barrier_post(p.barw, xst);
        if (threadIdx.x == 0) xst[2] = xb0.x;
        __syncthreads();
    }
#define GBAR() do { FRESH_P XcdBarrier b_; b_.bar = p.barw; b_.st = (volatile LAS unsigned*)(ldsL + 2 * SMEM_BYTES); b_.x = b_.st[2]; xcd_barrier(b_); } while (0)

    { FRESH_P
    for (int i = vb * 256 + tid; i < 64 * 16 + 64 * 8; i += VG * 256) {
        if (i < 1024) { const int pos = i >> 4, k = i & 15; const float inv = fexp2(-(float)k * (13.287712379549449f / 16.f)); const float a = (float)pos * inv; p.rt16[i] = (f32x2){__cosf(a), __sinf(a)}; }
        else { const int q = i - 1024; const int pos = q >> 3, k = q & 7; const float inv = fexp2(-(float)k * (13.287712379549449f / 8.f)); const float a = (float)pos * inv; p.rt8[q] = (f32x2){__cosf(a), __sinf(a)}; }
    }
    for (int t = vb; t < 384 + CONV_TILES; t += VG) { if (t < 384) mod_item(p, t, smraw); else conv_job(p, 0, t - 384, (float*)smraw); }
    }
    GBAR();
    { FRESH_P r_phase(p, 0, 0, vb, VG, 0, MTOT); }
    GBAR();

    for (int layer = 0; layer < DEPTH; ++layer) {
        const bool lastL = (layer == DEPTH - 1);
        for (int ch = 0; ch < NCH; ++ch) {
            { FRESH_P FRESH_BG
              const bf16_t* A = p.U + (size_t)ch * MC * 1024;
              { pg8::Gemm g{A, WL(p.WinT, layer), MC, 2816, 1024}; XSched S{11, 792, GL, bidL}; EpiGemm1 E{&p, layer};
                pg8::gemm_phase<EpiGemm1, XSched, true, true, false>(ldsL, g, S, E); }
              { pg8::Gemm g{A, WL(p.WinT, layer) + (size_t)2816 * 1024, MC, 768, 1024}; XSched S{3, 216, GL, (bidL + GL - (792 % GL)) % GL}; EpiVT E{p.VT};
                pg8::gemm_phase<EpiVT, XSched, true, true, true>(ldsL, g, S, E); }
              { pg8::Gemm g{A, WL(p.WinT, layer) + (size_t)NPROJ * 1024, MC, 4096, 1024}; XSched S{16, lastL ? 1024 : 1152, GL, (bidL + GL - (1008 % GL)) % GL}; EpiGate E{(u32x4*)p.G};
                pg8::gemm_phase<EpiGate, XSched, true, true, false>(ldsL, g, S, E); }
            }
            GBAR();
            { FRESH_P for (int t = vb; t < (lastL ? 4064 : 4448); t += VG) {
                if (t < 1024) attn_item<2>(p, layer, t, false, smraw);
                else if (t < 2048) attn_item<1>(p, layer, t - 1024, false, smraw);
                else if (t < 4064) { const int q = t - 2048; stage2_tile(p, layer, q / 14, q % 14, smraw); }
                else if (t < 4192) attn_item<1>(p, layer, t - 4064, true, smraw);
                else if (t < 4320) attn_item<2>(p, layer, t - 4192, true, smraw);
                else attn_item<3>(p, layer, t - 4320, true, smraw);
            } }
            GBAR();
            { FRESH_P for (int t = vb; t < (lastL ? 2048 : 2176); t += VG) {
                if (t < 1024) attn_item<0>(p, layer, t, false, smraw);
                else if (t < 2048) attn_item<3>(p, layer, t - 1024, false, smraw);
                else attn_item<0>(p, layer, t - 2048, true, smraw);
            } }
            GBAR();
            { FRESH_P FRESH_BG pg8::Gemm g{p.O, WL(p.WbrT, layer), MC, 1024, 2048}; XSched S{4, lastL ? 256 : 288, GL, bidL}; EpiMerge E{p.MB, (const u32x4*)p.G};
              pg8::gemm_phase<EpiMerge, XSched, true, true, false>(ldsL, g, S, E);
              if (!lastL && ch + 1 == NCH) { const int cb = G > 64 ? 32 : 0; if (bid >= cb) for (int q = bid - cb; 2 * q + 1 < CONV_TILES; q += G - cb) conv_job(p, layer + 1, 2 * q + half, (float*)smraw); } }
            GBAR();
            { FRESH_P FRESH_BG pg8::Gemm g{p.MB, WL(p.WoutT, layer), MC, 1024, 1024}; XSched S{4, lastL ? 256 : 288, GL, bidL}; EpiStoreT E{p.YC, 1024, 0};
              pg8::gemm_phase<EpiStoreT, XSched, true, true, false>(ldsL, g, S, E); }
            GBAR();
            { FRESH_P r_phase(p, 1, layer, vb, VG, ch * MC, ch * MC + (lastL ? LAT_C : MC)); }
            if (ch + 1 == NCH) GBAR();
        }
        { FRESH_P FRESH_BG pg8::Gemm g{p.U, WL(p.Wf1T, layer), MTOT, 2 * DFF, 1024}; XSched S{22, lastL ? 2816 : 3168, GL, bidL, lastL ? 1 : 0}; EpiSwiglu E{p.ACT};
          pg8::gemm_phase<EpiSwiglu, XSched, true, true, false>(ldsL, g, S, E); }
        GBAR();
        { FRESH_P FRESH_BG pg8::Gemm g{p.ACT, WL(p.Wf2T, layer), MTOT, 1024, DFF}; XSched S{4, lastL ? 512 : 576, GL, bidL, lastL ? 1 : 0}; EpiStoreT E{p.U, 1024, 0};
          pg8::gemm_phase<EpiStoreT, XSched, true, true, false>(ldsL, g, S, E); }
        GBAR();
        { FRESH_P r_phase(p, 2, layer, vb, VG, 0, MTOT, lastL); }
        GBAR();
    }
}

extern "C" void kernel_launch(void* const* d_in, const int* in_sizes, int n_in, void* d_out, int out_size, void* d_ws, size_t ws_size, hipStream_t stream) {
    static int grid_blocks = 0;
    if (!grid_blocks) {
        int dev = 0, cus = 0, per_cu = 0;
        (void)hipGetDevice(&dev);
        (void)hipDeviceGetAttribute(&cus, hipDeviceAttributeMultiprocessorCount, dev);
        if (hipFuncSetAttribute((const void*)mega, hipFuncAttributeMaxDynamicSharedMemorySize, DYN_LDS) != hipSuccess) fprintf(stderr, "hipFuncSetAttribute failed\n");
        (void)hipOccupancyMaxActiveBlocksPerMultiprocessor(&per_cu, mega, 512, DYN_LDS);
        grid_blocks = cus;
    }
    P p{};
    const float** f = (const float**)&p;
    for (int i = 0; i < 23; ++i) f[i] = (const float*)d_in[i];
    p.out = (float*)d_out;
    unsigned char* w = (unsigned char*)d_ws; size_t off = 0;
    auto take = [&](size_t bytes) { void* r = w + off; off += (bytes + 255) & ~(size_t)255; return r; };
    p.WinT = (bf16_t*)take((size_t)NWIN * 1024 * 2);
    p.WuqT = (bf16_t*)take((size_t)768 * 256 * 2);
    p.WukvT = (bf16_t*)take((size_t)1024 * 128 * 2);
    p.WbrT = (bf16_t*)take((size_t)4 * 1024 * 512 * 2);
    p.WoutT = (bf16_t*)take((size_t)1024 * 1024 * 2);
    p.Wf1T = (bf16_t*)take((size_t)2 * DFF * 1024 * 2);
    p.Wf2T = (bf16_t*)take((size_t)1024 * DFF * 2);
    p.wset = (size_t)((unsigned char*)take(0) - (unsigned char*)p.WinT) / 2;
    (void)take((size_t)p.wset * 2);
    p.mod = (float*)take((size_t)DEPTH * 17 * 6144 * 4);
    p.rt16 = (f32x2*)take(64 * 16 * 8);
    p.rt8 = (f32x2*)take(64 * 8 * 8);
    p.hc = (float*)take((size_t)NBATCH * CTX * 1024 * 4);
    p.U = (bf16_t*)take((size_t)MTOT * 1024 * 2);
    p.G = (unsigned char*)take((size_t)MC * 4096);
    p.barw = (unsigned*)take((size_t)XCD_BAR_WORDS * 4);
    unsigned char* R = (unsigned char*)take(0);
    p.PJ = (bf16_t*)take((size_t)MC * PJLD * 2);
    p.QA = (bf16_t*)take((size_t)MC * 768 * 2);
    p.KN = (bf16_t*)take((size_t)MC * 512 * 2);
    p.VT = (bf16_t*)take((size_t)VTROWS * MC * 2);
    p.O = (bf16_t*)take((size_t)MC * 2048 * 2);
    p.YC = p.O;
    p.MB = p.PJ;
    p.ACT = (bf16_t*)R;
    if (off > ws_size) { fprintf(stderr, "workspace too small: need %zu have %zu\n", off, ws_size); return; }
    (void)hipMemsetAsync(p.barw, 0, (size_t)XCD_BAR_WORDS * 4, stream);
    void* args[] = {&p};
    hipError_t e = hipLaunchCooperativeKernel((void*)mega, dim3(grid_blocks), dim3(512), args, DYN_LDS, stream);
    if (e != hipSuccess) fprintf(stderr, "cooperative launch failed: %s (grid %d)\n", hipGetErrorString(e), grid_blocks);
}
```
